# Optimizing an MI355X kernel written in HIP

```python
import jax, jax.numpy as jnp
from jax import lax
import numpy as np

D_MODEL = 1024
BATCH = 8
SEQ = 4096
DEPTH = 1

GRID_W = 64
CTX_LEN = 256
MIX_W = D_MODEL
F_W = MIX_W // 2
F_GROUPS = 4
F_GROUP_W = F_W // F_GROUPS
M_W = MIX_W - F_W
M_HEADS = 4
M_HEAD_DIM = M_W // M_HEADS
N_DIRS = 2
N_GATES = N_DIRS * 2 * M_HEADS
MLSTM_END = F_W + 2 * M_W + N_GATES
IN_W = MLSTM_END + M_W
CHUNK = 128
CONV_W = 3
D_FF = 5 * D_MODEL // 2
NORM_EPS = 1e-6

kernel_name = 'hybrid_fourier_mlstm_convffn_dit'


def _rmsnorm(x, w):
    xf = x.astype(jnp.float32)
    y = xf * lax.rsqrt(jnp.mean(xf * xf, axis=-1, keepdims=True) + NORM_EPS)
    return (y * w.astype(jnp.float32)).astype(x.dtype)


def _adaln(cond, w_ada, b_ada):
    mod = jax.nn.silu(cond) @ w_ada + b_ada
    return [m[..., None, :] for m in jnp.split(mod, 6, axis=-1)]


def _modnorm(x, w, shift, scale):
    return _rmsnorm(x, w) * (1 + scale) + shift


def _dwconv1d(x, w, b):
    y = lax.conv_general_dilated(x, w.astype(x.dtype)[:, None, :], (1,), 'SAME',
                                 dimension_numbers=('NWC', 'WIO', 'NWC'),
                                 feature_group_count=x.shape[-1])
    return y + b


def _dwconv_grid(x, w, b):
    bsz, length, ch = x.shape
    rows = length // GRID_W
    xg = x.reshape(bsz, rows, GRID_W, ch)
    y = lax.conv_general_dilated(xg, w.astype(x.dtype)[:, :, None, :], (1, 1), 'SAME',
                                 dimension_numbers=('NHWC', 'HWIO', 'NHWC'),
                                 feature_group_count=ch)
    return y.reshape(bsz, length, ch) + b


def _fourier_mix(u):
    bsz, length, _ = u.shape
    ug = u.astype(jnp.float32).reshape(bsz, length, F_GROUPS, F_GROUP_W)
    y = jnp.fft.fftn(ug, axes=(1, 3), norm='ortho').real
    return y.reshape(bsz, length, F_W).astype(u.dtype)


def _zero_state(bsz):
    return (jnp.zeros((bsz, M_HEADS, M_HEAD_DIM, M_HEAD_DIM), jnp.float32),
            jnp.zeros((bsz, M_HEADS, M_HEAD_DIM), jnp.float32),
            jnp.zeros((bsz, M_HEADS), jnp.float32))


def _state_update(state, k, v, li, lf):
    c_mat, n_vec, m = state
    b = jnp.cumsum(lf, axis=-1)
    b_end = b[..., -1]
    g = b_end[..., None] - b + li
    m_new = jnp.maximum(b_end + m, jnp.max(g, axis=-1))
    w_old = jnp.exp(b_end + m - m_new)
    w_tok = jnp.exp(g - m_new[..., None])
    c_new = w_old[..., None, None] * c_mat + jnp.einsum('bhj,bhjd,bhje->bhde', w_tok, k, v)
    n_new = w_old[..., None] * n_vec + jnp.einsum('bhj,bhjd->bhd', w_tok, k)
    return (c_new, n_new, m_new)


def _mlstm_chunk(state, inp):
    c_mat, n_vec, m = state
    q, k, v, li, lf = inp
    length = q.shape[-2]
    b = jnp.cumsum(lf, axis=-1)
    lower = jnp.tril(jnp.ones((length, length), dtype=bool))
    dmat = jnp.where(lower, b[..., :, None] - b[..., None, :] + li[..., None, :], -jnp.inf)
    inter = b + m[..., None]
    m_t = jnp.maximum(inter, jnp.max(dmat, axis=-1))
    w_inter = jnp.exp(inter - m_t)
    s = jnp.einsum('bhld,bhjd->bhlj', q, k) * jnp.exp(dmat - m_t[..., None])
    num = w_inter[..., None] * jnp.einsum('bhld,bhde->bhle', q, c_mat) + jnp.einsum('bhlj,bhje->bhle', s, v)
    den = w_inter * jnp.einsum('bhld,bhd->bhl', q, n_vec) + jnp.sum(s, axis=-1)
    h = num / jnp.maximum(jnp.abs(den), jnp.exp(-m_t))[..., None]
    return _state_update(state, k, v, li, lf), h


def _mlstm_scan(q, k, v, li, lf, state0):
    bsz, heads, length, dh = q.shape
    nc = length // CHUNK

    def chunks(t):
        return jnp.moveaxis(t.reshape(bsz, heads, nc, CHUNK, *t.shape[3:]), 2, 0)

    state, h = lax.scan(_mlstm_chunk, state0, (chunks(q), chunks(k), chunks(v), chunks(li), chunks(lf)))
    return jnp.moveaxis(h, 0, 2).reshape(bsz, heads, length, dh), state


def _mlstm_inputs(p, mconv_w, mconv_b, w_k, b_gate):
    bsz, length, _ = p.shape
    xm, v, g = jnp.split(p, [M_W, 2 * M_W], axis=-1)
    a = jax.nn.silu(_dwconv1d(xm, mconv_w, mconv_b))
    ah = a.reshape(bsz, length, M_HEADS, M_HEAD_DIM)
    k = (jnp.einsum('blhd,hde->bhle', ah, w_k) * M_HEAD_DIM ** -0.5).astype(jnp.float32)
    vh = v.reshape(bsz, length, M_HEADS, M_HEAD_DIM).transpose(0, 2, 1, 3).astype(jnp.float32)
    g = (g + b_gate).astype(jnp.float32).reshape(bsz, length, N_DIRS, 2, M_HEADS)
    g = jnp.transpose(g, (2, 3, 0, 4, 1))
    li = g[:, 0]
    lf = jax.nn.log_sigmoid(g[:, 1])
    return a, k, vh, li, lf


def _mlstm_head_out(h, a, z, mnorm_w, m_skip):
    bsz, heads, length, dh = h.shape
    mu = jnp.mean(h, axis=-1, keepdims=True)
    var = jnp.mean(jnp.square(h - mu), axis=-1, keepdims=True)
    hn = ((h - mu) * lax.rsqrt(var + NORM_EPS)).transpose(0, 2, 1, 3).reshape(bsz, length, M_W)
    hn = (hn * mnorm_w.astype(jnp.float32)).astype(a.dtype)
    return (hn + m_skip * a) * jax.nn.silu(z)


def _token_mixer(h, w_in, w_out, mconv_w, mconv_b, w_q, w_k, b_gate, mnorm_w, m_skip, st_f, st_b):
    bsz, length, _ = h.shape
    proj = h @ w_in
    a, k, v, li, lf = _mlstm_inputs(proj[..., F_W:MLSTM_END], mconv_w, mconv_b, w_k, b_gate)
    q = jnp.einsum('blhd,hde->bhle', a.reshape(bsz, length, M_HEADS, M_HEAD_DIM), w_q).astype(jnp.float32)
    h_f, fin_f = _mlstm_scan(q, k, v, li[0], lf[0], st_f)
    h_b, fin_b = _mlstm_scan(jnp.flip(q, 2), jnp.flip(k, 2), jnp.flip(v, 2),
                             jnp.flip(li[1], -1), jnp.flip(lf[1], -1), st_b)
    y_m = _mlstm_head_out(h_f + jnp.flip(h_b, 2), a, proj[..., MLSTM_END:], mnorm_w, m_skip)
    y = jnp.concatenate([_fourier_mix(proj[..., :F_W]), y_m], axis=-1) @ w_out
    return y, fin_f, fin_b


def _context_states(p, mconv_w, mconv_b, w_k, b_gate):
    _, k, v, li, lf = _mlstm_inputs(p, mconv_w, mconv_b, w_k, b_gate)
    zero = _zero_state(p.shape[0])
    st_f = _state_update(zero, k, v, li[0], lf[0])
    st_b = _state_update(zero, jnp.flip(k, 2), jnp.flip(v, 2), jnp.flip(li[1], -1), jnp.flip(lf[1], -1))
    return st_f, st_b


def _conv_ffn(h, w_up, b_up, fconv_w, fconv_b, w_down, b_down, on_grid):
    u = h @ w_up + b_up
    u = _dwconv_grid(u, fconv_w, fconv_b) if on_grid else _dwconv1d(u, fconv_w[1], fconv_b)
    val, gate = jnp.split(u, 2, axis=-1)
    return (val * jax.nn.silu(gate)) @ w_down + b_down


def setup_inputs(seed: int = 0) -> dict:
    key = jax.random.key(seed)
    ks = jax.random.split(key, 28)
    f32 = jnp.float32

    def nrm(k, shape, scale):
        return jax.random.normal(k, shape, f32) * scale

    L = DEPTH
    ig = nrm(ks[12], (L, N_DIRS, 1, M_HEADS), 0.1)
    fg = jnp.linspace(3.0, 6.0, M_HEADS, dtype=f32) + nrm(ks[13], (L, N_DIRS, 1, M_HEADS), 0.1)
    return {
        'x': nrm(ks[0], (BATCH, SEQ, D_MODEL), 1.0),
        'c': nrm(ks[1], (BATCH, D_MODEL), 1.0),
        'ctx': nrm(ks[2], (BATCH, CTX_LEN, D_MODEL), 1.0),
        'c_ctx': nrm(ks[3], (D_MODEL,), 1.0),
        'w_ada': nrm(ks[4], (L, D_MODEL, 6 * D_MODEL), 0.5 * D_MODEL ** -0.5),
        'b_ada': nrm(ks[5], (L, 6 * D_MODEL), 0.02),
        'norm1_w': 1.0 + nrm(ks[6], (L, D_MODEL), 0.02),
        'w_in': nrm(ks[7], (L, D_MODEL, IN_W), D_MODEL ** -0.5),
        'mconv_w': nrm(ks[8], (L, CONV_W, M_W), CONV_W ** -0.5),
        'mconv_b': nrm(ks[9], (L, M_W), 0.02),
        'w_q': nrm(ks[10], (L, M_HEADS, M_HEAD_DIM, M_HEAD_DIM), M_HEAD_DIM ** -0.5),
        'w_k': nrm(ks[11], (L, M_HEADS, M_HEAD_DIM, M_HEAD_DIM), M_HEAD_DIM ** -0.5),
        'b_gate': jnp.concatenate([ig, fg], axis=2).reshape(L, N_GATES),
        'mnorm_w': 1.0 + nrm(ks[14], (L, M_W), 0.02),
        'm_skip': 1.0 + nrm(ks[15], (L, M_W), 0.02),
        'w_out': nrm(ks[16], (L, MIX_W, D_MODEL), MIX_W ** -0.5),
        'norm2_w': 1.0 + nrm(ks[17], (L, D_MODEL), 0.02),
        'w_up': nrm(ks[18], (L, D_MODEL, 2 * D_FF), D_MODEL ** -0.5),
        'b_up': nrm(ks[19], (L, 2 * D_FF), 0.02),
        'fconv_w': nrm(ks[20], (L, CONV_W, CONV_W, 2 * D_FF), 1.0 / CONV_W),
        'fconv_b': nrm(ks[21], (L, 2 * D_FF), 0.02),
        'w_down': nrm(ks[22], (L, D_FF, D_MODEL), D_FF ** -0.5),
        'b_down': nrm(ks[23], (L, D_MODEL), 0.02),
        'final_norm_w': 1.0 + nrm(ks[24], (D_MODEL,), 0.02),
    }


def reference(x, c, ctx, c_ctx, w_ada, b_ada, norm1_w, w_in, mconv_w, mconv_b, w_q, w_k, b_gate,
              mnorm_w, m_skip, w_out, norm2_w, w_up, b_up, fconv_w, fconv_b, w_down, b_down,
              final_norm_w):
    bsz = x.shape[0]
    for l in range(DEPTH):
        sh1, sc1, g1, sh2, sc2, g2 = _adaln(c, w_ada[l], b_ada[l])
        sh1c, sc1c, g1c, sh2c, sc2c, g2c = _adaln(c_ctx, w_ada[l], b_ada[l])
        mix_p = (w_in[l], w_out[l], mconv_w[l], mconv_b[l], w_q[l], w_k[l], b_gate[l], mnorm_w[l], m_skip[l])
        ffn_p = (w_up[l], b_up[l], fconv_w[l], fconv_b[l], w_down[l], b_down[l])

        hc = _modnorm(ctx, norm1_w[l], sh1c, sc1c)
        if l + 1 < DEPTH:
            zero = _zero_state(bsz)
            yc, st_f, st_b = _token_mixer(hc, *mix_p, zero, zero)
            ctx = ctx + g1c * yc
            ctx = ctx + g2c * _conv_ffn(_modnorm(ctx, norm2_w[l], sh2c, sc2c), *ffn_p, False)
        else:
            st_f, st_b = _context_states(hc @ w_in[l][:, F_W:MLSTM_END], mconv_w[l], mconv_b[l], w_k[l], b_gate[l])

        hx = _modnorm(x, norm1_w[l], sh1, sc1)
        y, _, _ = _token_mixer(hx, *mix_p, st_f, st_b)
        x = x + g1 * y
        x = x + g2 * _conv_ffn(_modnorm(x, norm2_w[l], sh2, sc2), *ffn_p, True)
    return _rmsnorm(x, final_norm_w)
```

```cpp
#include <hip/hip_runtime.h>
#include <cstdio>
#include <cstdint>
namespace pg8 {
#define PG8_LAS __attribute__((address_space(3)))
typedef unsigned short bf16_t;
typedef short bf16x8 __attribute__((ext_vector_type(8)));
typedef float f32x4 __attribute__((ext_vector_type(4)));
typedef unsigned u32x4 __attribute__((ext_vector_type(4)));
constexpr int BM = 256, BK = 64, HALF = 128, HTB = HALF * BK * 2  , STAGE_BYTES = 8 * HTB, NXCD = 8, WGM = 8;

__host__ __device__ __forceinline__ int lds_byte(int r, int c) { const int st = (r >> 4) * 2 + (c >> 5), rr = r & 15, cc = c & 31, ob = rr * 64 + cc * 2; return st * 1024 + (ob ^ (((ob >> 9) & 1) << 5)); }
__host__ __device__ __forceinline__ void stage_rc(int b, int& R, int& C) { const int st = b / 1024, sb = b % 1024, swz = sb ^ (((sb >> 9) & 1) << 5); R = (st >> 1) * 16 + swz / 64; C = (st & 1) * 32 + (swz % 64) / 2; }
__host__ __device__ __forceinline__ int perm32(int rho) { const int n = rho >> 4, i = rho & 15; return 8 * (i >> 2) + 4 * n + (i & 3); }

struct Unit { int pm, pn; };
struct Gemm { const bf16_t* A; const bf16_t* Bt; int M, N, K; };

struct StaticOrder {
    int nM, nN, nwg, G, c;
    __host__ __device__ void init(int M, int N, int G_, int c_) { nM = M / BM; nN = N / BM; nwg = nM * nN; G = G_; c = c_; }
    __host__ __device__ bool next(int i, Unit& u) const {
        const long L = (long)i * G + c; if (L >= nwg) return false;
        int wgid = (int)L; { const int q = nwg / NXCD, r = nwg % NXCD, xcd = wgid % NXCD, off = wgid / NXCD; wgid = (xcd < r ? xcd * (q + 1) : r * (q + 1) + (xcd - r) * q) + off; }
        const int nig = WGM * nN, gid = wgid / nig, fm = gid * WGM, gsz = (nM - fm) < WGM ? (nM - fm) : WGM;
        u.pm = fm + ((wgid % nig) % gsz); u.pn = (wgid % nig) / gsz; return true;
    }
    __device__ __forceinline__ void a_ready(const Unit&) const {}
    __device__ __forceinline__ void done(const Unit&) const {}
};
__device__ __forceinline__ unsigned cvt_pk_bf16(float lo, float hi) { unsigned r; asm volatile("v_cvt_pk_bf16_f32 %0, %1, %2" : "=v"(r) : "v"(lo), "v"(hi)); return r; }
template <class Epi, class Sched, bool ALIGN_EPI = false, bool SP2 = false>
__device__ __forceinline__ void gemm_phase(PG8_LAS unsigned char* lds, const Gemm g, const Sched& S, const Epi& E) {
    const int tid = threadIdx.x, wid = __builtin_amdgcn_readfirstlane(tid >> 6), lane = tid & 63, wr = wid >> 2, wc = wid & 3, fr = lane & 15, fq = lane >> 4;
    const int K = g.K, nt = K / BK;
    unsigned voffA[2], voffB[2];
#pragma unroll
    for (int i = 0; i < 2; ++i) { int R, C; stage_rc(tid * 16 + i * 8192, R, C); const int Rb = Epi::PERM ? ((R & ~31) + perm32(R & 31)) : R;
        voffA[i] = (unsigned)(R * K + C) * 2u; voffB[i] = (unsigned)(Rb * K + C) * 2u; }
    const size_t kstep = (size_t)(BK * 2);
    const size_t hstep = (size_t)HALF * K * 2;
    const size_t tstep = 2 * hstep;
    const unsigned ldsw = (unsigned)wid * 1024u;
    const int aoff = lds_byte(wr * 64 + fr, fq * 8), boff = lds_byte(wc * 32 + fr, fq * 8);
#define PG8_SA(b, h) (((b) * 2 + (h)) * HTB)
#define PG8_SB(b, h) ((4 + (b) * 2 + (h)) * HTB)
#define PG8_STAGE(bufoff, gbase, voff) do { _Pragma("unroll") for (int _i = 0; _i < 2; ++_i) \
        __builtin_amdgcn_global_load_lds((const unsigned*)((const char*)(gbase) + (voff)[_i]), (PG8_LAS unsigned*)(lds + (bufoff) + ldsw + _i * 8192), 16, 0, 0); } while (0)
#define PG8_LDA(dst, b, h) do { _Pragma("unroll") for (int m = 0; m < 4; ++m) _Pragma("unroll") for (int k = 0; k < 2; ++k) dst[m][k] = *(const PG8_LAS bf16x8*)(lds + PG8_SA(b, h) + aoff + m * 2048 + k * 1024); } while (0)
#define PG8_LDB(dst, b, h) do { _Pragma("unroll") for (int n = 0; n < 2; ++n) _Pragma("unroll") for (int k = 0; k < 2; ++k) dst[n][k] = *(const PG8_LAS bf16x8*)(lds + PG8_SB(b, h) + boff + n * 2048 + k * 1024); } while (0)
#define PG8_MMA(ai, bj, At, Bt) do { __builtin_amdgcn_s_setprio(1); _Pragma("unroll") for (int m = 0; m < 4; ++m) _Pragma("unroll") for (int n = 0; n < 2; ++n) _Pragma("unroll") for (int k = 0; k < 2; ++k) \
        acc[ai][bj][m][n] = __builtin_amdgcn_mfma_f32_16x16x32_bf16(Bt[n][k], At[m][k], acc[ai][bj][m][n], 0, 0, 0); __builtin_amdgcn_s_setprio(0); } while (0)
#define PG8_WAIT_V(n) asm volatile("s_waitcnt vmcnt(" #n ")" ::: "memory")
#define PG8_WAIT_L(n) asm volatile("s_waitcnt lgkmcnt(" #n ")" ::: "memory")
#define PG8_BAR __builtin_amdgcn_s_barrier()
#define PG8_SCHED __builtin_amdgcn_sched_barrier(0)
    Unit cur, nxt; int ui = 0;
    if (!S.next(0, cur)) return;
    f32x4 acc[2][2][4][2];
#pragma unroll
    for (int a = 0; a < 2; ++a)
#pragma unroll
        for (int b = 0; b < 2; ++b)
#pragma unroll
            for (int m = 0; m < 4; ++m)
#pragma unroll
                for (int n = 0; n < 2; ++n) acc[a][b][m][n] = (f32x4){0.f, 0.f, 0.f, 0.f};
    bf16x8 At[4][2], B0[2][2], B1[2][2];
    const char* cA = (const char*)g.A + (size_t)cur.pm * tstep; const char* cB = (const char*)g.Bt + (size_t)cur.pn * tstep;
    S.a_ready(cur);
    if constexpr (SP2) {
        PG8_STAGE(PG8_SB(0, 0), cB, voffB); PG8_STAGE(PG8_SB(0, 1), cB + hstep, voffB); PG8_STAGE(PG8_SA(0, 0), cA, voffA); PG8_STAGE(PG8_SA(0, 1), cA + hstep, voffA);
        if (wr == 1) PG8_BAR;
        PG8_WAIT_V(2); PG8_BAR;
        PG8_STAGE(PG8_SB(1, 0), cB + kstep, voffB); PG8_STAGE(PG8_SA(1, 0), cA + kstep, voffA); PG8_STAGE(PG8_SB(1, 1), cB + hstep + kstep, voffB);
        PG8_WAIT_V(6); PG8_BAR;
    } else {
        PG8_STAGE(PG8_SB(0, 0), cB, voffB); PG8_STAGE(PG8_SA(0, 0), cA, voffA); PG8_STAGE(PG8_SB(0, 1), cB + hstep, voffB); PG8_STAGE(PG8_SA(0, 1), cA + hstep, voffA);
        if (wr == 1) PG8_BAR;
        PG8_WAIT_V(4); PG8_BAR;
        PG8_STAGE(PG8_SB(1, 0), cB + kstep, voffB); PG8_STAGE(PG8_SA(1, 0), cA + kstep, voffA); PG8_STAGE(PG8_SB(1, 1), cB + hstep + kstep, voffB);
        PG8_WAIT_V(6); PG8_BAR;
    }
    for (;;) {
        const bool has_next = S.next(ui + 1, nxt);
        const char* nA = has_next ? (const char*)g.A + (size_t)nxt.pm * tstep : cA; const char* nB = has_next ? (const char*)g.Bt + (size_t)nxt.pn * tstep : cB;
        for (int t = 0; t < nt; t += 2) {
            const bool last = (t == nt - 2);
            const char* a1 = cA + (size_t)(t + 1) * kstep;
            const char* a2 = last ? nA : cA + (size_t)(t + 2) * kstep; const char* b2 = last ? nB : cB + (size_t)(t + 2) * kstep;
            const char* a3 = a2 + kstep; const char* b3 = b2 + kstep;
            if (last && has_next) S.a_ready(nxt);
            if constexpr (SP2) {
            PG8_LDB(B0, 0, 0); PG8_LDB(B1, 0, 1); PG8_SCHED; PG8_LDA(At, 0, 0); PG8_STAGE(PG8_SA(1, 1), a1 + hstep, voffA);
            PG8_WAIT_V(8); PG8_WAIT_L(0); PG8_BAR; PG8_MMA(0, 0, At, B0); PG8_MMA(0, 1, At, B1); PG8_BAR; PG8_SCHED;
            PG8_LDA(At, 0, 1); PG8_STAGE(PG8_SB(0, 0), b2, voffB); PG8_STAGE(PG8_SB(0, 1), b2 + hstep, voffB); PG8_STAGE(PG8_SA(0, 0), a2, voffA);
            PG8_WAIT_V(8); PG8_WAIT_L(0); PG8_BAR; PG8_MMA(1, 0, At, B0); PG8_MMA(1, 1, At, B1); PG8_BAR; PG8_SCHED;
            PG8_LDB(B0, 1, 0); PG8_LDB(B1, 1, 1); PG8_SCHED; PG8_LDA(At, 1, 0); PG8_STAGE(PG8_SA(0, 1), a2 + hstep, voffA);
            PG8_WAIT_V(8); PG8_WAIT_L(0); PG8_BAR; PG8_MMA(0, 0, At, B0); PG8_MMA(0, 1, At, B1); PG8_BAR; PG8_SCHED;
            PG8_LDA(At, 1, 1); PG8_STAGE(PG8_SB(1, 0), b3, voffB); PG8_STAGE(PG8_SB(1, 1), b3 + hstep, voffB); PG8_STAGE(PG8_SA(1, 0), a3, voffA);
            PG8_WAIT_V(8); PG8_WAIT_L(0); PG8_BAR; PG8_MMA(1, 0, At, B0); PG8_MMA(1, 1, At, B1); PG8_BAR; PG8_SCHED;
            } else {
            PG8_LDB(B0, 0, 0); PG8_SCHED; PG8_LDA(At, 0, 0); PG8_STAGE(PG8_SA(1, 1), a1 + hstep, voffA);
            PG8_WAIT_L(8); PG8_BAR; PG8_WAIT_L(0); PG8_MMA(0, 0, At, B0); PG8_BAR; PG8_SCHED;
            PG8_LDB(B1, 0, 1); PG8_STAGE(PG8_SB(0, 0), b2, voffB);
            PG8_BAR; PG8_WAIT_L(0); PG8_MMA(0, 1, At, B1); PG8_BAR;
            PG8_LDA(At, 0, 1); PG8_STAGE(PG8_SA(0, 0), a2, voffA);
            PG8_BAR; PG8_WAIT_L(0); PG8_MMA(1, 0, At, B0); PG8_BAR; PG8_SCHED;
            PG8_STAGE(PG8_SB(0, 1), b2 + hstep, voffB);
            PG8_WAIT_V(6); PG8_BAR; PG8_MMA(1, 1, At, B1); PG8_BAR;
            PG8_LDB(B0, 1, 0); PG8_SCHED; PG8_LDA(At, 1, 0); PG8_STAGE(PG8_SA(0, 1), a2 + hstep, voffA);
            PG8_WAIT_L(8); PG8_BAR; PG8_WAIT_L(0); PG8_MMA(0, 0, At, B0); PG8_BAR; PG8_SCHED;
            PG8_LDB(B1, 1, 1); PG8_STAGE(PG8_SB(1, 0), b3, voffB);
            PG8_BAR; PG8_WAIT_L(0); PG8_MMA(0, 1, At, B1); PG8_BAR;
            PG8_LDA(At, 1, 1); PG8_STAGE(PG8_SA(1, 0), a3, voffA);
            PG8_BAR; PG8_WAIT_L(0); PG8_MMA(1, 0, At, B0); PG8_BAR; PG8_SCHED;
            PG8_STAGE(PG8_SB(1, 1), b3 + hstep, voffB);
            PG8_WAIT_V(6); PG8_BAR; PG8_MMA(1, 1, At, B1); PG8_BAR;
            }
        }
        if constexpr (ALIGN_EPI) { if (wr == 0) PG8_BAR; }
        if constexpr (!Epi::AFTER_DRAIN) { E(acc, cur, wr, wc, fr, fq); S.done(cur); }
        if (!has_next) break;
#pragma unroll
        for (int a = 0; a < 2; ++a)
#pragma unroll
            for (int b = 0; b < 2; ++b)
#pragma unroll
                for (int m = 0; m < 4; ++m)
#pragma unroll
                    for (int n = 0; n < 2; ++n) acc[a][b][m][n] = (f32x4){0.f, 0.f, 0.f, 0.f};
        cur = nxt; cA = nA; cB = nB; ++ui;
        if constexpr (ALIGN_EPI) { if (wr == 1) PG8_BAR; }
    }
    PG8_WAIT_V(0);
    if constexpr (!ALIGN_EPI) { if (wr == 0) PG8_BAR; }
    PG8_BAR;
    if constexpr (Epi::AFTER_DRAIN) { E.fused(acc, cur, wr, wc, fr, fq, lds, wid, lane); S.done(cur); }
#undef PG8_SA
#undef PG8_SB
#undef PG8_STAGE
#undef PG8_LDA
#undef PG8_LDB
#undef PG8_MMA
#undef PG8_WAIT_V
#undef PG8_WAIT_L
#undef PG8_BAR
#undef PG8_SCHED
}
}

#define GAS __attribute__((address_space(1)))
#define LAS __attribute__((address_space(3)))
typedef unsigned short bf16;
typedef unsigned char uchar;
typedef unsigned v4u __attribute__((ext_vector_type(4)));
typedef unsigned v2u __attribute__((ext_vector_type(2)));
typedef float f32x4 __attribute__((ext_vector_type(4)));
typedef float f32x2 __attribute__((ext_vector_type(2)));
typedef short bf16x8 __attribute__((ext_vector_type(8)));
#define LDS_WAIT() asm volatile("s_waitcnt lgkmcnt(0)" ::: "memory")
#define VM_WAIT() asm volatile("s_waitcnt vmcnt(0)" ::: "memory")

constexpr int NWAVES = 8, NTHR = 512;
constexpr int NB = 8, SEQ = 4096, DM = 1024, CTXL = 256;
constexpr int MROWS = NB * SEQ;
constexpr int CROWS = NB * CTXL;
constexpr int TROWS = MROWS + CROWS;
constexpr int NHEAD = 4, HD = 128, INW = 2064, DFF = 2560, UPW = 5120;
constexpr float EPS = 1e-6f;
constexpr int NUNIT_L = NB * NHEAD * 32, NUNIT_C = NB * NHEAD * 2, NUNIT = NUNIT_L + NUNIT_C;
constexpr int CT_SLOT = 129 * 128;

constexpr size_t MiB = 1u << 20;
constexpr size_t WS_HX = 0, WS_TP = 0, WS_H2 = 0, WS_ACT = 0;
constexpr size_t WS_UF = 68 * MiB, WS_XM = 100 * MiB, WS_CT = 68 * MiB;
constexpr size_t WS_G = 134 * MiB, WS_SC = 137 * MiB, WS_MS = 138 * MiB;
constexpr size_t WS_V = 160 * MiB, WS_Z = 194 * MiB, WS_DC = 226 * MiB, WS_YM = 364 * MiB, WS_U = 160 * MiB;
constexpr size_t WS_WIN = 480 * MiB, WS_WOUT = 484 * MiB, WS_WUP = 486 * MiB, WS_WDN = 496 * MiB, WS_WQ = 501 * MiB, WS_WK = WS_WQ + 131072;
constexpr size_t WS_F1 = 502 * MiB, WS_G2 = WS_F1 + 16384, WS_TW = WS_G2 + 16384;
constexpr size_t WS_MOD = 503 * MiB, WS_CTL = 504 * MiB, WS_ZERO0 = WS_MOD, WS_ZERO_BYTES = 2 * MiB, WS_END = 512 * MiB;
static_assert(WS_DC + (size_t)NUNIT * 2 * CT_SLOT * 4 <= WS_YM && WS_YM + (size_t)MROWS * 1024 * 2 <= WS_U + (size_t)MROWS * UPW * 2 && WS_U + (size_t)MROWS * UPW * 2 <= WS_WIN, "ws map");
static_assert(WS_CT + (size_t)NUNIT_L * 2 * CT_SLOT * 2 <= WS_G && WS_XM + (size_t)TROWS * 512 * 2 <= WS_G && (size_t)MROWS * DFF * 2 <= WS_U, "ws map 2");
constexpr size_t DO_AB = 0, DO_Q = 32 * MiB, DO_K = 64 * MiB;

__device__ __forceinline__ unsigned f2bf(float f) { unsigned u = __builtin_bit_cast(unsigned, f); return (u + 0x7fffu + ((u >> 16) & 1u)) >> 16; }
__device__ __forceinline__ unsigned pk2(float lo, float hi) { return f2bf(lo) | (f2bf(hi) << 16); }
__device__ __forceinline__ float bflo(unsigned w) { return __builtin_bit_cast(float, w << 16); }
__device__ __forceinline__ float bfhi(unsigned w) { return __builtin_bit_cast(float, w & 0xffff0000u); }
__device__ __forceinline__ float silu_f(float x) { return x / (1.0f + __expf(-x)); }
__device__ __forceinline__ float logsig_f(float x) { return fminf(x, 0.f) - log1pf(__expf(-fabsf(x))); }
__device__ __forceinline__ float wave_sum(float v) {
#pragma unroll
    for (int o = 1; o < 64; o <<= 1) v += __shfl_xor(v, o);
    return v;
}
__device__ __forceinline__ int img_off(int row, int ch) { return row * 256 + ((ch ^ (row & 15)) << 4); }
struct BFrag { bf16x8 f[4]; };
__device__ __forceinline__ BFrag load_bfrag(const LAS uchar* Bimg, int brow, int kq) { BFrag b;
#pragma unroll
    for (int s = 0; s < 4; ++s) b.f[s] = *(const LAS bf16x8*)(Bimg + img_off(brow, 4 * s + kq));
    return b; }
__device__ __forceinline__ f32x4 mma_a(f32x4 acc, const LAS uchar* Aimg, int arow, const BFrag& b, int kq) {
    bf16x8 a[4];
#pragma unroll
    for (int s = 0; s < 4; ++s) a[s] = *(const LAS bf16x8*)(Aimg + img_off(arow, 4 * s + kq));
#pragma unroll
    for (int s = 0; s < 4; ++s) acc = __builtin_amdgcn_mfma_f32_16x16x32_bf16(a[s], b.f[s], acc, 0, 0, 0);
    return acc; }
#define MEMFENCE() asm volatile("" ::: "memory")

#define XB_TMO      128
#define XB_XCNT(j)  (256  + 64 * (j))
#define XB_XSUB(j)  (1280 + 64 * (j))
#define XB_XGEN(j)  (2304 + 64 * (j))
#define XB_TOP      3328
#define XB_TOPGEN   3392
#define XCD_BAR_WORDS 3456
#define XB_SPIN_CAP (1u << 18)

__device__ __forceinline__ unsigned xb_ld(unsigned* p)              { return __hip_atomic_load(p, __ATOMIC_RELAXED, __HIP_MEMORY_SCOPE_AGENT); }
__device__ __forceinline__ unsigned xb_add(unsigned* p, unsigned v) { return __hip_atomic_fetch_add(p, v, __ATOMIC_RELAXED, __HIP_MEMORY_SCOPE_AGENT); }
__device__ __forceinline__ unsigned xb_xcc_id() { return (unsigned)__builtin_amdgcn_s_getreg((3 << 11) | 20) & 0xFu; }
#define XB_SPIN(cond, bar) do { unsigned _sp = 0; while (cond) { __builtin_amdgcn_s_sleep(1); \
    if ((++_sp & 255u) == 0u) { if (xb_ld(&(bar)[XB_TMO])) break; if (_sp > XB_SPIN_CAP) { atomicAdd(&(bar)[XB_TMO], 1u); break; } } } } while (0)

struct XcdBarrier {
    unsigned* bar; unsigned x;
    volatile LAS unsigned* st;
};

__device__ __forceinline__ XcdBarrier xcd_barrier_post(unsigned* bar, volatile LAS unsigned* st) {
    XcdBarrier b; b.bar = bar; b.x = xb_xcc_id(); b.st = st;
    if (threadIdx.x == 0) (void)xb_add(&bar[XB_XCNT(b.x)], 1u);
    return b;
}
__device__ __forceinline__ void xcd_barrier_complete(unsigned* bar, unsigned x, unsigned& nloc, unsigned& nx) {
    const unsigned G = gridDim.x * gridDim.y * gridDim.z;
    unsigned sum, cnt, mine, sp = 0u;
    for (;;) {
        sum = 0u; cnt = 0u; mine = 0u;
#pragma unroll
        for (unsigned j = 0; j < 16; ++j) { const unsigned c = xb_ld(&bar[XB_XCNT(j)]); sum += c; cnt += (c > 0u) ? 1u : 0u; mine = (j == x) ? c : mine; }
        if (sum == G) break;
        __builtin_amdgcn_s_sleep(1);
        if ((++sp & 255u) == 0u) { if (xb_ld(&bar[XB_TMO])) break; if (sp > XB_SPIN_CAP) { atomicAdd(&bar[XB_TMO], 1u); break; } }
    }
    nloc = mine > 0u ? mine : 1u; nx = cnt > 0u ? cnt : 1u;
}

__device__ __forceinline__ void xcd_barrier(const XcdBarrier& b) {
    asm volatile("s_waitcnt vmcnt(0)" ::: "memory");
    __syncthreads();
    if (threadIdx.x == 0) {
        unsigned* bar = b.bar;
        __builtin_amdgcn_s_waitcnt(0);
        unsigned nloc = b.st[0], nx = b.st[1];
        if (nloc == 0u) { xcd_barrier_complete(bar, b.x, nloc, nx); b.st[0] = nloc; b.st[1] = nx; }
        const unsigned old = xb_add(&bar[XB_XSUB(b.x)], 1u);
        const unsigned gen = old / nloc;
        if (old + 1u == (gen + 1u) * nloc) {
            __builtin_amdgcn_fence(__ATOMIC_RELEASE, "agent");
            asm volatile("s_waitcnt vmcnt(0)" ::: "memory");
            const unsigned og = xb_add(&bar[XB_TOP], 1u);
            const unsigned tg = og / nx;
            if (og + 1u == (tg + 1u) * nx) xb_add(&bar[XB_TOPGEN], 1u);
            else XB_SPIN(xb_ld(&bar[XB_TOPGEN]) == tg, bar);
            __builtin_amdgcn_fence(__ATOMIC_ACQUIRE, "agent");
            xb_add(&bar[XB_XGEN(b.x)], 1u);
            asm volatile("s_waitcnt vmcnt(0)" ::: "memory");
        } else {
            XB_SPIN(xb_ld(&bar[XB_XGEN(b.x)]) == gen, bar);
            __builtin_amdgcn_fence(__ATOMIC_ACQUIRE, "agent");
            asm volatile("s_waitcnt vmcnt(0)" ::: "memory");
        }
    }
    __syncthreads();
}


struct Args { const float* in[24]; float* out; uchar* ws; int ph_lo, ph_hi; };

template <class F>
__device__ __forceinline__ void tr_item(F src, bf16* WT, size_t drow0, int ldk, int dk0, LAS float* scr, int lane) {
#pragma unroll 4
    for (int i = 0; i < 32; ++i) { const int kk = 2 * i + (lane >> 5); scr[kk * 33 + (lane & 31)] = src(kk, lane & 31); }
    LDS_WAIT(); asm volatile("" ::: "memory");
    const int c = lane & 7;
#pragma unroll
    for (int j = 0; j < 4; ++j) { const int n = (lane >> 3) + 8 * j; const LAS float* s = scr + (8 * c) * 33 + n;
        v4u o; o.x = pk2(s[0 * 33], s[1 * 33]); o.y = pk2(s[2 * 33], s[3 * 33]); o.z = pk2(s[4 * 33], s[5 * 33]); o.w = pk2(s[6 * 33], s[7 * 33]);
        *(v4u*)(WT + (drow0 + n) * ldk + dk0 + 8 * c) = o; }
    LDS_WAIT(); asm volatile("" ::: "memory");
}

__device__ __forceinline__ void p0_prologue(const Args& a, LAS uchar* lds, int vcu, int G) {
    const int tid = threadIdx.x, lane = tid & 63, wave = __builtin_amdgcn_readfirstlane(tid >> 6);
    uchar* ws = a.ws;
    {
        LAS float* sl = (LAS float*)lds;
        float* MOD = (float*)(ws + WS_MOD);
        const float* w_ada = a.in[4]; const float* b_ada = a.in[5];
        for (int it = blockIdx.x; it < 32 * 12; it += G) {
            const int kc = it / 12, nb = it % 12;
            __syncthreads();
            if (tid < 288) { const int r = tid >> 5, kk = tid & 31; const float cv = (r < 8) ? a.in[1][r * DM + kc * 32 + kk] : a.in[3][kc * 32 + kk]; sl[tid] = silu_f(cv); }
            __syncthreads();
            const int n = nb * 512 + tid;
            float acc[9];
#pragma unroll
            for (int r = 0; r < 9; ++r) acc[r] = 0.f;
#pragma unroll 8
            for (int kk = 0; kk < 32; ++kk) { const float w = w_ada[(size_t)(kc * 32 + kk) * 6144 + n];
#pragma unroll
                for (int r = 0; r < 9; ++r) acc[r] += sl[r * 32 + kk] * w; }
            const float bb = (kc == 0) ? b_ada[n] : 0.f;
#pragma unroll
            for (int r = 0; r < 9; ++r) atomicAdd(&MOD[r * 6144 + n], acc[r] + bb);
        }
        __syncthreads();
    }
    {
        LAS float* tab = (LAS float*)(lds + 8 * 16384);
        if (tid < 128) tab[tid] = cospif((float)tid * (1.0f / 64.0f)) * 0.08838834764831845f;
        __syncthreads();
        const int gt = blockIdx.x * NTHR + tid;
        bf16* F1 = (bf16*)(ws + WS_F1); bf16* G2 = (bf16*)(ws + WS_G2); float* TW = (float*)(ws + WS_TW);
        if (gt < 8192) { const int row = gt >> 6, n1 = gt & 63, ri = row >> 6, k1 = row & 63; const float ang = (float)((k1 * n1) & 63) * (1.0f / 32.0f);
            F1[gt] = (bf16)f2bf((ri == 0 ? cospif(ang) : -sinpif(ang)) * 0.125f); }
        else if (gt < 16384) { const int i = gt - 8192, k2 = i >> 7, kap = i & 127, n2 = kap & 63; const float ang = (float)((k2 * n2) & 63) * (1.0f / 32.0f);
            G2[i] = (bf16)f2bf((kap < 64 ? cospif(ang) : sinpif(ang)) * 0.125f); }
        else if (gt < 16384 + 4096) { const int i = gt - 16384; TW[i] = cospif((float)i * (1.0f / 2048.0f)); }
    }
    {
        LAS float* scr = (LAS float*)(lds + wave * 16384);
        const LAS float* tab = (const LAS float*)(lds + 8 * 16384);
        const int gw = vcu * NWAVES + wave, NGW = G * NWAVES;
        const float* w_in = a.in[7]; const float* w_out = a.in[15]; const float* w_up = a.in[17]; const float* w_dn = a.in[21];
        const float* w_q = a.in[10]; const float* w_k = a.in[11];
        bf16* WIN = (bf16*)(ws + WS_WIN); bf16* WOUT = (bf16*)(ws + WS_WOUT); bf16* WUP = (bf16*)(ws + WS_WUP); bf16* WDN = (bf16*)(ws + WS_WDN);
        bf16* WQ = (bf16*)(ws + WS_WQ); bf16* WK = (bf16*)(ws + WS_WK);
        constexpr int I_F = 16 * 16, I_XV = 16 * 32, I_Z = 16 * 16, I_OF = 8 * 32, I_OM = 8 * 32, I_UP = 16 * 160, I_DN = 40 * 32, I_QK = 2 * 4 * 4;
        constexpr int NIT = I_F + I_XV + I_Z + I_OF + I_OM + I_UP + I_DN + 2 * I_QK;
        for (int it = gw; it < NIT; it += NGW) {
            int r = it;
            if (r < I_F) {
                const int kb = r / 16, nb = r % 16, k0 = kb * 64, n0 = nb * 32, g = n0 >> 7;
                auto src = [&](int kk, int nn) -> float { const int s = (n0 + nn) & 127; const int mult = (s <= 64) ? s : (s - 64); const int off = (s <= 64) ? 0 : 96;
                    const float* wr = w_in + (size_t)(k0 + kk) * INW + g * 128; float acc = 0.f;
#pragma unroll 8
                    for (int c = 0; c < 128; ++c) acc += wr[c] * tab[(c * mult + off) & 127];
                    return acc; };
                tr_item(src, WIN, (size_t)n0, DM, k0, scr, lane); continue; } r -= I_F;
            if (r < I_XV) { const int kb = r / 32, nb = r % 32, k0 = kb * 64, n0 = nb * 32;
                auto src = [&](int kk, int nn) -> float { return w_in[(size_t)(k0 + kk) * INW + 512 + n0 + nn]; };
                tr_item(src, WIN, (size_t)(512 + n0), DM, k0, scr, lane); continue; } r -= I_XV;
            if (r < I_Z) { const int kb = r / 16, nb = r % 16, k0 = kb * 64, n0 = nb * 32;
                auto src = [&](int kk, int nn) -> float { return w_in[(size_t)(k0 + kk) * INW + 1552 + n0 + nn]; };
                tr_item(src, WIN, (size_t)(1536 + n0), DM, k0, scr, lane); continue; } r -= I_Z;
            if (r < I_OF) { const int kb = r / 32, nb = r % 32, k0 = kb * 64, n0 = nb * 32;
                auto src = [&](int kk, int nn) -> float { const int k = k0 + kk, g = k >> 7, s = k & 127; const float* wo = w_out + (size_t)(g * 128) * DM + n0 + nn;
                    if (s == 0 || s == 64) return wo[(size_t)s * DM];
                    if (s < 64) return wo[(size_t)s * DM] + wo[(size_t)(128 - s) * DM];
                    const int kq = s - 64; return wo[(size_t)(128 - kq) * DM] - wo[(size_t)kq * DM]; };
                tr_item(src, WOUT, (size_t)n0, DM, k0, scr, lane); continue; } r -= I_OF;
            if (r < I_OM) { const int kb = r / 32, nb = r % 32, k0 = kb * 64, n0 = nb * 32;
                auto src = [&](int kk, int nn) -> float { return w_out[(size_t)(512 + k0 + kk) * DM + n0 + nn]; };
                tr_item(src, WOUT, (size_t)n0, DM, 512 + k0, scr, lane); continue; } r -= I_OM;
            if (r < I_UP) { const int kb = r / 160, nb = r % 160, k0 = kb * 64, n0 = nb * 32;
                auto src = [&](int kk, int nn) -> float { return w_up[(size_t)(k0 + kk) * UPW + n0 + nn]; };
                tr_item(src, WUP, (size_t)n0, DM, k0, scr, lane); continue; } r -= I_UP;
            if (r < I_DN) { const int kb = r / 32, nb = r % 32, k0 = kb * 64, n0 = nb * 32;
                auto src = [&](int kk, int nn) -> float { return w_dn[(size_t)(k0 + kk) * DM + n0 + nn]; };
                tr_item(src, WDN, (size_t)n0, DFF, k0, scr, lane); continue; } r -= I_DN;
            {   const bool isk = r >= I_QK; if (isk) r -= I_QK;
                const int h = r / 8, kb = (r % 8) / 4, nb = r % 4, k0 = kb * 64, n0 = nb * 32;
                const float* W = (isk ? w_k : w_q) + (size_t)h * HD * HD; const float sc = isk ? 0.08838834764831845f : 1.0f;
                auto src = [&](int kk, int nn) -> float { return W[(size_t)(k0 + kk) * HD + n0 + nn] * sc; };
                tr_item(src, (isk ? WK : WQ) + (size_t)h * HD * HD, (size_t)n0, HD, k0, scr, lane); }
        }
    }
}

__device__ __forceinline__ void p1_rows(const Args& a, LAS uchar* lds, int vcu, int G) {
    const int tid = threadIdx.x, lane = tid & 63, wave = __builtin_amdgcn_readfirstlane(tid >> 6);
    uchar* ws = a.ws;
    {
        LAS f32x4* wg = (LAS f32x4*)lds;
        const float* w_in = a.in[7];
        for (int id = tid; id < 4096; id += NTHR) { const int k = id >> 2, q = id & 3; const int l = (k & 255) >> 2, i = k & 3, j = k >> 8;
            wg[((j * 4 + i) * 4 + q) * 64 + l] = *(const f32x4*)(w_in + (size_t)k * INW + 1536 + 4 * q); }
        __syncthreads();
    }
    const LAS f32x4* wg = (const LAS f32x4*)lds;
    const float* MOD = (const float*)(ws + WS_MOD);
    const float* nw = a.in[6]; const float* bg = a.in[12];
    bf16* HX = (bf16*)(ws + WS_HX); float* GG = (float*)(ws + WS_G);
    const int gw = vcu * NWAVES + wave, NGW = G * NWAVES;
    for (int row = gw; row < TROWS; row += NGW) {
        const float* xr; const float* md;
        if (row < MROWS) { xr = a.in[0] + (size_t)row * DM; md = MOD + (size_t)(row >> 12) * 6144; }
        else { xr = a.in[2] + (size_t)(row - MROWS) * DM; md = MOD + (size_t)8 * 6144; }
        f32x4 v[4]; float s = 0.f;
#pragma unroll
        for (int j = 0; j < 4; ++j) { v[j] = *(const f32x4*)(xr + 4 * lane + 256 * j); s += (v[j].x * v[j].x + v[j].y * v[j].y) + (v[j].z * v[j].z + v[j].w * v[j].w); }
        const float rstd = rsqrtf(wave_sum(s) * (1.0f / DM) + EPS);
        float g[16];
#pragma unroll
        for (int i = 0; i < 16; ++i) g[i] = 0.f;
#pragma unroll
        for (int j = 0; j < 4; ++j) {
            const f32x4 w = *(const f32x4*)(nw + 4 * lane + 256 * j), sh = *(const f32x4*)(md + 4 * lane + 256 * j), sc = *(const f32x4*)(md + 1024 + 4 * lane + 256 * j);
            v[j] = v[j] * rstd * w * (sc + 1.0f) + sh;
            *(v2u*)(HX + (size_t)row * DM + 4 * lane + 256 * j) = (v2u){pk2(v[j].x, v[j].y), pk2(v[j].z, v[j].w)};
        }
#pragma unroll
        for (int j = 0; j < 4; ++j) {
#pragma unroll
            for (int i = 0; i < 4; ++i) {
#pragma unroll
                for (int q = 0; q < 4; ++q) { const f32x4 ww = wg[((j * 4 + i) * 4 + q) * 64 + lane];
                    g[4 * q + 0] += v[j][i] * ww.x; g[4 * q + 1] += v[j][i] * ww.y; g[4 * q + 2] += v[j][i] * ww.z; g[4 * q + 3] += v[j][i] * ww.w; }
                if (i & 1) MEMFENCE(); }
        }
        float g8[8], g4[4], g2[2], g1;
        { const bool hi = (lane & 32) != 0;
#pragma unroll
          for (int i = 0; i < 8; ++i) { const float keep = hi ? g[i + 8] : g[i], send = hi ? g[i] : g[i + 8]; g8[i] = keep + __shfl_xor(send, 32); } }
        { const bool hi = (lane & 16) != 0;
#pragma unroll
          for (int i = 0; i < 4; ++i) { const float keep = hi ? g8[i + 4] : g8[i], send = hi ? g8[i] : g8[i + 4]; g4[i] = keep + __shfl_xor(send, 16); } }
        { const bool hi = (lane & 8) != 0;
#pragma unroll
          for (int i = 0; i < 2; ++i) { const float keep = hi ? g4[i + 2] : g4[i], send = hi ? g4[i] : g4[i + 2]; g2[i] = keep + __shfl_xor(send, 8); } }
        { const bool hi = (lane & 4) != 0; const float keep = hi ? g2[1] : g2[0], send = hi ? g2[0] : g2[1]; g1 = keep + __shfl_xor(send, 4); }
        g1 += __shfl_xor(g1, 2); g1 += __shfl_xor(g1, 1);
        if ((lane & 3) == 0) { const int idx = ((lane & 32) ? 8 : 0) + ((lane & 16) ? 4 : 0) + ((lane & 8) ? 2 : 0) + ((lane & 4) ? 1 : 0); GG[(size_t)row * 16 + idx] = g1 + bg[idx]; }
    }
}
__device__ __forceinline__ void p7_rows(const Args& a, int vcu, int G) {
    const int tid = threadIdx.x, lane = tid & 63, wave = __builtin_amdgcn_readfirstlane(tid >> 6);
    const float* MOD = (const float*)(a.ws + WS_MOD); const float* nw = a.in[16]; bf16* H2 = (bf16*)(a.ws + WS_H2);
    const int gw = vcu * NWAVES + wave, NGW = G * NWAVES;
    for (int row = gw; row < MROWS; row += NGW) {
        const float* xr = a.out + (size_t)row * DM; const float* md = MOD + (size_t)(row >> 12) * 6144;
        f32x4 v[4]; float s = 0.f;
#pragma unroll
        for (int j = 0; j < 4; ++j) { v[j] = *(const f32x4*)(xr + 4 * lane + 256 * j); s += (v[j].x * v[j].x + v[j].y * v[j].y) + (v[j].z * v[j].z + v[j].w * v[j].w); }
        const float rstd = rsqrtf(wave_sum(s) * (1.0f / DM) + EPS);
#pragma unroll
        for (int j = 0; j < 4; ++j) {
            const f32x4 w = *(const f32x4*)(nw + 4 * lane + 256 * j), sh = *(const f32x4*)(md + 3072 + 4 * lane + 256 * j), sc = *(const f32x4*)(md + 4096 + 4 * lane + 256 * j);
            const f32x4 hv = v[j] * rstd * w * (sc + 1.0f) + sh;
            *(v2u*)(H2 + (size_t)row * DM + 4 * lane + 256 * j) = (v2u){pk2(hv.x, hv.y), pk2(hv.z, hv.w)}; }
    }
}
__device__ __forceinline__ void p11_rows(const Args& a, int vcu, int G) {
    const int tid = threadIdx.x, lane = tid & 63, wave = __builtin_amdgcn_readfirstlane(tid >> 6);
    const float* nw = a.in[23];
    const int gw = vcu * NWAVES + wave, NGW = G * NWAVES;
    for (int row = gw; row < MROWS; row += NGW) {
        float* xr = a.out + (size_t)row * DM;
        f32x4 v[4]; float s = 0.f;
#pragma unroll
        for (int j = 0; j < 4; ++j) { v[j] = *(const f32x4*)(xr + 4 * lane + 256 * j); s += (v[j].x * v[j].x + v[j].y * v[j].y) + (v[j].z * v[j].z + v[j].w * v[j].w); }
        const float rstd = rsqrtf(wave_sum(s) * (1.0f / DM) + EPS);
#pragma unroll
        for (int j = 0; j < 4; ++j) { const f32x4 w = *(const f32x4*)(nw + 4 * lane + 256 * j); *(f32x4*)(xr + 4 * lane + 256 * j) = v[j] * rstd * w; }
    }
}

struct SchedP2 {
    pg8::StaticOrder so;
    __device__ void init(int G, int c) { so.init(MROWS, 2048, G, c); }
    __device__ bool next(int i, pg8::Unit& u) const {
        const long L = (long)i * so.G + so.c;
        if (L < so.nwg) return so.next(i, u);
        const int r = (int)(L - so.nwg); if (r >= 32) return false;
        u.pm = 128 + (r & 7); u.pn = 2 + (r >> 3); return true;
    }
    __device__ __forceinline__ void a_ready(const pg8::Unit&) const {}
    __device__ __forceinline__ void done(const pg8::Unit&) const {}
};
struct EpiP2 {
    static constexpr bool PERM = true, AFTER_DRAIN = false;
    bf16 *base0, *base1, *base2, *base3;
    __device__ __forceinline__ void operator()(const f32x4 (&acc)[2][2][4][2], const pg8::Unit& u, int wr, int wc, int fr, int fq) const {
        const int row0 = u.pm * 256 + wr * 64 + fr; const int sel = u.pn >> 1; bf16* O = sel == 0 ? base0 : (sel == 1 ? base1 : (sel == 2 ? base2 : base3)); const int col0 = (u.pn & 1) * 256 + wc * 32 + 8 * fq;
#pragma unroll
        for (int ai = 0; ai < 2; ++ai)
#pragma unroll
            for (int m = 0; m < 4; ++m) { bf16* rowp = O + (size_t)(row0 + ai * 128 + m * 16) * 512 + col0;
#pragma unroll
                for (int bj = 0; bj < 2; ++bj) { const f32x4 v0 = acc[ai][bj][m][0], v1 = acc[ai][bj][m][1];
                    v4u w; w.x = pg8::cvt_pk_bf16(v0[0], v0[1]); w.y = pg8::cvt_pk_bf16(v0[2], v0[3]); w.z = pg8::cvt_pk_bf16(v1[0], v1[1]); w.w = pg8::cvt_pk_bf16(v1[2], v1[3]);
                    *(v4u*)(rowp + bj * 128) = w; } }
    }
};
struct EpiBias16 {
    static constexpr bool PERM = true, AFTER_DRAIN = false;
    bf16* O; int ldc; const float* bias;
    __device__ __forceinline__ void operator()(const f32x4 (&acc)[2][2][4][2], const pg8::Unit& u, int wr, int wc, int fr, int fq) const {
        const int row0 = u.pm * 256 + wr * 64 + fr; const int col0 = u.pn * 256 + wc * 32 + 8 * fq;
        f32x4 bv[2][2];
#pragma unroll
        for (int bj = 0; bj < 2; ++bj)
#pragma unroll
            for (int n = 0; n < 2; ++n) bv[bj][n] = *(const f32x4*)(bias + col0 + bj * 128 + 4 * n);
#pragma unroll
        for (int ai = 0; ai < 2; ++ai)
#pragma unroll
            for (int m = 0; m < 4; ++m) { bf16* rowp = O + (size_t)(row0 + ai * 128 + m * 16) * ldc + col0;
#pragma unroll
                for (int bj = 0; bj < 2; ++bj) { const f32x4 v0 = acc[ai][bj][m][0] + bv[bj][0], v1 = acc[ai][bj][m][1] + bv[bj][1];
                    v4u w; w.x = pg8::cvt_pk_bf16(v0[0], v0[1]); w.y = pg8::cvt_pk_bf16(v0[2], v0[3]); w.z = pg8::cvt_pk_bf16(v1[0], v1[1]); w.w = pg8::cvt_pk_bf16(v1[2], v1[3]);
                    *(v4u*)(rowp + bj * 128) = w; } }
    }
};
struct EpiRes {
    static constexpr bool PERM = false, AFTER_DRAIN = false;
    const float* res; float* out; const float* gate; const float* bias;
    __device__ __forceinline__ void operator()(const f32x4 (&acc)[2][2][4][2], const pg8::Unit& u, int wr, int wc, int fr, int fq) const {
        const int row0 = u.pm * 256 + wr * 64 + fr, col0 = u.pn * 256 + wc * 32 + 4 * fq;
        const float* gp = gate + (size_t)((u.pm * 256) >> 12) * 6144 + col0;
        f32x4 gv[2][2], bv[2][2];
#pragma unroll
        for (int bj = 0; bj < 2; ++bj)
#pragma unroll
            for (int n = 0; n < 2; ++n) { gv[bj][n] = *(const f32x4*)(gp + bj * 128 + n * 16); bv[bj][n] = bias ? *(const f32x4*)(bias + col0 + bj * 128 + n * 16) : (f32x4){0.f, 0.f, 0.f, 0.f}; }
#pragma unroll
        for (int ai = 0; ai < 2; ++ai)
#pragma unroll
            for (int m = 0; m < 4; ++m) { const size_t off = (size_t)(row0 + ai * 128 + m * 16) * DM + col0;
#pragma unroll
                for (int bj = 0; bj < 2; ++bj)
#pragma unroll
                    for (int n = 0; n < 2; ++n) { const f32x4 r = *(const f32x4*)(res + off + bj * 128 + n * 16);
                        *(f32x4*)(out + off + bj * 128 + n * 16) = r + gv[bj][n] * (acc[ai][bj][m][n] + bv[bj][n]); }
                asm volatile("" ::: "memory"); }
    }
};

constexpr int PR_A = 0, PR_W = 32768, PR_KT = 65536, PR_VT = 98304, PR_SM = 98304 + 36864;
__device__ __forceinline__ void unit_decode(int unit, int& bh, int& row0, int& t0, int& L) {
    if (unit < NUNIT_L) { bh = unit >> 5; const int c = unit & 31; row0 = (bh >> 2) * SEQ + c * 128; t0 = c * 128; L = SEQ; }
    else { const int uc = unit - NUNIT_L; bh = uc >> 1; const int cc = uc & 1; row0 = MROWS + (bh >> 2) * CTXL + cc * 128; t0 = cc * 128; L = CTXL; }
}
__device__ __forceinline__ void load_gates(const float* GG, int row0, int h, LAS float* sm, int tid) {
    if (tid < 128) { const float* g = GG + (size_t)(row0 + tid) * 16;
        sm[tid] = g[h]; sm[128 + tid] = logsig_f(g[4 + h]); sm[256 + tid] = g[8 + h]; sm[384 + tid] = logsig_f(g[12 + h]); }
}
__device__ __forceinline__ void prep_unit(const Args& a, LAS uchar* lds, int unit) {
    int tid_ = threadIdx.x; asm volatile("" : "+v"(tid_)); const int tid = tid_, lane = tid & 63, wave = __builtin_amdgcn_readfirstlane(tid >> 6), kq = lane >> 4, fr = lane & 15;
    uchar* ws = a.ws;
    int bh, row0, t0, L; unit_decode(unit, bh, row0, t0, L);
    const int h = bh & 3; const bool latent = unit < NUNIT_L;
    LAS float* sm = (LAS float*)(lds + PR_SM);
    const bf16* XM = (const bf16*)(ws + WS_XM); const bf16* V = (const bf16*)(ws + WS_V);
    bf16* AB = (bf16*)((uchar*)a.out + DO_AB); bf16* Q = (bf16*)((uchar*)a.out + DO_Q); bf16* K = (bf16*)((uchar*)a.out + DO_K);
    __syncthreads();
    load_gates((const float*)(ws + WS_G), row0, h, sm, tid);
    for (int id = tid; id < 15 * 16; id += NTHR) *(LAS v4u*)(lds + PR_VT + (129 + (id >> 4)) * 256 + (id & 15) * 16) = (v4u){0u, 0u, 0u, 0u};
    {
        const int l = tid >> 2, seg = tid & 3, t = t0 + l; const int colg = h * HD + seg * 32;
        const bool hp = t > 0, hn = t + 1 < L;
        const bf16* xc = XM + (size_t)(row0 + l) * 512 + colg;
        const float* cw = a.in[8]; const float* cb = a.in[9];
#pragma unroll
        for (int i = 0; i < 4; ++i) {
            const v4u c = *(const v4u*)(xc + 8 * i); v4u p = (v4u){0u, 0u, 0u, 0u}, n = (v4u){0u, 0u, 0u, 0u};
            if (hp) p = *(const v4u*)(xc - 512 + 8 * i);
            if (hn) n = *(const v4u*)(xc + 512 + 8 * i);
            float o[8];
#pragma unroll
            for (int e = 0; e < 8; ++e) { const int ch = colg + 8 * i + e; const unsigned pw = p[e >> 1], cw_ = c[e >> 1], nw_ = n[e >> 1];
                const float xp = (e & 1) ? bfhi(pw) : bflo(pw), xcv = (e & 1) ? bfhi(cw_) : bflo(cw_), xn = (e & 1) ? bfhi(nw_) : bflo(nw_);
                o[e] = silu_f(cw[ch] * xp + cw[512 + ch] * xcv + cw[1024 + ch] * xn + cb[ch]); }
            const v4u w = (v4u){pk2(o[0], o[1]), pk2(o[2], o[3]), pk2(o[4], o[5]), pk2(o[6], o[7])};
            *(LAS v4u*)(lds + PR_A + img_off(l, seg * 4 + i)) = w;
            if (latent) *(v4u*)(AB + (size_t)(row0 + l) * 512 + colg + 8 * i) = w;
        }
    }
    const bf16* WQ = (const bf16*)(ws + WS_WQ) + (size_t)h * HD * HD; const bf16* WK = (const bf16*)(ws + WS_WK) + (size_t)h * HD * HD;
    for (int pass = latent ? 0 : 1; pass < 2; ++pass) {
        const bf16* W = pass ? WK : WQ;
        if (pass == 1 && latent) __syncthreads();
#pragma unroll
        for (int i = 0; i < 4; ++i) { const int id = tid + NTHR * i, row = id >> 4, ch = id & 15; *(LAS v4u*)(lds + PR_W + img_off(row, ch)) = *(const v4u*)(W + row * 128 + ch * 8); }
        __syncthreads();
        f32x4 acc[8];
        { const BFrag bq = load_bfrag(lds + PR_A, 16 * wave + fr, kq);
#pragma unroll
          for (int mt = 0; mt < 8; ++mt) { acc[mt] = mma_a((f32x4){0.f, 0.f, 0.f, 0.f}, lds + PR_W, 16 * mt + fr, bq, kq); if (mt & 1) MEMFENCE(); } }
        const int tok = row0 + 16 * wave + fr;
        bf16* dst = (pass ? K : Q) + (size_t)tok * 512 + h * HD;
#pragma unroll
        for (int mt = 0; mt < 8; ++mt) { const v2u w = (v2u){pk2(acc[mt][0], acc[mt][1]), pk2(acc[mt][2], acc[mt][3])};
            if (latent) *(v2u*)(dst + 16 * mt + 4 * kq) = w;
            if (pass) {
                const int j = 16 * wave + fr;
#pragma unroll
                for (int r = 0; r < 4; ++r) { const int d = 16 * mt + 4 * kq + r; *(LAS bf16*)(lds + PR_KT + img_off(d, j >> 3) + (j & 7) * 2) = (bf16)((r & 1) ? (w[r >> 1] >> 16) : (w[r >> 1] & 0xffffu)); } }
        }
    }
    __syncthreads();
    if (tid == 0) { float b = 0.f; for (int j = 0; j < 128; ++j) b += sm[128 + j]; const float bend = b; float run = 0.f, mx = -3.0e38f;
        for (int j = 0; j < 128; ++j) { run += sm[128 + j]; const float g = bend - run + sm[j]; sm[512 + j] = g; mx = fmaxf(mx, g); }
        sm[768] = bend; sm[769] = mx; }
    if (tid == 64) { float b = 0.f; for (int j = 0; j < 128; ++j) b += sm[384 + j]; const float bend = b; float run = 0.f, mx = -3.0e38f;
        for (int j = 127; j >= 0; --j) { run += sm[384 + j]; const float g = bend - run + sm[256 + j]; sm[640 + j] = g; mx = fmaxf(mx, g); }
        sm[770] = bend; sm[771] = mx; }
    __syncthreads();
    if (tid < 128) sm[512 + tid] = __expf(sm[512 + tid] - sm[769]); else if (tid < 256) sm[640 + tid - 128] = __expf(sm[640 + tid - 128] - sm[771]);
    __syncthreads();
    float* DC = (float*)(ws + WS_DC); float* SC = (float*)(ws + WS_SC);
    for (int dir = 0; dir < 2; ++dir) {
        if (dir) __syncthreads();
        {
            const int j = tid >> 2, seg = tid & 3; const float wj = sm[512 + dir * 128 + j];
            const bf16* vr = V + (size_t)(row0 + j) * 512 + h * HD + seg * 32;
#pragma unroll
            for (int i = 0; i < 4; ++i) { const v4u c = *(const v4u*)(vr + 8 * i);
#pragma unroll
                for (int e = 0; e < 8; ++e) { const unsigned cw_ = c[e >> 1]; const float x = ((e & 1) ? bfhi(cw_) : bflo(cw_)) * wj;
                    *(LAS bf16*)(lds + PR_VT + img_off(seg * 32 + 8 * i + e, j >> 3) + (j & 7) * 2) = (bf16)f2bf(x); } }
            if (seg == 0) *(LAS bf16*)(lds + PR_VT + img_off(128, j >> 3) + (j & 7) * 2) = (bf16)f2bf(wj);
        }
        __syncthreads();
        f32x4 acc[9];
        { const BFrag bk = load_bfrag(lds + PR_KT, 16 * wave + fr, kq);
#pragma unroll
          for (int mt = 0; mt < 9; ++mt) { acc[mt] = mma_a((f32x4){0.f, 0.f, 0.f, 0.f}, lds + PR_VT, 16 * mt + fr, bk, kq); if (mt & 1) MEMFENCE(); } }
        float* dst = DC + (size_t)(unit * 2 + dir) * CT_SLOT + 16 * wave + fr;
#pragma unroll
        for (int mt = 0; mt < 8; ++mt)
#pragma unroll
            for (int r = 0; r < 4; ++r) dst[(size_t)(16 * mt + 4 * kq + r) * 128] = acc[mt][r];
        if (kq == 0) dst[(size_t)128 * 128] = acc[8][0];
        if (tid == 0) { SC[(unit * 2 + dir) * 2] = sm[768 + 2 * dir]; SC[(unit * 2 + dir) * 2 + 1] = sm[769 + 2 * dir]; }
    }
}

__device__ __forceinline__ void fft1_item(const Args& a, LAS uchar* lds, int item) {
    int tid_ = threadIdx.x; asm volatile("" : "+v"(tid_)); const int tid = tid_, lane = tid & 63, wave = __builtin_amdgcn_readfirstlane(tid >> 6), kq = lane >> 4, fr = lane & 15;
    uchar* ws = a.ws;
    const int b = item >> 7, cblk = item & 127;
    const bf16* UF = (const bf16*)(ws + WS_UF) + (size_t)b * SEQ * 512 + cblk * 256;
    bf16* TP = (bf16*)(ws + WS_TP);
    const bf16* F1 = (const bf16*)(ws + WS_F1); const float* TW = (const float*)(ws + WS_TW);
    __syncthreads();
#pragma unroll
    for (int i = 0; i < 4; ++i) { const int id = tid + NTHR * i, n1 = id >> 5, c8 = id & 31; const v4u v = *(const v4u*)(UF + (size_t)n1 * 32768 + c8 * 8);
#pragma unroll
        for (int e = 0; e < 8; ++e) *(LAS bf16*)(lds + (c8 * 8 + e) * 144 + n1 * 2) = (bf16)((e & 1) ? (v[e >> 1] >> 16) : (v[e >> 1] & 0xffffu)); }
    bf16x8 bfr[8][2];
#pragma unroll
    for (int nt = 0; nt < 8; ++nt)
#pragma unroll
        for (int s = 0; s < 2; ++s) bfr[nt][s] = *(const bf16x8*)(F1 + (16 * nt + fr) * 64 + 32 * s + 8 * kq);
    __syncthreads();
    const int n2 = cblk >> 1;
    for (int mi = 0; mi < 2; ++mi) {
        const int mt = wave * 2 + mi;
        const bf16x8 a0 = *(const LAS bf16x8*)(lds + (16 * mt + fr) * 144 + kq * 16), a1 = *(const LAS bf16x8*)(lds + (16 * mt + fr) * 144 + 64 + kq * 16);
        f32x4 acc[8];
#pragma unroll
        for (int nt = 0; nt < 8; ++nt) { acc[nt] = (f32x4){0.f, 0.f, 0.f, 0.f};
            acc[nt] = __builtin_amdgcn_mfma_f32_16x16x32_bf16(a0, bfr[nt][0], acc[nt], 0, 0, 0); acc[nt] = __builtin_amdgcn_mfma_f32_16x16x32_bf16(a1, bfr[nt][1], acc[nt], 0, 0, 0); }
        const int c0 = 16 * mt + 4 * kq, col0 = (cblk & 1) * 256 + c0;
#pragma unroll
        for (int nt = 0; nt < 4; ++nt) { const int k1 = 16 * nt + fr; const int idx = (n2 * k1) & 4095; const float cs = TW[idx], sn = TW[(idx - 1024) & 4095];
            float pr[4], pi[4];
#pragma unroll
            for (int r = 0; r < 4; ++r) { const float tr = acc[nt][r], ti = acc[nt + 4][r]; const float xr = tr * cs + ti * sn, xi = ti * cs - tr * sn;
                const bool st = ((col0 + r) & 127) >= 65; pr[r] = st ? -xi : xr; pi[r] = st ? xr : xi; }
            const size_t o = ((size_t)(b * 2) * 64 + k1) * 32768 + (size_t)cblk * 256 + c0;
            *(v2u*)(TP + o) = (v2u){pk2(pr[0], pr[1]), pk2(pr[2], pr[3])};
            *(v2u*)(TP + o + (size_t)64 * 32768) = (v2u){pk2(pi[0], pi[1]), pk2(pi[2], pi[3])}; }
    }
}
__device__ __forceinline__ void fft2_item(const Args& a, LAS uchar* lds, int item) {
    int tid_ = threadIdx.x; asm volatile("" : "+v"(tid_)); const int tid = tid_, lane = tid & 63, wave = __builtin_amdgcn_readfirstlane(tid >> 6), kq = lane >> 4, fr = lane & 15;
    uchar* ws = a.ws;
    const int b = item >> 7, k1 = (item >> 1) & 63, half = item & 1;
    const bf16* TP = (const bf16*)(ws + WS_TP); const bf16* G2 = (const bf16*)(ws + WS_G2);
    bf16* YM = (bf16*)(ws + WS_YM);
    __syncthreads();
#pragma unroll
    for (int i = 0; i < 8; ++i) { const int id = tid + NTHR * i, kap = id >> 5, c8 = id & 31, ri = kap >> 6, n2 = kap & 63;
        const v4u v = *(const v4u*)(TP + ((size_t)(b * 2 + ri) * 64 + k1) * 32768 + (size_t)n2 * 512 + half * 256 + c8 * 8);
#pragma unroll
        for (int e = 0; e < 8; ++e) { const int c = c8 * 8 + e; *(LAS bf16*)(lds + img_off(c, kap >> 3) + (kap & 7) * 2) = (bf16)((e & 1) ? (v[e >> 1] >> 16) : (v[e >> 1] & 0xffffu)); } }
    bf16x8 bfr[4][4];
#pragma unroll
    for (int nt = 0; nt < 4; ++nt)
#pragma unroll
        for (int s = 0; s < 4; ++s) bfr[nt][s] = *(const bf16x8*)(G2 + (16 * nt + fr) * 128 + 32 * s + 8 * kq);
    __syncthreads();
    for (int mi = 0; mi < 2; ++mi) {
        const int mt = wave * 2 + mi;
        f32x4 acc[4];
#pragma unroll
        for (int nt = 0; nt < 4; ++nt) acc[nt] = (f32x4){0.f, 0.f, 0.f, 0.f};
#pragma unroll
        for (int s = 0; s < 4; ++s) { const bf16x8 av = *(const LAS bf16x8*)(lds + img_off(16 * mt + fr, 4 * s + kq));
#pragma unroll
            for (int nt = 0; nt < 4; ++nt) acc[nt] = __builtin_amdgcn_mfma_f32_16x16x32_bf16(av, bfr[nt][s], acc[nt], 0, 0, 0); }
#pragma unroll
        for (int nt = 0; nt < 4; ++nt) { const int k2 = 16 * nt + fr; const size_t row = (size_t)b * SEQ + k1 + 64 * k2;
            *(v2u*)(YM + row * 1024 + half * 256 + 16 * mt + 4 * kq) = (v2u){pk2(acc[nt][0], acc[nt][1]), pk2(acc[nt][2], acc[nt][3])}; }
    }
}

__device__ __forceinline__ void p4_scan(const Args& a, int G) {
    uchar* ws = a.ws;
    const float* DC = (const float*)(ws + WS_DC); const float* SC = (const float*)(ws + WS_SC);
    bf16* CT = (bf16*)(ws + WS_CT); float* MS = (float*)(ws + WS_MS);
    constexpr int F4 = CT_SLOT / 4;
    const int total = 64 * F4;
    for (int gi = blockIdx.x * NTHR + threadIdx.x; gi < total; gi += G * NTHR) {
        const int seq = gi / F4, i = gi - seq * F4; const int bh = seq >> 1, dir = seq & 1;
        f32x4 s = (f32x4){0.f, 0.f, 0.f, 0.f}; float m = 0.f;
        for (int step = 0; step < 34; ++step) {
            int unit;
            if (step < 2) unit = NUNIT_L + bh * 2 + (dir ? 1 - step : step);
            else { const int c = dir ? 33 - step : step - 2; unit = bh * 32 + c; }
            const int slot = unit * 2 + dir;
            if (step >= 2) { *(v2u*)(CT + (size_t)slot * CT_SLOT + 4 * i) = (v2u){pk2(s.x, s.y), pk2(s.z, s.w)}; if (i == 0) MS[slot] = m; }
            const float bend = SC[slot * 2], mloc = SC[slot * 2 + 1];
            const float mn = fmaxf(bend + m, mloc), al = __expf(bend + m - mn), be = __expf(mloc - mn);
            const f32x4 d = *(const f32x4*)(DC + (size_t)slot * CT_SLOT + 4 * i);
            s = s * al + d * be; m = mn;
        }
    }
}

constexpr int OU_Q = 0, OU_KC = 32768, OU_VT = 69632, OU_P = 106496, OU_SM = 139264;
__device__ __forceinline__ void out_unit(const Args& a, LAS uchar* lds, int unit) {
    int tid_ = threadIdx.x; asm volatile("" : "+v"(tid_)); const int tid = tid_, lane = tid & 63, wave = __builtin_amdgcn_readfirstlane(tid >> 6), kq = lane >> 4, fr = lane & 15;
    uchar* ws = a.ws;
    const int bh = unit >> 5, c = unit & 31, h = bh & 3, row0 = (bh >> 2) * SEQ + c * 128;
    LAS float* sm = (LAS float*)(lds + OU_SM);
    const bf16* Q = (const bf16*)((const uchar*)a.out + DO_Q); const bf16* K = (const bf16*)((const uchar*)a.out + DO_K); const bf16* AB = (const bf16*)((const uchar*)a.out + DO_AB);
    const bf16* V = (const bf16*)(ws + WS_V); const bf16* Z = (const bf16*)(ws + WS_Z);
    const bf16* CT = (const bf16*)(ws + WS_CT); const float* MS = (const float*)(ws + WS_MS);
    bf16* YM = (bf16*)(ws + WS_YM);
    __syncthreads();
    load_gates((const float*)(ws + WS_G), row0, h, sm, tid);
    const float m_f = MS[unit * 2], m_b = MS[unit * 2 + 1];
#pragma unroll
    for (int i = 0; i < 4; ++i) { const int id = tid + NTHR * i, row = id >> 4, ch = id & 15; const size_t g = (size_t)(row0 + row) * 512 + h * HD + ch * 8;
        *(LAS v4u*)(lds + OU_Q + img_off(row, ch)) = *(const v4u*)(Q + g); *(LAS v4u*)(lds + OU_KC + img_off(row, ch)) = *(const v4u*)(K + g); }
    for (int id = tid; id < 15 * 16; id += NTHR) *(LAS v4u*)(lds + OU_VT + (129 + (id >> 4)) * 256 + (id & 15) * 16) = (v4u){0u, 0u, 0u, 0u};
    {   const int j = tid >> 2, seg = tid & 3; const bf16* vr = V + (size_t)(row0 + j) * 512 + h * HD + seg * 32;
#pragma unroll
        for (int i = 0; i < 4; ++i) { const v4u cv = *(const v4u*)(vr + 8 * i);
#pragma unroll
            for (int e = 0; e < 8; ++e) *(LAS bf16*)(lds + OU_VT + img_off(seg * 32 + 8 * i + e, j >> 3) + (j & 7) * 2) = (bf16)((e & 1) ? (cv[e >> 1] >> 16) : (cv[e >> 1] & 0xffffu)); }
        if (seg == 0) *(LAS bf16*)(lds + OU_VT + img_off(128, j >> 3) + (j & 7) * 2) = (bf16)0x3f80u; }
    __syncthreads();
    if (tid == 0) { float b = 0.f, R = -3.0e38f; for (int j = 0; j < 128; ++j) { b += sm[128 + j]; const float r = sm[j] - b; R = fmaxf(R, r); sm[512 + j] = r; sm[640 + j] = fmaxf(m_f, R); sm[768 + j] = b; } }
    if (tid == 64) { float b = 0.f, R = -3.0e38f; for (int j = 127; j >= 0; --j) { b += sm[384 + j]; const float r = sm[256 + j] - b; R = fmaxf(R, r); sm[896 + j] = r; sm[1024 + j] = fmaxf(m_b, R); sm[1152 + j] = b; } }
    f32x4 S[8];
    { const BFrag bq = load_bfrag(lds + OU_Q, 16 * wave + fr, kq);
#pragma unroll
      for (int mt = 0; mt < 8; ++mt) { S[mt] = mma_a((f32x4){0.f, 0.f, 0.f, 0.f}, lds + OU_KC, 16 * mt + fr, bq, kq); if (mt & 1) MEMFENCE(); } }
    __syncthreads();
    const int l = 16 * wave + fr; const int tok = row0 + l;
    LAS uchar* Pw = lds + OU_P + wave * 4096;
    f32x4 hs[8];
    for (int dir = 0; dir < 2; ++dir) {
        const LAS float* rr = sm + 512 + dir * 384; const LAS float* rho = rr + 128; const LAS float* bl = rr + 256;
        const float rho_l = rho[l], mst = dir ? m_b : m_f;
        { const bf16* src = CT + (size_t)(unit * 2 + dir) * CT_SLOT;
#pragma unroll
          for (int i = 0; i < 5; ++i) { const int id = tid + NTHR * i; if (id < 129 * 16) { const int row = id >> 4, ch = id & 15; *(LAS v4u*)(lds + OU_KC + img_off(row, ch)) = *(const v4u*)(src + row * 128 + ch * 8); } } }
#pragma unroll
        for (int mt = 0; mt < 8; ++mt) { float p[4]; const f32x4 rv = *(const LAS f32x4*)(rr + 16 * mt + 4 * kq);
#pragma unroll
            for (int r = 0; r < 4; ++r) { const int j = 16 * mt + 4 * kq + r; const bool ok = dir ? (j >= l) : (j <= l); p[r] = ok ? S[mt][r] * __expf(fminf(rv[r] - rho_l, 0.f)) : 0.f; }
            *(LAS v2u*)(Pw + img_off(fr, 2 * mt + (kq >> 1)) + (kq & 1) * 8) = (v2u){pk2(p[0], p[1]), pk2(p[2], p[3])}; if (mt & 1) MEMFENCE(); }
        __syncthreads();
        f32x4 acc[9];
        const float wi = __expf(mst - rho_l);
        { const BFrag bq = load_bfrag(lds + OU_Q, 16 * wave + fr, kq);
#pragma unroll
          for (int mt = 0; mt < 9; ++mt) { acc[mt] = mma_a((f32x4){0.f, 0.f, 0.f, 0.f}, lds + OU_KC, 16 * mt + fr, bq, kq) * wi; if (mt & 1) MEMFENCE(); } }
        MEMFENCE();
        { const BFrag bp = load_bfrag(Pw, fr, kq);
#pragma unroll
          for (int mt = 0; mt < 9; ++mt) { acc[mt] = mma_a(acc[mt], lds + OU_VT, 16 * mt + fr, bp, kq); if (mt & 1) MEMFENCE(); } }
        const float den = __shfl(acc[8][0], fr);
        const float sc = 1.0f / fmaxf(fabsf(den), __expf(-bl[l] - rho_l));
#pragma unroll
        for (int mt = 0; mt < 8; ++mt) hs[mt] = dir ? hs[mt] + acc[mt] * sc : acc[mt] * sc;
        __syncthreads();
    }
    float s1 = 0.f;
#pragma unroll
    for (int mt = 0; mt < 8; ++mt) s1 += (hs[mt][0] + hs[mt][1]) + (hs[mt][2] + hs[mt][3]);
    s1 += __shfl_xor(s1, 16); s1 += __shfl_xor(s1, 32);
    const float mu = s1 * (1.0f / 128.0f); float s2 = 0.f;
#pragma unroll
    for (int mt = 0; mt < 8; ++mt) { const f32x4 d = hs[mt] - mu; s2 += (d[0] * d[0] + d[1] * d[1]) + (d[2] * d[2] + d[3] * d[3]); }
    s2 += __shfl_xor(s2, 16); s2 += __shfl_xor(s2, 32);
    const float rstd = rsqrtf(s2 * (1.0f / 128.0f) + EPS);
    const float* mw = a.in[13] + h * HD; const float* msk = a.in[14] + h * HD;
#pragma unroll
    for (int mt = 0; mt < 8; ++mt) { const int e0 = 16 * mt + 4 * kq;
        const f32x4 w = *(const f32x4*)(mw + e0), k4 = *(const f32x4*)(msk + e0);
        const v2u av = *(const v2u*)(AB + (size_t)tok * 512 + h * HD + e0), zv = *(const v2u*)(Z + (size_t)tok * 512 + h * HD + e0);
        const float a4[4] = {bflo(av.x), bfhi(av.x), bflo(av.y), bfhi(av.y)}, z4[4] = {bflo(zv.x), bfhi(zv.x), bflo(zv.y), bfhi(zv.y)};
        float y[4];
#pragma unroll
        for (int r = 0; r < 4; ++r) y[r] = ((hs[mt][r] - mu) * rstd * w[r] + k4[r] * a4[r]) * silu_f(z4[r]);
        *(v2u*)(YM + (size_t)tok * 1024 + 512 + h * HD + e0) = (v2u){pk2(y[0], y[1]), pk2(y[2], y[3])}; MEMFENCE(); }
}

__device__ __forceinline__ void p9_conv(const Args& a, int vcu, int G) {
    const int tid = threadIdx.x, lane = tid & 63, wave = __builtin_amdgcn_readfirstlane(tid >> 6);
    const bf16* U = (const bf16*)(a.ws + WS_U); bf16* ACT = (bf16*)(a.ws + WS_ACT);
    const float* fw = a.in[19]; const float* fb = a.in[20];
    const int gw = vcu * NWAVES + wave, NGW = G * NWAVES;
    for (int it = gw; it < NB * 64 * 10; it += NGW) {
        const int qb = it % 10, br = it / 10, r = br & 63, b = br >> 6;
        const int ch = (qb * 64 + lane) * 4;
        f32x4 wv[9], wg[9];
#pragma unroll
        for (int t = 0; t < 9; ++t) { wv[t] = *(const f32x4*)(fw + t * UPW + ch); wg[t] = *(const f32x4*)(fw + t * UPW + DFF + ch); }
        const f32x4 bv = *(const f32x4*)(fb + ch), bgt = *(const f32x4*)(fb + DFF + ch);
#pragma unroll 2
        for (int c = 0; c < 64; ++c) {
            f32x4 av = bv, ag = bgt;
#pragma unroll
            for (int i = 0; i < 3; ++i) { const int rr = r + i - 1; if (rr < 0 || rr > 63) continue;
#pragma unroll
                for (int j = 0; j < 3; ++j) { const int cc = c + j - 1; if (cc < 0 || cc > 63) continue;
                    const bf16* p = U + (size_t)(b * SEQ + rr * 64 + cc) * UPW + ch;
                    const v2u xv = *(const v2u*)p, xg = *(const v2u*)(p + DFF);
                    av += wv[i * 3 + j] * (f32x4){bflo(xv.x), bfhi(xv.x), bflo(xv.y), bfhi(xv.y)};
                    ag += wg[i * 3 + j] * (f32x4){bflo(xg.x), bfhi(xg.x), bflo(xg.y), bfhi(xg.y)}; } }
            float o[4];
#pragma unroll
            for (int e = 0; e < 4; ++e) o[e] = av[e] * silu_f(ag[e]);
            *(v2u*)(ACT + (size_t)(b * SEQ + r * 64 + c) * DFF + ch) = (v2u){pk2(o[0], o[1]), pk2(o[2], o[3])};
        }
    }
}

constexpr int LDS_BYTES = 147456, MISC_OFF = 147456 - 256;
constexpr int NPHASE = 12;
#ifndef MK_PER_PHASE
#define MK_PER_PHASE 0
#endif
__global__ void __launch_bounds__(NTHR, 2) mk_fwd(Args args) {
    extern __shared__ __attribute__((aligned(16))) uchar lds_raw[];
    LAS uchar* lds = (LAS uchar*)lds_raw;
    const int tid = threadIdx.x;
    const int G = gridDim.x; const int bx = blockIdx.x; const int vcu = (G % 8 == 0) ? (bx % 8) * (G / 8) + bx / 8 : bx;
    volatile LAS unsigned* MISC = (volatile LAS unsigned*)(lds + MISC_OFF);
    if (tid < 64) MISC[tid] = 0u;
    __syncthreads();
    XcdBarrier bar; bar.bar = (unsigned*)(args.ws + WS_CTL); bar.x = 0; bar.st = nullptr;
    if (!MK_PER_PHASE) bar = xcd_barrier_post((unsigned*)(args.ws + WS_CTL), MISC + 8);
    const int lo = args.ph_lo, hi = args.ph_hi;
#ifndef PH_MASK
#define PH_MASK 0xFFF
#endif
#define IN(k) (((PH_MASK >> (k)) & 1) && lo <= (k) && (k) < hi)
#define SEAM(k) do { if (IN(k) && IN((k) + 1)) xcd_barrier(bar); } while (0)
    uchar* ws = args.ws;
    if (IN(0)) { p0_prologue(args, lds, vcu, G); } SEAM(0);
    if (IN(1)) { p1_rows(args, lds, vcu, G); } SEAM(1);
    if (IN(2)) {
        pg8::Gemm g{(const bf16*)(ws + WS_HX), (const bf16*)(ws + WS_WIN), TROWS, 2048, DM}; SchedP2 S; S.init(G, bx);
        EpiP2 E{(bf16*)(ws + WS_UF), (bf16*)(ws + WS_XM), (bf16*)(ws + WS_V), (bf16*)(ws + WS_Z)};
        pg8::gemm_phase<EpiP2, SchedP2, true, true>(lds, g, S, E);
    } SEAM(2);
    if (IN(3)) {
        for (int it = bx; it < NUNIT + 1024; it += G) { if (it < NUNIT) prep_unit(args, lds, it); else fft1_item(args, lds, it - NUNIT); }
    } SEAM(3);
    if (IN(4)) {
        for (int it = bx; it < 1024; it += G) fft2_item(args, lds, it);
        p4_scan(args, G);
    } SEAM(4);
    if (IN(5)) { for (int it = bx; it < NUNIT_L; it += G) out_unit(args, lds, it); __syncthreads(); } SEAM(5);
    if (IN(6)) {
        pg8::Gemm g{(const bf16*)(ws + WS_YM), (const bf16*)(ws + WS_WOUT), MROWS, DM, 1024}; pg8::StaticOrder S; S.init(MROWS, DM, G, bx);
        EpiRes E{args.in[0], args.out, (const float*)(ws + WS_MOD) + 2048, nullptr};
        pg8::gemm_phase<EpiRes, pg8::StaticOrder, true, true>(lds, g, S, E);
    } SEAM(6);
    if (IN(7)) { p7_rows(args, vcu, G); } SEAM(7);
    if (IN(8)) {
        pg8::Gemm g{(const bf16*)(ws + WS_H2), (const bf16*)(ws + WS_WUP), MROWS, UPW, DM}; pg8::StaticOrder S; S.init(MROWS, UPW, G, bx);
        EpiBias16 E{(bf16*)(ws + WS_U), UPW, args.in[18]};
        pg8::gemm_phase<EpiBias16, pg8::StaticOrder, true, true>(lds, g, S, E);
    } SEAM(8);
    if (IN(9)) { p9_conv(args, vcu, G); } SEAM(9);
    if (IN(10)) {
        pg8::Gemm g{(const bf16*)(ws + WS_ACT), (const bf16*)(ws + WS_WDN), MROWS, DM, DFF}; pg8::StaticOrder S; S.init(MROWS, DM, G, bx);
        EpiRes E{args.out, args.out, (const float*)(ws + WS_MOD) + 5120, args.in[22]};
        pg8::gemm_phase<EpiRes, pg8::StaticOrder, true, true>(lds, g, S, E);
    } SEAM(10);
    if (IN(11)) { p11_rows(args, vcu, G); }
#undef IN
#undef SEAM
}

extern "C" void kernel_launch(void* const* d_in, const int* in_sizes, int n_in, void* d_out, int out_size, void* d_ws, size_t ws_size, hipStream_t stream) {
    static int grid = 0;
    if (grid == 0) {
        if (n_in != 24 || out_size != MROWS * DM || ws_size < WS_END) { fprintf(stderr, "kernel_launch: unexpected problem (n_in %d, out %d, ws %zu); nothing launched\n", n_in, out_size, ws_size); grid = -1; return; }
        int dev = 0, cus = 0, per_cu = 0;
        if (hipGetDevice(&dev) != hipSuccess || hipDeviceGetAttribute(&cus, hipDeviceAttributeMultiprocessorCount, dev) != hipSuccess) { grid = -1; return; }
        if (hipFuncSetAttribute((const void*)mk_fwd, hipFuncAttributeMaxDynamicSharedMemorySize, LDS_BYTES) != hipSuccess) { fprintf(stderr, "kernel_launch: hipFuncSetAttribute failed\n"); grid = -1; return; }
        if (hipOccupancyMaxActiveBlocksPerMultiprocessor(&per_cu, (const void*)mk_fwd, NTHR, LDS_BYTES) != hipSuccess || per_cu < 1) { fprintf(stderr, "kernel_launch: occupancy query says %d blocks per CU\n", per_cu); grid = -1; (void)hipGetLastError(); return; }
        grid = cus;
    }
    if (grid < 0) return;
    (void)hipMemsetAsync((char*)d_ws + WS_ZERO0, 0, WS_ZERO_BYTES, stream);
    Args a{};
    for (int i = 0; i < 24; ++i) a.in[i] = (const float*)d_in[i];
    a.out = (float*)d_out; a.ws = (uchar*)d_ws;
#if MK_PER_PHASE
    for (int p = 0; p < NPHASE; ++p) { a.ph_lo = p; a.ph_hi = p + 1; hipLaunchKernelGGL(mk_fwd, dim3(grid), dim3(NTHR), LDS_BYTES, stream, a); }
#else
    a.ph_lo = 0; a.ph_hi = NPHASE; hipLaunchKernelGGL(mk_fwd, dim3(grid), dim3(NTHR), LDS_BYTES, stream, a);
#endif
}
```

```cpp
#include <hip/hip_runtime.h>
#include <cstdio>
#include <cstdint>
namespace pg8 {
#define PG8_LAS __attribute__((address_space(3)))
typedef unsigned short bf16_t;
typedef short bf16x8 __attribute__((ext_vector_type(8)));
typedef float f32x4 __attribute__((ext_vector_type(4)));
typedef unsigned u32x4 __attribute__((ext_vector_type(4)));
constexpr int BM = 256, BK = 64, HALF = 128, HTB = HALF * BK * 2  , STAGE_BYTES = 8 * HTB, NXCD = 8, WGM = 8;

__host__ __device__ __forceinline__ int lds_byte(int r, int c) { const int st = (r >> 4) * 2 + (c >> 5), rr = r & 15, cc = c & 31, ob = rr * 64 + cc * 2; return st * 1024 + (ob ^ (((ob >> 9) & 1) << 5)); }
__host__ __device__ __forceinline__ void stage_rc(int b, int& R, int& C) { const int st = b / 1024, sb = b % 1024, swz = sb ^ (((sb >> 9) & 1) << 5); R = (st >> 1) * 16 + swz / 64; C = (st & 1) * 32 + (swz % 64) / 2; }
__host__ __device__ __forceinline__ int perm32(int rho) { const int n = rho >> 4, i = rho & 15; return 8 * (i >> 2) + 4 * n + (i & 3); }

struct Unit { int pm, pn; };
struct Gemm { const bf16_t* A; const bf16_t* Bt; int M, N, K; };

struct StaticOrder {
    int nM, nN, nwg, G, c;
    __host__ __device__ void init(int M, int N, int G_, int c_) { nM = M / BM; nN = N / BM; nwg = nM * nN; G = G_; c = c_; }
    __host__ __device__ bool next(int i, Unit& u) const {
        const long L = (long)i * G + c; if (L >= nwg) return false;
        int wgid = (int)L; { const int q = nwg / NXCD, r = nwg % NXCD, xcd = wgid % NXCD, off = wgid / NXCD; wgid = (xcd < r ? xcd * (q + 1) : r * (q + 1) + (xcd - r) * q) + off; }
        const int nig = WGM * nN, gid = wgid / nig, fm = gid * WGM, gsz = (nM - fm) < WGM ? (nM - fm) : WGM;
        u.pm = fm + ((wgid % nig) % gsz); u.pn = (wgid % nig) / gsz; return true;
    }
    __device__ __forceinline__ void a_ready(const Unit&) const {}
    __device__ __forceinline__ void done(const Unit&) const {}
};
__device__ __forceinline__ unsigned cvt_pk_bf16(float lo, float hi) { unsigned r; asm volatile("v_cvt_pk_bf16_f32 %0, %1, %2" : "=v"(r) : "v"(lo), "v"(hi)); return r; }
template <class Epi, class Sched, bool ALIGN_EPI = false, bool SP2 = false>
__device__ __forceinline__ void gemm_phase(PG8_LAS unsigned char* lds, const Gemm g, const Sched& S, const Epi& E) {
    const int tid = threadIdx.x, wid = __builtin_amdgcn_readfirstlane(tid >> 6), lane = tid & 63, wr = wid >> 2, wc = wid & 3, fr = lane & 15, fq = lane >> 4;
    const int K = g.K, nt = K / BK;
    unsigned voffA[2], voffB[2];
#pragma unroll
    for (int i = 0; i < 2; ++i) { int R, C; stage_rc(tid * 16 + i * 8192, R, C); const int Rb = Epi::PERM ? ((R & ~31) + perm32(R & 31)) : R;
        voffA[i] = (unsigned)(R * K + C) * 2u; voffB[i] = (unsigned)(Rb * K + C) * 2u; }
    const size_t kstep = (size_t)(BK * 2);
    const size_t hstep = (size_t)HALF * K * 2;
    const size_t tstep = 2 * hstep;
    const unsigned ldsw = (unsigned)wid * 1024u;
    const int aoff = lds_byte(wr * 64 + fr, fq * 8), boff = lds_byte(wc * 32 + fr, fq * 8);
#define PG8_SA(b, h) (((b) * 2 + (h)) * HTB)
#define PG8_SB(b, h) ((4 + (b) * 2 + (h)) * HTB)
#define PG8_STAGE(bufoff, gbase, voff) do { _Pragma("unroll") for (int _i = 0; _i < 2; ++_i) \
        __builtin_amdgcn_global_load_lds((const unsigned*)((const char*)(gbase) + (voff)[_i]), (PG8_LAS unsigned*)(lds + (bufoff) + ldsw + _i * 8192), 16, 0, 0); } while (0)
#define PG8_LDA(dst, b, h) do { _Pragma("unroll") for (int m = 0; m < 4; ++m) _Pragma("unroll") for (int k = 0; k < 2; ++k) dst[m][k] = *(const PG8_LAS bf16x8*)(lds + PG8_SA(b, h) + aoff + m * 2048 + k * 1024); } while (0)
#define PG8_LDB(dst, b, h) do { _Pragma("unroll") for (int n = 0; n < 2; ++n) _Pragma("unroll") for (int k = 0; k < 2; ++k) dst[n][k] = *(const PG8_LAS bf16x8*)(lds + PG8_SB(b, h) + boff + n * 2048 + k * 1024); } while (0)
#define PG8_MMA(ai, bj, At, Bt) do { __builtin_amdgcn_s_setprio(1); _Pragma("unroll") for (int m = 0; m < 4; ++m) _Pragma("unroll") for (int n = 0; n < 2; ++n) _Pragma("unroll") for (int k = 0; k < 2; ++k) \
        acc[ai][bj][m][n] = __builtin_amdgcn_mfma_f32_16x16x32_bf16(Bt[n][k], At[m][k], acc[ai][bj][m][n], 0, 0, 0); __builtin_amdgcn_s_setprio(0); } while (0)
#define PG8_WAIT_V(n) asm volatile("s_waitcnt vmcnt(" #n ")" ::: "memory")
#define PG8_WAIT_L(n) asm volatile("s_waitcnt lgkmcnt(" #n ")" ::: "memory")
#define PG8_BAR __builtin_amdgcn_s_barrier()
#define PG8_SCHED __builtin_amdgcn_sched_barrier(0)
    Unit cur, nxt; int ui = 0;
    if (!S.next(0, cur)) return;
    f32x4 acc[2][2][4][2];
#pragma unroll
    for (int a = 0; a < 2; ++a)
#pragma unroll
        for (int b = 0; b < 2; ++b)
#pragma unroll
            for (int m = 0; m < 4; ++m)
#pragma unroll
                for (int n = 0; n < 2; ++n) acc[a][b][m][n] = (f32x4){0.f, 0.f, 0.f, 0.f};
    bf16x8 At[4][2], B0[2][2], B1[2][2];
    const char* cA = (const char*)g.A + (size_t)cur.pm * tstep; const char* cB = (const char*)g.Bt + (size_t)cur.pn * tstep;
    S.a_ready(cur);
    if constexpr (SP2) {
        PG8_STAGE(PG8_SB(0, 0), cB, voffB); PG8_STAGE(PG8_SB(0, 1), cB + hstep, voffB); PG8_STAGE(PG8_SA(0, 0), cA, voffA); PG8_STAGE(PG8_SA(0, 1), cA + hstep, voffA);
        if (wr == 1) PG8_BAR;
        PG8_WAIT_V(2); PG8_BAR;
        PG8_STAGE(PG8_SB(1, 0), cB + kstep, voffB); PG8_STAGE(PG8_SA(1, 0), cA + kstep, voffA); PG8_STAGE(PG8_SB(1, 1), cB + hstep + kstep, voffB);
        PG8_WAIT_V(6); PG8_BAR;
    } else {
        PG8_STAGE(PG8_SB(0, 0), cB, voffB); PG8_STAGE(PG8_SA(0, 0), cA, voffA); PG8_STAGE(PG8_SB(0, 1), cB + hstep, voffB); PG8_STAGE(PG8_SA(0, 1), cA + hstep, voffA);
        if (wr == 1) PG8_BAR;
        PG8_WAIT_V(4); PG8_BAR;
        PG8_STAGE(PG8_SB(1, 0), cB + kstep, voffB); PG8_STAGE(PG8_SA(1, 0), cA + kstep, voffA); PG8_STAGE(PG8_SB(1, 1), cB + hstep + kstep, voffB);
        PG8_WAIT_V(6); PG8_BAR;
    }
    for (;;) {
        const bool has_next = S.next(ui + 1, nxt);
        const char* nA = has_next ? (const char*)g.A + (size_t)nxt.pm * tstep : cA; const char* nB = has_next ? (const char*)g.Bt + (size_t)nxt.pn * tstep : cB;
        for (int t = 0; t < nt; t += 2) {
            const bool last = (t == nt - 2);
            const char* a1 = cA + (size_t)(t + 1) * kstep;
            const char* a2 = last ? nA : cA + (size_t)(t + 2) * kstep; const char* b2 = last ? nB : cB + (size_t)(t + 2) * kstep;
            const char* a3 = a2 + kstep; const char* b3 = b2 + kstep;
            if (last && has_next) S.a_ready(nxt);
            if constexpr (SP2) {
            PG8_LDB(B0, 0, 0); PG8_LDB(B1, 0, 1); PG8_SCHED; PG8_LDA(At, 0, 0); PG8_STAGE(PG8_SA(1, 1), a1 + hstep, voffA);
            PG8_WAIT_V(8); PG8_WAIT_L(0); PG8_BAR; PG8_MMA(0, 0, At, B0); PG8_MMA(0, 1, At, B1); PG8_BAR; PG8_SCHED;
            PG8_LDA(At, 0, 1); PG8_STAGE(PG8_SB(0, 0), b2, voffB); PG8_STAGE(PG8_SB(0, 1), b2 + hstep, voffB); PG8_STAGE(PG8_SA(0, 0), a2, voffA);
            PG8_WAIT_V(8); PG8_WAIT_L(0); PG8_BAR; PG8_MMA(1, 0, At, B0); PG8_MMA(1, 1, At, B1); PG8_BAR; PG8_SCHED;
            PG8_LDB(B0, 1, 0); PG8_LDB(B1, 1, 1); PG8_SCHED; PG8_LDA(At, 1, 0); PG8_STAGE(PG8_SA(0, 1), a2 + hstep, voffA);
            PG8_WAIT_V(8); PG8_WAIT_L(0); PG8_BAR; PG8_MMA(0, 0, At, B0); PG8_MMA(0, 1, At, B1); PG8_BAR; PG8_SCHED;
            PG8_LDA(At, 1, 1); PG8_STAGE(PG8_SB(1, 0), b3, voffB); PG8_STAGE(PG8_SB(1, 1), b3 + hstep, voffB); PG8_STAGE(PG8_SA(1, 0), a3, voffA);
            PG8_WAIT_V(8); PG8_WAIT_L(0); PG8_BAR; PG8_MMA(1, 0, At, B0); PG8_MMA(1, 1, At, B1); PG8_BAR; PG8_SCHED;
            } else {
            PG8_LDB(B0, 0, 0); PG8_SCHED; PG8_LDA(At, 0, 0); PG8_STAGE(PG8_SA(1, 1), a1 + hstep, voffA);
            PG8_WAIT_L(8); PG8_BAR; PG8_WAIT_L(0); PG8_MMA(0, 0, At, B0); PG8_BAR; PG8_SCHED;
            PG8_LDB(B1, 0, 1); PG8_STAGE(PG8_SB(0, 0), b2, voffB);
            PG8_BAR; PG8_WAIT_L(0); PG8_MMA(0, 1, At, B1); PG8_BAR;
            PG8_LDA(At, 0, 1); PG8_STAGE(PG8_SA(0, 0), a2, voffA);
            PG8_BAR; PG8_WAIT_L(0); PG8_MMA(1, 0, At, B0); PG8_BAR; PG8_SCHED;
            PG8_STAGE(PG8_SB(0, 1), b2 + hstep, voffB);
            PG8_WAIT_V(6); PG8_BAR; PG8_MMA(1, 1, At, B1); PG8_BAR;
            PG8_LDB(B0, 1, 0); PG8_SCHED; PG8_LDA(At, 1, 0); PG8_STAGE(PG8_SA(0, 1), a2 + hstep, voffA);
            PG8_WAIT_L(8); PG8_BAR; PG8_WAIT_L(0); PG8_MMA(0, 0, At, B0); PG8_BAR; PG8_SCHED;
            PG8_LDB(B1, 1, 1); PG8_STAGE(PG8_SB(1, 0), b3, voffB);
            PG8_BAR; PG8_WAIT_L(0); PG8_MMA(0, 1, At, B1); PG8_BAR;
            PG8_LDA(At, 1, 1); PG8_STAGE(PG8_SA(1, 0), a3, voffA);
            PG8_BAR; PG8_WAIT_L(0); PG8_MMA(1, 0, At, B0); PG8_BAR; PG8_SCHED;
            PG8_STAGE(PG8_SB(1, 1), b3 + hstep, voffB);
            PG8_WAIT_V(6); PG8_BAR; PG8_MMA(1, 1, At, B1); PG8_BAR;
            }
        }
        if constexpr (ALIGN_EPI) { if (wr == 0) PG8_BAR; }
        if constexpr (!Epi::AFTER_DRAIN) { E(acc, cur, wr, wc, fr, fq); S.done(cur); }
        if (!has_next) break;
#pragma unroll
        for (int a = 0; a < 2; ++a)
#pragma unroll
            for (int b = 0; b < 2; ++b)
#pragma unroll
                for (int m = 0; m < 4; ++m)
#pragma unroll
                    for (int n = 0; n < 2; ++n) acc[a][b][m][n] = (f32x4){0.f, 0.f, 0.f, 0.f};
        cur = nxt; cA = nA; cB = nB; ++ui;
        if constexpr (ALIGN_EPI) { if (wr == 1) PG8_BAR; }
    }
    PG8_WAIT_V(0);
    if constexpr (!ALIGN_EPI) { if (wr == 0) PG8_BAR; }
    PG8_BAR;
    if constexpr (Epi::AFTER_DRAIN) { E.fused(acc, cur, wr, wc, fr, fq, lds, wid, lane); S.done(cur); }
#undef PG8_SA
#undef PG8_SB
#undef PG8_STAGE
#undef PG8_LDA
#undef PG8_LDB
#undef PG8_MMA
#undef PG8_WAIT_V
#undef PG8_WAIT_L
#undef PG8_BAR
#undef PG8_SCHED
}
}

#define GAS __attribute__((address_space(1)))
#define LAS __attribute__((address_space(3)))
typedef unsigned short bf16;
typedef unsigned char uchar;
typedef unsigned v4u __attribute__((ext_vector_type(4)));
typedef unsigned v2u __attribute__((ext_vector_type(2)));
typedef float f32x4 __attribute__((ext_vector_type(4)));
typedef float f32x2 __attribute__((ext_vector_type(2)));
typedef short bf16x8 __attribute__((ext_vector_type(8)));
#define LDS_WAIT() asm volatile("s_waitcnt lgkmcnt(0)" ::: "memory")
#define VM_WAIT() asm volatile("s_waitcnt vmcnt(0)" ::: "memory")

constexpr int NWAVES = 8, NTHR = 512;
constexpr int NB = 8, SEQ = 4096, DM = 1024, CTXL = 256;
constexpr int MROWS = NB * SEQ;
constexpr int CROWS = NB * CTXL;
constexpr int TROWS = MROWS + CROWS;
constexpr int NHEAD = 4, HD = 128, INW = 2064, DFF = 2560, UPW = 5120;
constexpr float EPS = 1e-6f;
constexpr int NUNIT_L = NB * NHEAD * 32, NUNIT_C = NB * NHEAD * 2, NUNIT = NUNIT_L + NUNIT_C;
constexpr int CT_SLOT = 129 * 128;

constexpr size_t MiB = 1u << 20;
constexpr size_t WS_HX = 0, WS_TP = 0, WS_H2 = 0, WS_ACT = 0;
constexpr size_t WS_UF = 68 * MiB, WS_XM = 100 * MiB, WS_CT = 68 * MiB;
constexpr size_t WS_G = 134 * MiB, WS_SC = 137 * MiB, WS_MS = 138 * MiB;
constexpr size_t WS_V = 160 * MiB, WS_Z = 194 * MiB, WS_DC = 226 * MiB, WS_YM = 364 * MiB, WS_U = 160 * MiB;
constexpr size_t WS_WIN = 480 * MiB, WS_WOUT = 484 * MiB, WS_WUP = 486 * MiB, WS_WDN = 496 * MiB, WS_WQ = 501 * MiB, WS_WK = WS_WQ + 131072;
constexpr size_t WS_F1 = 502 * MiB, WS_G2 = WS_F1 + 16384, WS_TW = WS_G2 + 16384;
constexpr size_t WS_MOD = 503 * MiB, WS_CTL = 504 * MiB, WS_ZERO0 = WS_MOD, WS_ZERO_BYTES = 2 * MiB, WS_END = 512 * MiB;
static_assert(WS_DC + (size_t)NUNIT * 2 * CT_SLOT * 4 <= WS_YM && WS_YM + (size_t)MROWS * 1024 * 2 <= WS_U + (size_t)MROWS * UPW * 2 && WS_U + (size_t)MROWS * UPW * 2 <= WS_WIN, "ws map");
static_assert(WS_CT + (size_t)NUNIT_L * 2 * CT_SLOT * 2 <= WS_G && WS_XM + (size_t)TROWS * 512 * 2 <= WS_G && (size_t)MROWS * DFF * 2 <= WS_U, "ws map 2");
constexpr size_t DO_AB = 0, DO_Q = 32 * MiB, DO_K = 64 * MiB;

__device__ __forceinline__ unsigned f2bf(float f) { unsigned u = __builtin_bit_cast(unsigned, f); return (u + 0x7fffu + ((u >> 16) & 1u)) >> 16; }
__device__ __forceinline__ unsigned pk2(float lo, float hi) { return f2bf(lo) | (f2bf(hi) << 16); }
__device__ __forceinline__ float bflo(unsigned w) { return __builtin_bit_cast(float, w << 16); }
__device__ __forceinline__ float bfhi(unsigned w) { return __builtin_bit_cast(float, w & 0xffff0000u); }
__device__ __forceinline__ float silu_f(float x) { return x / (1.0f + __expf(-x)); }
__device__ __forceinline__ float logsig_f(float x) { return fminf(x, 0.f) - log1pf(__expf(-fabsf(x))); }
__device__ __forceinline__ float wave_sum(float v) {
#pragma unroll
    for (int o = 1; o < 64; o <<= 1) v += __shfl_xor(v, o);
    return v;
}
__device__ __forceinline__ int img_off(int row, int ch) { return row * 256 + ((ch ^ (row & 15)) << 4); }
struct BFrag { bf16x8 f[4]; };
__device__ __forceinline__ BFrag load_bfrag(const LAS uchar* Bimg, int brow, int kq) { BFrag b;
#pragma unroll
    for (int s = 0; s < 4; ++s) b.f[s] = *(const LAS bf16x8*)(Bimg + img_off(brow, 4 * s + kq));
    return b; }
__device__ __forceinline__ f32x4 mma_a(f32x4 acc, const LAS uchar* Aimg, int arow, const BFrag& b, int kq) {
    bf16x8 a[4];
#pragma unroll
    for (int s = 0; s < 4; ++s) a[s] = *(const LAS bf16x8*)(Aimg + img_off(arow, 4 * s + kq));
#pragma unroll
    for (int s = 0; s < 4; ++s) acc = __builtin_amdgcn_mfma_f32_16x16x32_bf16(a[s], b.f[s], acc, 0, 0, 0);
    return acc; }
#define MEMFENCE() asm volatile("" ::: "memory")

#define XB_TMO      128
#define XB_XCNT(j)  (256  + 64 * (j))
#define XB_XSUB(j)  (1280 + 64 * (j))
#define XB_XGEN(j)  (2304 + 64 * (j))
#define XB_TOP      3328
#define XB_TOPGEN   3392
#define XCD_BAR_WORDS 3456
#define XB_SPIN_CAP (1u << 18)

__device__ __forceinline__ unsigned xb_ld(unsigned* p)              { return __hip_atomic_load(p, __ATOMIC_RELAXED, __HIP_MEMORY_SCOPE_AGENT); }
__device__ __forceinline__ unsigned xb_add(unsigned* p, unsigned v) { return __hip_atomic_fetch_add(p, v, __ATOMIC_RELAXED, __HIP_MEMORY_SCOPE_AGENT); }
__device__ __forceinline__ unsigned xb_xcc_id() { return (unsigned)__builtin_amdgcn_s_getreg((3 << 11) | 20) & 0xFu; }
#define XB_SPIN(cond, bar) do { unsigned _sp = 0; while (cond) { __builtin_amdgcn_s_sleep(1); \
    if ((++_sp & 255u) == 0u) { if (xb_ld(&(bar)[XB_TMO])) break; if (_sp > XB_SPIN_CAP) { atomicAdd(&(bar)[XB_TMO], 1u); break; } } } } while (0)

struct XcdBarrier {
    unsigned* bar; unsigned x;
    volatile LAS unsigned* st;
};

__device__ __forceinline__ XcdBarrier xcd_barrier_post(unsigned* bar, volatile LAS unsigned* st) {
    XcdBarrier b; b.bar = bar; b.x = xb_xcc_id(); b.st = st;
    if (threadIdx.x == 0) (void)xb_add(&bar[XB_XCNT(b.x)], 1u);
    return b;
}
__device__ __forceinline__ void xcd_barrier_complete(unsigned* bar, unsigned x, unsigned& nloc, unsigned& nx) {
    const unsigned G = gridDim.x * gridDim.y * gridDim.z;
    unsigned sum, cnt, mine, sp = 0u;
    for (;;) {
        sum = 0u; cnt = 0u; mine = 0u;
#pragma unroll
        for (unsigned j = 0; j < 16; ++j) { const unsigned c = xb_ld(&bar[XB_XCNT(j)]); sum += c; cnt += (c > 0u) ? 1u : 0u; mine = (j == x) ? c : mine; }
        if (sum == G) break;
        __builtin_amdgcn_s_sleep(1);
        if ((++sp & 255u) == 0u) { if (xb_ld(&bar[XB_TMO])) break; if (sp > XB_SPIN_CAP) { atomicAdd(&bar[XB_TMO], 1u); break; } }
    }
    nloc = mine > 0u ? mine : 1u; nx = cnt > 0u ? cnt : 1u;
}

__device__ __forceinline__ void xcd_barrier(const XcdBarrier& b) {
    asm volatile("s_waitcnt vmcnt(0)" ::: "memory");
    __syncthreads();
    if (threadIdx.x == 0) {
        unsigned* bar = b.bar;
        __builtin_amdgcn_s_waitcnt(0);
        unsigned nloc = b.st[0], nx = b.st[1];
        if (nloc == 0u) { xcd_barrier_complete(bar, b.x, nloc, nx); b.st[0] = nloc; b.st[1] = nx; }
        const unsigned old = xb_add(&bar[XB_XSUB(b.x)], 1u);
        const unsigned gen = old / nloc;
        if (old + 1u == (gen + 1u) * nloc) {
            __builtin_amdgcn_fence(__ATOMIC_RELEASE, "agent");
            asm volatile("s_waitcnt vmcnt(0)" ::: "memory");
            const unsigned og = xb_add(&bar[XB_TOP], 1u);
            const unsigned tg = og / nx;
            if (og + 1u == (tg + 1u) * nx) xb_add(&bar[XB_TOPGEN], 1u);
            else XB_SPIN(xb_ld(&bar[XB_TOPGEN]) == tg, bar);
            __builtin_amdgcn_fence(__ATOMIC_ACQUIRE, "agent");
            xb_add(&bar[XB_XGEN(b.x)], 1u);
            asm volatile("s_waitcnt vmcnt(0)" ::: "memory");
        } else {
            XB_SPIN(xb_ld(&bar[XB_XGEN(b.x)]) == gen, bar);
            __builtin_amdgcn_fence(__ATOMIC_ACQUIRE, "agent");
            asm volatile("s_waitcnt vmcnt(0)" ::: "memory");
        }
    }
    __syncthreads();
}


struct Args { const float* in[24]; float* out; uchar* ws; int ph_lo, ph_hi; };

template <class F>
__device__ __forceinline__ void tr_item(F src, bf16* WT, size_t drow0, int ldk, int dk0, LAS float* scr, int lane) {
#pragma unroll 4
    for (int i = 0; i < 32; ++i) { const int kk = 2 * i + (lane >> 5); scr[kk * 33 + (lane & 31)] = src(kk, lane & 31); }
    LDS_WAIT(); asm volatile("" ::: "memory");
    const int c = lane & 7;
#pragma unroll
    for (int j = 0; j < 4; ++j) { const int n = (lane >> 3) + 8 * j; const LAS float* s = scr + (8 * c) * 33 + n;
        v4u o; o.x = pk2(s[0 * 33], s[1 * 33]); o.y = pk2(s[2 * 33], s[3 * 33]); o.z = pk2(s[4 * 33], s[5 * 33]); o.w = pk2(s[6 * 33], s[7 * 33]);
        *(v4u*)(WT + (drow0 + n) * ldk + dk0 + 8 * c) = o; }
    LDS_WAIT(); asm volatile("" ::: "memory");
}

__device__ __forceinline__ void p0_prologue(const Args& a, LAS uchar* lds, int vcu, int G) {
    const int tid = threadIdx.x, lane = tid & 63, wave = __builtin_amdgcn_readfirstlane(tid >> 6);
    uchar* ws = a.ws;
    {
        LAS float* sl = (LAS float*)lds;
        float* MOD = (float*)(ws + WS_MOD);
        const float* w_ada = a.in[4]; const float* b_ada = a.in[5];
        for (int it = blockIdx.x; it < 32 * 12; it += G) {
            const int kc = it / 12, nb = it % 12;
            __syncthreads();
            if (tid < 288) { const int r = tid >> 5, kk = tid & 31; const float cv = (r < 8) ? a.in[1][r * DM + kc * 32 + kk] : a.in[3][kc * 32 + kk]; sl[tid] = silu_f(cv); }
            __syncthreads();
            const int n = nb * 512 + tid;
            float acc[9];
#pragma unroll
            for (int r = 0; r < 9; ++r) acc[r] = 0.f;
#pragma unroll 8
            for (int kk = 0; kk < 32; ++kk) { const float w = w_ada[(size_t)(kc * 32 + kk) * 6144 + n];
#pragma unroll
                for (int r = 0; r < 9; ++r) acc[r] += sl[r * 32 + kk] * w; }
            const float bb = (kc == 0) ? b_ada[n] : 0.f;
#pragma unroll
            for (int r = 0; r < 9; ++r) atomicAdd(&MOD[r * 6144 + n], acc[r] + bb);
        }
        __syncthreads();
    }
    {
        LAS float* tab = (LAS float*)(lds + 8 * 16384);
        if (tid < 128) tab[tid] = cospif((float)tid * (1.0f / 64.0f)) * 0.08838834764831845f;
        __syncthreads();
        const int gt = blockIdx.x * NTHR + tid;
        bf16* F1 = (bf16*)(ws + WS_F1); bf16* G2 = (bf16*)(ws + WS_G2); float* TW = (float*)(ws + WS_TW);
        if (gt < 8192) { const int row = gt >> 6, n1 = gt & 63, ri = row >> 6, k1 = row & 63; const float ang = (float)((k1 * n1) & 63) * (1.0f / 32.0f);
            F1[gt] = (bf16)f2bf((ri == 0 ? cospif(ang) : -sinpif(ang)) * 0.125f); }
        else if (gt < 16384) { const int i = gt - 8192, k2 = i >> 7, kap = i & 127, n2 = kap & 63; const float ang = (float)((k2 * n2) & 63) * (1.0f / 32.0f);
            G2[i] = (bf16)f2bf((kap < 64 ? cospif(ang) : sinpif(ang)) * 0.125f); }
        else if (gt < 16384 + 4096) { const int i = gt - 16384; TW[i] = cospif((float)i * (1.0f / 2048.0f)); }
    }
    {
        const LAS float* tab = (const LAS float*)(lds + 8 * 16384);
        LAS float* Tm = (LAS float*)lds;
        LAS float* wT = (LAS float*)(lds + 65536);
        const float* w_in = a.in[7]; bf16* WIN = (bf16*)(a.ws + WS_WIN);
        bool have_T = false;
        for (int it = blockIdx.x; it < 64; it += G) {
            const int g = it >> 4, k0 = (it & 15) * 64;
            __syncthreads();
            if (!have_T) { for (int id = tid; id < 128 * 128; id += NTHR) { const int c = id >> 7, s_ = id & 127; const int mult = (s_ <= 64) ? s_ : (s_ - 64), off = (s_ <= 64) ? 0 : 96; Tm[id] = tab[(c * mult + off) & 127]; } have_T = true; }
            for (int id = tid; id < 64 * 32; id += NTHR) { const int kk = id >> 5, c4 = id & 31; const f32x4 v = *(const f32x4*)(w_in + (size_t)(k0 + kk) * INW + g * 128 + 4 * c4);
                wT[(4 * c4 + 0) * 64 + kk] = v.x; wT[(4 * c4 + 1) * 64 + kk] = v.y; wT[(4 * c4 + 2) * 64 + kk] = v.z; wT[(4 * c4 + 3) * 64 + kk] = v.w; }
            __syncthreads();
            const int s4 = (tid & 31) * 4, k4 = (tid >> 5) * 4;
            f32x4 acc[4];
#pragma unroll
            for (int j = 0; j < 4; ++j) acc[j] = (f32x4){0.f, 0.f, 0.f, 0.f};
#pragma unroll 4
            for (int c = 0; c < 128; ++c) { const f32x4 tv = *(const LAS f32x4*)(Tm + c * 128 + s4), wv_ = *(const LAS f32x4*)(wT + c * 64 + k4);
                acc[0] += wv_ * tv.x; acc[1] += wv_ * tv.y; acc[2] += wv_ * tv.z; acc[3] += wv_ * tv.w; }
#pragma unroll
            for (int j = 0; j < 4; ++j) *(v2u*)(WIN + (size_t)(g * 128 + s4 + j) * DM + k0 + k4) = (v2u){pk2(acc[j].x, acc[j].y), pk2(acc[j].z, acc[j].w)};
        }
        __syncthreads();
    }
    {
        LAS float* scr = (LAS float*)(lds + wave * 16384);
        const LAS float* tab = (const LAS float*)(lds + 8 * 16384);
        const int gw = vcu * NWAVES + wave, NGW = G * NWAVES;
        const float* w_in = a.in[7]; const float* w_out = a.in[15]; const float* w_up = a.in[17]; const float* w_dn = a.in[21];
        const float* w_q = a.in[10]; const float* w_k = a.in[11];
        bf16* WIN = (bf16*)(ws + WS_WIN); bf16* WOUT = (bf16*)(ws + WS_WOUT); bf16* WUP = (bf16*)(ws + WS_WUP); bf16* WDN = (bf16*)(ws + WS_WDN);
        bf16* WQ = (bf16*)(ws + WS_WQ); bf16* WK = (bf16*)(ws + WS_WK);
        constexpr int I_XV = 16 * 32, I_Z = 16 * 16, I_OF = 8 * 32, I_OM = 8 * 32, I_UP = 16 * 160, I_DN = 40 * 32, I_QK = 2 * 4 * 4;
        constexpr int NIT = I_XV + I_Z + I_OF + I_OM + I_UP + I_DN + 2 * I_QK;
        for (int it = gw; it < NIT; it += NGW) {
            int r = it;
            if (r < I_XV) { const int kb = r / 32, nb = r % 32, k0 = kb * 64, n0 = nb * 32;
                auto src = [&](int kk, int nn) -> float { return w_in[(size_t)(k0 + kk) * INW + 512 + n0 + nn]; };
                tr_item(src, WIN, (size_t)(512 + n0), DM, k0, scr, lane); continue; } r -= I_XV;
            if (r < I_Z) { const int kb = r / 16, nb = r % 16, k0 = kb * 64, n0 = nb * 32;
                auto src = [&](int kk, int nn) -> float { return w_in[(size_t)(k0 + kk) * INW + 1552 + n0 + nn]; };
                tr_item(src, WIN, (size_t)(1536 + n0), DM, k0, scr, lane); continue; } r -= I_Z;
            if (r < I_OF) { const int kb = r / 32, nb = r % 32, k0 = kb * 64, n0 = nb * 32;
                auto src = [&](int kk, int nn) -> float { const int k = k0 + kk, g = k >> 7, s = k & 127; const float* wo = w_out + (size_t)(g * 128) * DM + n0 + nn;
                    if (s == 0 || s == 64) return wo[(size_t)s * DM];
                    if (s < 64) return wo[(size_t)s * DM] + wo[(size_t)(128 - s) * DM];
                    const int kq = s - 64; return wo[(size_t)(128 - kq) * DM] - wo[(size_t)kq * DM]; };
                tr_item(src, WOUT, (size_t)n0, DM, k0, scr, lane); continue; } r -= I_OF;
            if (r < I_OM) { const int kb = r / 32, nb = r % 32, k0 = kb * 64, n0 = nb * 32;
                auto src = [&](int kk, int nn) -> float { return w_out[(size_t)(512 + k0 + kk) * DM + n0 + nn]; };
                tr_item(src, WOUT, (size_t)n0, DM, 512 + k0, scr, lane); continue; } r -= I_OM;
            if (r < I_UP) { const int kb = r / 160, nb = r % 160, k0 = kb * 64, n0 = nb * 32;
                auto src = [&](int kk, int nn) -> float { return w_up[(size_t)(k0 + kk) * UPW + n0 + nn]; };
                tr_item(src, WUP, (size_t)n0, DM, k0, scr, lane); continue; } r -= I_UP;
            if (r < I_DN) { const int kb = r / 32, nb = r % 32, k0 = kb * 64, n0 = nb * 32;
                auto src = [&](int kk, int nn) -> float { return w_dn[(size_t)(k0 + kk) * DM + n0 + nn]; };
                tr_item(src, WDN, (size_t)n0, DFF, k0, scr, lane); continue; } r -= I_DN;
            {   const bool isk = r >= I_QK; if (isk) r -= I_QK;
                const int h = r / 8, kb = (r % 8) / 4, nb = r % 4, k0 = kb * 64, n0 = nb * 32;
                const float* W = (isk ? w_k : w_q) + (size_t)h * HD * HD; const float sc = isk ? 0.08838834764831845f : 1.0f;
                auto src = [&](int kk, int nn) -> float { return W[(size_t)(k0 + kk) * HD + n0 + nn] * sc; };
                tr_item(src, (isk ? WK : WQ) + (size_t)h * HD * HD, (size_t)n0, HD, k0, scr, lane); }
        }
    }
}

__device__ __forceinline__ void p1_rows(const Args& a, LAS uchar* lds, int vcu, int G) {
    const int tid = threadIdx.x, lane = tid & 63, wave = __builtin_amdgcn_readfirstlane(tid >> 6);
    uchar* ws = a.ws;
    {
        LAS f32x4* wg = (LAS f32x4*)lds;
        const float* w_in = a.in[7];
        for (int id = tid; id < 4096; id += NTHR) { const int k = id >> 2, q = id & 3; const int l = (k & 255) >> 2, i = k & 3, j = k >> 8;
            wg[((j * 4 + i) * 4 + q) * 64 + l] = *(const f32x4*)(w_in + (size_t)k * INW + 1536 + 4 * q); }
        __syncthreads();
    }
    const LAS f32x4* wg = (const LAS f32x4*)lds;
    const float* MOD = (const float*)(ws + WS_MOD);
    const float* nw = a.in[6]; const float* bg = a.in[12];
    bf16* HX = (bf16*)(ws + WS_HX); float* GG = (float*)(ws + WS_G);
    const int gw = vcu * NWAVES + wave, NGW = G * NWAVES;
    for (int row = gw; row < TROWS; row += NGW) {
        const float* xr; const float* md;
        if (row < MROWS) { xr = a.in[0] + (size_t)row * DM; md = MOD + (size_t)(row >> 12) * 6144; }
        else { xr = a.in[2] + (size_t)(row - MROWS) * DM; md = MOD + (size_t)8 * 6144; }
        f32x4 v[4]; float s = 0.f;
#pragma unroll
        for (int j = 0; j < 4; ++j) { v[j] = *(const f32x4*)(xr + 4 * lane + 256 * j); s += (v[j].x * v[j].x + v[j].y * v[j].y) + (v[j].z * v[j].z + v[j].w * v[j].w); }
        const float rstd = rsqrtf(wave_sum(s) * (1.0f / DM) + EPS);
        float g[16];
#pragma unroll
        for (int i = 0; i < 16; ++i) g[i] = 0.f;
#pragma unroll
        for (int j = 0; j < 4; ++j) {
            const f32x4 w = *(const f32x4*)(nw + 4 * lane + 256 * j), sh = *(const f32x4*)(md + 4 * lane + 256 * j), sc = *(const f32x4*)(md + 1024 + 4 * lane + 256 * j);
            v[j] = v[j] * rstd * w * (sc + 1.0f) + sh;
            *(v2u*)(HX + (size_t)row * DM + 4 * lane + 256 * j) = (v2u){pk2(v[j].x, v[j].y), pk2(v[j].z, v[j].w)};
        }
#pragma unroll
        for (int j = 0; j < 4; ++j) {
#pragma unroll
            for (int i = 0; i < 4; ++i) {
#pragma unroll
                for (int q = 0; q < 4; ++q) { const f32x4 ww = wg[((j * 4 + i) * 4 + q) * 64 + lane];
                    g[4 * q + 0] += v[j][i] * ww.x; g[4 * q + 1] += v[j][i] * ww.y; g[4 * q + 2] += v[j][i] * ww.z; g[4 * q + 3] += v[j][i] * ww.w; }
                if (i & 1) MEMFENCE(); }
        }
        float g8[8], g4[4], g2[2], g1;
        { const bool hi = (lane & 32) != 0;
#pragma unroll
          for (int i = 0; i < 8; ++i) { const float keep = hi ? g[i + 8] : g[i], send = hi ? g[i] : g[i + 8]; g8[i] = keep + __shfl_xor(send, 32); } }
        { const bool hi = (lane & 16) != 0;
#pragma unroll
          for (int i = 0; i < 4; ++i) { const float keep = hi ? g8[i + 4] : g8[i], send = hi ? g8[i] : g8[i + 4]; g4[i] = keep + __shfl_xor(send, 16); } }
        { const bool hi = (lane & 8) != 0;
#pragma unroll
          for (int i = 0; i < 2; ++i) { const float keep = hi ? g4[i + 2] : g4[i], send = hi ? g4[i] : g4[i + 2]; g2[i] = keep + __shfl_xor(send, 8); } }
        { const bool hi = (lane & 4) != 0; const float keep = hi ? g2[1] : g2[0], send = hi ? g2[0] : g2[1]; g1 = keep + __shfl_xor(send, 4); }
        g1 += __shfl_xor(g1, 2); g1 += __shfl_xor(g1, 1);
        if ((lane & 3) == 0) { const int idx = ((lane & 32) ? 8 : 0) + ((lane & 16) ? 4 : 0) + ((lane & 8) ? 2 : 0) + ((lane & 4) ? 1 : 0); GG[(size_t)row * 16 + idx] = g1 + bg[idx]; }
    }
}
__device__ __forceinline__ void p7_rows(const Args& a, int vcu, int G) {
    const int tid = threadIdx.x, lane = tid & 63, wave = __builtin_amdgcn_readfirstlane(tid >> 6);
    const float* MOD = (const float*)(a.ws + WS_MOD); const float* nw = a.in[16]; bf16* H2 = (bf16*)(a.ws + WS_H2);
    const int gw = vcu * NWAVES + wave, NGW = G * NWAVES;
    for (int row = gw; row < MROWS; row += NGW) {
        const float* xr = a.out + (size_t)row * DM; const float* md = MOD + (size_t)(row >> 12) * 6144;
        f32x4 v[4]; float s = 0.f;
#pragma unroll
        for (int j = 0; j < 4; ++j) { v[j] = *(const f32x4*)(xr + 4 * lane + 256 * j); s += (v[j].x * v[j].x + v[j].y * v[j].y) + (v[j].z * v[j].z + v[j].w * v[j].w); }
        const float rstd = rsqrtf(wave_sum(s) * (1.0f / DM) + EPS);
#pragma unroll
        for (int j = 0; j < 4; ++j) {
            const f32x4 w = *(const f32x4*)(nw + 4 * lane + 256 * j), sh = *(const f32x4*)(md + 3072 + 4 * lane + 256 * j), sc = *(const f32x4*)(md + 4096 + 4 * lane + 256 * j);
            const f32x4 hv = v[j] * rstd * w * (sc + 1.0f) + sh;
            *(v2u*)(H2 + (size_t)row * DM + 4 * lane + 256 * j) = (v2u){pk2(hv.x, hv.y), pk2(hv.z, hv.w)}; }
    }
}
__device__ __forceinline__ void p11_rows(const Args& a, int vcu, int G) {
    const int tid = threadIdx.x, lane = tid & 63, wave = __builtin_amdgcn_readfirstlane(tid >> 6);
    const float* nw = a.in[23];
    const int gw = vcu * NWAVES + wave, NGW = G * NWAVES;
    for (int row = gw; row < MROWS; row += NGW) {
        float* xr = a.out + (size_t)row * DM;
        f32x4 v[4]; float s = 0.f;
#pragma unroll
        for (int j = 0; j < 4; ++j) { v[j] = *(const f32x4*)(xr + 4 * lane + 256 * j); s += (v[j].x * v[j].x + v[j].y * v[j].y) + (v[j].z * v[j].z + v[j].w * v[j].w); }
        const float rstd = rsqrtf(wave_sum(s) * (1.0f / DM) + EPS);
#pragma unroll
        for (int j = 0; j < 4; ++j) { const f32x4 w = *(const f32x4*)(nw + 4 * lane + 256 * j); *(f32x4*)(xr + 4 * lane + 256 * j) = v[j] * rstd * w; }
    }
}

struct SchedP2 {
    pg8::StaticOrder so;
    __device__ void init(int G, int c) { so.init(MROWS, 2048, G, c); }
    __device__ bool next(int i, pg8::Unit& u) const {
        const long L = (long)i * so.G + so.c;
        if (L < so.nwg) return so.next(i, u);
        const int r = (int)(L - so.nwg); if (r >= 32) return false;
        u.pm = 128 + (r & 7); u.pn = 2 + (r >> 3); return true;
    }
    __device__ __forceinline__ void a_ready(const pg8::Unit&) const {}
    __device__ __forceinline__ void done(const pg8::Unit&) const {}
};
struct EpiP2 {
    static constexpr bool PERM = true, AFTER_DRAIN = false;
    bf16 *base0, *base1, *base2, *base3;
    __device__ __forceinline__ void operator()(const f32x4 (&acc)[2][2][4][2], const pg8::Unit& u, int wr, int wc, int fr, int fq) const {
        const int row0 = u.pm * 256 + wr * 64 + fr; const int sel = u.pn >> 1; bf16* O = sel == 0 ? base0 : (sel == 1 ? base1 : (sel == 2 ? base2 : base3)); const int col0 = (u.pn & 1) * 256 + wc * 32 + 8 * fq;
#pragma unroll
        for (int ai = 0; ai < 2; ++ai)
#pragma unroll
            for (int m = 0; m < 4; ++m) { bf16* rowp = O + (size_t)(row0 + ai * 128 + m * 16) * 512 + col0;
#pragma unroll
                for (int bj = 0; bj < 2; ++bj) { const f32x4 v0 = acc[ai][bj][m][0], v1 = acc[ai][bj][m][1];
                    v4u w; w.x = pg8::cvt_pk_bf16(v0[0], v0[1]); w.y = pg8::cvt_pk_bf16(v0[2], v0[3]); w.z = pg8::cvt_pk_bf16(v1[0], v1[1]); w.w = pg8::cvt_pk_bf16(v1[2], v1[3]);
                    *(v4u*)(rowp + bj * 128) = w; } }
    }
};
struct EpiBias16 {
    static constexpr bool PERM = true, AFTER_DRAIN = false;
    bf16* O; int ldc; const float* bias;
    __device__ __forceinline__ void operator()(const f32x4 (&acc)[2][2][4][2], const pg8::Unit& u, int wr, int wc, int fr, int fq) const {
        const int row0 = u.pm * 256 + wr * 64 + fr; const int col0 = u.pn * 256 + wc * 32 + 8 * fq;
        f32x4 bv[2][2];
#pragma unroll
        for (int bj = 0; bj < 2; ++bj)
#pragma unroll
            for (int n = 0; n < 2; ++n) bv[bj][n] = *(const f32x4*)(bias + col0 + bj * 128 + 4 * n);
#pragma unroll
        for (int ai = 0; ai < 2; ++ai)
#pragma unroll
            for (int m = 0; m < 4; ++m) { bf16* rowp = O + (size_t)(row0 + ai * 128 + m * 16) * ldc + col0;
#pragma unroll
                for (int bj = 0; bj < 2; ++bj) { const f32x4 v0 = acc[ai][bj][m][0] + bv[bj][0], v1 = acc[ai][bj][m][1] + bv[bj][1];
                    v4u w; w.x = pg8::cvt_pk_bf16(v0[0], v0[1]); w.y = pg8::cvt_pk_bf16(v0[2], v0[3]); w.z = pg8::cvt_pk_bf16(v1[0], v1[1]); w.w = pg8::cvt_pk_bf16(v1[2], v1[3]);
                    *(v4u*)(rowp + bj * 128) = w; } }
    }
};
struct EpiRes {
    static constexpr bool PERM = false, AFTER_DRAIN = false;
    const float* res; float* out; const float* gate; const float* bias;
    __device__ __forceinline__ void operator()(const f32x4 (&acc)[2][2][4][2], const pg8::Unit& u, int wr, int wc, int fr, int fq) const {
        const int row0 = u.pm * 256 + wr * 64 + fr, col0 = u.pn * 256 + wc * 32 + 4 * fq;
        const float* gp = gate + (size_t)((u.pm * 256) >> 12) * 6144 + col0;
        f32x4 gv[2][2], bv[2][2];
#pragma unroll
        for (int bj = 0; bj < 2; ++bj)
#pragma unroll
            for (int n = 0; n < 2; ++n) { gv[bj][n] = *(const f32x4*)(gp + bj * 128 + n * 16); bv[bj][n] = bias ? *(const f32x4*)(bias + col0 + bj * 128 + n * 16) : (f32x4){0.f, 0.f, 0.f, 0.f}; }
#pragma unroll
        for (int ai = 0; ai < 2; ++ai)
#pragma unroll
            for (int m = 0; m < 4; ++m) { const size_t off = (size_t)(row0 + ai * 128 + m * 16) * DM + col0;
#pragma unroll
                for (int bj = 0; bj < 2; ++bj)
#pragma unroll
                    for (int n = 0; n < 2; ++n) { const f32x4 r = *(const f32x4*)(res + off + bj * 128 + n * 16);
                        *(f32x4*)(out + off + bj * 128 + n * 16) = r + gv[bj][n] * (acc[ai][bj][m][n] + bv[bj][n]); }
                asm volatile("" ::: "memory"); }
    }
};

constexpr int PR_A = 0, PR_W = 32768, PR_KT = 65536, PR_VT = 98304, PR_SM = 98304 + 36864;
__device__ __forceinline__ void unit_decode(int unit, int& bh, int& row0, int& t0, int& L) {
    if (unit < NUNIT_L) { bh = unit >> 5; const int c = unit & 31; row0 = (bh >> 2) * SEQ + c * 128; t0 = c * 128; L = SEQ; }
    else { const int uc = unit - NUNIT_L; bh = uc >> 1; const int cc = uc & 1; row0 = MROWS + (bh >> 2) * CTXL + cc * 128; t0 = cc * 128; L = CTXL; }
}
__device__ __forceinline__ void load_gates(const float* GG, int row0, int h, LAS float* sm, int tid) {
    if (tid < 128) { const float* g = GG + (size_t)(row0 + tid) * 16;
        sm[tid] = g[h]; sm[128 + tid] = logsig_f(g[4 + h]); sm[256 + tid] = g[8 + h]; sm[384 + tid] = logsig_f(g[12 + h]); }
}
__device__ __forceinline__ void prep_unit(const Args& a, LAS uchar* lds, int unit) {
    int tid_ = threadIdx.x; asm volatile("" : "+v"(tid_)); const int tid = tid_, lane = tid & 63, wave = __builtin_amdgcn_readfirstlane(tid >> 6), kq = lane >> 4, fr = lane & 15;
    uchar* ws = a.ws;
    int bh, row0, t0, L; unit_decode(unit, bh, row0, t0, L);
    const int h = bh & 3; const bool latent = unit < NUNIT_L;
    LAS float* sm = (LAS float*)(lds + PR_SM);
    const bf16* XM = (const bf16*)(ws + WS_XM); const bf16* V = (const bf16*)(ws + WS_V);
    bf16* AB = (bf16*)((uchar*)a.out + DO_AB); bf16* Q = (bf16*)((uchar*)a.out + DO_Q); bf16* K = (bf16*)((uchar*)a.out + DO_K);
    __syncthreads();
    load_gates((const float*)(ws + WS_G), row0, h, sm, tid);
    for (int id = tid; id < 15 * 16; id += NTHR) *(LAS v4u*)(lds + PR_VT + (129 + (id >> 4)) * 256 + (id & 15) * 16) = (v4u){0u, 0u, 0u, 0u};
    {
        const int l = tid >> 2, seg = tid & 3, t = t0 + l; const int colg = h * HD + seg * 32;
        const bool hp = t > 0, hn = t + 1 < L;
        const bf16* xc = XM + (size_t)(row0 + l) * 512 + colg;
        const float* cw = a.in[8]; const float* cb = a.in[9];
#pragma unroll
        for (int i = 0; i < 4; ++i) {
            const v4u c = *(const v4u*)(xc + 8 * i); v4u p = (v4u){0u, 0u, 0u, 0u}, n = (v4u){0u, 0u, 0u, 0u};
            if (hp) p = *(const v4u*)(xc - 512 + 8 * i);
            if (hn) n = *(const v4u*)(xc + 512 + 8 * i);
            float o[8];
#pragma unroll
            for (int e = 0; e < 8; ++e) { const int ch = colg + 8 * i + e; const unsigned pw = p[e >> 1], cw_ = c[e >> 1], nw_ = n[e >> 1];
                const float xp = (e & 1) ? bfhi(pw) : bflo(pw), xcv = (e & 1) ? bfhi(cw_) : bflo(cw_), xn = (e & 1) ? bfhi(nw_) : bflo(nw_);
                o[e] = silu_f(cw[ch] * xp + cw[512 + ch] * xcv + cw[1024 + ch] * xn + cb[ch]); }
            const v4u w = (v4u){pk2(o[0], o[1]), pk2(o[2], o[3]), pk2(o[4], o[5]), pk2(o[6], o[7])};
            *(LAS v4u*)(lds + PR_A + img_off(l, seg * 4 + i)) = w;
            if (latent) *(v4u*)(AB + (size_t)(row0 + l) * 512 + colg + 8 * i) = w;
        }
    }
    const bf16* WQ = (const bf16*)(ws + WS_WQ) + (size_t)h * HD * HD; const bf16* WK = (const bf16*)(ws + WS_WK) + (size_t)h * HD * HD;
    for (int pass = latent ? 0 : 1; pass < 2; ++pass) {
        const bf16* W = pass ? WK : WQ;
        if (pass == 1 && latent) __syncthreads();
#pragma unroll
        for (int i = 0; i < 4; ++i) { const int id = tid + NTHR * i, row = id >> 4, ch = id & 15; *(LAS v4u*)(lds + PR_W + img_off(row, ch)) = *(const v4u*)(W + row * 128 + ch * 8); }
        __syncthreads();
        f32x4 acc[8];
        { const BFrag bq = load_bfrag(lds + PR_A, 16 * wave + fr, kq);
#pragma unroll
          for (int mt = 0; mt < 8; ++mt) { acc[mt] = mma_a((f32x4){0.f, 0.f, 0.f, 0.f}, lds + PR_W, 16 * mt + fr, bq, kq); if (mt & 1) MEMFENCE(); } }
        const int tok = row0 + 16 * wave + fr;
        bf16* dst = (pass ? K : Q) + (size_t)tok * 512 + h * HD;
#pragma unroll
        for (int mt = 0; mt < 8; ++mt) { const v2u w = (v2u){pk2(acc[mt][0], acc[mt][1]), pk2(acc[mt][2], acc[mt][3])};
            if (latent) *(v2u*)(dst + 16 * mt + 4 * kq) = w;
            if (pass) {
                const int j = 16 * wave + fr;
#pragma unroll
                for (int r = 0; r < 4; ++r) { const int d = 16 * mt + 4 * kq + r; *(LAS bf16*)(lds + PR_KT + img_off(d, j >> 3) + (j & 7) * 2) = (bf16)((r & 1) ? (w[r >> 1] >> 16) : (w[r >> 1] & 0xffffu)); } }
        }
    }
    __syncthreads();
    if (tid == 0) { float b = 0.f; for (int j = 0; j < 128; ++j) b += sm[128 + j]; const float bend = b; float run = 0.f, mx = -3.0e38f;
        for (int j = 0; j < 128; ++j) { run += sm[128 + j]; const float g = bend - run + sm[j]; sm[512 + j] = g; mx = fmaxf(mx, g); }
        sm[768] = bend; sm[769] = mx; }
    if (tid == 64) { float b = 0.f; for (int j = 0; j < 128; ++j) b += sm[384 + j]; const float bend = b; float run = 0.f, mx = -3.0e38f;
        for (int j = 127; j >= 0; --j) { run += sm[384 + j]; const float g = bend - run + sm[256 + j]; sm[640 + j] = g; mx = fmaxf(mx, g); }
        sm[770] = bend; sm[771] = mx; }
    __syncthreads();
    if (tid < 128) sm[512 + tid] = __expf(sm[512 + tid] - sm[769]); else if (tid < 256) sm[640 + tid - 128] = __expf(sm[640 + tid - 128] - sm[771]);
    __syncthreads();
    float* DC = (float*)(ws + WS_DC); float* SC = (float*)(ws + WS_SC);
    for (int dir = 0; dir < 2; ++dir) {
        if (dir) __syncthreads();
        {
            const int j = tid >> 2, seg = tid & 3; const float wj = sm[512 + dir * 128 + j];
            const bf16* vr = V + (size_t)(row0 + j) * 512 + h * HD + seg * 32;
#pragma unroll
            for (int i = 0; i < 4; ++i) { const v4u c = *(const v4u*)(vr + 8 * i);
#pragma unroll
                for (int e = 0; e < 8; ++e) { const unsigned cw_ = c[e >> 1]; const float x = ((e & 1) ? bfhi(cw_) : bflo(cw_)) * wj;
                    *(LAS bf16*)(lds + PR_VT + img_off(seg * 32 + 8 * i + e, j >> 3) + (j & 7) * 2) = (bf16)f2bf(x); } }
            if (seg == 0) *(LAS bf16*)(lds + PR_VT + img_off(128, j >> 3) + (j & 7) * 2) = (bf16)f2bf(wj);
        }
        __syncthreads();
        f32x4 acc[9];
        { const BFrag bk = load_bfrag(lds + PR_KT, 16 * wave + fr, kq);
#pragma unroll
          for (int mt = 0; mt < 9; ++mt) { acc[mt] = mma_a((f32x4){0.f, 0.f, 0.f, 0.f}, lds + PR_VT, 16 * mt + fr, bk, kq); if (mt & 1) MEMFENCE(); } }
        float* dst = DC + (size_t)(unit * 2 + dir) * CT_SLOT + 16 * wave + fr;
#pragma unroll
        for (int mt = 0; mt < 8; ++mt)
#pragma unroll
            for (int r = 0; r < 4; ++r) dst[(size_t)(16 * mt + 4 * kq + r) * 128] = acc[mt][r];
        if (kq == 0) dst[(size_t)128 * 128] = acc[8][0];
        if (tid == 0) { SC[(unit * 2 + dir) * 2] = sm[768 + 2 * dir]; SC[(unit * 2 + dir) * 2 + 1] = sm[769 + 2 * dir]; }
    }
}

__device__ __forceinline__ void fft1_item(const Args& a, LAS uchar* lds, int item) {
    int tid_ = threadIdx.x; asm volatile("" : "+v"(tid_)); const int tid = tid_, lane = tid & 63, wave = __builtin_amdgcn_readfirstlane(tid >> 6), kq = lane >> 4, fr = lane & 15;
    uchar* ws = a.ws;
    const int b = item >> 7, cblk = item & 127;
    const bf16* UF = (const bf16*)(ws + WS_UF) + (size_t)b * SEQ * 512 + cblk * 256;
    bf16* TP = (bf16*)(ws + WS_TP);
    const bf16* F1 = (const bf16*)(ws + WS_F1); const float* TW = (const float*)(ws + WS_TW);
    __syncthreads();
#pragma unroll
    for (int i = 0; i < 4; ++i) { const int id = tid + NTHR * i, n1 = id >> 5, c8 = id & 31; const v4u v = *(const v4u*)(UF + (size_t)n1 * 32768 + c8 * 8);
#pragma unroll
        for (int e = 0; e < 8; ++e) *(LAS bf16*)(lds + (c8 * 8 + e) * 144 + n1 * 2) = (bf16)((e & 1) ? (v[e >> 1] >> 16) : (v[e >> 1] & 0xffffu)); }
    bf16x8 bfr[8][2];
#pragma unroll
    for (int nt = 0; nt < 8; ++nt)
#pragma unroll
        for (int s = 0; s < 2; ++s) bfr[nt][s] = *(const bf16x8*)(F1 + (16 * nt + fr) * 64 + 32 * s + 8 * kq);
    __syncthreads();
    const int n2 = cblk >> 1;
    for (int mi = 0; mi < 2; ++mi) {
        const int mt = wave * 2 + mi;
        const bf16x8 a0 = *(const LAS bf16x8*)(lds + (16 * mt + fr) * 144 + kq * 16), a1 = *(const LAS bf16x8*)(lds + (16 * mt + fr) * 144 + 64 + kq * 16);
        f32x4 acc[8];
#pragma unroll
        for (int nt = 0; nt < 8; ++nt) { acc[nt] = (f32x4){0.f, 0.f, 0.f, 0.f};
            acc[nt] = __builtin_amdgcn_mfma_f32_16x16x32_bf16(a0, bfr[nt][0], acc[nt], 0, 0, 0); acc[nt] = __builtin_amdgcn_mfma_f32_16x16x32_bf16(a1, bfr[nt][1], acc[nt], 0, 0, 0); }
        const int c0 = 16 * mt + 4 * kq, col0 = (cblk & 1) * 256 + c0;
#pragma unroll
        for (int nt = 0; nt < 4; ++nt) { const int k1 = 16 * nt + fr; const int idx = (n2 * k1) & 4095; const float cs = TW[idx], sn = TW[(idx - 1024) & 4095];
            float pr[4], pi[4];
#pragma unroll
            for (int r = 0; r < 4; ++r) { const float tr = acc[nt][r], ti = acc[nt + 4][r]; const float xr = tr * cs + ti * sn, xi = ti * cs - tr * sn;
                const bool st = ((col0 + r) & 127) >= 65; pr[r] = st ? -xi : xr; pi[r] = st ? xr : xi; }
            const size_t o = ((size_t)(b * 2) * 64 + k1) * 32768 + (size_t)cblk * 256 + c0;
            *(v2u*)(TP + o) = (v2u){pk2(pr[0], pr[1]), pk2(pr[2], pr[3])};
            *(v2u*)(TP + o + (size_t)64 * 32768) = (v2u){pk2(pi[0], pi[1]), pk2(pi[2], pi[3])}; }
    }
}
__device__ __forceinline__ void fft2_item(const Args& a, LAS uchar* lds, int item) {
    int tid_ = threadIdx.x; asm volatile("" : "+v"(tid_)); const int tid = tid_, lane = tid & 63, wave = __builtin_amdgcn_readfirstlane(tid >> 6), kq = lane >> 4, fr = lane & 15;
    uchar* ws = a.ws;
    const int b = item >> 7, k1 = (item >> 1) & 63, half = item & 1;
    const bf16* TP = (const bf16*)(ws + WS_TP); const bf16* G2 = (const bf16*)(ws + WS_G2);
    bf16* YM = (bf16*)(ws + WS_YM);
    __syncthreads();
#pragma unroll
    for (int i = 0; i < 8; ++i) { const int id = tid + NTHR * i, kap = id >> 5, c8 = id & 31, ri = kap >> 6, n2 = kap & 63;
        const v4u v = *(const v4u*)(TP + ((size_t)(b * 2 + ri) * 64 + k1) * 32768 + (size_t)n2 * 512 + half * 256 + c8 * 8);
#pragma unroll
        for (int e = 0; e < 8; ++e) { const int c = c8 * 8 + e; *(LAS bf16*)(lds + img_off(c, kap >> 3) + (kap & 7) * 2) = (bf16)((e & 1) ? (v[e >> 1] >> 16) : (v[e >> 1] & 0xffffu)); } }
    bf16x8 bfr[4][4];
#pragma unroll
    for (int nt = 0; nt < 4; ++nt)
#pragma unroll
        for (int s = 0; s < 4; ++s) bfr[nt][s] = *(const bf16x8*)(G2 + (16 * nt + fr) * 128 + 32 * s + 8 * kq);
    __syncthreads();
    for (int mi = 0; mi < 2; ++mi) {
        const int mt = wave * 2 + mi;
        f32x4 acc[4];
#pragma unroll
        for (int nt = 0; nt < 4; ++nt) acc[nt] = (f32x4){0.f, 0.f, 0.f, 0.f};
#pragma unroll
        for (int s = 0; s < 4; ++s) { const bf16x8 av = *(const LAS bf16x8*)(lds + img_off(16 * mt + fr, 4 * s + kq));
#pragma unroll
            for (int nt = 0; nt < 4; ++nt) acc[nt] = __builtin_amdgcn_mfma_f32_16x16x32_bf16(av, bfr[nt][s], acc[nt], 0, 0, 0); }
#pragma unroll
        for (int nt = 0; nt < 4; ++nt) { const int k2 = 16 * nt + fr; const size_t row = (size_t)b * SEQ + k1 + 64 * k2;
            *(v2u*)(YM + row * 1024 + half * 256 + 16 * mt + 4 * kq) = (v2u){pk2(acc[nt][0], acc[nt][1]), pk2(acc[nt][2], acc[nt][3])}; }
    }
}

__device__ __forceinline__ void p4_scan(const Args& a, int G) {
    uchar* ws = a.ws;
    const float* DC = (const float*)(ws + WS_DC); const float* SC = (const float*)(ws + WS_SC);
    bf16* CT = (bf16*)(ws + WS_CT); float* MS = (float*)(ws + WS_MS);
    constexpr int F4 = CT_SLOT / 4;
    const int total = 64 * F4;
    for (int gi = blockIdx.x * NTHR + threadIdx.x; gi < total; gi += G * NTHR) {
        const int seq = gi / F4, i = gi - seq * F4; const int bh = seq >> 1, dir = seq & 1;
        f32x4 s = (f32x4){0.f, 0.f, 0.f, 0.f}; float m = 0.f;
        for (int step = 0; step < 34; ++step) {
            int unit;
            if (step < 2) unit = NUNIT_L + bh * 2 + (dir ? 1 - step : step);
            else { const int c = dir ? 33 - step : step - 2; unit = bh * 32 + c; }
            const int slot = unit * 2 + dir;
            if (step >= 2) { *(v2u*)(CT + (size_t)slot * CT_SLOT + 4 * i) = (v2u){pk2(s.x, s.y), pk2(s.z, s.w)}; if (i == 0) MS[slot] = m; }
            const float bend = SC[slot * 2], mloc = SC[slot * 2 + 1];
            const float mn = fmaxf(bend + m, mloc), al = __expf(bend + m - mn), be = __expf(mloc - mn);
            const f32x4 d = *(const f32x4*)(DC + (size_t)slot * CT_SLOT + 4 * i);
            s = s * al + d * be; m = mn;
        }
    }
}

constexpr int OU_Q = 0, OU_KC = 32768, OU_VT = 69632, OU_P = 106496, OU_SM = 139264;
__device__ __forceinline__ void out_unit(const Args& a, LAS uchar* lds, int unit) {
    int tid_ = threadIdx.x; asm volatile("" : "+v"(tid_)); const int tid = tid_, lane = tid & 63, wave = __builtin_amdgcn_readfirstlane(tid >> 6), kq = lane >> 4, fr = lane & 15;
    uchar* ws = a.ws;
    const int bh = unit >> 5, c = unit & 31, h = bh & 3, row0 = (bh >> 2) * SEQ + c * 128;
    LAS float* sm = (LAS float*)(lds + OU_SM);
    const bf16* Q = (const bf16*)((const uchar*)a.out + DO_Q); const bf16* K = (const bf16*)((const uchar*)a.out + DO_K); const bf16* AB = (const bf16*)((const uchar*)a.out + DO_AB);
    const bf16* V = (const bf16*)(ws + WS_V); const bf16* Z = (const bf16*)(ws + WS_Z);
    const bf16* CT = (const bf16*)(ws + WS_CT); const float* MS = (const float*)(ws + WS_MS);
    bf16* YM = (bf16*)(ws + WS_YM);
    __syncthreads();
    load_gates((const float*)(ws + WS_G), row0, h, sm, tid);
    const float m_f = MS[unit * 2], m_b = MS[unit * 2 + 1];
#pragma unroll
    for (int i = 0; i < 4; ++i) { const int id = tid + NTHR * i, row = id >> 4, ch = id & 15; const size_t g = (size_t)(row0 + row) * 512 + h * HD + ch * 8;
        *(LAS v4u*)(lds + OU_Q + img_off(row, ch)) = *(const v4u*)(Q + g); *(LAS v4u*)(lds + OU_KC + img_off(row, ch)) = *(const v4u*)(K + g); }
    for (int id = tid; id < 15 * 16; id += NTHR) *(LAS v4u*)(lds + OU_VT + (129 + (id >> 4)) * 256 + (id & 15) * 16) = (v4u){0u, 0u, 0u, 0u};
    {   const int j = tid >> 2, seg = tid & 3; const bf16* vr = V + (size_t)(row0 + j) * 512 + h * HD + seg * 32;
#pragma unroll
        for (int i = 0; i < 4; ++i) { const v4u cv = *(const v4u*)(vr + 8 * i);
#pragma unroll
            for (int e = 0; e < 8; ++e) *(LAS bf16*)(lds + OU_VT + img_off(seg * 32 + 8 * i + e, j >> 3) + (j & 7) * 2) = (bf16)((e & 1) ? (cv[e >> 1] >> 16) : (cv[e >> 1] & 0xffffu)); }
        if (seg == 0) *(LAS bf16*)(lds + OU_VT + img_off(128, j >> 3) + (j & 7) * 2) = (bf16)0x3f80u; }
    __syncthreads();
    if (tid == 0) { float b = 0.f, R = -3.0e38f; for (int j = 0; j < 128; ++j) { b += sm[128 + j]; const float r = sm[j] - b; R = fmaxf(R, r); sm[512 + j] = r; sm[640 + j] = fmaxf(m_f, R); sm[768 + j] = b; } }
    if (tid == 64) { float b = 0.f, R = -3.0e38f; for (int j = 127; j >= 0; --j) { b += sm[384 + j]; const float r = sm[256 + j] - b; R = fmaxf(R, r); sm[896 + j] = r; sm[1024 + j] = fmaxf(m_b, R); sm[1152 + j] = b; } }
    f32x4 S[8];
    { const BFrag bq = load_bfrag(lds + OU_Q, 16 * wave + fr, kq);
#pragma unroll
      for (int mt = 0; mt < 8; ++mt) { S[mt] = mma_a((f32x4){0.f, 0.f, 0.f, 0.f}, lds + OU_KC, 16 * mt + fr, bq, kq); if (mt & 1) MEMFENCE(); } }
    __syncthreads();
    const int l = 16 * wave + fr; const int tok = row0 + l;
    LAS uchar* Pw = lds + OU_P + wave * 4096;
    f32x4 hs[8];
    for (int dir = 0; dir < 2; ++dir) {
        const LAS float* rr = sm + 512 + dir * 384; const LAS float* rho = rr + 128; const LAS float* bl = rr + 256;
        const float rho_l = rho[l], mst = dir ? m_b : m_f;
        { const bf16* src = CT + (size_t)(unit * 2 + dir) * CT_SLOT;
#pragma unroll
          for (int i = 0; i < 5; ++i) { const int id = tid + NTHR * i; if (id < 129 * 16) { const int row = id >> 4, ch = id & 15; *(LAS v4u*)(lds + OU_KC + img_off(row, ch)) = *(const v4u*)(src + row * 128 + ch * 8); } } }
#pragma unroll
        for (int mt = 0; mt < 8; ++mt) { float p[4]; const f32x4 rv = *(const LAS f32x4*)(rr + 16 * mt + 4 * kq);
#pragma unroll
            for (int r = 0; r < 4; ++r) { const int j = 16 * mt + 4 * kq + r; const bool ok = dir ? (j >= l) : (j <= l); p[r] = ok ? S[mt][r] * __expf(fminf(rv[r] - rho_l, 0.f)) : 0.f; }
            *(LAS v2u*)(Pw + img_off(fr, 2 * mt + (kq >> 1)) + (kq & 1) * 8) = (v2u){pk2(p[0], p[1]), pk2(p[2], p[3])}; if (mt & 1) MEMFENCE(); }
        __syncthreads();
        f32x4 acc[9];
        const float wi = __expf(mst - rho_l);
        { const BFrag bq = load_bfrag(lds + OU_Q, 16 * wave + fr, kq);
#pragma unroll
          for (int mt = 0; mt < 9; ++mt) { acc[mt] = mma_a((f32x4){0.f, 0.f, 0.f, 0.f}, lds + OU_KC, 16 * mt + fr, bq, kq) * wi; if (mt & 1) MEMFENCE(); } }
        MEMFENCE();
        { const BFrag bp = load_bfrag(Pw, fr, kq);
#pragma unroll
          for (int mt = 0; mt < 9; ++mt) { acc[mt] = mma_a(acc[mt], lds + OU_VT, 16 * mt + fr, bp, kq); if (mt & 1) MEMFENCE(); } }
        const float den = __shfl(acc[8][0], fr);
        const float sc = 1.0f / fmaxf(fabsf(den), __expf(-bl[l] - rho_l));
#pragma unroll
        for (int mt = 0; mt < 8; ++mt) hs[mt] = dir ? hs[mt] + acc[mt] * sc : acc[mt] * sc;
        __syncthreads();
    }
    float s1 = 0.f;
#pragma unroll
    for (int mt = 0; mt < 8; ++mt) s1 += (hs[mt][0] + hs[mt][1]) + (hs[mt][2] + hs[mt][3]);
    s1 += __shfl_xor(s1, 16); s1 += __shfl_xor(s1, 32);
    const float mu = s1 * (1.0f / 128.0f); float s2 = 0.f;
#pragma unroll
    for (int mt = 0; mt < 8; ++mt) { const f32x4 d = hs[mt] - mu; s2 += (d[0] * d[0] + d[1] * d[1]) + (d[2] * d[2] + d[3] * d[3]); }
    s2 += __shfl_xor(s2, 16); s2 += __shfl_xor(s2, 32);
    const float rstd = rsqrtf(s2 * (1.0f / 128.0f) + EPS);
    const float* mw = a.in[13] + h * HD; const float* msk = a.in[14] + h * HD;
#pragma unroll
    for (int mt = 0; mt < 8; ++mt) { const int e0 = 16 * mt + 4 * kq;
        const f32x4 w = *(const f32x4*)(mw + e0), k4 = *(const f32x4*)(msk + e0);
        const v2u av = *(const v2u*)(AB + (size_t)tok * 512 + h * HD + e0), zv = *(const v2u*)(Z + (size_t)tok * 512 + h * HD + e0);
        const float a4[4] = {bflo(av.x), bfhi(av.x), bflo(av.y), bfhi(av.y)}, z4[4] = {bflo(zv.x), bfhi(zv.x), bflo(zv.y), bfhi(zv.y)};
        float y[4];
#pragma unroll
        for (int r = 0; r < 4; ++r) y[r] = ((hs[mt][r] - mu) * rstd * w[r] + k4[r] * a4[r]) * silu_f(z4[r]);
        *(v2u*)(YM + (size_t)tok * 1024 + 512 + h * HD + e0) = (v2u){pk2(y[0], y[1]), pk2(y[2], y[3])}; MEMFENCE(); }
}

__device__ __forceinline__ f32x4 bf4(v2u x) { return (f32x4){bflo(x.x), bfhi(x.x), bflo(x.y), bfhi(x.y)}; }
__device__ __forceinline__ void p9_conv(const Args& a, int vcu, int G) {
    const int tid = threadIdx.x, lane = tid & 63, wave = __builtin_amdgcn_readfirstlane(tid >> 6);
    const bf16* U = (const bf16*)(a.ws + WS_U); bf16* ACT = (bf16*)(a.ws + WS_ACT);
    const float* fw = a.in[19]; const float* fb = a.in[20];
    const int gw = vcu * NWAVES + wave, NGW = G * NWAVES;
    for (int it = gw; it < NB * 64 * 10 * 2; it += NGW) {
        const int half = it & 1, qb = (it >> 1) % 10, br = (it >> 1) / 10, r = br & 63, b = br >> 6;
        const int ch = (qb * 64 + lane) * 4;
        f32x4 wv[9], wg[9];
#pragma unroll
        for (int t = 0; t < 9; ++t) { wv[t] = *(const f32x4*)(fw + t * UPW + ch); wg[t] = *(const f32x4*)(fw + t * UPW + DFF + ch); }
        const f32x4 bv = *(const f32x4*)(fb + ch), bgt = *(const f32x4*)(fb + DFF + ch);
        const bf16* rp = U + (size_t)(b * SEQ + r * 64) * UPW + ch;
        const bool rv0 = r > 0, rv2 = r < 63;
        v2u xv[3][6], xg[3][6];
        const int c0 = half * 32;
#pragma unroll
        for (int i = 0; i < 3; ++i) {
            const bool rvi = (i == 0) ? rv0 : (i == 2 ? rv2 : true);
            const bf16* p = rp + (ptrdiff_t)(i - 1) * 64 * UPW + (ptrdiff_t)(c0 - 1) * UPW;
            xv[i][0] = (v2u){0u, 0u}; xg[i][0] = (v2u){0u, 0u}; xv[i][1] = (v2u){0u, 0u}; xg[i][1] = (v2u){0u, 0u};
            if (rvi) { if (c0 > 0) { xv[i][0] = *(const v2u*)p; xg[i][0] = *(const v2u*)(p + DFF); } xv[i][1] = *(const v2u*)(p + UPW); xg[i][1] = *(const v2u*)(p + UPW + DFF); }
        }
#pragma unroll 1
        for (int cb = 0; cb < 8; ++cb) {
            const int c = c0 + 4 * cb;
#pragma unroll
            for (int i = 0; i < 3; ++i) {
                const bool rvi = (i == 0) ? rv0 : (i == 2 ? rv2 : true);
                const bf16* p = rp + (ptrdiff_t)(i - 1) * 64 * UPW + (ptrdiff_t)(c + 1) * UPW;
#pragma unroll
                for (int j = 0; j < 4; ++j) { xv[i][2 + j] = (v2u){0u, 0u}; xg[i][2 + j] = (v2u){0u, 0u};
                    if (rvi && (c + 1 + j <= 63)) { xv[i][2 + j] = *(const v2u*)(p + j * UPW); xg[i][2 + j] = *(const v2u*)(p + j * UPW + DFF); } }
            }
#pragma unroll
            for (int o = 0; o < 4; ++o) {
                f32x4 av = bv, ag = bgt;
#pragma unroll
                for (int i = 0; i < 3; ++i)
#pragma unroll
                    for (int j = 0; j < 3; ++j) { av += wv[i * 3 + j] * bf4(xv[i][o + j]); ag += wg[i * 3 + j] * bf4(xg[i][o + j]); }
                float ov[4];
#pragma unroll
                for (int e = 0; e < 4; ++e) ov[e] = av[e] * silu_f(ag[e]);
                *(v2u*)(ACT + (size_t)(b * SEQ + r * 64 + c + o) * DFF + ch) = (v2u){pk2(ov[0], ov[1]), pk2(ov[2], ov[3])};
            }
#pragma unroll
            for (int i = 0; i < 3; ++i) { xv[i][0] = xv[i][4]; xv[i][1] = xv[i][5]; xg[i][0] = xg[i][4]; xg[i][1] = xg[i][5]; }
        }
    }
}

constexpr int LDS_BYTES = 147456, MISC_OFF = 147456 - 256;
constexpr int NPHASE = 12;
#ifndef MK_PER_PHASE
#define MK_PER_PHASE 0
#endif
__global__ void __launch_bounds__(NTHR, 2) mk_fwd(Args args) {
    extern __shared__ __attribute__((aligned(16))) uchar lds_raw[];
    LAS uchar* lds = (LAS uchar*)lds_raw;
    const int tid = threadIdx.x;
    const int G = gridDim.x; const int bx = blockIdx.x; const int vcu = (G % 8 == 0) ? (bx % 8) * (G / 8) + bx / 8 : bx;
    volatile LAS unsigned* MISC = (volatile LAS unsigned*)(lds + MISC_OFF);
    if (tid < 64) MISC[tid] = 0u;
    __syncthreads();
    XcdBarrier bar; bar.bar = (unsigned*)(args.ws + WS_CTL); bar.x = 0; bar.st = nullptr;
    if (!MK_PER_PHASE) bar = xcd_barrier_post((unsigned*)(args.ws + WS_CTL), MISC + 8);
    const int lo = args.ph_lo, hi = args.ph_hi;
#ifndef PH_MASK
#define PH_MASK 0xFFF
#endif
#define IN(k) (((PH_MASK >> (k)) & 1) && lo <= (k) && (k) < hi)
#ifndef REP_MASK
#define REP_MASK 0
#endif
#define REP(k) for (int rep_ = 0; rep_ <= ((REP_MASK >> (k)) & 1); ++rep_, __syncthreads())
#define SEAM(k) do { if (IN(k) && IN((k) + 1)) xcd_barrier(bar); } while (0)
    uchar* ws = args.ws;
    if (IN(0)) REP(0) { p0_prologue(args, lds, vcu, G); } SEAM(0);
    if (IN(1)) REP(1) { p1_rows(args, lds, vcu, G); } SEAM(1);
    if (IN(2)) REP(2) {
        pg8::Gemm g{(const bf16*)(ws + WS_HX), (const bf16*)(ws + WS_WIN), TROWS, 2048, DM}; SchedP2 S; S.init(G, bx);
        EpiP2 E{(bf16*)(ws + WS_UF), (bf16*)(ws + WS_XM), (bf16*)(ws + WS_V), (bf16*)(ws + WS_Z)};
        pg8::gemm_phase<EpiP2, SchedP2, true, true>(lds, g, S, E);
    } SEAM(2);
    if (IN(3)) REP(3) {
        for (int it = bx; it < NUNIT + 1024; it += G) { if (it < NUNIT) prep_unit(args, lds, it); else fft1_item(args, lds, it - NUNIT); }
    } SEAM(3);
    if (IN(4)) REP(4) {
        for (int it = bx; it < 1024; it += G) fft2_item(args, lds, it);
        p4_scan(args, G);
    } SEAM(4);
    if (IN(5)) REP(5) { for (int it = bx; it < NUNIT_L; it += G) out_unit(args, lds, it); __syncthreads(); } SEAM(5);
    if (IN(6)) REP(6) {
        pg8::Gemm g{(const bf16*)(ws + WS_YM), (const bf16*)(ws + WS_WOUT), MROWS, DM, 1024}; pg8::StaticOrder S; S.init(MROWS, DM, G, bx);
        EpiRes E{args.in[0], args.out, (const float*)(ws + WS_MOD) + 2048, nullptr};
        pg8::gemm_phase<EpiRes, pg8::StaticOrder, true, true>(lds, g, S, E);
    } SEAM(6);
    if (IN(7)) REP(7) { p7_rows(args, vcu, G); } SEAM(7);
    if (IN(8)) REP(8) {
        pg8::Gemm g{(const bf16*)(ws + WS_H2), (const bf16*)(ws + WS_WUP), MROWS, UPW, DM}; pg8::StaticOrder S; S.init(MROWS, UPW, G, bx);
        EpiBias16 E{(bf16*)(ws + WS_U), UPW, args.in[18]};
        pg8::gemm_phase<EpiBias16, pg8::StaticOrder, true, true>(lds, g, S, E);
    } SEAM(8);
    if (IN(9)) REP(9) { p9_conv(args, vcu, G); } SEAM(9);
    if (IN(10)) REP(10) {
        pg8::Gemm g{(const bf16*)(ws + WS_ACT), (const bf16*)(ws + WS_WDN), MROWS, DM, DFF}; pg8::StaticOrder S; S.init(MROWS, DM, G, bx);
        EpiRes E{args.out, args.out, (const float*)(ws + WS_MOD) + 5120, args.in[22]};
        pg8::gemm_phase<EpiRes, pg8::StaticOrder, true, true>(lds, g, S, E);
    } SEAM(10);
    if (IN(11)) REP(11) { p11_rows(args, vcu, G); }
#undef IN
#undef SEAM
}

extern "C" void kernel_launch(void* const* d_in, const int* in_sizes, int n_in, void* d_out, int out_size, void* d_ws, size_t ws_size, hipStream_t stream) {
    static int grid = 0;
    if (grid == 0) {
        if (n_in != 24 || out_size != MROWS * DM || ws_size < WS_END) { fprintf(stderr, "kernel_launch: unexpected problem (n_in %d, out %d, ws %zu); nothing launched\n", n_in, out_size, ws_size); grid = -1; return; }
        int dev = 0, cus = 0, per_cu = 0;
        if (hipGetDevice(&dev) != hipSuccess || hipDeviceGetAttribute(&cus, hipDeviceAttributeMultiprocessorCount, dev) != hipSuccess) { grid = -1; return; }
        if (hipFuncSetAttribute((const void*)mk_fwd, hipFuncAttributeMaxDynamicSharedMemorySize, LDS_BYTES) != hipSuccess) { fprintf(stderr, "kernel_launch: hipFuncSetAttribute failed\n"); grid = -1; return; }
        if (hipOccupancyMaxActiveBlocksPerMultiprocessor(&per_cu, (const void*)mk_fwd, NTHR, LDS_BYTES) != hipSuccess || per_cu < 1) { fprintf(stderr, "kernel_launch: occupancy query says %d blocks per CU\n", per_cu); grid = -1; (void)hipGetLastError(); return; }
        grid = cus;
    }
    if (grid < 0) return;
    (void)hipMemsetAsync((char*)d_ws + WS_ZERO0, 0, WS_ZERO_BYTES, stream);
    Args a{};
    for (int i = 0; i < 24; ++i) a.in[i] = (const float*)d_in[i];
    a.out = (float*)d_out; a.ws = (uchar*)d_ws;
#if MK_PER_PHASE
    for (int p = 0; p < NPHASE; ++p) { a.ph_lo = p; a.ph_hi = p + 1; hipLaunchKernelGGL(mk_fwd, dim3(grid), dim3(NTHR), LDS_BYTES, stream, a); }
#else
    a.ph_lo = 0; a.ph_hi = NPHASE; hipLaunchKernelGGL(mk_fwd, dim3(grid), dim3(NTHR), LDS_BYTES, stream, a);
#endif
}
```

```cpp
#include <hip/hip_runtime.h>
#include <cstdio>
#include <cstdint>
namespace pg8 {
#define PG8_LAS __attribute__((address_space(3)))
typedef unsigned short bf16_t;
typedef short bf16x8 __attribute__((ext_vector_type(8)));
typedef float f32x4 __attribute__((ext_vector_type(4)));
typedef unsigned u32x4 __attribute__((ext_vector_type(4)));
constexpr int BM = 256, BK = 64, HALF = 128, HTB = HALF * BK * 2  , STAGE_BYTES = 8 * HTB, NXCD = 8, WGM = 8;

__host__ __device__ __forceinline__ int lds_byte(int r, int c) { const int st = (r >> 4) * 2 + (c >> 5), rr = r & 15, cc = c & 31, ob = rr * 64 + cc * 2; return st * 1024 + (ob ^ (((ob >> 9) & 1) << 5)); }
__host__ __device__ __forceinline__ void stage_rc(int b, int& R, int& C) { const int st = b / 1024, sb = b % 1024, swz = sb ^ (((sb >> 9) & 1) << 5); R = (st >> 1) * 16 + swz / 64; C = (st & 1) * 32 + (swz % 64) / 2; }
__host__ __device__ __forceinline__ int perm32(int rho) { const int n = rho >> 4, i = rho & 15; return 8 * (i >> 2) + 4 * n + (i & 3); }

struct Unit { int pm, pn; };
struct Gemm { const bf16_t* A; const bf16_t* Bt; int M, N, K; };

struct StaticOrder {
    int nM, nN, nwg, G, c;
    __host__ __device__ void init(int M, int N, int G_, int c_) { nM = M / BM; nN = N / BM; nwg = nM * nN; G = G_; c = c_; }
    __host__ __device__ bool next(int i, Unit& u) const {
        const long L = (long)i * G + c; if (L >= nwg) return false;
        int wgid = (int)L; { const int q = nwg / NXCD, r = nwg % NXCD, xcd = wgid % NXCD, off = wgid / NXCD; wgid = (xcd < r ? xcd * (q + 1) : r * (q + 1) + (xcd - r) * q) + off; }
        const int nig = WGM * nN, gid = wgid / nig, fm = gid * WGM, gsz = (nM - fm) < WGM ? (nM - fm) : WGM;
        u.pm = fm + ((wgid % nig) % gsz); u.pn = (wgid % nig) / gsz; return true;
    }
    __device__ __forceinline__ void a_ready(const Unit&) const {}
    __device__ __forceinline__ void done(const Unit&) const {}
};
__device__ __forceinline__ unsigned cvt_pk_bf16(float lo, float hi) { unsigned r; asm volatile("v_cvt_pk_bf16_f32 %0, %1, %2" : "=v"(r) : "v"(lo), "v"(hi)); return r; }
template <class Epi, class Sched, bool ALIGN_EPI = false, bool SP2 = false>
__device__ __forceinline__ void gemm_phase(PG8_LAS unsigned char* lds, const Gemm g, const Sched& S, const Epi& E) {
    const int tid = threadIdx.x, wid = __builtin_amdgcn_readfirstlane(tid >> 6), lane = tid & 63, wr = wid >> 2, wc = wid & 3, fr = lane & 15, fq = lane >> 4;
    const int K = g.K, nt = K / BK;
    unsigned voffA[2], voffB[2];
#pragma unroll
    for (int i = 0; i < 2; ++i) { int R, C; stage_rc(tid * 16 + i * 8192, R, C); const int Rb = Epi::PERM ? ((R & ~31) + perm32(R & 31)) : R;
        voffA[i] = (unsigned)(R * K + C) * 2u; voffB[i] = (unsigned)(Rb * K + C) * 2u; }
    const size_t kstep = (size_t)(BK * 2);
    const size_t hstep = (size_t)HALF * K * 2;
    const size_t tstep = 2 * hstep;
    const unsigned ldsw = (unsigned)wid * 1024u;
    const int aoff = lds_byte(wr * 64 + fr, fq * 8), boff = lds_byte(wc * 32 + fr, fq * 8);
#define PG8_SA(b, h) (((b) * 2 + (h)) * HTB)
#define PG8_SB(b, h) ((4 + (b) * 2 + (h)) * HTB)
#define PG8_STAGE(bufoff, gbase, voff) do { _Pragma("unroll") for (int _i = 0; _i < 2; ++_i) \
        __builtin_amdgcn_global_load_lds((const unsigned*)((const char*)(gbase) + (voff)[_i]), (PG8_LAS unsigned*)(lds + (bufoff) + ldsw + _i * 8192), 16, 0, 0); } while (0)
#define PG8_LDA(dst, b, h) do { _Pragma("unroll") for (int m = 0; m < 4; ++m) _Pragma("unroll") for (int k = 0; k < 2; ++k) dst[m][k] = *(const PG8_LAS bf16x8*)(lds + PG8_SA(b, h) + aoff + m * 2048 + k * 1024); } while (0)
#define PG8_LDB(dst, b, h) do { _Pragma("unroll") for (int n = 0; n < 2; ++n) _Pragma("unroll") for (int k = 0; k < 2; ++k) dst[n][k] = *(const PG8_LAS bf16x8*)(lds + PG8_SB(b, h) + boff + n * 2048 + k * 1024); } while (0)
#define PG8_MMA(ai, bj, At, Bt) do { __builtin_amdgcn_s_setprio(1); _Pragma("unroll") for (int m = 0; m < 4; ++m) _Pragma("unroll") for (int n = 0; n < 2; ++n) _Pragma("unroll") for (int k = 0; k < 2; ++k) \
        acc[ai][bj][m][n] = __builtin_amdgcn_mfma_f32_16x16x32_bf16(Bt[n][k], At[m][k], acc[ai][bj][m][n], 0, 0, 0); __builtin_amdgcn_s_setprio(0); } while (0)
#define PG8_WAIT_V(n) asm volatile("s_waitcnt vmcnt(" #n ")" ::: "memory")
#define PG8_WAIT_L(n) asm volatile("s_waitcnt lgkmcnt(" #n ")" ::: "memory")
#define PG8_BAR __builtin_amdgcn_s_barrier()
#define PG8_SCHED __builtin_amdgcn_sched_barrier(0)
    Unit cur, nxt; int ui = 0;
    if (!S.next(0, cur)) return;
    f32x4 acc[2][2][4][2];
#pragma unroll
    for (int a = 0; a < 2; ++a)
#pragma unroll
        for (int b = 0; b < 2; ++b)
#pragma unroll
            for (int m = 0; m < 4; ++m)
#pragma unroll
                for (int n = 0; n < 2; ++n) acc[a][b][m][n] = (f32x4){0.f, 0.f, 0.f, 0.f};
    bf16x8 At[4][2], B0[2][2], B1[2][2];
    const char* cA = (const char*)g.A + (size_t)cur.pm * tstep; const char* cB = (const char*)g.Bt + (size_t)cur.pn * tstep;
    S.a_ready(cur);
    if constexpr (SP2) {
        PG8_STAGE(PG8_SB(0, 0), cB, voffB); PG8_STAGE(PG8_SB(0, 1), cB + hstep, voffB); PG8_STAGE(PG8_SA(0, 0), cA, voffA); PG8_STAGE(PG8_SA(0, 1), cA + hstep, voffA);
        if (wr == 1) PG8_BAR;
        PG8_WAIT_V(2); PG8_BAR;
        PG8_STAGE(PG8_SB(1, 0), cB + kstep, voffB); PG8_STAGE(PG8_SA(1, 0), cA + kstep, voffA); PG8_STAGE(PG8_SB(1, 1), cB + hstep + kstep, voffB);
        PG8_WAIT_V(6); PG8_BAR;
    } else {
        PG8_STAGE(PG8_SB(0, 0), cB, voffB); PG8_STAGE(PG8_SA(0, 0), cA, voffA); PG8_STAGE(PG8_SB(0, 1), cB + hstep, voffB); PG8_STAGE(PG8_SA(0, 1), cA + hstep, voffA);
        if (wr == 1) PG8_BAR;
        PG8_WAIT_V(4); PG8_BAR;
        PG8_STAGE(PG8_SB(1, 0), cB + kstep, voffB); PG8_STAGE(PG8_SA(1, 0), cA + kstep, voffA); PG8_STAGE(PG8_SB(1, 1), cB + hstep + kstep, voffB);
        PG8_WAIT_V(6); PG8_BAR;
    }
    for (;;) {
        const bool has_next = S.next(ui + 1, nxt);
        const char* nA = has_next ? (const char*)g.A + (size_t)nxt.pm * tstep : cA; const char* nB = has_next ? (const char*)g.Bt + (size_t)nxt.pn * tstep : cB;
        for (int t = 0; t < nt; t += 2) {
            const bool last = (t == nt - 2);
            const char* a1 = cA + (size_t)(t + 1) * kstep;
            const char* a2 = last ? nA : cA + (size_t)(t + 2) * kstep; const char* b2 = last ? nB : cB + (size_t)(t + 2) * kstep;
            const char* a3 = a2 + kstep; const char* b3 = b2 + kstep;
            if (last && has_next) S.a_ready(nxt);
            if constexpr (SP2) {
            PG8_LDB(B0, 0, 0); PG8_LDB(B1, 0, 1); PG8_SCHED; PG8_LDA(At, 0, 0); PG8_STAGE(PG8_SA(1, 1), a1 + hstep, voffA);
            PG8_WAIT_V(8); PG8_WAIT_L(0); PG8_BAR; PG8_MMA(0, 0, At, B0); PG8_MMA(0, 1, At, B1); PG8_BAR; PG8_SCHED;
            PG8_LDA(At, 0, 1); PG8_STAGE(PG8_SB(0, 0), b2, voffB); PG8_STAGE(PG8_SB(0, 1), b2 + hstep, voffB); PG8_STAGE(PG8_SA(0, 0), a2, voffA);
            PG8_WAIT_V(8); PG8_WAIT_L(0); PG8_BAR; PG8_MMA(1, 0, At, B0); PG8_MMA(1, 1, At, B1); PG8_BAR; PG8_SCHED;
            PG8_LDB(B0, 1, 0); PG8_LDB(B1, 1, 1); PG8_SCHED; PG8_LDA(At, 1, 0); PG8_STAGE(PG8_SA(0, 1), a2 + hstep, voffA);
            PG8_WAIT_V(8); PG8_WAIT_L(0); PG8_BAR; PG8_MMA(0, 0, At, B0); PG8_MMA(0, 1, At, B1); PG8_BAR; PG8_SCHED;
            PG8_LDA(At, 1, 1); PG8_STAGE(PG8_SB(1, 0), b3, voffB); PG8_STAGE(PG8_SB(1, 1), b3 + hstep, voffB); PG8_STAGE(PG8_SA(1, 0), a3, voffA);
            PG8_WAIT_V(8); PG8_WAIT_L(0); PG8_BAR; PG8_MMA(1, 0, At, B0); PG8_MMA(1, 1, At, B1); PG8_BAR; PG8_SCHED;
            } else {
            PG8_LDB(B0, 0, 0); PG8_SCHED; PG8_LDA(At, 0, 0); PG8_STAGE(PG8_SA(1, 1), a1 + hstep, voffA);
            PG8_WAIT_L(8); PG8_BAR; PG8_WAIT_L(0); PG8_MMA(0, 0, At, B0); PG8_BAR; PG8_SCHED;
            PG8_LDB(B1, 0, 1); PG8_STAGE(PG8_SB(0, 0), b2, voffB);
            PG8_BAR; PG8_WAIT_L(0); PG8_MMA(0, 1, At, B1); PG8_BAR;
            PG8_LDA(At, 0, 1); PG8_STAGE(PG8_SA(0, 0), a2, voffA);
            PG8_BAR; PG8_WAIT_L(0); PG8_MMA(1, 0, At, B0); PG8_BAR; PG8_SCHED;
            PG8_STAGE(PG8_SB(0, 1), b2 + hstep, voffB);
            PG8_WAIT_V(6); PG8_BAR; PG8_MMA(1, 1, At, B1); PG8_BAR;
            PG8_LDB(B0, 1, 0); PG8_SCHED; PG8_LDA(At, 1, 0); PG8_STAGE(PG8_SA(0, 1), a2 + hstep, voffA);
            PG8_WAIT_L(8); PG8_BAR; PG8_WAIT_L(0); PG8_MMA(0, 0, At, B0); PG8_BAR; PG8_SCHED;
            PG8_LDB(B1, 1, 1); PG8_STAGE(PG8_SB(1, 0), b3, voffB);
            PG8_BAR; PG8_WAIT_L(0); PG8_MMA(0, 1, At, B1); PG8_BAR;
            PG8_LDA(At, 1, 1); PG8_STAGE(PG8_SA(1, 0), a3, voffA);
            PG8_BAR; PG8_WAIT_L(0); PG8_MMA(1, 0, At, B0); PG8_BAR; PG8_SCHED;
            PG8_STAGE(PG8_SB(1, 1), b3 + hstep, voffB);
            PG8_WAIT_V(6); PG8_BAR; PG8_MMA(1, 1, At, B1); PG8_BAR;
            }
        }
        if constexpr (ALIGN_EPI) { if (wr == 0) PG8_BAR; }
        if constexpr (!Epi::AFTER_DRAIN) { E(acc, cur, wr, wc, fr, fq); S.done(cur); }
        if (!has_next) break;
#pragma unroll
        for (int a = 0; a < 2; ++a)
#pragma unroll
            for (int b = 0; b < 2; ++b)
#pragma unroll
                for (int m = 0; m < 4; ++m)
#pragma unroll
                    for (int n = 0; n < 2; ++n) acc[a][b][m][n] = (f32x4){0.f, 0.f, 0.f, 0.f};
        cur = nxt; cA = nA; cB = nB; ++ui;
        if constexpr (ALIGN_EPI) { if (wr == 1) PG8_BAR; }
    }
    PG8_WAIT_V(0);
    if constexpr (!ALIGN_EPI) { if (wr == 0) PG8_BAR; }
    PG8_BAR;
    if constexpr (Epi::AFTER_DRAIN) { E.fused(acc, cur, wr, wc, fr, fq, lds, wid, lane); S.done(cur); }
#undef PG8_SA
#undef PG8_SB
#undef PG8_STAGE
#undef PG8_LDA
#undef PG8_LDB
#undef PG8_MMA
#undef PG8_WAIT_V
#undef PG8_WAIT_L
#undef PG8_BAR
#undef PG8_SCHED
}
}

#define GAS __attribute__((address_space(1)))
#define LAS __attribute__((address_space(3)))
typedef unsigned short bf16;
typedef unsigned char uchar;
typedef unsigned v4u __attribute__((ext_vector_type(4)));
typedef unsigned v2u __attribute__((ext_vector_type(2)));
typedef float f32x4 __attribute__((ext_vector_type(4)));
typedef float f32x2 __attribute__((ext_vector_type(2)));
typedef short bf16x8 __attribute__((ext_vector_type(8)));
#define LDS_WAIT() asm volatile("s_waitcnt lgkmcnt(0)" ::: "memory")
#define VM_WAIT() asm volatile("s_waitcnt vmcnt(0)" ::: "memory")

constexpr int NWAVES = 8, NTHR = 512;
constexpr int NB = 8, SEQ = 4096, DM = 1024, CTXL = 256;
constexpr int MROWS = NB * SEQ;
constexpr int CROWS = NB * CTXL;
constexpr int TROWS = MROWS + CROWS;
constexpr int NHEAD = 4, HD = 128, INW = 2064, DFF = 2560, UPW = 5120;
constexpr float EPS = 1e-6f;
constexpr int NUNIT_L = NB * NHEAD * 32, NUNIT_C = NB * NHEAD * 2, NUNIT = NUNIT_L + NUNIT_C;
constexpr int CT_SLOT = 129 * 128;

constexpr size_t MiB = 1u << 20;
constexpr size_t WS_HX = 0, WS_TP = 0, WS_H2 = 0, WS_ACT = 0;
constexpr size_t WS_UF = 68 * MiB, WS_XM = 100 * MiB, WS_CT = 68 * MiB;
constexpr size_t WS_G = 134 * MiB, WS_SC = 137 * MiB, WS_MS = 138 * MiB;
constexpr size_t WS_V = 160 * MiB, WS_Z = 194 * MiB, WS_DC = 226 * MiB, WS_YM = 364 * MiB, WS_U = 160 * MiB;
constexpr size_t WS_WIN = 480 * MiB, WS_WOUT = 484 * MiB, WS_WUP = 486 * MiB, WS_WDN = 496 * MiB, WS_WQ = 501 * MiB, WS_WK = WS_WQ + 131072;
constexpr size_t WS_F1 = 502 * MiB, WS_G2 = WS_F1 + 16384, WS_TW = WS_G2 + 16384;
constexpr size_t WS_MOD = 503 * MiB, WS_CTL = 504 * MiB, WS_ZERO0 = WS_MOD, WS_ZERO_BYTES = 2 * MiB, WS_END = 512 * MiB;
static_assert(WS_DC + (size_t)NUNIT * 2 * CT_SLOT * 4 <= WS_YM && WS_YM + (size_t)MROWS * 1024 * 2 <= WS_U + (size_t)MROWS * UPW * 2 && WS_U + (size_t)MROWS * UPW * 2 <= WS_WIN, "ws map");
static_assert(WS_CT + (size_t)NUNIT_L * 2 * CT_SLOT * 2 <= WS_G && WS_XM + (size_t)TROWS * 512 * 2 <= WS_G && (size_t)MROWS * DFF * 2 <= WS_U, "ws map 2");
constexpr size_t DO_AB = 0, DO_Q = 32 * MiB, DO_K = 64 * MiB;

__device__ __forceinline__ unsigned f2bf(float f) { unsigned u = __builtin_bit_cast(unsigned, f); return (u + 0x7fffu + ((u >> 16) & 1u)) >> 16; }
__device__ __forceinline__ unsigned pk2(float lo, float hi) { return f2bf(lo) | (f2bf(hi) << 16); }
__device__ __forceinline__ float bflo(unsigned w) { return __builtin_bit_cast(float, w << 16); }
__device__ __forceinline__ float bfhi(unsigned w) { return __builtin_bit_cast(float, w & 0xffff0000u); }
__device__ __forceinline__ f32x4 bf4(v2u x) { return (f32x4){bflo(x.x), bfhi(x.x), bflo(x.y), bfhi(x.y)}; }
__device__ __forceinline__ float silu_f(float x) { return x / (1.0f + __expf(-x)); }
__device__ __forceinline__ float logsig_f(float x) { return fminf(x, 0.f) - log1pf(__expf(-fabsf(x))); }
__device__ __forceinline__ float wave_sum(float v) {
#pragma unroll
    for (int o = 1; o < 64; o <<= 1) v += __shfl_xor(v, o);
    return v;
}
__device__ __forceinline__ int img_off(int row, int ch) { return row * 256 + ((ch ^ (row & 15)) << 4); }
struct BFrag { bf16x8 f[4]; };
__device__ __forceinline__ BFrag load_bfrag(const LAS uchar* Bimg, int brow, int kq) { BFrag b;
#pragma unroll
    for (int s = 0; s < 4; ++s) b.f[s] = *(const LAS bf16x8*)(Bimg + img_off(brow, 4 * s + kq));
    return b; }
__device__ __forceinline__ f32x4 mma_a(f32x4 acc, const LAS uchar* Aimg, int arow, const BFrag& b, int kq) {
    bf16x8 a[4];
#pragma unroll
    for (int s = 0; s < 4; ++s) a[s] = *(const LAS bf16x8*)(Aimg + img_off(arow, 4 * s + kq));
#pragma unroll
    for (int s = 0; s < 4; ++s) acc = __builtin_amdgcn_mfma_f32_16x16x32_bf16(a[s], b.f[s], acc, 0, 0, 0);
    return acc; }
#define MEMFENCE() asm volatile("" ::: "memory")


template <int S> __device__ __forceinline__ unsigned tr_lane_off(int lane) { return (unsigned)((8 * (lane >> 4) + ((lane & 15) >> 2)) * S + 8 * (lane & 3)); }
__device__ __forceinline__ unsigned lds_addr(const LAS uchar* p) { return (unsigned)(unsigned long long)p; }
__device__ __forceinline__ bf16x8 pack_frag(v2u lo, v2u hi) { const v4u w = (v4u){lo.x, lo.y, hi.x, hi.y}; return __builtin_bit_cast(bf16x8, w); }
template <int S> __device__ __forceinline__ void tr_load4(unsigned addr, BFrag& f) {
    v2u r0, r1, r2, r3, r4, r5, r6, r7;
    asm volatile("ds_read_b64_tr_b16 %0, %8\n\tds_read_b64_tr_b16 %1, %8 offset:%9\n\tds_read_b64_tr_b16 %2, %8 offset:%10\n\tds_read_b64_tr_b16 %3, %8 offset:%11\n\t"
                 "ds_read_b64_tr_b16 %4, %8 offset:%12\n\tds_read_b64_tr_b16 %5, %8 offset:%13\n\tds_read_b64_tr_b16 %6, %8 offset:%14\n\tds_read_b64_tr_b16 %7, %8 offset:%15\n\ts_waitcnt lgkmcnt(0)"
                 : "=&v"(r0), "=&v"(r1), "=&v"(r2), "=&v"(r3), "=&v"(r4), "=&v"(r5), "=&v"(r6), "=&v"(r7)
                 : "v"(addr), "i"(4 * S), "i"(32 * S), "i"(36 * S), "i"(64 * S), "i"(68 * S), "i"(96 * S), "i"(100 * S) : "memory");
    f.f[0] = pack_frag(r0, r1); f.f[1] = pack_frag(r2, r3); f.f[2] = pack_frag(r4, r5); f.f[3] = pack_frag(r6, r7);
}
template <int S> __device__ __forceinline__ void tr_load2(unsigned addr, bf16x8& f0, bf16x8& f1) {
    v2u r0, r1, r2, r3;
    asm volatile("ds_read_b64_tr_b16 %0, %4\n\tds_read_b64_tr_b16 %1, %4 offset:%5\n\tds_read_b64_tr_b16 %2, %4 offset:%6\n\tds_read_b64_tr_b16 %3, %4 offset:%7\n\ts_waitcnt lgkmcnt(0)"
                 : "=&v"(r0), "=&v"(r1), "=&v"(r2), "=&v"(r3) : "v"(addr), "i"(4 * S), "i"(32 * S), "i"(36 * S) : "memory");
    f0 = pack_frag(r0, r1); f1 = pack_frag(r2, r3);
}
__device__ __forceinline__ f32x4 mma_ff(f32x4 acc, const BFrag& a, const BFrag& b) {
#pragma unroll
    for (int s = 0; s < 4; ++s) acc = __builtin_amdgcn_mfma_f32_16x16x32_bf16(a.f[s], b.f[s], acc, 0, 0, 0);
    return acc; }
__device__ __forceinline__ float lane_scan_add(float v, int lane) {
#pragma unroll
    for (int o = 1; o < 64; o <<= 1) { const float t = __shfl_up(v, o); if (lane >= o) v += t; }
    return v; }
__device__ __forceinline__ float lane_scan_max(float v, int lane) {
#pragma unroll
    for (int o = 1; o < 64; o <<= 1) { const float t = __shfl_up(v, o); if (lane >= o) v = fmaxf(v, t); }
    return v; }
__device__ __forceinline__ float wave_max(float v) {
#pragma unroll
    for (int o = 1; o < 64; o <<= 1) v = fmaxf(v, __shfl_xor(v, o));
    return v; }

#define XB_TMO      128
#define XB_XCNT(j)  (256  + 64 * (j))
#define XB_XSUB(j)  (1280 + 64 * (j))
#define XB_XGEN(j)  (2304 + 64 * (j))
#define XB_TOP      3328
#define XB_TOPGEN   3392
#define XCD_BAR_WORDS 3456
#define XB_SPIN_CAP (1u << 18)

__device__ __forceinline__ unsigned xb_ld(unsigned* p)              { return __hip_atomic_load(p, __ATOMIC_RELAXED, __HIP_MEMORY_SCOPE_AGENT); }
__device__ __forceinline__ unsigned xb_add(unsigned* p, unsigned v) { return __hip_atomic_fetch_add(p, v, __ATOMIC_RELAXED, __HIP_MEMORY_SCOPE_AGENT); }
__device__ __forceinline__ unsigned xb_xcc_id() { return (unsigned)__builtin_amdgcn_s_getreg((3 << 11) | 20) & 0xFu; }
#define XB_SPIN(cond, bar) do { unsigned _sp = 0; while (cond) { __builtin_amdgcn_s_sleep(1); \
    if ((++_sp & 255u) == 0u) { if (xb_ld(&(bar)[XB_TMO])) break; if (_sp > XB_SPIN_CAP) { atomicAdd(&(bar)[XB_TMO], 1u); break; } } } } while (0)

struct XcdBarrier {
    unsigned* bar; unsigned x;
    volatile LAS unsigned* st;
};

__device__ __forceinline__ XcdBarrier xcd_barrier_post(unsigned* bar, volatile LAS unsigned* st) {
    XcdBarrier b; b.bar = bar; b.x = xb_xcc_id(); b.st = st;
    if (threadIdx.x == 0) (void)xb_add(&bar[XB_XCNT(b.x)], 1u);
    return b;
}
__device__ __forceinline__ void xcd_barrier_complete(unsigned* bar, unsigned x, unsigned& nloc, unsigned& nx) {
    const unsigned G = gridDim.x * gridDim.y * gridDim.z;
    unsigned sum, cnt, mine, sp = 0u;
    for (;;) {
        sum = 0u; cnt = 0u; mine = 0u;
#pragma unroll
        for (unsigned j = 0; j < 16; ++j) { const unsigned c = xb_ld(&bar[XB_XCNT(j)]); sum += c; cnt += (c > 0u) ? 1u : 0u; mine = (j == x) ? c : mine; }
        if (sum == G) break;
        __builtin_amdgcn_s_sleep(1);
        if ((++sp & 255u) == 0u) { if (xb_ld(&bar[XB_TMO])) break; if (sp > XB_SPIN_CAP) { atomicAdd(&bar[XB_TMO], 1u); break; } }
    }
    nloc = mine > 0u ? mine : 1u; nx = cnt > 0u ? cnt : 1u;
}

__device__ __forceinline__ void xcd_barrier(const XcdBarrier& b) {
    asm volatile("s_waitcnt vmcnt(0)" ::: "memory");
    __syncthreads();
    if (threadIdx.x == 0) {
        unsigned* bar = b.bar;
        __builtin_amdgcn_s_waitcnt(0);
        unsigned nloc = b.st[0], nx = b.st[1];
        if (nloc == 0u) { xcd_barrier_complete(bar, b.x, nloc, nx); b.st[0] = nloc; b.st[1] = nx; }
        const unsigned old = xb_add(&bar[XB_XSUB(b.x)], 1u);
        const unsigned gen = old / nloc;
        if (old + 1u == (gen + 1u) * nloc) {
            __builtin_amdgcn_fence(__ATOMIC_RELEASE, "agent");
            asm volatile("s_waitcnt vmcnt(0)" ::: "memory");
            const unsigned og = xb_add(&bar[XB_TOP], 1u);
            const unsigned tg = og / nx;
            if (og + 1u == (tg + 1u) * nx) xb_add(&bar[XB_TOPGEN], 1u);
            else XB_SPIN(xb_ld(&bar[XB_TOPGEN]) == tg, bar);
            __builtin_amdgcn_fence(__ATOMIC_ACQUIRE, "agent");
            xb_add(&bar[XB_XGEN(b.x)], 1u);
            asm volatile("s_waitcnt vmcnt(0)" ::: "memory");
        } else {
            XB_SPIN(xb_ld(&bar[XB_XGEN(b.x)]) == gen, bar);
            __builtin_amdgcn_fence(__ATOMIC_ACQUIRE, "agent");
            asm volatile("s_waitcnt vmcnt(0)" ::: "memory");
        }
    }
    __syncthreads();
}


struct Args { const float* in[24]; float* out; uchar* ws; int ph_lo, ph_hi; };

template <class F>
__device__ __forceinline__ void tr_item(F src, bf16* WT, size_t drow0, int ldk, int dk0, LAS float* scr, int lane) {
#pragma unroll 4
    for (int i = 0; i < 32; ++i) { const int kk = 2 * i + (lane >> 5); scr[kk * 33 + (lane & 31)] = src(kk, lane & 31); }
    LDS_WAIT(); asm volatile("" ::: "memory");
    const int c = lane & 7;
#pragma unroll
    for (int j = 0; j < 4; ++j) { const int n = (lane >> 3) + 8 * j; const LAS float* s = scr + (8 * c) * 33 + n;
        v4u o; o.x = pk2(s[0 * 33], s[1 * 33]); o.y = pk2(s[2 * 33], s[3 * 33]); o.z = pk2(s[4 * 33], s[5 * 33]); o.w = pk2(s[6 * 33], s[7 * 33]);
        *(v4u*)(WT + (drow0 + n) * ldk + dk0 + 8 * c) = o; }
    LDS_WAIT(); asm volatile("" ::: "memory");
}

__device__ __forceinline__ void p0_prologue(const Args& a, LAS uchar* lds, int vcu, int G, size_t mod_off) {
    const int tid = threadIdx.x, lane = tid & 63, wave = __builtin_amdgcn_readfirstlane(tid >> 6);
    uchar* ws = a.ws;
    {
        LAS float* sl = (LAS float*)lds;
        float* MOD = (float*)(ws + mod_off);
        const float* w_ada = a.in[4]; const float* b_ada = a.in[5];
        for (int it = blockIdx.x; it < 32 * 12; it += G) {
            const int kc = it / 12, nb = it % 12;
            __syncthreads();
            if (tid < 288) { const int r = tid >> 5, kk = tid & 31; const float cv = (r < 8) ? a.in[1][r * DM + kc * 32 + kk] : a.in[3][kc * 32 + kk]; sl[tid] = silu_f(cv); }
            __syncthreads();
            const int n = nb * 512 + tid;
            float acc[9];
#pragma unroll
            for (int r = 0; r < 9; ++r) acc[r] = 0.f;
#pragma unroll 8
            for (int kk = 0; kk < 32; ++kk) { const float w = w_ada[(size_t)(kc * 32 + kk) * 6144 + n];
#pragma unroll
                for (int r = 0; r < 9; ++r) acc[r] += sl[r * 32 + kk] * w; }
            const float bb = (kc == 0) ? b_ada[n] : 0.f;
#pragma unroll
            for (int r = 0; r < 9; ++r) atomicAdd(&MOD[r * 6144 + n], acc[r] + bb);
        }
        __syncthreads();
    }
    {
        LAS float* tab = (LAS float*)(lds + 8 * 16384);
        if (tid < 128) tab[tid] = cospif((float)tid * (1.0f / 64.0f)) * 0.08838834764831845f;
        __syncthreads();
        const int gt = blockIdx.x * NTHR + tid;
        bf16* F1 = (bf16*)(ws + WS_F1); bf16* G2 = (bf16*)(ws + WS_G2); float* TW = (float*)(ws + WS_TW);
        if (gt < 8192) { const int row = gt >> 6, n1 = gt & 63, ri = row >> 6, k1 = row & 63; const float ang = (float)((k1 * n1) & 63) * (1.0f / 32.0f);
            F1[gt] = (bf16)f2bf((ri == 0 ? cospif(ang) : -sinpif(ang)) * 0.125f); }
        else if (gt < 16384) { const int i = gt - 8192, k2 = i >> 7, kap = i & 127, n2 = kap & 63; const float ang = (float)((k2 * n2) & 63) * (1.0f / 32.0f);
            G2[i] = (bf16)f2bf((kap < 64 ? cospif(ang) : sinpif(ang)) * 0.125f); }
        else if (gt < 16384 + 4096) { const int i = gt - 16384; TW[i] = cospif((float)i * (1.0f / 2048.0f)); }
    }
    {
        const LAS float* tab = (const LAS float*)(lds + 8 * 16384);
        LAS float* Tm = (LAS float*)lds;
        LAS float* wT = (LAS float*)(lds + 65536);
        const float* w_in = a.in[7]; bf16* WIN = (bf16*)(a.ws + WS_WIN);
        bool have_T = false;
        for (int it = blockIdx.x; it < 64; it += G) {
            const int g = it >> 4, k0 = (it & 15) * 64;
            __syncthreads();
            if (!have_T) { for (int id = tid; id < 128 * 128; id += NTHR) { const int c = id >> 7, s_ = id & 127; const int mult = (s_ <= 64) ? s_ : (s_ - 64), off = (s_ <= 64) ? 0 : 96; Tm[id] = tab[(c * mult + off) & 127]; } have_T = true; }
            for (int id = tid; id < 64 * 32; id += NTHR) { const int kk = id >> 5, c4 = id & 31; const f32x4 v = *(const f32x4*)(w_in + (size_t)(k0 + kk) * INW + g * 128 + 4 * c4);
                wT[(4 * c4 + 0) * 64 + kk] = v.x; wT[(4 * c4 + 1) * 64 + kk] = v.y; wT[(4 * c4 + 2) * 64 + kk] = v.z; wT[(4 * c4 + 3) * 64 + kk] = v.w; }
            __syncthreads();
            const int s4 = (tid & 31) * 4, k4 = (tid >> 5) * 4;
            f32x4 acc[4];
#pragma unroll
            for (int j = 0; j < 4; ++j) acc[j] = (f32x4){0.f, 0.f, 0.f, 0.f};
#pragma unroll 4
            for (int c = 0; c < 128; ++c) { const f32x4 tv = *(const LAS f32x4*)(Tm + c * 128 + s4), wv_ = *(const LAS f32x4*)(wT + c * 64 + k4);
                acc[0] += wv_ * tv.x; acc[1] += wv_ * tv.y; acc[2] += wv_ * tv.z; acc[3] += wv_ * tv.w; }
#pragma unroll
            for (int j = 0; j < 4; ++j) *(v2u*)(WIN + (size_t)(g * 128 + s4 + j) * DM + k0 + k4) = (v2u){pk2(acc[j].x, acc[j].y), pk2(acc[j].z, acc[j].w)};
        }
        __syncthreads();
    }
    {
        LAS float* scr = (LAS float*)(lds + wave * 16384);
        const LAS float* tab = (const LAS float*)(lds + 8 * 16384);
        const int gw = vcu * NWAVES + wave, NGW = G * NWAVES;
        const float* w_in = a.in[7]; const float* w_out = a.in[15]; const float* w_up = a.in[17]; const float* w_dn = a.in[21];
        const float* w_q = a.in[10]; const float* w_k = a.in[11];
        bf16* WIN = (bf16*)(ws + WS_WIN); bf16* WOUT = (bf16*)(ws + WS_WOUT); bf16* WUP = (bf16*)(ws + WS_WUP); bf16* WDN = (bf16*)(ws + WS_WDN);
        bf16* WQ = (bf16*)(ws + WS_WQ); bf16* WK = (bf16*)(ws + WS_WK);
        constexpr int I_XV = 16 * 32, I_Z = 16 * 16, I_OF = 8 * 32, I_OM = 8 * 32, I_UP = 16 * 160, I_DN = 40 * 32, I_QK = 2 * 4 * 4;
        constexpr int NIT = I_XV + I_Z + I_OF + I_OM + I_UP + I_DN + 2 * I_QK;
        for (int it = gw; it < NIT; it += NGW) {
            int r = it;
            if (r < I_XV) { const int kb = r / 32, nb = r % 32, k0 = kb * 64, n0 = nb * 32;
                auto src = [&](int kk, int nn) -> float { return w_in[(size_t)(k0 + kk) * INW + 512 + n0 + nn]; };
                tr_item(src, WIN, (size_t)(512 + n0), DM, k0, scr, lane); continue; } r -= I_XV;
            if (r < I_Z) { const int kb = r / 16, nb = r % 16, k0 = kb * 64, n0 = nb * 32;
                auto src = [&](int kk, int nn) -> float { return w_in[(size_t)(k0 + kk) * INW + 1552 + n0 + nn]; };
                tr_item(src, WIN, (size_t)(1536 + n0), DM, k0, scr, lane); continue; } r -= I_Z;
            if (r < I_OF) { const int kb = r / 32, nb = r % 32, k0 = kb * 64, n0 = nb * 32;
                auto src = [&](int kk, int nn) -> float { const int k = k0 + kk, g = k >> 7, s = k & 127; const float* wo = w_out + (size_t)(g * 128) * DM + n0 + nn;
                    if (s == 0 || s == 64) return wo[(size_t)s * DM];
                    if (s < 64) return wo[(size_t)s * DM] + wo[(size_t)(128 - s) * DM];
                    const int kq = s - 64; return wo[(size_t)(128 - kq) * DM] - wo[(size_t)kq * DM]; };
                tr_item(src, WOUT, (size_t)n0, DM, k0, scr, lane); continue; } r -= I_OF;
            if (r < I_OM) { const int kb = r / 32, nb = r % 32, k0 = kb * 64, n0 = nb * 32;
                auto src = [&](int kk, int nn) -> float { return w_out[(size_t)(512 + k0 + kk) * DM + n0 + nn]; };
                tr_item(src, WOUT, (size_t)n0, DM, 512 + k0, scr, lane); continue; } r -= I_OM;
            if (r < I_UP) { const int kb = r / 160, nb = r % 160, k0 = kb * 64, n0 = nb * 32;
                auto src = [&](int kk, int nn) -> float { return w_up[(size_t)(k0 + kk) * UPW + n0 + nn]; };
                tr_item(src, WUP, (size_t)n0, DM, k0, scr, lane); continue; } r -= I_UP;
            if (r < I_DN) { const int kb = r / 32, nb = r % 32, k0 = kb * 64, n0 = nb * 32;
                auto src = [&](int kk, int nn) -> float { return w_dn[(size_t)(k0 + kk) * DM + n0 + nn]; };
                tr_item(src, WDN, (size_t)n0, DFF, k0, scr, lane); continue; } r -= I_DN;
            {   const bool isk = r >= I_QK; if (isk) r -= I_QK;
                const int h = r / 8, kb = (r % 8) / 4, nb = r % 4, k0 = kb * 64, n0 = nb * 32;
                const float* W = (isk ? w_k : w_q) + (size_t)h * HD * HD; const float sc = isk ? 0.08838834764831845f : 1.0f;
                auto src = [&](int kk, int nn) -> float { return W[(size_t)(k0 + kk) * HD + n0 + nn] * sc; };
                tr_item(src, (isk ? WK : WQ) + (size_t)h * HD * HD, (size_t)n0, HD, k0, scr, lane); }
        }
    }
}

__device__ __forceinline__ void p1_rows(const Args& a, LAS uchar* lds, int vcu, int G) {
    const int tid = threadIdx.x, lane = tid & 63, wave = __builtin_amdgcn_readfirstlane(tid >> 6);
    uchar* ws = a.ws;
    {
        LAS f32x4* wg = (LAS f32x4*)lds;
        const float* w_in = a.in[7];
        for (int id = tid; id < 4096; id += NTHR) { const int k = id >> 2, q = id & 3; const int l = (k & 255) >> 2, i = k & 3, j = k >> 8;
            wg[((j * 4 + i) * 4 + q) * 64 + l] = *(const f32x4*)(w_in + (size_t)k * INW + 1536 + 4 * q); }
        __syncthreads();
    }
    const LAS f32x4* wg = (const LAS f32x4*)lds;
    const float* MOD = (const float*)(ws + WS_MOD);
    const float* nw = a.in[6]; const float* bg = a.in[12];
    bf16* HX = (bf16*)(ws + WS_HX); float* GG = (float*)(ws + WS_G);
    const int gw = vcu * NWAVES + wave, NGW = G * NWAVES;
    for (int row = gw; row < TROWS; row += NGW) {
        const float* xr; const float* md;
        if (row < MROWS) { xr = a.in[0] + (size_t)row * DM; md = MOD + (size_t)(row >> 12) * 6144; }
        else { xr = a.in[2] + (size_t)(row - MROWS) * DM; md = MOD + (size_t)8 * 6144; }
        f32x4 v[4]; float s = 0.f;
#pragma unroll
        for (int j = 0; j < 4; ++j) { v[j] = *(const f32x4*)(xr + 4 * lane + 256 * j); s += (v[j].x * v[j].x + v[j].y * v[j].y) + (v[j].z * v[j].z + v[j].w * v[j].w); }
        const float rstd = rsqrtf(wave_sum(s) * (1.0f / DM) + EPS);
        float g[16];
#pragma unroll
        for (int i = 0; i < 16; ++i) g[i] = 0.f;
#pragma unroll
        for (int j = 0; j < 4; ++j) {
            const f32x4 w = *(const f32x4*)(nw + 4 * lane + 256 * j), sh = *(const f32x4*)(md + 4 * lane + 256 * j), sc = *(const f32x4*)(md + 1024 + 4 * lane + 256 * j);
            v[j] = v[j] * rstd * w * (sc + 1.0f) + sh;
            *(v2u*)(HX + (size_t)row * DM + 4 * lane + 256 * j) = (v2u){pk2(v[j].x, v[j].y), pk2(v[j].z, v[j].w)};
        }
#pragma unroll
        for (int j = 0; j < 4; ++j) {
#pragma unroll
            for (int i = 0; i < 4; ++i) {
#pragma unroll
                for (int q = 0; q < 4; ++q) { const f32x4 ww = wg[((j * 4 + i) * 4 + q) * 64 + lane];
                    g[4 * q + 0] += v[j][i] * ww.x; g[4 * q + 1] += v[j][i] * ww.y; g[4 * q + 2] += v[j][i] * ww.z; g[4 * q + 3] += v[j][i] * ww.w; }
                if (i & 1) MEMFENCE(); }
        }
        float g8[8], g4[4], g2[2], g1;
        { const bool hi = (lane & 32) != 0;
#pragma unroll
          for (int i = 0; i < 8; ++i) { const float keep = hi ? g[i + 8] : g[i], send = hi ? g[i] : g[i + 8]; g8[i] = keep + __shfl_xor(send, 32); } }
        { const bool hi = (lane & 16) != 0;
#pragma unroll
          for (int i = 0; i < 4; ++i) { const float keep = hi ? g8[i + 4] : g8[i], send = hi ? g8[i] : g8[i + 4]; g4[i] = keep + __shfl_xor(send, 16); } }
        { const bool hi = (lane & 8) != 0;
#pragma unroll
          for (int i = 0; i < 2; ++i) { const float keep = hi ? g4[i + 2] : g4[i], send = hi ? g4[i] : g4[i + 2]; g2[i] = keep + __shfl_xor(send, 8); } }
        { const bool hi = (lane & 4) != 0; const float keep = hi ? g2[1] : g2[0], send = hi ? g2[0] : g2[1]; g1 = keep + __shfl_xor(send, 4); }
        g1 += __shfl_xor(g1, 2); g1 += __shfl_xor(g1, 1);
        if ((lane & 3) == 0) { const int idx = ((lane & 32) ? 8 : 0) + ((lane & 16) ? 4 : 0) + ((lane & 8) ? 2 : 0) + ((lane & 4) ? 1 : 0); GG[(size_t)row * 16 + idx] = g1 + bg[idx]; }
    }
}
__device__ __forceinline__ void p7_rows(const Args& a, int vcu, int G) {
    const int tid = threadIdx.x, lane = tid & 63, wave = __builtin_amdgcn_readfirstlane(tid >> 6);
    const float* MOD = (const float*)(a.ws + WS_MOD); const float* nw = a.in[16]; bf16* H2 = (bf16*)(a.ws + WS_H2);
    const int gw = vcu * NWAVES + wave, NGW = G * NWAVES;
    for (int row = gw; row < MROWS; row += NGW) {
        const float* xr = a.out + (size_t)row * DM; const float* md = MOD + (size_t)(row >> 12) * 6144;
        f32x4 v[4]; float s = 0.f;
#pragma unroll
        for (int j = 0; j < 4; ++j) { v[j] = *(const f32x4*)(xr + 4 * lane + 256 * j); s += (v[j].x * v[j].x + v[j].y * v[j].y) + (v[j].z * v[j].z + v[j].w * v[j].w); }
        const float rstd = rsqrtf(wave_sum(s) * (1.0f / DM) + EPS);
#pragma unroll
        for (int j = 0; j < 4; ++j) {
            const f32x4 w = *(const f32x4*)(nw + 4 * lane + 256 * j), sh = *(const f32x4*)(md + 3072 + 4 * lane + 256 * j), sc = *(const f32x4*)(md + 4096 + 4 * lane + 256 * j);
            const f32x4 hv = v[j] * rstd * w * (sc + 1.0f) + sh;
            *(v2u*)(H2 + (size_t)row * DM + 4 * lane + 256 * j) = (v2u){pk2(hv.x, hv.y), pk2(hv.z, hv.w)}; }
    }
}
__device__ __forceinline__ void p11_rows(const Args& a, int vcu, int G, float* dst) {
    const int tid = threadIdx.x, lane = tid & 63, wave = __builtin_amdgcn_readfirstlane(tid >> 6);
    const float* nw = a.in[23];
    const int gw = vcu * NWAVES + wave, NGW = G * NWAVES;
    for (int row = gw; row < MROWS; row += NGW) {
        float* xr = a.out + (size_t)row * DM;
        f32x4 v[4]; float s = 0.f;
#pragma unroll
        for (int j = 0; j < 4; ++j) { v[j] = *(const f32x4*)(xr + 4 * lane + 256 * j); s += (v[j].x * v[j].x + v[j].y * v[j].y) + (v[j].z * v[j].z + v[j].w * v[j].w); }
        const float rstd = rsqrtf(wave_sum(s) * (1.0f / DM) + EPS);
#pragma unroll
        for (int j = 0; j < 4; ++j) { const f32x4 w = *(const f32x4*)(nw + 4 * lane + 256 * j); *(f32x4*)(dst + (size_t)row * DM + 4 * lane + 256 * j) = v[j] * rstd * w; }
    }
}

struct SchedP2 {
    pg8::StaticOrder so;
    __device__ void init(int G, int c) { so.init(MROWS, 2048, G, c); }
    __device__ bool next(int i, pg8::Unit& u) const {
        const long L = (long)i * so.G + so.c;
        if (L < so.nwg) return so.next(i, u);
        const int r = (int)(L - so.nwg); if (r >= 32) return false;
        u.pm = 128 + (r & 7); u.pn = 2 + (r >> 3); return true;
    }
    __device__ __forceinline__ void a_ready(const pg8::Unit&) const {}
    __device__ __forceinline__ void done(const pg8::Unit&) const {}
};
struct EpiP2 {
    static constexpr bool PERM = true, AFTER_DRAIN = false;
    bf16 *base0, *base1, *base2, *base3;
    __device__ __forceinline__ void operator()(const f32x4 (&acc)[2][2][4][2], const pg8::Unit& u, int wr, int wc, int fr, int fq) const {
        const int row0 = u.pm * 256 + wr * 64 + fr; const int sel = u.pn >> 1; bf16* O = sel == 0 ? base0 : (sel == 1 ? base1 : (sel == 2 ? base2 : base3)); const int col0 = (u.pn & 1) * 256 + wc * 32 + 8 * fq;
#pragma unroll
        for (int ai = 0; ai < 2; ++ai)
#pragma unroll
            for (int m = 0; m < 4; ++m) { bf16* rowp = O + (size_t)(row0 + ai * 128 + m * 16) * 512 + col0;
#pragma unroll
                for (int bj = 0; bj < 2; ++bj) { const f32x4 v0 = acc[ai][bj][m][0], v1 = acc[ai][bj][m][1];
                    v4u w; w.x = pg8::cvt_pk_bf16(v0[0], v0[1]); w.y = pg8::cvt_pk_bf16(v0[2], v0[3]); w.z = pg8::cvt_pk_bf16(v1[0], v1[1]); w.w = pg8::cvt_pk_bf16(v1[2], v1[3]);
                    *(v4u*)(rowp + bj * 128) = w; } }
    }
};
struct EpiBias16 {
    static constexpr bool PERM = true, AFTER_DRAIN = false;
    bf16* O; int ldc; const float* bias;
    __device__ __forceinline__ void operator()(const f32x4 (&acc)[2][2][4][2], const pg8::Unit& u, int wr, int wc, int fr, int fq) const {
        const int row0 = u.pm * 256 + wr * 64 + fr; const int col0 = u.pn * 256 + wc * 32 + 8 * fq;
        f32x4 bv[2][2];
#pragma unroll
        for (int bj = 0; bj < 2; ++bj)
#pragma unroll
            for (int n = 0; n < 2; ++n) bv[bj][n] = *(const f32x4*)(bias + col0 + bj * 128 + 4 * n);
#pragma unroll
        for (int ai = 0; ai < 2; ++ai)
#pragma unroll
            for (int m = 0; m < 4; ++m) { bf16* rowp = O + (size_t)(row0 + ai * 128 + m * 16) * ldc + col0;
#pragma unroll
                for (int bj = 0; bj < 2; ++bj) { const f32x4 v0 = acc[ai][bj][m][0] + bv[bj][0], v1 = acc[ai][bj][m][1] + bv[bj][1];
                    v4u w; w.x = pg8::cvt_pk_bf16(v0[0], v0[1]); w.y = pg8::cvt_pk_bf16(v0[2], v0[3]); w.z = pg8::cvt_pk_bf16(v1[0], v1[1]); w.w = pg8::cvt_pk_bf16(v1[2], v1[3]);
                    *(v4u*)(rowp + bj * 128) = w; } }
    }
};
struct EpiRes {
    static constexpr bool PERM = false, AFTER_DRAIN = false;
    const float* res; float* out; const float* gate; const float* bias;
    __device__ __forceinline__ void operator()(const f32x4 (&acc)[2][2][4][2], const pg8::Unit& u, int wr, int wc, int fr, int fq) const {
        const int row0 = u.pm * 256 + wr * 64 + fr, col0 = u.pn * 256 + wc * 32 + 4 * fq;
        const float* gp = gate + (size_t)((u.pm * 256) >> 12) * 6144 + col0;
        f32x4 gv[2][2], bv[2][2];
#pragma unroll
        for (int bj = 0; bj < 2; ++bj)
#pragma unroll
            for (int n = 0; n < 2; ++n) { gv[bj][n] = *(const f32x4*)(gp + bj * 128 + n * 16); bv[bj][n] = bias ? *(const f32x4*)(bias + col0 + bj * 128 + n * 16) : (f32x4){0.f, 0.f, 0.f, 0.f}; }
#pragma unroll
        for (int ai = 0; ai < 2; ++ai)
#pragma unroll
            for (int m = 0; m < 4; ++m) { const size_t off = (size_t)(row0 + ai * 128 + m * 16) * DM + col0;
#pragma unroll
                for (int bj = 0; bj < 2; ++bj)
#pragma unroll
                    for (int n = 0; n < 2; ++n) { const f32x4 r = *(const f32x4*)(res + off + bj * 128 + n * 16);
                        *(f32x4*)(out + off + bj * 128 + n * 16) = r + gv[bj][n] * (acc[ai][bj][m][n] + bv[bj][n]); }
                asm volatile("" ::: "memory"); }
    }
};

constexpr int PA_A = 0, PA_V = 32768, PA_KF = 69632, PA_KB = 106496, PA_SM = 143360, VS = 288;
__device__ __forceinline__ void unit_decode(int unit, int& bh, int& row0, int& t0, int& L) {
    if (unit < NUNIT_L) { bh = unit >> 5; const int c = unit & 31; row0 = (bh >> 2) * SEQ + c * 128; t0 = c * 128; L = SEQ; }
    else { const int uc = unit - NUNIT_L; bh = uc >> 1; const int cc = uc & 1; row0 = MROWS + (bh >> 2) * CTXL + cc * 128; t0 = cc * 128; L = CTXL; }
}
__device__ __forceinline__ void stage_v(const bf16* V, int row0, int h, LAS uchar* img, int tid) {
    const int j = tid >> 2, seg = tid & 3; const bf16* vr = V + (size_t)(row0 + j) * 512 + h * HD + seg * 32;
#pragma unroll
    for (int i = 0; i < 4; ++i) *(LAS v4u*)(img + j * VS + (seg * 32 + 8 * i) * 2) = *(const v4u*)(vr + 8 * i);
    if (seg == 0) *(LAS v4u*)(img + j * VS + 256) = (v4u){0x00003f80u, 0u, 0u, 0u};
    if (seg == 1) *(LAS v4u*)(img + j * VS + 272) = (v4u){0u, 0u, 0u, 0u};
}
__device__ __forceinline__ void prep_unit(const Args& a, LAS uchar* lds, int unit) {
    int tid_ = threadIdx.x; asm volatile("" : "+v"(tid_)); const int tid = tid_, lane = tid & 63, wave = __builtin_amdgcn_readfirstlane(tid >> 6), kq = lane >> 4, fr = lane & 15;
    uchar* ws = a.ws;
    int bh, row0, t0, L; unit_decode(unit, bh, row0, t0, L);
    const int h = bh & 3; const bool latent = unit < NUNIT_L;
    LAS float* sm = (LAS float*)(lds + PA_SM);
    const bf16* XM = (const bf16*)(ws + WS_XM); const bf16* V = (const bf16*)(ws + WS_V);
    bf16* AB = (bf16*)((uchar*)a.out + DO_AB); bf16* Q = (bf16*)((uchar*)a.out + DO_Q); bf16* K = (bf16*)((uchar*)a.out + DO_K);
    __syncthreads();
    if (wave < 2) {
        const float* GG = (const float*)(ws + WS_G) + (size_t)row0 * 16 + wave * 8 + h;
        const int j0 = wave ? 127 - 2 * lane : 2 * lane, j1 = wave ? 126 - 2 * lane : 2 * lane + 1;
        const float li0 = GG[j0 * 16], lf0 = logsig_f(GG[j0 * 16 + 4]), li1 = GG[j1 * 16], lf1 = logsig_f(GG[j1 * 16 + 4]);
        const float incl = lane_scan_add(lf0 + lf1, lane), total = __shfl(incl, 63);
        const float g0 = total - (incl - lf1) + li0, g1 = total - incl + li1;
        const float mx = wave_max(fmaxf(g0, g1));
        sm[wave * 128 + j0] = __expf(g0 - mx); sm[wave * 128 + j1] = __expf(g1 - mx);
        if (lane == 0) { sm[256 + 2 * wave] = total; sm[257 + 2 * wave] = mx; }
    }
    {
        const int l = tid >> 2, seg = tid & 3, t = t0 + l; const int colg = h * HD + seg * 32;
        const bool hp = t > 0, hn = t + 1 < L;
        const bf16* xc = XM + (size_t)(row0 + l) * 512 + colg;
        const float* cw = a.in[8]; const float* cb = a.in[9];
#pragma unroll
        for (int i = 0; i < 4; ++i) {
            const v4u c = *(const v4u*)(xc + 8 * i); v4u p = (v4u){0u, 0u, 0u, 0u}, n = (v4u){0u, 0u, 0u, 0u};
            if (hp) p = *(const v4u*)(xc - 512 + 8 * i);
            if (hn) n = *(const v4u*)(xc + 512 + 8 * i);
            float o[8];
#pragma unroll
            for (int e = 0; e < 8; ++e) { const int ch = colg + 8 * i + e; const unsigned pw = p[e >> 1], cw_ = c[e >> 1], nw_ = n[e >> 1];
                const float xp = (e & 1) ? bfhi(pw) : bflo(pw), xcv = (e & 1) ? bfhi(cw_) : bflo(cw_), xn = (e & 1) ? bfhi(nw_) : bflo(nw_);
                o[e] = silu_f(cw[ch] * xp + cw[512 + ch] * xcv + cw[1024 + ch] * xn + cb[ch]); }
            const v4u w = (v4u){pk2(o[0], o[1]), pk2(o[2], o[3]), pk2(o[4], o[5]), pk2(o[6], o[7])};
            *(LAS v4u*)(lds + PA_A + img_off(l, seg * 4 + i)) = w;
            if (latent) *(v4u*)(AB + (size_t)(row0 + l) * 512 + colg + 8 * i) = w;
        }
    }
    stage_v(V, row0, h, lds + PA_V, tid);
    __syncthreads();
    {
        const BFrag ba = load_bfrag(lds + PA_A, 16 * wave + fr, kq);
        const int j = 16 * wave + fr; const float wfj = sm[j], wbj = sm[128 + j];
        const size_t tok = (size_t)(row0 + j);
        for (int pass = latent ? 0 : 1; pass < 2; ++pass) {
            const bf16* W = (const bf16*)(ws + (pass ? WS_WK : WS_WQ)) + (size_t)h * HD * HD + fr * 128 + 8 * kq;
            f32x4 acc[8];
#pragma unroll
            for (int mt = 0; mt < 8; ++mt) { BFrag aw;
#pragma unroll
                for (int s_ = 0; s_ < 4; ++s_) aw.f[s_] = *(const bf16x8*)(W + mt * 2048 + 32 * s_);
                acc[mt] = mma_ff((f32x4){0.f, 0.f, 0.f, 0.f}, aw, ba); if ((mt & 3) == 3) MEMFENCE(); }
            bf16* dst = (pass ? K : Q) + tok * 512 + h * HD + 4 * kq;
#pragma unroll
            for (int mt = 0; mt < 8; ++mt) {
                if (latent) *(v2u*)(dst + 16 * mt) = (v2u){pk2(acc[mt][0], acc[mt][1]), pk2(acc[mt][2], acc[mt][3])};
                if (pass) { const f32x4 kf = acc[mt] * wfj, kb = acc[mt] * wbj;
                    *(LAS v2u*)(lds + PA_KF + j * VS + (16 * mt + 4 * kq) * 2) = (v2u){pk2(kf[0], kf[1]), pk2(kf[2], kf[3])};
                    *(LAS v2u*)(lds + PA_KB + j * VS + (16 * mt + 4 * kq) * 2) = (v2u){pk2(kb[0], kb[1]), pk2(kb[2], kb[3])}; } }
        }
    }
    __syncthreads();
    {
        bf16* DC = (bf16*)(ws + WS_DC); float* SC = (float*)(ws + WS_SC);
        const unsigned lo = tr_lane_off<VS>(lane);
        BFrag bv, b1; tr_load4<VS>(lds_addr(lds + PA_V) + lo + 32 * wave, bv); tr_load4<VS>(lds_addr(lds + PA_V) + lo + 32 * 8, b1);
        for (int dir = 0; dir < 2; ++dir) {
            const unsigned kbase = lds_addr(lds + (dir ? PA_KB : PA_KF)) + lo;
            bf16* dst = DC + (size_t)(unit * 2 + dir) * CT_SLOT;
#pragma unroll
            for (int mt = 0; mt < 8; ++mt) { BFrag ak; tr_load4<VS>(kbase + 32 * mt, ak);
                const f32x4 acc = mma_ff((f32x4){0.f, 0.f, 0.f, 0.f}, ak, bv);
                *(v2u*)(dst + (size_t)(16 * wave + fr) * 128 + 16 * mt + 4 * kq) = (v2u){pk2(acc[0], acc[1]), pk2(acc[2], acc[3])};
                if (mt == wave) { const f32x4 an = mma_ff((f32x4){0.f, 0.f, 0.f, 0.f}, ak, b1);
                    if (fr == 0) *(v2u*)(dst + (size_t)128 * 128 + 16 * mt + 4 * kq) = (v2u){pk2(an[0], an[1]), pk2(an[2], an[3])}; } }
            if (tid == 0) { SC[(unit * 2 + dir) * 2] = sm[256 + 2 * dir]; SC[(unit * 2 + dir) * 2 + 1] = sm[257 + 2 * dir]; }
        }
    }
}

constexpr int F1S = 144, F2S = 80;
__device__ __forceinline__ void fft1_wave(const Args& a, LAS uchar* wl, int item, const bf16x8 (&bfr)[8][2], int lane) {
    const int kq = lane >> 4, fr = lane & 15;
    const int b = item >> 9, chunk = item & 511, cg0 = chunk * 64, n2 = cg0 >> 9, colb = cg0 & 511;
    const bf16* UF = (const bf16*)(a.ws + WS_UF) + (size_t)b * SEQ * 512 + cg0;
    bf16* TP = (bf16*)(a.ws + WS_TP); const float* TW = (const float*)(a.ws + WS_TW);
    v4u ld[8];
#pragma unroll
    for (int i = 0; i < 8; ++i) ld[i] = *(const v4u*)(UF + (size_t)(i * 8 + (lane >> 3)) * 32768 + (lane & 7) * 8);
#pragma unroll
    for (int i = 0; i < 8; ++i) *(LAS v4u*)(wl + (i * 8 + (lane >> 3)) * F1S + (lane & 7) * 16) = ld[i];
    LDS_WAIT();
    const unsigned base = lds_addr(wl) + tr_lane_off<F1S>(lane);
#pragma unroll 1
    for (int mt = 0; mt < 4; ++mt) {
        bf16x8 a0, a1; tr_load2<F1S>(base + 32 * mt, a0, a1);
        f32x4 acc[8];
#pragma unroll
        for (int nt = 0; nt < 8; ++nt) { acc[nt] = __builtin_amdgcn_mfma_f32_16x16x32_bf16(a0, bfr[nt][0], (f32x4){0.f, 0.f, 0.f, 0.f}, 0, 0, 0); acc[nt] = __builtin_amdgcn_mfma_f32_16x16x32_bf16(a1, bfr[nt][1], acc[nt], 0, 0, 0); }
        const int c0 = 16 * mt + 4 * kq, col0 = colb + c0;
#pragma unroll
        for (int nt = 0; nt < 4; ++nt) { const int k1 = 16 * nt + fr; const int idx = (n2 * k1) & 4095; const float cs = TW[idx], sn = TW[(idx - 1024) & 4095];
            float pr[4], pi[4];
#pragma unroll
            for (int r = 0; r < 4; ++r) { const float tr = acc[nt][r], ti = acc[nt + 4][r]; const float xr = tr * cs + ti * sn, xi = ti * cs - tr * sn;
                const bool st = ((col0 + r) & 127) >= 65; pr[r] = st ? -xi : xr; pi[r] = st ? xr : xi; }
            const size_t o = ((size_t)(b * 2) * 64 + k1) * 32768 + (size_t)cg0 + c0;
            *(v2u*)(TP + o) = (v2u){pk2(pr[0], pr[1]), pk2(pr[2], pr[3])};
            *(v2u*)(TP + o + (size_t)64 * 32768) = (v2u){pk2(pi[0], pi[1]), pk2(pi[2], pi[3])}; }
    }
}
__device__ __forceinline__ void fft2_wave(const Args& a, LAS uchar* wl, int item, const bf16x8 (&bfr)[4][4], int lane) {
    const int kq = lane >> 4, fr = lane & 15;
    const int b = item >> 10, k1 = (item >> 4) & 63, chunk = item & 15;
    const bf16* TP = (const bf16*)(a.ws + WS_TP); bf16* YM = (bf16*)(a.ws + WS_YM);
    v4u ld[8];
#pragma unroll
    for (int i = 0; i < 8; ++i) { const int kap = i * 16 + (lane >> 2), ri = kap >> 6, n2 = kap & 63;
        ld[i] = *(const v4u*)(TP + ((size_t)(b * 2 + ri) * 64 + k1) * 32768 + (size_t)n2 * 512 + chunk * 32 + (lane & 3) * 8); }
#pragma unroll
    for (int i = 0; i < 8; ++i) *(LAS v4u*)(wl + (i * 16 + (lane >> 2)) * F2S + (lane & 3) * 16) = ld[i];
    LDS_WAIT();
    const unsigned base = lds_addr(wl) + tr_lane_off<F2S>(lane);
#pragma unroll
    for (int mt = 0; mt < 2; ++mt) {
        BFrag af; tr_load4<F2S>(base + 32 * mt, af);
#pragma unroll
        for (int nt = 0; nt < 4; ++nt) { f32x4 acc = (f32x4){0.f, 0.f, 0.f, 0.f};
#pragma unroll
            for (int s_ = 0; s_ < 4; ++s_) acc = __builtin_amdgcn_mfma_f32_16x16x32_bf16(af.f[s_], bfr[nt][s_], acc, 0, 0, 0);
            const int k2 = 16 * nt + fr; const size_t row = (size_t)b * SEQ + k1 + 64 * k2;
            *(v2u*)(YM + row * 1024 + chunk * 32 + 16 * mt + 4 * kq) = (v2u){pk2(acc[0], acc[1]), pk2(acc[2], acc[3])}; }
    }
}
__device__ __forceinline__ void fft1_phase(const Args& a, LAS uchar* lds, int vcu, int G) {
    const int tid = threadIdx.x, lane = tid & 63, wave = __builtin_amdgcn_readfirstlane(tid >> 6), kq = lane >> 4, fr = lane & 15;
    const bf16* F1 = (const bf16*)(a.ws + WS_F1);
    bf16x8 bfr[8][2];
#pragma unroll
    for (int nt = 0; nt < 8; ++nt)
#pragma unroll
        for (int s_ = 0; s_ < 2; ++s_) bfr[nt][s_] = *(const bf16x8*)(F1 + (16 * nt + fr) * 64 + 32 * s_ + 8 * kq);
    LAS uchar* wl = lds + wave * 9216;
    for (int it = vcu * NWAVES + wave; it < NB * 512; it += G * NWAVES) fft1_wave(a, wl, it, bfr, lane);
}
__device__ __forceinline__ void fft2_phase(const Args& a, LAS uchar* lds, int vcu, int G) {
    const int tid = threadIdx.x, lane = tid & 63, wave = __builtin_amdgcn_readfirstlane(tid >> 6), kq = lane >> 4, fr = lane & 15;
    const bf16* G2 = (const bf16*)(a.ws + WS_G2);
    bf16x8 bfr[4][4];
#pragma unroll
    for (int nt = 0; nt < 4; ++nt)
#pragma unroll
        for (int s_ = 0; s_ < 4; ++s_) bfr[nt][s_] = *(const bf16x8*)(G2 + (16 * nt + fr) * 128 + 32 * s_ + 8 * kq);
    LAS uchar* wl = lds + wave * 10240;
    for (int it = vcu * NWAVES + wave; it < NB * 1024; it += G * NWAVES) fft2_wave(a, wl, it, bfr, lane);
}

__device__ __forceinline__ void p4_scan(const Args& a, int G) {
    uchar* ws = a.ws;
    const bf16* DC = (const bf16*)(ws + WS_DC); const float* SC = (const float*)(ws + WS_SC);
    bf16* CT = (bf16*)(ws + WS_CT); float* MS = (float*)(ws + WS_MS);
    constexpr int F4 = CT_SLOT / 4;
    const int total = 64 * F4;
    for (int gi = blockIdx.x * NTHR + threadIdx.x; gi < total; gi += G * NTHR) {
        const int seq = gi / F4, i = gi - seq * F4; const int bh = seq >> 1, dir = seq & 1;
        f32x4 s = (f32x4){0.f, 0.f, 0.f, 0.f}; float m = 0.f;
#pragma unroll 2
        for (int step = 0; step < 34; ++step) {
            int unit;
            if (step < 2) unit = NUNIT_L + bh * 2 + (dir ? 1 - step : step);
            else { const int c = dir ? 33 - step : step - 2; unit = bh * 32 + c; }
            const int slot = unit * 2 + dir;
            if (step >= 2) { *(v2u*)(CT + (size_t)slot * CT_SLOT + 4 * i) = (v2u){pk2(s.x, s.y), pk2(s.z, s.w)}; if (i == 0) MS[slot] = m; }
            const float bend = SC[slot * 2], mloc = SC[slot * 2 + 1];
            const float mn = fmaxf(bend + m, mloc), al = __expf(bend + m - mn), be = __expf(mloc - mn);
            const v2u dv = *(const v2u*)(DC + (size_t)slot * CT_SLOT + 4 * i);
            s = s * al + bf4(dv) * be; m = mn;
        }
    }
}

constexpr int OU_CF = 0, OU_CB = 36864, OU_V = 73728, OU_P = 110592, OU_SM = 143360;
__device__ __forceinline__ void out_unit(const Args& a, LAS uchar* lds, int unit) {
    int tid_ = threadIdx.x; asm volatile("" : "+v"(tid_)); const int tid = tid_, lane = tid & 63, wave = __builtin_amdgcn_readfirstlane(tid >> 6), kq = lane >> 4, fr = lane & 15;
    uchar* ws = a.ws;
    const int bh = unit >> 5, c = unit & 31, h = bh & 3, row0 = (bh >> 2) * SEQ + c * 128;
    LAS float* sm = (LAS float*)(lds + OU_SM);
    const bf16* Q = (const bf16*)((const uchar*)a.out + DO_Q); const bf16* K = (const bf16*)((const uchar*)a.out + DO_K); const bf16* AB = (const bf16*)((const uchar*)a.out + DO_AB);
    const bf16* V = (const bf16*)(ws + WS_V); const bf16* Z = (const bf16*)(ws + WS_Z);
    const bf16* CT = (const bf16*)(ws + WS_CT); const float* MS = (const float*)(ws + WS_MS);
    bf16* YM = (bf16*)(ws + WS_YM);
    const float m_f = MS[unit * 2], m_b = MS[unit * 2 + 1];
    __syncthreads();
    if (wave < 2) {
        const float* GG = (const float*)(ws + WS_G) + (size_t)row0 * 16 + wave * 8 + h;
        const int j0 = wave ? 127 - 2 * lane : 2 * lane, j1 = wave ? 126 - 2 * lane : 2 * lane + 1;
        const float li0 = GG[j0 * 16], lf0 = logsig_f(GG[j0 * 16 + 4]), li1 = GG[j1 * 16], lf1 = logsig_f(GG[j1 * 16 + 4]);
        const float incl = lane_scan_add(lf0 + lf1, lane);
        const float b0 = incl - lf1, b1 = incl, r0 = li0 - b0, r1 = li1 - b1;
        const float mi = lane_scan_max(fmaxf(r0, r1), lane); float mprev = __shfl_up(mi, 1); if (lane == 0) mprev = -3.0e38f;
        const float R0 = fmaxf(mprev, r0), R1 = mi, mst = wave ? m_b : m_f;
        LAS float* d = sm + wave * 384;
        d[j0] = r0; d[j1] = r1; d[128 + j0] = fmaxf(mst, R0); d[128 + j1] = fmaxf(mst, R1); d[256 + j0] = b0; d[256 + j1] = b1;
    }
    {
        const bf16* sf = CT + (size_t)(unit * 2) * CT_SLOT; const bf16* sb = sf + CT_SLOT;
#pragma unroll
        for (int i = 0; i < 5; ++i) { const int id = tid + NTHR * i; if (id < 129 * 16) { const int row = id >> 4, ch = id & 15;
            *(LAS v4u*)(lds + OU_CF + img_off(row, ch)) = *(const v4u*)(sf + row * 128 + ch * 8); *(LAS v4u*)(lds + OU_CB + img_off(row, ch)) = *(const v4u*)(sb + row * 128 + ch * 8); } }
        stage_v(V, row0, h, lds + OU_V, tid);
    }
    const int l = 16 * wave + fr; const int tok = row0 + l;
    BFrag bq;
#pragma unroll
    for (int s_ = 0; s_ < 4; ++s_) bq.f[s_] = *(const bf16x8*)(Q + (size_t)tok * 512 + h * HD + 32 * s_ + 8 * kq);
    f32x4 S[8];
    { const bf16* kp = K + (size_t)(row0 + fr) * 512 + h * HD + 8 * kq;
#pragma unroll
      for (int mt = 0; mt < 8; ++mt) { BFrag ak;
#pragma unroll
          for (int s_ = 0; s_ < 4; ++s_) ak.f[s_] = *(const bf16x8*)(kp + (size_t)mt * 16 * 512 + 32 * s_);
          S[mt] = mma_ff((f32x4){0.f, 0.f, 0.f, 0.f}, ak, bq); if ((mt & 3) == 3) MEMFENCE(); } }
    __syncthreads();
    LAS uchar* Pw = lds + OU_P + wave * 4096;
    const unsigned vbase = lds_addr(lds + OU_V) + tr_lane_off<VS>(lane);
    f32x4 hs[8];
    for (int dir = 0; dir < 2; ++dir) {
        const LAS float* rr = sm + dir * 384; const LAS float* rho = rr + 128; const LAS float* bl = rr + 256;
        const float rho_l = rho[l], mst = dir ? m_b : m_f;
#pragma unroll
        for (int mt = 0; mt < 8; ++mt) { float p[4]; const f32x4 rv = *(const LAS f32x4*)(rr + 16 * mt + 4 * kq);
#pragma unroll
            for (int r = 0; r < 4; ++r) { const int j = 16 * mt + 4 * kq + r; const bool ok = dir ? (j >= l) : (j <= l); p[r] = ok ? S[mt][r] * __expf(fminf(rv[r] - rho_l, 0.f)) : 0.f; }
            *(LAS v2u*)(Pw + img_off(fr, 2 * mt + (kq >> 1)) + (kq & 1) * 8) = (v2u){pk2(p[0], p[1]), pk2(p[2], p[3])}; if (mt & 1) MEMFENCE(); }
        f32x4 acc[9];
        const float wi = __expf(mst - rho_l);
        const LAS uchar* cimg = lds + (dir ? OU_CB : OU_CF);
#pragma unroll
        for (int mt = 0; mt < 9; ++mt) { acc[mt] = mma_a((f32x4){0.f, 0.f, 0.f, 0.f}, cimg, 16 * mt + fr, bq, kq) * wi; if (mt & 1) MEMFENCE(); }
        MEMFENCE();
        { const BFrag bp = load_bfrag(Pw, fr, kq);
#pragma unroll
          for (int mt = 0; mt < 9; ++mt) { BFrag av; tr_load4<VS>(vbase + 32 * mt, av); acc[mt] = mma_ff(acc[mt], av, bp); } }
        const float den = __shfl(acc[8][0], fr);
        const float sc = 1.0f / fmaxf(fabsf(den), __expf(-bl[l] - rho_l));
#pragma unroll
        for (int mt = 0; mt < 8; ++mt) hs[mt] = dir ? hs[mt] + acc[mt] * sc : acc[mt] * sc;
    }
    float s1 = 0.f;
#pragma unroll
    for (int mt = 0; mt < 8; ++mt) s1 += (hs[mt][0] + hs[mt][1]) + (hs[mt][2] + hs[mt][3]);
    s1 += __shfl_xor(s1, 16); s1 += __shfl_xor(s1, 32);
    const float mu = s1 * (1.0f / 128.0f); float s2 = 0.f;
#pragma unroll
    for (int mt = 0; mt < 8; ++mt) { const f32x4 d = hs[mt] - mu; s2 += (d[0] * d[0] + d[1] * d[1]) + (d[2] * d[2] + d[3] * d[3]); }
    s2 += __shfl_xor(s2, 16); s2 += __shfl_xor(s2, 32);
    const float rstd = rsqrtf(s2 * (1.0f / 128.0f) + EPS);
    const float* mw = a.in[13] + h * HD; const float* msk = a.in[14] + h * HD;
#pragma unroll
    for (int mt = 0; mt < 8; ++mt) { const int e0 = 16 * mt + 4 * kq;
        const f32x4 w = *(const f32x4*)(mw + e0), k4 = *(const f32x4*)(msk + e0);
        const v2u av = *(const v2u*)(AB + (size_t)tok * 512 + h * HD + e0), zv = *(const v2u*)(Z + (size_t)tok * 512 + h * HD + e0);
        const float a4[4] = {bflo(av.x), bfhi(av.x), bflo(av.y), bfhi(av.y)}, z4[4] = {bflo(zv.x), bfhi(zv.x), bflo(zv.y), bfhi(zv.y)};
        float y[4];
#pragma unroll
        for (int r = 0; r < 4; ++r) y[r] = ((hs[mt][r] - mu) * rstd * w[r] + k4[r] * a4[r]) * silu_f(z4[r]);
        *(v2u*)(YM + (size_t)tok * 1024 + 512 + h * HD + e0) = (v2u){pk2(y[0], y[1]), pk2(y[2], y[3])}; MEMFENCE(); }
}

__device__ __forceinline__ void p9_conv(const Args& a, int vcu, int G) {
    const int tid = threadIdx.x, lane = tid & 63, wave = __builtin_amdgcn_readfirstlane(tid >> 6);
    const bf16* U = (const bf16*)(a.ws + WS_U); bf16* ACT = (bf16*)(a.ws + WS_ACT);
    const float* fw = a.in[19]; const float* fb = a.in[20];
    const int gw = vcu * NWAVES + wave, NGW = G * NWAVES;
    for (int it = gw; it < NB * 64 * 10 * 2; it += NGW) {
        const int half = it & 1, qb = (it >> 1) % 10, br = (it >> 1) / 10, r = br & 63, b = br >> 6;
        const int ch = (qb * 64 + lane) * 4;
        f32x4 wv[9], wg[9];
#pragma unroll
        for (int t = 0; t < 9; ++t) { wv[t] = *(const f32x4*)(fw + t * UPW + ch); wg[t] = *(const f32x4*)(fw + t * UPW + DFF + ch); }
        const f32x4 bv = *(const f32x4*)(fb + ch), bgt = *(const f32x4*)(fb + DFF + ch);
        const bf16* rp = U + (size_t)(b * SEQ + r * 64) * UPW + ch;
        const bool rv0 = r > 0, rv2 = r < 63;
        v2u xv[3][6], xg[3][6];
        const int c0 = half * 32;
#pragma unroll
        for (int i = 0; i < 3; ++i) {
            const bool rvi = (i == 0) ? rv0 : (i == 2 ? rv2 : true);
            const bf16* p = rp + (ptrdiff_t)(i - 1) * 64 * UPW + (ptrdiff_t)(c0 - 1) * UPW;
            xv[i][0] = (v2u){0u, 0u}; xg[i][0] = (v2u){0u, 0u}; xv[i][1] = (v2u){0u, 0u}; xg[i][1] = (v2u){0u, 0u};
            if (rvi) { if (c0 > 0) { xv[i][0] = *(const v2u*)p; xg[i][0] = *(const v2u*)(p + DFF); } xv[i][1] = *(const v2u*)(p + UPW); xg[i][1] = *(const v2u*)(p + UPW + DFF); }
        }
#pragma unroll 1
        for (int cb = 0; cb < 8; ++cb) {
            const int c = c0 + 4 * cb;
#pragma unroll
            for (int i = 0; i < 3; ++i) {
                const bool rvi = (i == 0) ? rv0 : (i == 2 ? rv2 : true);
                const bf16* p = rp + (ptrdiff_t)(i - 1) * 64 * UPW + (ptrdiff_t)(c + 1) * UPW;
#pragma unroll
                for (int j = 0; j < 4; ++j) { xv[i][2 + j] = (v2u){0u, 0u}; xg[i][2 + j] = (v2u){0u, 0u};
                    if (rvi && (c + 1 + j <= 63)) { xv[i][2 + j] = *(const v2u*)(p + j * UPW); xg[i][2 + j] = *(const v2u*)(p + j * UPW + DFF); } }
            }
#pragma unroll
            for (int o = 0; o < 4; ++o) {
                f32x4 av = bv, ag = bgt;
#pragma unroll
                for (int i = 0; i < 3; ++i)
#pragma unroll
                    for (int j = 0; j < 3; ++j) { av += wv[i * 3 + j] * bf4(xv[i][o + j]); ag += wg[i * 3 + j] * bf4(xg[i][o + j]); }
                float ov[4];
#pragma unroll
                for (int e = 0; e < 4; ++e) ov[e] = av[e] * silu_f(ag[e]);
                *(v2u*)(ACT + (size_t)(b * SEQ + r * 64 + c + o) * DFF + ch) = (v2u){pk2(ov[0], ov[1]), pk2(ov[2], ov[3])};
            }
#pragma unroll
            for (int i = 0; i < 3; ++i) { xv[i][0] = xv[i][4]; xv[i][1] = xv[i][5]; xg[i][0] = xg[i][4]; xg[i][1] = xg[i][5]; }
        }
    }
}

constexpr int LDS_BYTES = 147456, MISC_OFF = 147456 - 256;
constexpr int NPHASE = 12;
#ifndef MK_PER_PHASE
#define MK_PER_PHASE 0
#endif
__global__ void __launch_bounds__(NTHR, 2) mk_fwd(Args args) {
    extern __shared__ __attribute__((aligned(16))) uchar lds_raw[];
    LAS uchar* lds = (LAS uchar*)lds_raw;
    const int tid = threadIdx.x;
    const int G = gridDim.x; const int bx = blockIdx.x; const int vcu = (G % 8 == 0) ? (bx % 8) * (G / 8) + bx / 8 : bx;
    volatile LAS unsigned* MISC = (volatile LAS unsigned*)(lds + MISC_OFF);
    if (tid < 64) MISC[tid] = 0u;
    __syncthreads();
    XcdBarrier bar; bar.bar = (unsigned*)(args.ws + WS_CTL); bar.x = 0; bar.st = nullptr;
    if (!MK_PER_PHASE) bar = xcd_barrier_post((unsigned*)(args.ws + WS_CTL), MISC + 8);
    const int lo = args.ph_lo, hi = args.ph_hi;
#ifndef PH_MASK
#define PH_MASK 0xFFF
#endif
#define IN(k) (((PH_MASK >> (k)) & 1) && lo <= (k) && (k) < hi)
#ifndef REP_MASK
#define REP_MASK 0
#endif
#define REP(k) for (int rep_ = 0; rep_ <= ((REP_MASK >> (k)) & 1); ++rep_, __syncthreads())
#define SEAM(k) do { if (IN(k) && IN((k) + 1)) xcd_barrier(bar); } while (0)
    uchar* ws = args.ws;
    if (IN(0)) { if ((REP_MASK >> 16) & 1) { p0_prologue(args, lds, vcu, G, WS_MOD + 512 * 1024); __syncthreads(); } p0_prologue(args, lds, vcu, G, WS_MOD); } SEAM(0);
    if (IN(1)) REP(1) { p1_rows(args, lds, vcu, G); } SEAM(1);
    if (IN(2)) REP(2) {
        pg8::Gemm g{(const bf16*)(ws + WS_HX), (const bf16*)(ws + WS_WIN), TROWS, 2048, DM}; SchedP2 S; S.init(G, bx);
        EpiP2 E{(bf16*)(ws + WS_UF), (bf16*)(ws + WS_XM), (bf16*)(ws + WS_V), (bf16*)(ws + WS_Z)};
        pg8::gemm_phase<EpiP2, SchedP2, true, true>(lds, g, S, E);
    } SEAM(2);
    if (IN(3)) REP(3) {
        for (int rr_ = 0; rr_ <= ((REP_MASK >> 12) & 1); ++rr_) for (int it = bx; it < NUNIT; it += G) prep_unit(args, lds, it);
        __syncthreads();
        for (int rr_ = 0; rr_ <= ((REP_MASK >> 13) & 1); ++rr_) fft1_phase(args, lds, vcu, G);
    } SEAM(3);
    if (IN(4)) REP(4) {
        for (int rr_ = 0; rr_ <= ((REP_MASK >> 14) & 1); ++rr_) fft2_phase(args, lds, vcu, G);
        for (int rr_ = 0; rr_ <= ((REP_MASK >> 15) & 1); ++rr_) p4_scan(args, G);
    } SEAM(4);
    if (IN(5)) REP(5) { for (int it = bx; it < NUNIT_L; it += G) out_unit(args, lds, it); __syncthreads(); } SEAM(5);
    if (IN(6)) REP(6) {
        pg8::Gemm g{(const bf16*)(ws + WS_YM), (const bf16*)(ws + WS_WOUT), MROWS, DM, 1024}; pg8::StaticOrder S; S.init(MROWS, DM, G, bx);
        EpiRes E{args.in[0], args.out, (const float*)(ws + WS_MOD) + 2048, nullptr};
        pg8::gemm_phase<EpiRes, pg8::StaticOrder, true, true>(lds, g, S, E);
    } SEAM(6);
    if (IN(7)) REP(7) { p7_rows(args, vcu, G); } SEAM(7);
    if (IN(8)) REP(8) {
        pg8::Gemm g{(const bf16*)(ws + WS_H2), (const bf16*)(ws + WS_WUP), MROWS, UPW, DM}; pg8::StaticOrder S; S.init(MROWS, UPW, G, bx);
        EpiBias16 E{(bf16*)(ws + WS_U), UPW, args.in[18]};
        pg8::gemm_phase<EpiBias16, pg8::StaticOrder, true, true>(lds, g, S, E);
    } SEAM(8);
    if (IN(9)) REP(9) { p9_conv(args, vcu, G); } SEAM(9);
    if (IN(10)) {
        pg8::Gemm g{(const bf16*)(ws + WS_ACT), (const bf16*)(ws + WS_WDN), MROWS, DM, DFF}; pg8::StaticOrder S; S.init(MROWS, DM, G, bx);
        if ((REP_MASK >> 10) & 1) { EpiRes E0{args.out, (float*)(ws + WS_U), (const float*)(ws + WS_MOD) + 5120, args.in[22]}; pg8::gemm_phase<EpiRes, pg8::StaticOrder, true, true>(lds, g, S, E0); __syncthreads(); }
        EpiRes E{args.out, args.out, (const float*)(ws + WS_MOD) + 5120, args.in[22]};
        pg8::gemm_phase<EpiRes, pg8::StaticOrder, true, true>(lds, g, S, E);
    } SEAM(10);
    if (IN(11)) { if ((REP_MASK >> 11) & 1) p11_rows(args, vcu, G, (float*)(ws + 0)); p11_rows(args, vcu, G, args.out); }
#undef IN
#undef SEAM
}

extern "C" void kernel_launch(void* const* d_in, const int* in_sizes, int n_in, void* d_out, int out_size, void* d_ws, size_t ws_size, hipStream_t stream) {
    static int grid = 0;
    if (grid == 0) {
        if (n_in != 24 || out_size != MROWS * DM || ws_size < WS_END) { fprintf(stderr, "kernel_launch: unexpected problem (n_in %d, out %d, ws %zu); nothing launched\n", n_in, out_size, ws_size); grid = -1; return; }
        int dev = 0, cus = 0, per_cu = 0;
        if (hipGetDevice(&dev) != hipSuccess || hipDeviceGetAttribute(&cus, hipDeviceAttributeMultiprocessorCount, dev) != hipSuccess) { grid = -1; return; }
        if (hipFuncSetAttribute((const void*)mk_fwd, hipFuncAttributeMaxDynamicSharedMemorySize, LDS_BYTES) != hipSuccess) { fprintf(stderr, "kernel_launch: hipFuncSetAttribute failed\n"); grid = -1; return; }
        if (hipOccupancyMaxActiveBlocksPerMultiprocessor(&per_cu, (const void*)mk_fwd, NTHR, LDS_BYTES) != hipSuccess || per_cu < 1) { fprintf(stderr, "kernel_launch: occupancy query says %d blocks per CU\n", per_cu); grid = -1; (void)hipGetLastError(); return; }
        grid = cus;
    }
    if (grid < 0) return;
    (void)hipMemsetAsync((char*)d_ws + WS_ZERO0, 0, WS_ZERO_BYTES, stream);
    Args a{};
    for (int i = 0; i < 24; ++i) a.in[i] = (const float*)d_in[i];
    a.out = (float*)d_out; a.ws = (uchar*)d_ws;
#if MK_PER_PHASE
    for (int p = 0; p < NPHASE; ++p) { a.ph_lo = p; a.ph_hi = p + 1; hipLaunchKernelGGL(mk_fwd, dim3(grid), dim3(NTHR), LDS_BYTES, stream, a); }
#else
    a.ph_lo = 0; a.ph_hi = NPHASE; hipLaunchKernelGGL(mk_fwd, dim3(grid), dim3(NTHR), LDS_BYTES, stream, a);
#endif
}
```

```cpp
#include <hip/hip_runtime.h>
#include <cstdio>
#include <cstdint>
#ifndef REP_MASK
#define REP_MASK 0
#endif
namespace pg8 {
#define PG8_LAS __attribute__((address_space(3)))
typedef unsigned short bf16_t;
typedef short bf16x8 __attribute__((ext_vector_type(8)));
typedef float f32x4 __attribute__((ext_vector_type(4)));
typedef unsigned u32x4 __attribute__((ext_vector_type(4)));
constexpr int BM = 256, BK = 64, HALF = 128, HTB = HALF * BK * 2  , STAGE_BYTES = 8 * HTB, NXCD = 8, WGM = 8;

__host__ __device__ __forceinline__ int lds_byte(int r, int c) { const int st = (r >> 4) * 2 + (c >> 5), rr = r & 15, cc = c & 31, ob = rr * 64 + cc * 2; return st * 1024 + (ob ^ (((ob >> 9) & 1) << 5)); }
__host__ __device__ __forceinline__ void stage_rc(int b, int& R, int& C) { const int st = b / 1024, sb = b % 1024, swz = sb ^ (((sb >> 9) & 1) << 5); R = (st >> 1) * 16 + swz / 64; C = (st & 1) * 32 + (swz % 64) / 2; }
__host__ __device__ __forceinline__ int perm32(int rho) { const int n = rho >> 4, i = rho & 15; return 8 * (i >> 2) + 4 * n + (i & 3); }

struct Unit { int pm, pn; };
struct Gemm { const bf16_t* A; const bf16_t* Bt; int M, N, K; };

struct StaticOrder {
    int nM, nN, nwg, G, c;
    __host__ __device__ void init(int M, int N, int G_, int c_) { nM = M / BM; nN = N / BM; nwg = nM * nN; G = G_; c = c_; }
    __host__ __device__ bool next(int i, Unit& u) const {
        const long L = (long)i * G + c; if (L >= nwg) return false;
        int wgid = (int)L; { const int q = nwg / NXCD, r = nwg % NXCD, xcd = wgid % NXCD, off = wgid / NXCD; wgid = (xcd < r ? xcd * (q + 1) : r * (q + 1) + (xcd - r) * q) + off; }
        const int nig = WGM * nN, gid = wgid / nig, fm = gid * WGM, gsz = (nM - fm) < WGM ? (nM - fm) : WGM;
        u.pm = fm + ((wgid % nig) % gsz); u.pn = (wgid % nig) / gsz; return true;
    }
    __device__ __forceinline__ void a_ready(const Unit&) const {}
    __device__ __forceinline__ void done(const Unit&) const {}
};
__device__ __forceinline__ unsigned cvt_pk_bf16(float lo, float hi) { unsigned r; asm volatile("v_cvt_pk_bf16_f32 %0, %1, %2" : "=v"(r) : "v"(lo), "v"(hi)); return r; }
template <class Epi, class Sched, bool ALIGN_EPI = false, bool SP2 = false>
__device__ __forceinline__ void gemm_phase(PG8_LAS unsigned char* lds, const Gemm g, const Sched& S, const Epi& E) {
    const int tid = threadIdx.x, wid = __builtin_amdgcn_readfirstlane(tid >> 6), lane = tid & 63, wr = wid >> 2, wc = wid & 3, fr = lane & 15, fq = lane >> 4;
    const int K = g.K, nt = K / BK;
    unsigned voffA[2], voffB[2];
#pragma unroll
    for (int i = 0; i < 2; ++i) { int R, C; stage_rc(tid * 16 + i * 8192, R, C); const int Rb = Epi::PERM ? ((R & ~31) + perm32(R & 31)) : R;
        voffA[i] = (unsigned)(R * K + C) * 2u; voffB[i] = (unsigned)(Rb * K + C) * 2u; }
    const size_t kstep = (size_t)(BK * 2);
    const size_t hstep = (size_t)HALF * K * 2;
    const size_t tstep = 2 * hstep;
    const unsigned ldsw = (unsigned)wid * 1024u;
    const int aoff = lds_byte(wr * 64 + fr, fq * 8), boff = lds_byte(wc * 32 + fr, fq * 8);
#define PG8_SA(b, h) (((b) * 2 + (h)) * HTB)
#define PG8_SB(b, h) ((4 + (b) * 2 + (h)) * HTB)
#define PG8_STAGE(bufoff, gbase, voff) do { _Pragma("unroll") for (int _i = 0; _i < 2; ++_i) \
        __builtin_amdgcn_global_load_lds((const unsigned*)((const char*)(gbase) + (voff)[_i]), (PG8_LAS unsigned*)(lds + (bufoff) + ldsw + _i * 8192), 16, 0, 0); } while (0)
#define PG8_LDA(dst, b, h) do { _Pragma("unroll") for (int m = 0; m < 4; ++m) _Pragma("unroll") for (int k = 0; k < 2; ++k) dst[m][k] = *(const PG8_LAS bf16x8*)(lds + PG8_SA(b, h) + aoff + m * 2048 + k * 1024); } while (0)
#define PG8_LDB(dst, b, h) do { _Pragma("unroll") for (int n = 0; n < 2; ++n) _Pragma("unroll") for (int k = 0; k < 2; ++k) dst[n][k] = *(const PG8_LAS bf16x8*)(lds + PG8_SB(b, h) + boff + n * 2048 + k * 1024); } while (0)
#define PG8_MMA(ai, bj, At, Bt) do { __builtin_amdgcn_s_setprio(1); _Pragma("unroll") for (int m = 0; m < 4; ++m) _Pragma("unroll") for (int n = 0; n < 2; ++n) _Pragma("unroll") for (int k = 0; k < 2; ++k) \
        acc[ai][bj][m][n] = __builtin_amdgcn_mfma_f32_16x16x32_bf16(Bt[n][k], At[m][k], acc[ai][bj][m][n], 0, 0, 0); __builtin_amdgcn_s_setprio(0); } while (0)
#define PG8_WAIT_V(n) asm volatile("s_waitcnt vmcnt(" #n ")" ::: "memory")
#define PG8_WAIT_L(n) asm volatile("s_waitcnt lgkmcnt(" #n ")" ::: "memory")
#define PG8_BAR __builtin_amdgcn_s_barrier()
#define PG8_SCHED __builtin_amdgcn_sched_barrier(0)
    Unit cur, nxt; int ui = 0;
    if (!S.next(0, cur)) return;
    f32x4 acc[2][2][4][2];
#pragma unroll
    for (int a = 0; a < 2; ++a)
#pragma unroll
        for (int b = 0; b < 2; ++b)
#pragma unroll
            for (int m = 0; m < 4; ++m)
#pragma unroll
                for (int n = 0; n < 2; ++n) acc[a][b][m][n] = (f32x4){0.f, 0.f, 0.f, 0.f};
    bf16x8 At[4][2], B0[2][2], B1[2][2];
    const char* cA = (const char*)g.A + (size_t)cur.pm * tstep; const char* cB = (const char*)g.Bt + (size_t)cur.pn * tstep;
    S.a_ready(cur);
    if constexpr (SP2) {
        PG8_STAGE(PG8_SB(0, 0), cB, voffB); PG8_STAGE(PG8_SB(0, 1), cB + hstep, voffB); PG8_STAGE(PG8_SA(0, 0), cA, voffA); PG8_STAGE(PG8_SA(0, 1), cA + hstep, voffA);
        if (wr == 1) PG8_BAR;
        PG8_WAIT_V(2); PG8_BAR;
        PG8_STAGE(PG8_SB(1, 0), cB + kstep, voffB); PG8_STAGE(PG8_SA(1, 0), cA + kstep, voffA); PG8_STAGE(PG8_SB(1, 1), cB + hstep + kstep, voffB);
        PG8_WAIT_V(6); PG8_BAR;
    } else {
        PG8_STAGE(PG8_SB(0, 0), cB, voffB); PG8_STAGE(PG8_SA(0, 0), cA, voffA); PG8_STAGE(PG8_SB(0, 1), cB + hstep, voffB); PG8_STAGE(PG8_SA(0, 1), cA + hstep, voffA);
        if (wr == 1) PG8_BAR;
        PG8_WAIT_V(4); PG8_BAR;
        PG8_STAGE(PG8_SB(1, 0), cB + kstep, voffB); PG8_STAGE(PG8_SA(1, 0), cA + kstep, voffA); PG8_STAGE(PG8_SB(1, 1), cB + hstep + kstep, voffB);
        PG8_WAIT_V(6); PG8_BAR;
    }
    for (;;) {
        const bool has_next = S.next(ui + 1, nxt);
        const char* nA = has_next ? (const char*)g.A + (size_t)nxt.pm * tstep : cA; const char* nB = has_next ? (const char*)g.Bt + (size_t)nxt.pn * tstep : cB;
        for (int t = 0; t < nt; t += 2) {
            const bool last = (t == nt - 2);
            const char* a1 = cA + (size_t)(t + 1) * kstep;
            const char* a2 = last ? nA : cA + (size_t)(t + 2) * kstep; const char* b2 = last ? nB : cB + (size_t)(t + 2) * kstep;
            const char* a3 = a2 + kstep; const char* b3 = b2 + kstep;
            if (last && has_next) S.a_ready(nxt);
            if constexpr (SP2) {
            PG8_LDB(B0, 0, 0); PG8_LDB(B1, 0, 1); PG8_SCHED; PG8_LDA(At, 0, 0); PG8_STAGE(PG8_SA(1, 1), a1 + hstep, voffA);
            PG8_WAIT_V(8); PG8_WAIT_L(0); PG8_BAR; PG8_MMA(0, 0, At, B0); PG8_MMA(0, 1, At, B1); PG8_BAR; PG8_SCHED;
            PG8_LDA(At, 0, 1); PG8_STAGE(PG8_SB(0, 0), b2, voffB); PG8_STAGE(PG8_SB(0, 1), b2 + hstep, voffB); PG8_STAGE(PG8_SA(0, 0), a2, voffA);
            PG8_WAIT_V(8); PG8_WAIT_L(0); PG8_BAR; PG8_MMA(1, 0, At, B0); PG8_MMA(1, 1, At, B1); PG8_BAR; PG8_SCHED;
            PG8_LDB(B0, 1, 0); PG8_LDB(B1, 1, 1); PG8_SCHED; PG8_LDA(At, 1, 0); PG8_STAGE(PG8_SA(0, 1), a2 + hstep, voffA);
            PG8_WAIT_V(8); PG8_WAIT_L(0); PG8_BAR; PG8_MMA(0, 0, At, B0); PG8_MMA(0, 1, At, B1); PG8_BAR; PG8_SCHED;
            PG8_LDA(At, 1, 1); PG8_STAGE(PG8_SB(1, 0), b3, voffB); PG8_STAGE(PG8_SB(1, 1), b3 + hstep, voffB); PG8_STAGE(PG8_SA(1, 0), a3, voffA);
            PG8_WAIT_V(8); PG8_WAIT_L(0); PG8_BAR; PG8_MMA(1, 0, At, B0); PG8_MMA(1, 1, At, B1); PG8_BAR; PG8_SCHED;
            } else {
            PG8_LDB(B0, 0, 0); PG8_SCHED; PG8_LDA(At, 0, 0); PG8_STAGE(PG8_SA(1, 1), a1 + hstep, voffA);
            PG8_WAIT_L(8); PG8_BAR; PG8_WAIT_L(0); PG8_MMA(0, 0, At, B0); PG8_BAR; PG8_SCHED;
            PG8_LDB(B1, 0, 1); PG8_STAGE(PG8_SB(0, 0), b2, voffB);
            PG8_BAR; PG8_WAIT_L(0); PG8_MMA(0, 1, At, B1); PG8_BAR;
            PG8_LDA(At, 0, 1); PG8_STAGE(PG8_SA(0, 0), a2, voffA);
            PG8_BAR; PG8_WAIT_L(0); PG8_MMA(1, 0, At, B0); PG8_BAR; PG8_SCHED;
            PG8_STAGE(PG8_SB(0, 1), b2 + hstep, voffB);
            PG8_WAIT_V(6); PG8_BAR; PG8_MMA(1, 1, At, B1); PG8_BAR;
            PG8_LDB(B0, 1, 0); PG8_SCHED; PG8_LDA(At, 1, 0); PG8_STAGE(PG8_SA(0, 1), a2 + hstep, voffA);
            PG8_WAIT_L(8); PG8_BAR; PG8_WAIT_L(0); PG8_MMA(0, 0, At, B0); PG8_BAR; PG8_SCHED;
            PG8_LDB(B1, 1, 1); PG8_STAGE(PG8_SB(1, 0), b3, voffB);
            PG8_BAR; PG8_WAIT_L(0); PG8_MMA(0, 1, At, B1); PG8_BAR;
            PG8_LDA(At, 1, 1); PG8_STAGE(PG8_SA(1, 0), a3, voffA);
            PG8_BAR; PG8_WAIT_L(0); PG8_MMA(1, 0, At, B0); PG8_BAR; PG8_SCHED;
            PG8_STAGE(PG8_SB(1, 1), b3 + hstep, voffB);
            PG8_WAIT_V(6); PG8_BAR; PG8_MMA(1, 1, At, B1); PG8_BAR;
            }
        }
        if constexpr (ALIGN_EPI) { if (wr == 0) PG8_BAR; }
        if constexpr (!Epi::AFTER_DRAIN) { E(acc, cur, wr, wc, fr, fq); S.done(cur); }
        if (!has_next) break;
#pragma unroll
        for (int a = 0; a < 2; ++a)
#pragma unroll
            for (int b = 0; b < 2; ++b)
#pragma unroll
                for (int m = 0; m < 4; ++m)
#pragma unroll
                    for (int n = 0; n < 2; ++n) acc[a][b][m][n] = (f32x4){0.f, 0.f, 0.f, 0.f};
        cur = nxt; cA = nA; cB = nB; ++ui;
        if constexpr (ALIGN_EPI) { if (wr == 1) PG8_BAR; }
    }
    PG8_WAIT_V(0);
    if constexpr (!ALIGN_EPI) { if (wr == 0) PG8_BAR; }
    PG8_BAR;
    if constexpr (Epi::AFTER_DRAIN) { E.fused(acc, cur, wr, wc, fr, fq, lds, wid, lane); S.done(cur); }
#undef PG8_SA
#undef PG8_SB
#undef PG8_STAGE
#undef PG8_LDA
#undef PG8_LDB
#undef PG8_MMA
#undef PG8_WAIT_V
#undef PG8_WAIT_L
#undef PG8_BAR
#undef PG8_SCHED
}
}

#define GAS __attribute__((address_space(1)))
#define LAS __attribute__((address_space(3)))
typedef unsigned short bf16;
typedef unsigned char uchar;
typedef unsigned v4u __attribute__((ext_vector_type(4)));
typedef unsigned v2u __attribute__((ext_vector_type(2)));
typedef float f32x4 __attribute__((ext_vector_type(4)));
typedef float f32x2 __attribute__((ext_vector_type(2)));
typedef short bf16x8 __attribute__((ext_vector_type(8)));
#define LDS_WAIT() asm volatile("s_waitcnt lgkmcnt(0)" ::: "memory")
#define VM_WAIT() asm volatile("s_waitcnt vmcnt(0)" ::: "memory")

constexpr int NWAVES = 8, NTHR = 512;
constexpr int NB = 8, SEQ = 4096, DM = 1024, CTXL = 256;
constexpr int MROWS = NB * SEQ;
constexpr int CROWS = NB * CTXL;
constexpr int TROWS = MROWS + CROWS;
constexpr int NHEAD = 4, HD = 128, INW = 2064, DFF = 2560, UPW = 5120;
constexpr float EPS = 1e-6f;
constexpr int NUNIT_L = NB * NHEAD * 32, NUNIT_C = NB * NHEAD * 2, NUNIT = NUNIT_L + NUNIT_C;
constexpr int CT_SLOT = 129 * 128;

constexpr size_t MiB = 1u << 20;
constexpr size_t WS_HX = 0, WS_TP = 0, WS_H2 = 0, WS_ACT = 0;
constexpr size_t WS_UF = 68 * MiB, WS_XM = 100 * MiB, WS_CT = 68 * MiB;
constexpr size_t WS_G = 134 * MiB, WS_SC = 137 * MiB, WS_MS = 138 * MiB;
constexpr size_t WS_V = 160 * MiB, WS_Z = 194 * MiB, WS_DC = 226 * MiB, WS_YM = 364 * MiB, WS_U = 160 * MiB;
constexpr size_t WS_WIN = 480 * MiB, WS_WOUT = 484 * MiB, WS_WUP = 486 * MiB, WS_WDN = 496 * MiB, WS_WQ = 501 * MiB, WS_WK = WS_WQ + 131072;
constexpr size_t WS_F1 = 502 * MiB, WS_G2 = WS_F1 + 16384, WS_TW = WS_G2 + 16384;
constexpr size_t WS_MOD = 503 * MiB, WS_CTL = 504 * MiB, WS_ZERO0 = WS_MOD, WS_ZERO_BYTES = 2 * MiB, WS_END = 512 * MiB;
static_assert(WS_DC + (size_t)NUNIT * 2 * CT_SLOT * 4 <= WS_YM && WS_YM + (size_t)MROWS * 1024 * 2 <= WS_U + (size_t)MROWS * UPW * 2 && WS_U + (size_t)MROWS * UPW * 2 <= WS_WIN, "ws map");
static_assert(WS_CT + (size_t)NUNIT_L * 2 * CT_SLOT * 2 <= WS_G && WS_XM + (size_t)TROWS * 512 * 2 <= WS_G && (size_t)MROWS * DFF * 2 <= WS_U, "ws map 2");
constexpr size_t DO_AB = 0, DO_Q = 32 * MiB, DO_K = 64 * MiB;

__device__ __forceinline__ unsigned f2bf(float f) { unsigned u = __builtin_bit_cast(unsigned, f); return (u + 0x7fffu + ((u >> 16) & 1u)) >> 16; }
__device__ __forceinline__ unsigned pk2(float lo, float hi) { return f2bf(lo) | (f2bf(hi) << 16); }
__device__ __forceinline__ float bflo(unsigned w) { return __builtin_bit_cast(float, w << 16); }
__device__ __forceinline__ float bfhi(unsigned w) { return __builtin_bit_cast(float, w & 0xffff0000u); }
__device__ __forceinline__ f32x4 bf4(v2u x) { return (f32x4){bflo(x.x), bfhi(x.x), bflo(x.y), bfhi(x.y)}; }
__device__ __forceinline__ float silu_f(float x) { return x / (1.0f + __expf(-x)); }
__device__ __forceinline__ float logsig_f(float x) { return fminf(x, 0.f) - log1pf(__expf(-fabsf(x))); }
__device__ __forceinline__ float wave_sum(float v) {
#pragma unroll
    for (int o = 1; o < 64; o <<= 1) v += __shfl_xor(v, o);
    return v;
}
__device__ __forceinline__ int img_off(int row, int ch) { return row * 256 + ((ch ^ (row & 15)) << 4); }
struct BFrag { bf16x8 f[4]; };
__device__ __forceinline__ BFrag load_bfrag(const LAS uchar* Bimg, int brow, int kq) { BFrag b;
#pragma unroll
    for (int s = 0; s < 4; ++s) b.f[s] = *(const LAS bf16x8*)(Bimg + img_off(brow, 4 * s + kq));
    return b; }
__device__ __forceinline__ f32x4 mma_a(f32x4 acc, const LAS uchar* Aimg, int arow, const BFrag& b, int kq) {
    bf16x8 a[4];
#pragma unroll
    for (int s = 0; s < 4; ++s) a[s] = *(const LAS bf16x8*)(Aimg + img_off(arow, 4 * s + kq));
#pragma unroll
    for (int s = 0; s < 4; ++s) acc = __builtin_amdgcn_mfma_f32_16x16x32_bf16(a[s], b.f[s], acc, 0, 0, 0);
    return acc; }
#define MEMFENCE() asm volatile("" ::: "memory")


template <int S> __device__ __forceinline__ unsigned tr_lane_off(int lane) { return (unsigned)((8 * (lane >> 4) + ((lane & 15) >> 2)) * S + 8 * (lane & 3)); }
__device__ __forceinline__ unsigned lds_addr(const LAS uchar* p) { return (unsigned)(unsigned long long)p; }
__device__ __forceinline__ bf16x8 pack_frag(v2u lo, v2u hi) { const v4u w = (v4u){lo.x, lo.y, hi.x, hi.y}; return __builtin_bit_cast(bf16x8, w); }
template <int S> __device__ __forceinline__ void tr_load4(unsigned addr, BFrag& f) {
    v2u r0, r1, r2, r3, r4, r5, r6, r7;
    asm volatile("ds_read_b64_tr_b16 %0, %8\n\tds_read_b64_tr_b16 %1, %8 offset:%9\n\tds_read_b64_tr_b16 %2, %8 offset:%10\n\tds_read_b64_tr_b16 %3, %8 offset:%11\n\t"
                 "ds_read_b64_tr_b16 %4, %8 offset:%12\n\tds_read_b64_tr_b16 %5, %8 offset:%13\n\tds_read_b64_tr_b16 %6, %8 offset:%14\n\tds_read_b64_tr_b16 %7, %8 offset:%15\n\ts_waitcnt lgkmcnt(0)"
                 : "=&v"(r0), "=&v"(r1), "=&v"(r2), "=&v"(r3), "=&v"(r4), "=&v"(r5), "=&v"(r6), "=&v"(r7)
                 : "v"(addr), "i"(4 * S), "i"(32 * S), "i"(36 * S), "i"(64 * S), "i"(68 * S), "i"(96 * S), "i"(100 * S) : "memory");
    f.f[0] = pack_frag(r0, r1); f.f[1] = pack_frag(r2, r3); f.f[2] = pack_frag(r4, r5); f.f[3] = pack_frag(r6, r7);
}
template <int S> __device__ __forceinline__ void tr_load2(unsigned addr, bf16x8& f0, bf16x8& f1) {
    v2u r0, r1, r2, r3;
    asm volatile("ds_read_b64_tr_b16 %0, %4\n\tds_read_b64_tr_b16 %1, %4 offset:%5\n\tds_read_b64_tr_b16 %2, %4 offset:%6\n\tds_read_b64_tr_b16 %3, %4 offset:%7\n\ts_waitcnt lgkmcnt(0)"
                 : "=&v"(r0), "=&v"(r1), "=&v"(r2), "=&v"(r3) : "v"(addr), "i"(4 * S), "i"(32 * S), "i"(36 * S) : "memory");
    f0 = pack_frag(r0, r1); f1 = pack_frag(r2, r3);
}
__device__ __forceinline__ f32x4 mma_ff(f32x4 acc, const BFrag& a, const BFrag& b) {
#pragma unroll
    for (int s = 0; s < 4; ++s) acc = __builtin_amdgcn_mfma_f32_16x16x32_bf16(a.f[s], b.f[s], acc, 0, 0, 0);
    return acc; }
__device__ __forceinline__ float lane_scan_add(float v, int lane) {
#pragma unroll
    for (int o = 1; o < 64; o <<= 1) { const float t = __shfl_up(v, o); if (lane >= o) v += t; }
    return v; }
__device__ __forceinline__ float lane_scan_max(float v, int lane) {
#pragma unroll
    for (int o = 1; o < 64; o <<= 1) { const float t = __shfl_up(v, o); if (lane >= o) v = fmaxf(v, t); }
    return v; }
__device__ __forceinline__ float wave_max(float v) {
#pragma unroll
    for (int o = 1; o < 64; o <<= 1) v = fmaxf(v, __shfl_xor(v, o));
    return v; }

#define XB_TMO      128
#define XB_XCNT(j)  (256  + 64 * (j))
#define XB_XSUB(j)  (1280 + 64 * (j))
#define XB_XGEN(j)  (2304 + 64 * (j))
#define XB_TOP      3328
#define XB_TOPGEN   3392
#define XCD_BAR_WORDS 3456
#define XB_SPIN_CAP (1u << 18)

__device__ __forceinline__ unsigned xb_ld(unsigned* p)              { return __hip_atomic_load(p, __ATOMIC_RELAXED, __HIP_MEMORY_SCOPE_AGENT); }
__device__ __forceinline__ unsigned xb_add(unsigned* p, unsigned v) { return __hip_atomic_fetch_add(p, v, __ATOMIC_RELAXED, __HIP_MEMORY_SCOPE_AGENT); }
__device__ __forceinline__ unsigned xb_xcc_id() { return (unsigned)__builtin_amdgcn_s_getreg((3 << 11) | 20) & 0xFu; }
#define XB_SPIN(cond, bar) do { unsigned _sp = 0; while (cond) { __builtin_amdgcn_s_sleep(1); \
    if ((++_sp & 255u) == 0u) { if (xb_ld(&(bar)[XB_TMO])) break; if (_sp > XB_SPIN_CAP) { atomicAdd(&(bar)[XB_TMO], 1u); break; } } } } while (0)

struct XcdBarrier {
    unsigned* bar; unsigned x;
    volatile LAS unsigned* st;
};

__device__ __forceinline__ XcdBarrier xcd_barrier_post(unsigned* bar, volatile LAS unsigned* st) {
    XcdBarrier b; b.bar = bar; b.x = xb_xcc_id(); b.st = st;
    if (threadIdx.x == 0) (void)xb_add(&bar[XB_XCNT(b.x)], 1u);
    return b;
}
__device__ __forceinline__ void xcd_barrier_complete(unsigned* bar, unsigned x, unsigned& nloc, unsigned& nx) {
    const unsigned G = gridDim.x * gridDim.y * gridDim.z;
    unsigned sum, cnt, mine, sp = 0u;
    for (;;) {
        sum = 0u; cnt = 0u; mine = 0u;
#pragma unroll
        for (unsigned j = 0; j < 16; ++j) { const unsigned c = xb_ld(&bar[XB_XCNT(j)]); sum += c; cnt += (c > 0u) ? 1u : 0u; mine = (j == x) ? c : mine; }
        if (sum == G) break;
        __builtin_amdgcn_s_sleep(1);
        if ((++sp & 255u) == 0u) { if (xb_ld(&bar[XB_TMO])) break; if (sp > XB_SPIN_CAP) { atomicAdd(&bar[XB_TMO], 1u); break; } }
    }
    nloc = mine > 0u ? mine : 1u; nx = cnt > 0u ? cnt : 1u;
}

__device__ __forceinline__ void xcd_barrier(const XcdBarrier& b) {
    asm volatile("s_waitcnt vmcnt(0)" ::: "memory");
    __syncthreads();
    if (threadIdx.x == 0) {
        unsigned* bar = b.bar;
        __builtin_amdgcn_s_waitcnt(0);
        unsigned nloc = b.st[0], nx = b.st[1];
        if (nloc == 0u) { xcd_barrier_complete(bar, b.x, nloc, nx); b.st[0] = nloc; b.st[1] = nx; }
        const unsigned old = xb_add(&bar[XB_XSUB(b.x)], 1u);
        const unsigned gen = old / nloc;
        if (old + 1u == (gen + 1u) * nloc) {
            __builtin_amdgcn_fence(__ATOMIC_RELEASE, "agent");
            asm volatile("s_waitcnt vmcnt(0)" ::: "memory");
            const unsigned og = xb_add(&bar[XB_TOP], 1u);
            const unsigned tg = og / nx;
            if (og + 1u == (tg + 1u) * nx) xb_add(&bar[XB_TOPGEN], 1u);
            else XB_SPIN(xb_ld(&bar[XB_TOPGEN]) == tg, bar);
            __builtin_amdgcn_fence(__ATOMIC_ACQUIRE, "agent");
            xb_add(&bar[XB_XGEN(b.x)], 1u);
            asm volatile("s_waitcnt vmcnt(0)" ::: "memory");
        } else {
            XB_SPIN(xb_ld(&bar[XB_XGEN(b.x)]) == gen, bar);
            __builtin_amdgcn_fence(__ATOMIC_ACQUIRE, "agent");
            asm volatile("s_waitcnt vmcnt(0)" ::: "memory");
        }
    }
    __syncthreads();
}


struct Args { const float* in[24]; float* out; uchar* ws; int ph_lo, ph_hi; };

template <class F>
__device__ __forceinline__ void tr_item(F src, bf16* WT, size_t drow0, int ldk, int dk0, LAS float* scr, int lane) {
#pragma unroll 4
    for (int i = 0; i < 32; ++i) { const int kk = 2 * i + (lane >> 5); scr[kk * 33 + (lane & 31)] = src(kk, lane & 31); }
    LDS_WAIT(); asm volatile("" ::: "memory");
    const int c = lane & 7;
#pragma unroll
    for (int j = 0; j < 4; ++j) { const int n = (lane >> 3) + 8 * j; const LAS float* s = scr + (8 * c) * 33 + n;
        v4u o; o.x = pk2(s[0 * 33], s[1 * 33]); o.y = pk2(s[2 * 33], s[3 * 33]); o.z = pk2(s[4 * 33], s[5 * 33]); o.w = pk2(s[6 * 33], s[7 * 33]);
        *(v4u*)(WT + (drow0 + n) * ldk + dk0 + 8 * c) = o; }
    LDS_WAIT(); asm volatile("" ::: "memory");
}

__device__ __forceinline__ void p0_prologue(const Args& a, LAS uchar* lds, int vcu, int G, size_t mod_off) {
    const int tid = threadIdx.x, lane = tid & 63, wave = __builtin_amdgcn_readfirstlane(tid >> 6);
    uchar* ws = a.ws;
    {
        LAS float* sl = (LAS float*)lds;
        float* MOD = (float*)(ws + mod_off);
        const float* w_ada = a.in[4]; const float* b_ada = a.in[5];
        for (int it = blockIdx.x; it < 32 * 12; it += G) {
            const int kc = it / 12, nb = it % 12;
            __syncthreads();
            if (tid < 288) { const int r = tid >> 5, kk = tid & 31; const float cv = (r < 8) ? a.in[1][r * DM + kc * 32 + kk] : a.in[3][kc * 32 + kk]; sl[tid] = silu_f(cv); }
            __syncthreads();
            const int n = nb * 512 + tid;
            float acc[9];
#pragma unroll
            for (int r = 0; r < 9; ++r) acc[r] = 0.f;
#pragma unroll 8
            for (int kk = 0; kk < 32; ++kk) { const float w = w_ada[(size_t)(kc * 32 + kk) * 6144 + n];
#pragma unroll
                for (int r = 0; r < 9; ++r) acc[r] += sl[r * 32 + kk] * w; }
            const float bb = (kc == 0) ? b_ada[n] : 0.f;
#pragma unroll
            for (int r = 0; r < 9; ++r) atomicAdd(&MOD[r * 6144 + n], acc[r] + bb);
        }
        __syncthreads();
    }
    {
        LAS float* tab = (LAS float*)(lds + 8 * 16384);
        if (tid < 128) tab[tid] = cospif((float)tid * (1.0f / 64.0f)) * 0.08838834764831845f;
        __syncthreads();
        const int gt = blockIdx.x * NTHR + tid;
        bf16* F1 = (bf16*)(ws + WS_F1); bf16* G2 = (bf16*)(ws + WS_G2); float* TW = (float*)(ws + WS_TW);
        if (gt < 8192) { const int row = gt >> 6, n1 = gt & 63, ri = row >> 6, k1 = row & 63; const float ang = (float)((k1 * n1) & 63) * (1.0f / 32.0f);
            F1[gt] = (bf16)f2bf((ri == 0 ? cospif(ang) : -sinpif(ang)) * 0.125f); }
        else if (gt < 16384) { const int i = gt - 8192, k2 = i >> 7, kap = i & 127, n2 = kap & 63; const float ang = (float)((k2 * n2) & 63) * (1.0f / 32.0f);
            G2[i] = (bf16)f2bf((kap < 64 ? cospif(ang) : sinpif(ang)) * 0.125f); }
        else if (gt < 16384 + 4096) { const int i = gt - 16384; TW[i] = cospif((float)i * (1.0f / 2048.0f)); }
    }
    {
        const LAS float* tab = (const LAS float*)(lds + 8 * 16384);
        LAS float* Tm = (LAS float*)lds;
        LAS float* wT = (LAS float*)(lds + 65536);
        const float* w_in = a.in[7]; bf16* WIN = (bf16*)(a.ws + WS_WIN);
        bool have_T = false;
        for (int it = blockIdx.x; it < 64; it += G) {
            const int g = it >> 4, k0 = (it & 15) * 64;
            __syncthreads();
            if (!have_T) { for (int id = tid; id < 128 * 128; id += NTHR) { const int c = id >> 7, s_ = id & 127; const int mult = (s_ <= 64) ? s_ : (s_ - 64), off = (s_ <= 64) ? 0 : 96; Tm[id] = tab[(c * mult + off) & 127]; } have_T = true; }
            for (int id = tid; id < 64 * 32; id += NTHR) { const int kk = id >> 5, c4 = id & 31; const f32x4 v = *(const f32x4*)(w_in + (size_t)(k0 + kk) * INW + g * 128 + 4 * c4);
                wT[(4 * c4 + 0) * 64 + kk] = v.x; wT[(4 * c4 + 1) * 64 + kk] = v.y; wT[(4 * c4 + 2) * 64 + kk] = v.z; wT[(4 * c4 + 3) * 64 + kk] = v.w; }
            __syncthreads();
            const int s4 = (tid & 31) * 4, k4 = (tid >> 5) * 4;
            f32x4 acc[4];
#pragma unroll
            for (int j = 0; j < 4; ++j) acc[j] = (f32x4){0.f, 0.f, 0.f, 0.f};
#pragma unroll 4
            for (int c = 0; c < 128; ++c) { const f32x4 tv = *(const LAS f32x4*)(Tm + c * 128 + s4), wv_ = *(const LAS f32x4*)(wT + c * 64 + k4);
                acc[0] += wv_ * tv.x; acc[1] += wv_ * tv.y; acc[2] += wv_ * tv.z; acc[3] += wv_ * tv.w; }
#pragma unroll
            for (int j = 0; j < 4; ++j) *(v2u*)(WIN + (size_t)(g * 128 + s4 + j) * DM + k0 + k4) = (v2u){pk2(acc[j].x, acc[j].y), pk2(acc[j].z, acc[j].w)};
        }
        __syncthreads();
    }
    {
        LAS float* scr = (LAS float*)(lds + wave * 16384);
        const LAS float* tab = (const LAS float*)(lds + 8 * 16384);
        const int gw = vcu * NWAVES + wave, NGW = G * NWAVES;
        const float* w_in = a.in[7]; const float* w_out = a.in[15]; const float* w_up = a.in[17]; const float* w_dn = a.in[21];
        const float* w_q = a.in[10]; const float* w_k = a.in[11];
        bf16* WIN = (bf16*)(ws + WS_WIN); bf16* WOUT = (bf16*)(ws + WS_WOUT); bf16* WUP = (bf16*)(ws + WS_WUP); bf16* WDN = (bf16*)(ws + WS_WDN);
        bf16* WQ = (bf16*)(ws + WS_WQ); bf16* WK = (bf16*)(ws + WS_WK);
        constexpr int I_XV = 16 * 32, I_Z = 16 * 16, I_OF = 8 * 32, I_OM = 8 * 32, I_UP = 16 * 160, I_DN = 40 * 32, I_QK = 2 * 4 * 4;
        constexpr int NIT = I_XV + I_Z + I_OF + I_OM + I_UP + I_DN + 2 * I_QK;
        for (int it = gw; it < NIT; it += NGW) {
            int r = it;
            if (r < I_XV) { const int kb = r / 32, nb = r % 32, k0 = kb * 64, n0 = nb * 32;
                auto src = [&](int kk, int nn) -> float { return w_in[(size_t)(k0 + kk) * INW + 512 + n0 + nn]; };
                tr_item(src, WIN, (size_t)(512 + n0), DM, k0, scr, lane); continue; } r -= I_XV;
            if (r < I_Z) { const int kb = r / 16, nb = r % 16, k0 = kb * 64, n0 = nb * 32;
                auto src = [&](int kk, int nn) -> float { return w_in[(size_t)(k0 + kk) * INW + 1552 + n0 + nn]; };
                tr_item(src, WIN, (size_t)(1536 + n0), DM, k0, scr, lane); continue; } r -= I_Z;
            if (r < I_OF) { const int kb = r / 32, nb = r % 32, k0 = kb * 64, n0 = nb * 32;
                auto src = [&](int kk, int nn) -> float { const int k = k0 + kk, g = k >> 7, s = k & 127; const float* wo = w_out + (size_t)(g * 128) * DM + n0 + nn;
                    if (s == 0 || s == 64) return wo[(size_t)s * DM];
                    if (s < 64) return wo[(size_t)s * DM] + wo[(size_t)(128 - s) * DM];
                    const int kq = s - 64; return wo[(size_t)(128 - kq) * DM] - wo[(size_t)kq * DM]; };
                tr_item(src, WOUT, (size_t)n0, DM, k0, scr, lane); continue; } r -= I_OF;
            if (r < I_OM) { const int kb = r / 32, nb = r % 32, k0 = kb * 64, n0 = nb * 32;
                auto src = [&](int kk, int nn) -> float { return w_out[(size_t)(512 + k0 + kk) * DM + n0 + nn]; };
                tr_item(src, WOUT, (size_t)n0, DM, 512 + k0, scr, lane); continue; } r -= I_OM;
            if (r < I_UP) { const int kb = r / 160, nb = r % 160, k0 = kb * 64, n0 = nb * 32;
                auto src = [&](int kk, int nn) -> float { return w_up[(size_t)(k0 + kk) * UPW + n0 + nn]; };
                tr_item(src, WUP, (size_t)n0, DM, k0, scr, lane); continue; } r -= I_UP;
            if (r < I_DN) { const int kb = r / 32, nb = r % 32, k0 = kb * 64, n0 = nb * 32;
                auto src = [&](int kk, int nn) -> float { return w_dn[(size_t)(k0 + kk) * DM + n0 + nn]; };
                tr_item(src, WDN, (size_t)n0, DFF, k0, scr, lane); continue; } r -= I_DN;
            {   const bool isk = r >= I_QK; if (isk) r -= I_QK;
                const int h = r / 8, kb = (r % 8) / 4, nb = r % 4, k0 = kb * 64, n0 = nb * 32;
                const float* W = (isk ? w_k : w_q) + (size_t)h * HD * HD; const float sc = isk ? 0.08838834764831845f : 1.0f;
                auto src = [&](int kk, int nn) -> float { return W[(size_t)(k0 + kk) * HD + n0 + nn] * sc; };
                tr_item(src, (isk ? WK : WQ) + (size_t)h * HD * HD, (size_t)n0, HD, k0, scr, lane); }
        }
    }
}

__device__ __forceinline__ void p1_rows(const Args& a, LAS uchar* lds, int vcu, int G) {
    const int tid = threadIdx.x, lane = tid & 63, wave = __builtin_amdgcn_readfirstlane(tid >> 6);
    uchar* ws = a.ws;
    {
        LAS f32x4* wg = (LAS f32x4*)lds;
        const float* w_in = a.in[7];
        for (int id = tid; id < 4096; id += NTHR) { const int k = id >> 2, q = id & 3; const int l = (k & 255) >> 2, i = k & 3, j = k >> 8;
            wg[((j * 4 + i) * 4 + q) * 64 + l] = *(const f32x4*)(w_in + (size_t)k * INW + 1536 + 4 * q); }
        __syncthreads();
    }
    const LAS f32x4* wg = (const LAS f32x4*)lds;
    const float* MOD = (const float*)(ws + WS_MOD);
    const float* nw = a.in[6]; const float* bg = a.in[12];
    bf16* HX = (bf16*)(ws + WS_HX); float* GG = (float*)(ws + WS_G);
    const int gw = vcu * NWAVES + wave, NGW = G * NWAVES;
    for (int row = gw; row < TROWS; row += NGW) {
        const float* xr; const float* md;
        if (row < MROWS) { xr = a.in[0] + (size_t)row * DM; md = MOD + (size_t)(row >> 12) * 6144; }
        else { xr = a.in[2] + (size_t)(row - MROWS) * DM; md = MOD + (size_t)8 * 6144; }
        f32x4 v[4]; float s = 0.f;
#pragma unroll
        for (int j = 0; j < 4; ++j) { v[j] = *(const f32x4*)(xr + 4 * lane + 256 * j); s += (v[j].x * v[j].x + v[j].y * v[j].y) + (v[j].z * v[j].z + v[j].w * v[j].w); }
        const float rstd = rsqrtf(wave_sum(s) * (1.0f / DM) + EPS);
        float g[16];
#pragma unroll
        for (int i = 0; i < 16; ++i) g[i] = 0.f;
#pragma unroll
        for (int j = 0; j < 4; ++j) {
            const f32x4 w = *(const f32x4*)(nw + 4 * lane + 256 * j), sh = *(const f32x4*)(md + 4 * lane + 256 * j), sc = *(const f32x4*)(md + 1024 + 4 * lane + 256 * j);
            v[j] = v[j] * rstd * w * (sc + 1.0f) + sh;
            *(v2u*)(HX + (size_t)row * DM + 4 * lane + 256 * j) = (v2u){pk2(v[j].x, v[j].y), pk2(v[j].z, v[j].w)};
        }
#pragma unroll
        for (int j = 0; j < 4; ++j) {
#pragma unroll
            for (int i = 0; i < 4; ++i) {
#pragma unroll
                for (int q = 0; q < 4; ++q) { const f32x4 ww = wg[((j * 4 + i) * 4 + q) * 64 + lane];
                    g[4 * q + 0] += v[j][i] * ww.x; g[4 * q + 1] += v[j][i] * ww.y; g[4 * q + 2] += v[j][i] * ww.z; g[4 * q + 3] += v[j][i] * ww.w; }
                if (i & 1) MEMFENCE(); }
        }
        float g8[8], g4[4], g2[2], g1;
        { const bool hi = (lane & 32) != 0;
#pragma unroll
          for (int i = 0; i < 8; ++i) { const float keep = hi ? g[i + 8] : g[i], send = hi ? g[i] : g[i + 8]; g8[i] = keep + __shfl_xor(send, 32); } }
        { const bool hi = (lane & 16) != 0;
#pragma unroll
          for (int i = 0; i < 4; ++i) { const float keep = hi ? g8[i + 4] : g8[i], send = hi ? g8[i] : g8[i + 4]; g4[i] = keep + __shfl_xor(send, 16); } }
        { const bool hi = (lane & 8) != 0;
#pragma unroll
          for (int i = 0; i < 2; ++i) { const float keep = hi ? g4[i + 2] : g4[i], send = hi ? g4[i] : g4[i + 2]; g2[i] = keep + __shfl_xor(send, 8); } }
        { const bool hi = (lane & 4) != 0; const float keep = hi ? g2[1] : g2[0], send = hi ? g2[0] : g2[1]; g1 = keep + __shfl_xor(send, 4); }
        g1 += __shfl_xor(g1, 2); g1 += __shfl_xor(g1, 1);
        if ((lane & 3) == 0) { const int idx = ((lane & 32) ? 8 : 0) + ((lane & 16) ? 4 : 0) + ((lane & 8) ? 2 : 0) + ((lane & 4) ? 1 : 0); GG[(size_t)row * 16 + idx] = g1 + bg[idx]; }
    }
}
__device__ __forceinline__ void p7_rows(const Args& a, int vcu, int G) {
    const int tid = threadIdx.x, lane = tid & 63, wave = __builtin_amdgcn_readfirstlane(tid >> 6);
    const float* MOD = (const float*)(a.ws + WS_MOD); const float* nw = a.in[16]; bf16* H2 = (bf16*)(a.ws + WS_H2);
    const int gw = vcu * NWAVES + wave, NGW = G * NWAVES;
    for (int row = gw; row < MROWS; row += NGW) {
        const float* xr = a.in[0] + (size_t)row * DM; const float* md = MOD + (size_t)(row >> 12) * 6144; const bf16* y1 = (const bf16*)a.out + (size_t)row * 2048;
        f32x4 v[4]; float s = 0.f;
#pragma unroll
        for (int j = 0; j < 4; ++j) { v[j] = *(const f32x4*)(xr + 4 * lane + 256 * j) + bf4(*(const v2u*)(y1 + 4 * lane + 256 * j)); s += (v[j].x * v[j].x + v[j].y * v[j].y) + (v[j].z * v[j].z + v[j].w * v[j].w); }
        const float rstd = rsqrtf(wave_sum(s) * (1.0f / DM) + EPS);
#pragma unroll
        for (int j = 0; j < 4; ++j) {
            const f32x4 w = *(const f32x4*)(nw + 4 * lane + 256 * j), sh = *(const f32x4*)(md + 3072 + 4 * lane + 256 * j), sc = *(const f32x4*)(md + 4096 + 4 * lane + 256 * j);
            const f32x4 hv = v[j] * rstd * w * (sc + 1.0f) + sh;
            *(v2u*)(H2 + (size_t)row * DM + 4 * lane + 256 * j) = (v2u){pk2(hv.x, hv.y), pk2(hv.z, hv.w)}; }
    }
}
__device__ __forceinline__ void p11_rows(const Args& a, int vcu, int G, float* dst) {
    const int tid = threadIdx.x, lane = tid & 63, wave = __builtin_amdgcn_readfirstlane(tid >> 6);
    const float* nw = a.in[23];
    const int gw = vcu * NWAVES + wave, NGW = G * NWAVES;
    for (int row = gw; row < MROWS; row += NGW) {
        const float* xr = a.in[0] + (size_t)row * DM; const bf16* y1 = (const bf16*)a.out + (size_t)row * 2048; const bf16* d2 = (const bf16*)(a.ws + WS_U) + (size_t)row * DM;
        f32x4 v[4]; float s = 0.f;
#pragma unroll
        for (int j = 0; j < 4; ++j) { v[j] = *(const f32x4*)(xr + 4 * lane + 256 * j) + bf4(*(const v2u*)(y1 + 4 * lane + 256 * j)) + bf4(*(const v2u*)(d2 + 4 * lane + 256 * j)); s += (v[j].x * v[j].x + v[j].y * v[j].y) + (v[j].z * v[j].z + v[j].w * v[j].w); }
        const float rstd = rsqrtf(wave_sum(s) * (1.0f / DM) + EPS);
#pragma unroll
        for (int j = 0; j < 4; ++j) { const f32x4 w = *(const f32x4*)(nw + 4 * lane + 256 * j); *(f32x4*)(dst + (size_t)row * DM + 4 * lane + 256 * j) = v[j] * rstd * w; }
    }
}

struct SchedP2 {
    pg8::StaticOrder so;
    __device__ void init(int G, int c) { so.init(MROWS, 2048, G, c); }
    __device__ bool next(int i, pg8::Unit& u) const {
        const long L = (long)i * so.G + so.c;
        if (L < so.nwg) return so.next(i, u);
        const int r = (int)(L - so.nwg); if (r >= 32) return false;
        u.pm = 128 + (r & 7); u.pn = 2 + (r >> 3); return true;
    }
    __device__ __forceinline__ void a_ready(const pg8::Unit&) const {}
    __device__ __forceinline__ void done(const pg8::Unit&) const {}
};
struct EpiP2 {
    static constexpr bool PERM = true, AFTER_DRAIN = false;
    bf16 *base0, *base1, *base2, *base3;
    __device__ __forceinline__ void operator()(const f32x4 (&acc)[2][2][4][2], const pg8::Unit& u, int wr, int wc, int fr, int fq) const {
        const int row0 = u.pm * 256 + wr * 64 + fr; const int sel = u.pn >> 1; bf16* O = sel == 0 ? base0 : (sel == 1 ? base1 : (sel == 2 ? base2 : base3)); const int col0 = (u.pn & 1) * 256 + wc * 32 + 8 * fq;
#pragma unroll
        for (int ai = 0; ai < 2; ++ai)
#pragma unroll
            for (int m = 0; m < 4; ++m) { bf16* rowp = O + (size_t)(row0 + ai * 128 + m * 16) * 512 + col0;
#pragma unroll
                for (int bj = 0; bj < 2; ++bj) { const f32x4 v0 = acc[ai][bj][m][0], v1 = acc[ai][bj][m][1];
                    v4u w; w.x = pg8::cvt_pk_bf16(v0[0], v0[1]); w.y = pg8::cvt_pk_bf16(v0[2], v0[3]); w.z = pg8::cvt_pk_bf16(v1[0], v1[1]); w.w = pg8::cvt_pk_bf16(v1[2], v1[3]);
                    *(v4u*)(rowp + bj * 128) = w; } }
    }
};
struct EpiBias16 {
    static constexpr bool PERM = true, AFTER_DRAIN = false;
    bf16* O; int ldc; const float* bias;
    __device__ __forceinline__ void operator()(const f32x4 (&acc)[2][2][4][2], const pg8::Unit& u, int wr, int wc, int fr, int fq) const {
        const int row0 = u.pm * 256 + wr * 64 + fr; const int col0 = u.pn * 256 + wc * 32 + 8 * fq;
        f32x4 bv[2][2];
#pragma unroll
        for (int bj = 0; bj < 2; ++bj)
#pragma unroll
            for (int n = 0; n < 2; ++n) bv[bj][n] = *(const f32x4*)(bias + col0 + bj * 128 + 4 * n);
#pragma unroll
        for (int ai = 0; ai < 2; ++ai)
#pragma unroll
            for (int m = 0; m < 4; ++m) { bf16* rowp = O + (size_t)(row0 + ai * 128 + m * 16) * ldc + col0;
#pragma unroll
                for (int bj = 0; bj < 2; ++bj) { const f32x4 v0 = acc[ai][bj][m][0] + bv[bj][0], v1 = acc[ai][bj][m][1] + bv[bj][1];
                    v4u w; w.x = pg8::cvt_pk_bf16(v0[0], v0[1]); w.y = pg8::cvt_pk_bf16(v0[2], v0[3]); w.z = pg8::cvt_pk_bf16(v1[0], v1[1]); w.w = pg8::cvt_pk_bf16(v1[2], v1[3]);
                    *(v4u*)(rowp + bj * 128) = w; } }
    }
};
struct EpiGate16 {
    static constexpr bool PERM = true, AFTER_DRAIN = false;
    bf16* O; int ldc; const float* gate; const float* bias;
    __device__ __forceinline__ void operator()(const f32x4 (&acc)[2][2][4][2], const pg8::Unit& u, int wr, int wc, int fr, int fq) const {
        const int row0 = u.pm * 256 + wr * 64 + fr; const int col0 = u.pn * 256 + wc * 32 + 8 * fq;
        const float* gp = gate + (size_t)((u.pm * 256) >> 12) * 6144 + col0;
        f32x4 gv[2][2], bv[2][2];
#pragma unroll
        for (int bj = 0; bj < 2; ++bj)
#pragma unroll
            for (int n = 0; n < 2; ++n) { gv[bj][n] = *(const f32x4*)(gp + bj * 128 + 4 * n); bv[bj][n] = bias ? *(const f32x4*)(bias + col0 + bj * 128 + 4 * n) : (f32x4){0.f, 0.f, 0.f, 0.f}; }
#pragma unroll
        for (int ai = 0; ai < 2; ++ai)
#pragma unroll
            for (int m = 0; m < 4; ++m) { bf16* rowp = O + (size_t)(row0 + ai * 128 + m * 16) * ldc + col0;
#pragma unroll
                for (int bj = 0; bj < 2; ++bj) { const f32x4 v0 = gv[bj][0] * (acc[ai][bj][m][0] + bv[bj][0]), v1 = gv[bj][1] * (acc[ai][bj][m][1] + bv[bj][1]);
                    v4u w; w.x = pg8::cvt_pk_bf16(v0[0], v0[1]); w.y = pg8::cvt_pk_bf16(v0[2], v0[3]); w.z = pg8::cvt_pk_bf16(v1[0], v1[1]); w.w = pg8::cvt_pk_bf16(v1[2], v1[3]);
                    *(v4u*)(rowp + bj * 128) = w; } }
    }
};
struct EpiRes {
    static constexpr bool PERM = false, AFTER_DRAIN = false;
    const float* res; float* out; const float* gate; const float* bias;
    __device__ __forceinline__ void operator()(const f32x4 (&acc)[2][2][4][2], const pg8::Unit& u, int wr, int wc, int fr, int fq) const {
        const int row0 = u.pm * 256 + wr * 64 + fr, col0 = u.pn * 256 + wc * 32 + 4 * fq;
        const float* gp = gate + (size_t)((u.pm * 256) >> 12) * 6144 + col0;
        f32x4 gv[2][2], bv[2][2];
#pragma unroll
        for (int bj = 0; bj < 2; ++bj)
#pragma unroll
            for (int n = 0; n < 2; ++n) { gv[bj][n] = *(const f32x4*)(gp + bj * 128 + n * 16); bv[bj][n] = bias ? *(const f32x4*)(bias + col0 + bj * 128 + n * 16) : (f32x4){0.f, 0.f, 0.f, 0.f}; }
#pragma unroll
        for (int ai = 0; ai < 2; ++ai)
#pragma unroll
            for (int m = 0; m < 4; ++m) { const size_t off = (size_t)(row0 + ai * 128 + m * 16) * DM + col0;
#pragma unroll
                for (int bj = 0; bj < 2; ++bj)
#pragma unroll
                    for (int n = 0; n < 2; ++n) { const f32x4 r = *(const f32x4*)(res + off + bj * 128 + n * 16);
                        *(f32x4*)(out + off + bj * 128 + n * 16) = r + gv[bj][n] * (acc[ai][bj][m][n] + bv[bj][n]); }
                if (m & 1) asm volatile("" ::: "memory"); }
    }
};

constexpr int PA_A = 0, PA_V = 32768, PA_KF = 69632, PA_KB = 106496, PA_SM = 143360, VS = 288;
__device__ __forceinline__ void unit_decode(int unit, int& bh, int& row0, int& t0, int& L) {
    if (unit < NUNIT_L) { bh = unit >> 5; const int c = unit & 31; row0 = (bh >> 2) * SEQ + c * 128; t0 = c * 128; L = SEQ; }
    else { const int uc = unit - NUNIT_L; bh = uc >> 1; const int cc = uc & 1; row0 = MROWS + (bh >> 2) * CTXL + cc * 128; t0 = cc * 128; L = CTXL; }
}
__device__ __forceinline__ void stage_v(const bf16* V, int row0, int h, LAS uchar* img, int tid) {
    const int j = tid >> 2, seg = tid & 3; const bf16* vr = V + (size_t)(row0 + j) * 512 + h * HD + seg * 32;
#pragma unroll
    for (int i = 0; i < 4; ++i) *(LAS v4u*)(img + j * VS + (seg * 32 + 8 * i) * 2) = *(const v4u*)(vr + 8 * i);
    if (seg == 0) *(LAS v4u*)(img + j * VS + 256) = (v4u){0x00003f80u, 0u, 0u, 0u};
    if (seg == 1) *(LAS v4u*)(img + j * VS + 272) = (v4u){0u, 0u, 0u, 0u};
}
__device__ __forceinline__ void prep_unit(const Args& a, LAS uchar* lds, int unit) {
    int tid_ = threadIdx.x; asm volatile("" : "+v"(tid_)); const int tid = tid_, lane = tid & 63, wave = __builtin_amdgcn_readfirstlane(tid >> 6), kq = lane >> 4, fr = lane & 15;
    uchar* ws = a.ws;
    int bh, row0, t0, L; unit_decode(unit, bh, row0, t0, L);
    const int h = bh & 3; const bool latent = unit < NUNIT_L;
    LAS float* sm = (LAS float*)(lds + PA_SM);
    const bf16* XM = (const bf16*)(ws + WS_XM); const bf16* V = (const bf16*)(ws + WS_V);
    bf16* AB = (bf16*)((uchar*)a.out + DO_AB); bf16* Q = (bf16*)((uchar*)a.out + DO_Q); bf16* K = (bf16*)((uchar*)a.out + DO_K);
    __syncthreads();
    if (wave < 2) {
        const float* GG = (const float*)(ws + WS_G) + (size_t)row0 * 16 + wave * 8 + h;
        const int j0 = wave ? 127 - 2 * lane : 2 * lane, j1 = wave ? 126 - 2 * lane : 2 * lane + 1;
        const float li0 = GG[j0 * 16], lf0 = logsig_f(GG[j0 * 16 + 4]), li1 = GG[j1 * 16], lf1 = logsig_f(GG[j1 * 16 + 4]);
        const float incl = lane_scan_add(lf0 + lf1, lane), total = __shfl(incl, 63);
        const float g0 = total - (incl - lf1) + li0, g1 = total - incl + li1;
        const float mx = wave_max(fmaxf(g0, g1));
        sm[wave * 128 + j0] = __expf(g0 - mx); sm[wave * 128 + j1] = __expf(g1 - mx);
        if (lane == 0) { sm[256 + 2 * wave] = total; sm[257 + 2 * wave] = mx; }
    }
    for (int rp_ = 0; rp_ <= ((REP_MASK >> 17) & 1); ++rp_) {
        if (rp_) __syncthreads();
        const int l = tid >> 2, seg = tid & 3, t = t0 + l; const int colg = h * HD + seg * 32;
        const bool hp = t > 0, hn = t + 1 < L;
        const bf16* xc = XM + (size_t)(row0 + l) * 512 + colg;
        const float* cw = a.in[8]; const float* cb = a.in[9];
#pragma unroll
        for (int i = 0; i < 4; ++i) {
            const v4u c = *(const v4u*)(xc + 8 * i); v4u p = (v4u){0u, 0u, 0u, 0u}, n = (v4u){0u, 0u, 0u, 0u};
            if (hp) p = *(const v4u*)(xc - 512 + 8 * i);
            if (hn) n = *(const v4u*)(xc + 512 + 8 * i);
            float o[8];
#pragma unroll
            for (int e = 0; e < 8; ++e) { const int ch = colg + 8 * i + e; const unsigned pw = p[e >> 1], cw_ = c[e >> 1], nw_ = n[e >> 1];
                const float xp = (e & 1) ? bfhi(pw) : bflo(pw), xcv = (e & 1) ? bfhi(cw_) : bflo(cw_), xn = (e & 1) ? bfhi(nw_) : bflo(nw_);
                o[e] = silu_f(cw[ch] * xp + cw[512 + ch] * xcv + cw[1024 + ch] * xn + cb[ch]); }
            const v4u w = (v4u){pk2(o[0], o[1]), pk2(o[2], o[3]), pk2(o[4], o[5]), pk2(o[6], o[7])};
            *(LAS v4u*)(lds + PA_A + img_off(l, seg * 4 + i)) = w;
            if (latent) *(v4u*)(AB + (size_t)(row0 + l) * 512 + colg + 8 * i) = w;
        }
    }
    stage_v(V, row0, h, lds + PA_V, tid);
    __syncthreads();
    for (int rp_ = 0; rp_ <= ((REP_MASK >> 18) & 1); ++rp_) {
        if (rp_) __syncthreads();
        const BFrag ba = load_bfrag(lds + PA_A, 16 * wave + fr, kq);
        const int j = 16 * wave + fr; const float wfj = sm[j], wbj = sm[128 + j];
        const size_t tok = (size_t)(row0 + j);
        for (int pass = latent ? 0 : 1; pass < 2; ++pass) {
            const bf16* W = (const bf16*)(ws + (pass ? WS_WK : WS_WQ)) + (size_t)h * HD * HD + fr * 128 + 8 * kq;
            f32x4 acc[8];
#pragma unroll
            for (int mt = 0; mt < 8; ++mt) { BFrag aw;
#pragma unroll
                for (int s_ = 0; s_ < 4; ++s_) aw.f[s_] = *(const bf16x8*)(W + mt * 2048 + 32 * s_);
                acc[mt] = mma_ff((f32x4){0.f, 0.f, 0.f, 0.f}, aw, ba); if ((mt & 3) == 3) MEMFENCE(); }
            bf16* dst = (pass ? K : Q) + tok * 512 + h * HD + 4 * kq;
#pragma unroll
            for (int mt = 0; mt < 8; ++mt) {
                if (latent) *(v2u*)(dst + 16 * mt) = (v2u){pk2(acc[mt][0], acc[mt][1]), pk2(acc[mt][2], acc[mt][3])};
                if (pass) { const f32x4 kf = acc[mt] * wfj, kb = acc[mt] * wbj;
                    *(LAS v2u*)(lds + PA_KF + j * VS + (16 * mt + 4 * kq) * 2) = (v2u){pk2(kf[0], kf[1]), pk2(kf[2], kf[3])};
                    *(LAS v2u*)(lds + PA_KB + j * VS + (16 * mt + 4 * kq) * 2) = (v2u){pk2(kb[0], kb[1]), pk2(kb[2], kb[3])}; } }
        }
    }
    __syncthreads();
    for (int rp_ = 0; rp_ <= ((REP_MASK >> 19) & 1); ++rp_) {
        if (rp_) __syncthreads();
        bf16* DC = (bf16*)(ws + WS_DC); float* SC = (float*)(ws + WS_SC);
        const unsigned lo = tr_lane_off<VS>(lane);
        BFrag bv, b1; tr_load4<VS>(lds_addr(lds + PA_V) + lo + 32 * wave, bv); tr_load4<VS>(lds_addr(lds + PA_V) + lo + 32 * 8, b1);
        for (int dir = 0; dir < 2; ++dir) {
            const unsigned kbase = lds_addr(lds + (dir ? PA_KB : PA_KF)) + lo;
            bf16* dst = DC + (size_t)(unit * 2 + dir) * CT_SLOT;
#pragma unroll
            for (int mt = 0; mt < 8; ++mt) { BFrag ak; tr_load4<VS>(kbase + 32 * mt, ak);
                const f32x4 acc = mma_ff((f32x4){0.f, 0.f, 0.f, 0.f}, ak, bv);
                *(v2u*)(dst + (size_t)(16 * wave + fr) * 128 + 16 * mt + 4 * kq) = (v2u){pk2(acc[0], acc[1]), pk2(acc[2], acc[3])};
                if (mt == wave) { const f32x4 an = mma_ff((f32x4){0.f, 0.f, 0.f, 0.f}, ak, b1);
                    if (fr == 0) *(v2u*)(dst + (size_t)128 * 128 + 16 * mt + 4 * kq) = (v2u){pk2(an[0], an[1]), pk2(an[2], an[3])}; } }
            if (tid == 0) { SC[(unit * 2 + dir) * 2] = sm[256 + 2 * dir]; SC[(unit * 2 + dir) * 2 + 1] = sm[257 + 2 * dir]; }
        }
    }
}

constexpr int F1S = 144, F2S = 80;
__device__ __forceinline__ void fft1_wave(const Args& a, LAS uchar* wl, int item, const bf16x8 (&bfr)[8][2], int lane) {
    const int kq = lane >> 4, fr = lane & 15;
    const int b = item >> 9, chunk = item & 511, cg0 = chunk * 64, n2 = cg0 >> 9, colb = cg0 & 511;
    const bf16* UF = (const bf16*)(a.ws + WS_UF) + (size_t)b * SEQ * 512 + cg0;
    bf16* TP = (bf16*)(a.ws + WS_TP); const float* TW = (const float*)(a.ws + WS_TW);
    v4u ld[8];
#pragma unroll
    for (int i = 0; i < 8; ++i) ld[i] = *(const v4u*)(UF + (size_t)(i * 8 + (lane >> 3)) * 32768 + (lane & 7) * 8);
#pragma unroll
    for (int i = 0; i < 8; ++i) *(LAS v4u*)(wl + (i * 8 + (lane >> 3)) * F1S + (lane & 7) * 16) = ld[i];
    LDS_WAIT();
    const unsigned base = lds_addr(wl) + tr_lane_off<F1S>(lane);
#pragma unroll 1
    for (int mt = 0; mt < 4; ++mt) {
        bf16x8 a0, a1; tr_load2<F1S>(base + 32 * mt, a0, a1);
        f32x4 acc[8];
#pragma unroll
        for (int nt = 0; nt < 8; ++nt) { acc[nt] = __builtin_amdgcn_mfma_f32_16x16x32_bf16(a0, bfr[nt][0], (f32x4){0.f, 0.f, 0.f, 0.f}, 0, 0, 0); acc[nt] = __builtin_amdgcn_mfma_f32_16x16x32_bf16(a1, bfr[nt][1], acc[nt], 0, 0, 0); }
        const int c0 = 16 * mt + 4 * kq, col0 = colb + c0;
#pragma unroll
        for (int nt = 0; nt < 4; ++nt) { const int k1 = 16 * nt + fr; const int idx = (n2 * k1) & 4095; const float cs = TW[idx], sn = TW[(idx - 1024) & 4095];
            float pr[4], pi[4];
#pragma unroll
            for (int r = 0; r < 4; ++r) { const float tr = acc[nt][r], ti = acc[nt + 4][r]; const float xr = tr * cs + ti * sn, xi = ti * cs - tr * sn;
                const bool st = ((col0 + r) & 127) >= 65; pr[r] = st ? -xi : xr; pi[r] = st ? xr : xi; }
            const size_t o = ((size_t)(b * 2) * 64 + k1) * 32768 + (size_t)cg0 + c0;
            *(v2u*)(TP + o) = (v2u){pk2(pr[0], pr[1]), pk2(pr[2], pr[3])};
            *(v2u*)(TP + o + (size_t)64 * 32768) = (v2u){pk2(pi[0], pi[1]), pk2(pi[2], pi[3])}; }
    }
}
__device__ __forceinline__ void fft2_wave(const Args& a, LAS uchar* wl, int item, const bf16x8 (&bfr)[4][4], int lane) {
    const int kq = lane >> 4, fr = lane & 15;
    const int b = item >> 10, k1 = (item >> 4) & 63, chunk = item & 15;
    const bf16* TP = (const bf16*)(a.ws + WS_TP); bf16* YM = (bf16*)(a.ws + WS_YM);
    v4u ld[8];
#pragma unroll
    for (int i = 0; i < 8; ++i) { const int kap = i * 16 + (lane >> 2), ri = kap >> 6, n2 = kap & 63;
        ld[i] = *(const v4u*)(TP + ((size_t)(b * 2 + ri) * 64 + k1) * 32768 + (size_t)n2 * 512 + chunk * 32 + (lane & 3) * 8); }
#pragma unroll
    for (int i = 0; i < 8; ++i) *(LAS v4u*)(wl + (i * 16 + (lane >> 2)) * F2S + (lane & 3) * 16) = ld[i];
    LDS_WAIT();
    const unsigned base = lds_addr(wl) + tr_lane_off<F2S>(lane);
#pragma unroll
    for (int mt = 0; mt < 2; ++mt) {
        BFrag af; tr_load4<F2S>(base + 32 * mt, af);
#pragma unroll
        for (int nt = 0; nt < 4; ++nt) { f32x4 acc = (f32x4){0.f, 0.f, 0.f, 0.f};
#pragma unroll
            for (int s_ = 0; s_ < 4; ++s_) acc = __builtin_amdgcn_mfma_f32_16x16x32_bf16(af.f[s_], bfr[nt][s_], acc, 0, 0, 0);
            const int k2 = 16 * nt + fr; const size_t row = (size_t)b * SEQ + k1 + 64 * k2;
            *(v2u*)(YM + row * 1024 + chunk * 32 + 16 * mt + 4 * kq) = (v2u){pk2(acc[0], acc[1]), pk2(acc[2], acc[3])}; }
    }
}
__device__ __forceinline__ void fft1_phase(const Args& a, LAS uchar* lds, int vcu, int G) {
    const int tid = threadIdx.x, lane = tid & 63, wave = __builtin_amdgcn_readfirstlane(tid >> 6), kq = lane >> 4, fr = lane & 15;
    const bf16* F1 = (const bf16*)(a.ws + WS_F1);
    bf16x8 bfr[8][2];
#pragma unroll
    for (int nt = 0; nt < 8; ++nt)
#pragma unroll
        for (int s_ = 0; s_ < 2; ++s_) bfr[nt][s_] = *(const bf16x8*)(F1 + (16 * nt + fr) * 64 + 32 * s_ + 8 * kq);
    LAS uchar* wl = lds + wave * 9216;
    for (int it = vcu * NWAVES + wave; it < NB * 512; it += G * NWAVES) fft1_wave(a, wl, it, bfr, lane);
}
__device__ __forceinline__ void fft2_phase(const Args& a, LAS uchar* lds, int vcu, int G) {
    const int tid = threadIdx.x, lane = tid & 63, wave = __builtin_amdgcn_readfirstlane(tid >> 6), kq = lane >> 4, fr = lane & 15;
    const bf16* G2 = (const bf16*)(a.ws + WS_G2);
    bf16x8 bfr[4][4];
#pragma unroll
    for (int nt = 0; nt < 4; ++nt)
#pragma unroll
        for (int s_ = 0; s_ < 4; ++s_) bfr[nt][s_] = *(const bf16x8*)(G2 + (16 * nt + fr) * 128 + 32 * s_ + 8 * kq);
    LAS uchar* wl = lds + wave * 10240;
    for (int it = vcu * NWAVES + wave; it < NB * 1024; it += G * NWAVES) fft2_wave(a, wl, it, bfr, lane);
}

__device__ __forceinline__ void p4_scan(const Args& a, int G) {
    uchar* ws = a.ws;
    const bf16* DC = (const bf16*)(ws + WS_DC); const float* SC = (const float*)(ws + WS_SC);
    bf16* CT = (bf16*)(ws + WS_CT); float* MS = (float*)(ws + WS_MS);
    constexpr int F4 = CT_SLOT / 4;
    const int total = 64 * F4;
    for (int gi = blockIdx.x * NTHR + threadIdx.x; gi < total; gi += G * NTHR) {
        const int seq = gi / F4, i = gi - seq * F4; const int bh = seq >> 1, dir = seq & 1;
        f32x4 s = (f32x4){0.f, 0.f, 0.f, 0.f}; float m = 0.f;
#pragma unroll 2
        for (int step = 0; step < 34; ++step) {
            int unit;
            if (step < 2) unit = NUNIT_L + bh * 2 + (dir ? 1 - step : step);
            else { const int c = dir ? 33 - step : step - 2; unit = bh * 32 + c; }
            const int slot = unit * 2 + dir;
            if (step >= 2) { *(v2u*)(CT + (size_t)slot * CT_SLOT + 4 * i) = (v2u){pk2(s.x, s.y), pk2(s.z, s.w)}; if (i == 0) MS[slot] = m; }
            const float bend = SC[slot * 2], mloc = SC[slot * 2 + 1];
            const float mn = fmaxf(bend + m, mloc), al = __expf(bend + m - mn), be = __expf(mloc - mn);
            const v2u dv = *(const v2u*)(DC + (size_t)slot * CT_SLOT + 4 * i);
            s = s * al + bf4(dv) * be; m = mn;
        }
    }
}

constexpr int OU_CF = 0, OU_CB = 36864, OU_V = 73728, OU_P = 110592, OU_SM = 143360;
__device__ __forceinline__ void out_unit(const Args& a, LAS uchar* lds, int unit) {
    int tid_ = threadIdx.x; asm volatile("" : "+v"(tid_)); const int tid = tid_, lane = tid & 63, wave = __builtin_amdgcn_readfirstlane(tid >> 6), kq = lane >> 4, fr = lane & 15;
    uchar* ws = a.ws;
    const int bh = unit >> 5, c = unit & 31, h = bh & 3, row0 = (bh >> 2) * SEQ + c * 128;
    LAS float* sm = (LAS float*)(lds + OU_SM);
    const bf16* Q = (const bf16*)((const uchar*)a.out + DO_Q); const bf16* K = (const bf16*)((const uchar*)a.out + DO_K); const bf16* AB = (const bf16*)((const uchar*)a.out + DO_AB);
    const bf16* V = (const bf16*)(ws + WS_V); const bf16* Z = (const bf16*)(ws + WS_Z);
    const bf16* CT = (const bf16*)(ws + WS_CT); const float* MS = (const float*)(ws + WS_MS);
    bf16* YM = (bf16*)(ws + WS_YM);
    const float m_f = MS[unit * 2], m_b = MS[unit * 2 + 1];
    __syncthreads();
    if (wave < 2) {
        const float* GG = (const float*)(ws + WS_G) + (size_t)row0 * 16 + wave * 8 + h;
        const int j0 = wave ? 127 - 2 * lane : 2 * lane, j1 = wave ? 126 - 2 * lane : 2 * lane + 1;
        const float li0 = GG[j0 * 16], lf0 = logsig_f(GG[j0 * 16 + 4]), li1 = GG[j1 * 16], lf1 = logsig_f(GG[j1 * 16 + 4]);
        const float incl = lane_scan_add(lf0 + lf1, lane);
        const float b0 = incl - lf1, b1 = incl, r0 = li0 - b0, r1 = li1 - b1;
        const float mi = lane_scan_max(fmaxf(r0, r1), lane); float mprev = __shfl_up(mi, 1); if (lane == 0) mprev = -3.0e38f;
        const float R0 = fmaxf(mprev, r0), R1 = mi, mst = wave ? m_b : m_f;
        LAS float* d = sm + wave * 384;
        d[j0] = r0; d[j1] = r1; d[128 + j0] = fmaxf(mst, R0); d[128 + j1] = fmaxf(mst, R1); d[256 + j0] = b0; d[256 + j1] = b1;
    }
    {
        const bf16* sf = CT + (size_t)(unit * 2) * CT_SLOT; const bf16* sb = sf + CT_SLOT;
#pragma unroll
        for (int i = 0; i < 5; ++i) { const int id = tid + NTHR * i; if (id < 129 * 16) { const int row = id >> 4, ch = id & 15;
            *(LAS v4u*)(lds + OU_CF + img_off(row, ch)) = *(const v4u*)(sf + row * 128 + ch * 8); *(LAS v4u*)(lds + OU_CB + img_off(row, ch)) = *(const v4u*)(sb + row * 128 + ch * 8); } }
        stage_v(V, row0, h, lds + OU_V, tid);
    }
    const int l = 16 * wave + fr; const int tok = row0 + l;
    BFrag bq;
#pragma unroll
    for (int s_ = 0; s_ < 4; ++s_) bq.f[s_] = *(const bf16x8*)(Q + (size_t)tok * 512 + h * HD + 32 * s_ + 8 * kq);
    f32x4 S[8];
    { const bf16* kp = K + (size_t)(row0 + fr) * 512 + h * HD + 8 * kq;
#pragma unroll
      for (int mt = 0; mt < 8; ++mt) { BFrag ak;
#pragma unroll
          for (int s_ = 0; s_ < 4; ++s_) ak.f[s_] = *(const bf16x8*)(kp + (size_t)mt * 16 * 512 + 32 * s_);
          S[mt] = mma_ff((f32x4){0.f, 0.f, 0.f, 0.f}, ak, bq); if ((mt & 3) == 3) MEMFENCE(); } }
    __syncthreads();
    LAS uchar* Pw = lds + OU_P + wave * 4096;
    const unsigned vbase = lds_addr(lds + OU_V) + tr_lane_off<VS>(lane);
    f32x4 hs[8];
    for (int dir = 0; dir < 2; ++dir) {
        const LAS float* rr = sm + dir * 384; const LAS float* rho = rr + 128; const LAS float* bl = rr + 256;
        const float rho_l = rho[l], mst = dir ? m_b : m_f;
#pragma unroll
        for (int mt = 0; mt < 8; ++mt) { float p[4]; const f32x4 rv = *(const LAS f32x4*)(rr + 16 * mt + 4 * kq);
#pragma unroll
            for (int r = 0; r < 4; ++r) { const int j = 16 * mt + 4 * kq + r; const bool ok = dir ? (j >= l) : (j <= l); p[r] = ok ? S[mt][r] * __expf(fminf(rv[r] - rho_l, 0.f)) : 0.f; }
            *(LAS v2u*)(Pw + img_off(fr, 2 * mt + (kq >> 1)) + (kq & 1) * 8) = (v2u){pk2(p[0], p[1]), pk2(p[2], p[3])}; if (mt & 1) MEMFENCE(); }
        f32x4 acc[9];
        const float wi = __expf(mst - rho_l);
        const LAS uchar* cimg = lds + (dir ? OU_CB : OU_CF);
#pragma unroll
        for (int mt = 0; mt < 9; ++mt) { acc[mt] = mma_a((f32x4){0.f, 0.f, 0.f, 0.f}, cimg, 16 * mt + fr, bq, kq) * wi; if (mt & 1) MEMFENCE(); }
        MEMFENCE();
        { const BFrag bp = load_bfrag(Pw, fr, kq);
#pragma unroll
          for (int mt = 0; mt < 9; ++mt) { BFrag av; tr_load4<VS>(vbase + 32 * mt, av); acc[mt] = mma_ff(acc[mt], av, bp); } }
        const float den = __shfl(acc[8][0], fr);
        const float sc = 1.0f / fmaxf(fabsf(den), __expf(-bl[l] - rho_l));
#pragma unroll
        for (int mt = 0; mt < 8; ++mt) hs[mt] = dir ? hs[mt] + acc[mt] * sc : acc[mt] * sc;
    }
    float s1 = 0.f;
#pragma unroll
    for (int mt = 0; mt < 8; ++mt) s1 += (hs[mt][0] + hs[mt][1]) + (hs[mt][2] + hs[mt][3]);
    s1 += __shfl_xor(s1, 16); s1 += __shfl_xor(s1, 32);
    const float mu = s1 * (1.0f / 128.0f); float s2 = 0.f;
#pragma unroll
    for (int mt = 0; mt < 8; ++mt) { const f32x4 d = hs[mt] - mu; s2 += (d[0] * d[0] + d[1] * d[1]) + (d[2] * d[2] + d[3] * d[3]); }
    s2 += __shfl_xor(s2, 16); s2 += __shfl_xor(s2, 32);
    const float rstd = rsqrtf(s2 * (1.0f / 128.0f) + EPS);
    const float* mw = a.in[13] + h * HD; const float* msk = a.in[14] + h * HD;
#pragma unroll
    for (int mt = 0; mt < 8; ++mt) { const int e0 = 16 * mt + 4 * kq;
        const f32x4 w = *(const f32x4*)(mw + e0), k4 = *(const f32x4*)(msk + e0);
        const v2u av = *(const v2u*)(AB + (size_t)tok * 512 + h * HD + e0), zv = *(const v2u*)(Z + (size_t)tok * 512 + h * HD + e0);
        const float a4[4] = {bflo(av.x), bfhi(av.x), bflo(av.y), bfhi(av.y)}, z4[4] = {bflo(zv.x), bfhi(zv.x), bflo(zv.y), bfhi(zv.y)};
        float y[4];
#pragma unroll
        for (int r = 0; r < 4; ++r) y[r] = ((hs[mt][r] - mu) * rstd * w[r] + k4[r] * a4[r]) * silu_f(z4[r]);
        *(v2u*)(YM + (size_t)tok * 1024 + 512 + h * HD + e0) = (v2u){pk2(y[0], y[1]), pk2(y[2], y[3])}; MEMFENCE(); }
}

__device__ __forceinline__ void p9_conv(const Args& a, int vcu, int G) {
    const int tid = threadIdx.x, lane = tid & 63, wave = __builtin_amdgcn_readfirstlane(tid >> 6);
    const bf16* U = (const bf16*)(a.ws + WS_U); bf16* ACT = (bf16*)(a.ws + WS_ACT);
    const float* fw = a.in[19]; const float* fb = a.in[20];
    const int gw = vcu * NWAVES + wave, NGW = G * NWAVES;
    for (int it = gw; it < NB * 64 * 10 * 2; it += NGW) {
        const int half = it & 1, qb = (it >> 1) % 10, br = (it >> 1) / 10, r = br & 63, b = br >> 6;
        const int ch = (qb * 64 + lane) * 4;
        f32x4 wv[9], wg[9];
#pragma unroll
        for (int t = 0; t < 9; ++t) { wv[t] = *(const f32x4*)(fw + t * UPW + ch); wg[t] = *(const f32x4*)(fw + t * UPW + DFF + ch); }
        const f32x4 bv = *(const f32x4*)(fb + ch), bgt = *(const f32x4*)(fb + DFF + ch);
        const bf16* rp = U + (size_t)(b * SEQ + r * 64) * UPW + ch;
        const bool rv0 = r > 0, rv2 = r < 63;
        v2u xv[3][6], xg[3][6];
        const int c0 = half * 32;
#pragma unroll
        for (int i = 0; i < 3; ++i) {
            const bool rvi = (i == 0) ? rv0 : (i == 2 ? rv2 : true);
            const bf16* p = rp + (ptrdiff_t)(i - 1) * 64 * UPW + (ptrdiff_t)(c0 - 1) * UPW;
            xv[i][0] = (v2u){0u, 0u}; xg[i][0] = (v2u){0u, 0u}; xv[i][1] = (v2u){0u, 0u}; xg[i][1] = (v2u){0u, 0u};
            if (rvi) { if (c0 > 0) { xv[i][0] = *(const v2u*)p; xg[i][0] = *(const v2u*)(p + DFF); } xv[i][1] = *(const v2u*)(p + UPW); xg[i][1] = *(const v2u*)(p + UPW + DFF); }
        }
#pragma unroll 1
        for (int cb = 0; cb < 8; ++cb) {
            const int c = c0 + 4 * cb;
#pragma unroll
            for (int i = 0; i < 3; ++i) {
                const bool rvi = (i == 0) ? rv0 : (i == 2 ? rv2 : true);
                const bf16* p = rp + (ptrdiff_t)(i - 1) * 64 * UPW + (ptrdiff_t)(c + 1) * UPW;
#pragma unroll
                for (int j = 0; j < 4; ++j) { xv[i][2 + j] = (v2u){0u, 0u}; xg[i][2 + j] = (v2u){0u, 0u};
                    if (rvi && (c + 1 + j <= 63)) { xv[i][2 + j] = *(const v2u*)(p + j * UPW); xg[i][2 + j] = *(const v2u*)(p + j * UPW + DFF); } }
            }
#pragma unroll
            for (int o = 0; o < 4; ++o) {
                f32x4 av = bv, ag = bgt;
#pragma unroll
                for (int i = 0; i < 3; ++i)
#pragma unroll
                    for (int j = 0; j < 3; ++j) { av += wv[i * 3 + j] * bf4(xv[i][o + j]); ag += wg[i * 3 + j] * bf4(xg[i][o + j]); }
                float ov[4];
#pragma unroll
                for (int e = 0; e < 4; ++e) ov[e] = av[e] * silu_f(ag[e]);
                *(v2u*)(ACT + (size_t)(b * SEQ + r * 64 + c + o) * DFF + ch) = (v2u){pk2(ov[0], ov[1]), pk2(ov[2], ov[3])};
            }
#pragma unroll
            for (int i = 0; i < 3; ++i) { xv[i][0] = xv[i][4]; xv[i][1] = xv[i][5]; xg[i][0] = xg[i][4]; xg[i][1] = xg[i][5]; }
        }
    }
}

constexpr int LDS_BYTES = 147456, MISC_OFF = 147456 - 256;
constexpr int NPHASE = 12;
#ifndef MK_PER_PHASE
#define MK_PER_PHASE 0
#endif
__global__ void __launch_bounds__(NTHR, 2) mk_fwd(Args args) {
    extern __shared__ __attribute__((aligned(16))) uchar lds_raw[];
    LAS uchar* lds = (LAS uchar*)lds_raw;
    const int tid = threadIdx.x;
    const int G = gridDim.x; const int bx = blockIdx.x; const int vcu = (G % 8 == 0) ? (bx % 8) * (G / 8) + bx / 8 : bx;
    volatile LAS unsigned* MISC = (volatile LAS unsigned*)(lds + MISC_OFF);
    if (tid < 64) MISC[tid] = 0u;
    __syncthreads();
    XcdBarrier bar; bar.bar = (unsigned*)(args.ws + WS_CTL); bar.x = 0; bar.st = nullptr;
    if (!MK_PER_PHASE) bar = xcd_barrier_post((unsigned*)(args.ws + WS_CTL), MISC + 8);
    const int lo = args.ph_lo, hi = args.ph_hi;
#ifndef PH_MASK
#define PH_MASK 0xFFF
#endif
#define IN(k) (((PH_MASK >> (k)) & 1) && lo <= (k) && (k) < hi)
#define REP(k) for (int rep_ = 0; rep_ <= ((REP_MASK >> (k)) & 1); ++rep_, __syncthreads())
#define SEAM(k) do { if (IN(k) && IN((k) + 1)) { xcd_barrier(bar); if ((REP_MASK >> 20) & 1) { xcd_barrier(bar); xcd_barrier(bar); } } } while (0)
    uchar* ws = args.ws;
    if (IN(0)) { if ((REP_MASK >> 16) & 1) { p0_prologue(args, lds, vcu, G, WS_MOD + 512 * 1024); __syncthreads(); } p0_prologue(args, lds, vcu, G, WS_MOD); } SEAM(0);
    if (IN(1)) REP(1) { p1_rows(args, lds, vcu, G); } SEAM(1);
    if (IN(2)) REP(2) {
        pg8::Gemm g{(const bf16*)(ws + WS_HX), (const bf16*)(ws + WS_WIN), TROWS, 2048, DM}; SchedP2 S; S.init(G, bx);
        EpiP2 E{(bf16*)(ws + WS_UF), (bf16*)(ws + WS_XM), (bf16*)(ws + WS_V), (bf16*)(ws + WS_Z)};
        pg8::gemm_phase<EpiP2, SchedP2, true, true>(lds, g, S, E);
    } SEAM(2);
    if (IN(3)) REP(3) {
        for (int rr_ = 0; rr_ <= ((REP_MASK >> 12) & 1); ++rr_) for (int it = bx; it < NUNIT; it += G) prep_unit(args, lds, it);
        __syncthreads();
        for (int rr_ = 0; rr_ <= ((REP_MASK >> 13) & 1); ++rr_) fft1_phase(args, lds, vcu, G);
    } SEAM(3);
    if (IN(4)) REP(4) {
        for (int rr_ = 0; rr_ <= ((REP_MASK >> 14) & 1); ++rr_) fft2_phase(args, lds, vcu, G);
        for (int rr_ = 0; rr_ <= ((REP_MASK >> 15) & 1); ++rr_) p4_scan(args, G);
    } SEAM(4);
    if (IN(5)) REP(5) { for (int it = bx; it < NUNIT_L; it += G) out_unit(args, lds, it); __syncthreads(); } SEAM(5);
    if (IN(6)) REP(6) {
        pg8::Gemm g{(const bf16*)(ws + WS_YM), (const bf16*)(ws + WS_WOUT), MROWS, DM, 1024}; pg8::StaticOrder S; S.init(MROWS, DM, G, bx);
        EpiGate16 E{(bf16*)args.out, 2048, (const float*)(ws + WS_MOD) + 2048, nullptr};
        pg8::gemm_phase<EpiGate16, pg8::StaticOrder, true, true>(lds, g, S, E);
    } SEAM(6);
    if (IN(7)) REP(7) { p7_rows(args, vcu, G); } SEAM(7);
    if (IN(8)) REP(8) {
        pg8::Gemm g{(const bf16*)(ws + WS_H2), (const bf16*)(ws + WS_WUP), MROWS, UPW, DM}; pg8::StaticOrder S; S.init(MROWS, UPW, G, bx);
        EpiBias16 E{(bf16*)(ws + WS_U), UPW, args.in[18]};
        pg8::gemm_phase<EpiBias16, pg8::StaticOrder, true, true>(lds, g, S, E);
    } SEAM(8);
    if (IN(9)) REP(9) { p9_conv(args, vcu, G); } SEAM(9);
    if (IN(10)) {
        pg8::Gemm g{(const bf16*)(ws + WS_ACT), (const bf16*)(ws + WS_WDN), MROWS, DM, DFF}; pg8::StaticOrder S; S.init(MROWS, DM, G, bx);
        EpiGate16 E{(bf16*)(ws + WS_U), 1024, (const float*)(ws + WS_MOD) + 5120, args.in[22]};
        for (int rr_ = 0; rr_ <= ((REP_MASK >> 10) & 1); ++rr_) { if (rr_) __syncthreads(); pg8::gemm_phase<EpiGate16, pg8::StaticOrder, true, true>(lds, g, S, E); }
    } SEAM(10);
    if (IN(11)) { if ((REP_MASK >> 11) & 1) p11_rows(args, vcu, G, (float*)(ws + 0)); p11_rows(args, vcu, G, args.out); }
#undef IN
#undef SEAM
}

extern "C" void kernel_launch(void* const* d_in, const int* in_sizes, int n_in, void* d_out, int out_size, void* d_ws, size_t ws_size, hipStream_t stream) {
    static int grid = 0;
    if (grid == 0) {
        if (n_in != 24 || out_size != MROWS * DM || ws_size < WS_END) { fprintf(stderr, "kernel_launch: unexpected problem (n_in %d, out %d, ws %zu); nothing launched\n", n_in, out_size, ws_size); grid = -1; return; }
        int dev = 0, cus = 0, per_cu = 0;
        if (hipGetDevice(&dev) != hipSuccess || hipDeviceGetAttribute(&cus, hipDeviceAttributeMultiprocessorCount, dev) != hipSuccess) { grid = -1; return; }
        if (hipFuncSetAttribute((const void*)mk_fwd, hipFuncAttributeMaxDynamicSharedMemorySize, LDS_BYTES) != hipSuccess) { fprintf(stderr, "kernel_launch: hipFuncSetAttribute failed\n"); grid = -1; return; }
        if (hipOccupancyMaxActiveBlocksPerMultiprocessor(&per_cu, (const void*)mk_fwd, NTHR, LDS_BYTES) != hipSuccess || per_cu < 1) { fprintf(stderr, "kernel_launch: occupancy query says %d blocks per CU\n", per_cu); grid = -1; (void)hipGetLastError(); return; }
        grid = cus;
    }
    if (grid < 0) return;
    (void)hipMemsetAsync((char*)d_ws + WS_ZERO0, 0, WS_ZERO_BYTES, stream);
    Args a{};
    for (int i = 0; i < 24; ++i) a.in[i] = (const float*)d_in[i];
    a.out = (float*)d_out; a.ws = (uchar*)d_ws;
#if MK_PER_PHASE
    for (int p = 0; p < NPHASE; ++p) { a.ph_lo = p; a.ph_hi = p + 1; hipLaunchKernelGGL(mk_fwd, dim3(grid), dim3(NTHR), LDS_BYTES, stream, a); }
#else
    a.ph_lo = 0; a.ph_hi = NPHASE; hipLaunchKernelGGL(mk_fwd, dim3(grid), dim3(NTHR), LDS_BYTES, stream, a);
#endif
}
```

```cpp
#include <hip/hip_runtime.h>
#include <cstdio>
#include <cstdint>
#ifndef REP_MASK
#define REP_MASK 0
#endif
namespace pg8 {
#define PG8_LAS __attribute__((address_space(3)))
typedef unsigned short bf16_t;
typedef short bf16x8 __attribute__((ext_vector_type(8)));
typedef float f32x4 __attribute__((ext_vector_type(4)));
typedef unsigned u32x4 __attribute__((ext_vector_type(4)));
constexpr int BM = 256, BK = 64, HALF = 128, HTB = HALF * BK * 2  , STAGE_BYTES = 8 * HTB, NXCD = 8, WGM = 8;

__host__ __device__ __forceinline__ int lds_byte(int r, int c) { const int st = (r >> 4) * 2 + (c >> 5), rr = r & 15, cc = c & 31, ob = rr * 64 + cc * 2; return st * 1024 + (ob ^ (((ob >> 9) & 1) << 5)); }
__host__ __device__ __forceinline__ void stage_rc(int b, int& R, int& C) { const int st = b / 1024, sb = b % 1024, swz = sb ^ (((sb >> 9) & 1) << 5); R = (st >> 1) * 16 + swz / 64; C = (st & 1) * 32 + (swz % 64) / 2; }
__host__ __device__ __forceinline__ int perm32(int rho) { const int n = rho >> 4, i = rho & 15; return 8 * (i >> 2) + 4 * n + (i & 3); }

struct Unit { int pm, pn; };
struct Gemm { const bf16_t* A; const bf16_t* Bt; int M, N, K; };

struct StaticOrder {
    int nM, nN, nwg, G, c;
    __host__ __device__ void init(int M, int N, int G_, int c_) { nM = M / BM; nN = N / BM; nwg = nM * nN; G = G_; c = c_; }
    __host__ __device__ bool next(int i, Unit& u) const {
        const long L = (long)i * G + c; if (L >= nwg) return false;
        int wgid = (int)L; { const int q = nwg / NXCD, r = nwg % NXCD, xcd = wgid % NXCD, off = wgid / NXCD; wgid = (xcd < r ? xcd * (q + 1) : r * (q + 1) + (xcd - r) * q) + off; }
        const int nig = WGM * nN, gid = wgid / nig, fm = gid * WGM, gsz = (nM - fm) < WGM ? (nM - fm) : WGM;
        u.pm = fm + ((wgid % nig) % gsz); u.pn = (wgid % nig) / gsz; return true;
    }
    __device__ __forceinline__ void a_ready(const Unit&) const {}
    __device__ __forceinline__ void done(const Unit&) const {}
};
__device__ __forceinline__ unsigned cvt_pk_bf16(float lo, float hi) { unsigned r; asm volatile("v_cvt_pk_bf16_f32 %0, %1, %2" : "=v"(r) : "v"(lo), "v"(hi)); return r; }
template <class Epi, class Sched, bool ALIGN_EPI = false, bool SP2 = false>
__device__ __forceinline__ void gemm_phase(PG8_LAS unsigned char* lds, const Gemm g, const Sched& S, const Epi& E) {
    const int tid = threadIdx.x, wid = __builtin_amdgcn_readfirstlane(tid >> 6), lane = tid & 63, wr = wid >> 2, wc = wid & 3, fr = lane & 15, fq = lane >> 4;
    const int K = g.K, nt = K / BK;
    unsigned voffA[2], voffB[2];
#pragma unroll
    for (int i = 0; i < 2; ++i) { int R, C; stage_rc(tid * 16 + i * 8192, R, C); const int Rb = Epi::PERM ? ((R & ~31) + perm32(R & 31)) : R;
        voffA[i] = (unsigned)(R * K + C) * 2u; voffB[i] = (unsigned)(Rb * K + C) * 2u; }
    const size_t kstep = (size_t)(BK * 2);
    const size_t hstep = (size_t)HALF * K * 2;
    const size_t tstep = 2 * hstep;
    const unsigned ldsw = (unsigned)wid * 1024u;
    const int aoff = lds_byte(wr * 64 + fr, fq * 8), boff = lds_byte(wc * 32 + fr, fq * 8);
#define PG8_SA(b, h) (((b) * 2 + (h)) * HTB)
#define PG8_SB(b, h) ((4 + (b) * 2 + (h)) * HTB)
#define PG8_STAGE(bufoff, gbase, voff) do { _Pragma("unroll") for (int _i = 0; _i < 2; ++_i) \
        __builtin_amdgcn_global_load_lds((const unsigned*)((const char*)(gbase) + (voff)[_i]), (PG8_LAS unsigned*)(lds + (bufoff) + ldsw + _i * 8192), 16, 0, 0); } while (0)
#define PG8_LDA(dst, b, h) do { _Pragma("unroll") for (int m = 0; m < 4; ++m) _Pragma("unroll") for (int k = 0; k < 2; ++k) dst[m][k] = *(const PG8_LAS bf16x8*)(lds + PG8_SA(b, h) + aoff + m * 2048 + k * 1024); } while (0)
#define PG8_LDB(dst, b, h) do { _Pragma("unroll") for (int n = 0; n < 2; ++n) _Pragma("unroll") for (int k = 0; k < 2; ++k) dst[n][k] = *(const PG8_LAS bf16x8*)(lds + PG8_SB(b, h) + boff + n * 2048 + k * 1024); } while (0)
#define PG8_MMA(ai, bj, At, Bt) do { __builtin_amdgcn_s_setprio(1); _Pragma("unroll") for (int m = 0; m < 4; ++m) _Pragma("unroll") for (int n = 0; n < 2; ++n) _Pragma("unroll") for (int k = 0; k < 2; ++k) \
        acc[ai][bj][m][n] = __builtin_amdgcn_mfma_f32_16x16x32_bf16(Bt[n][k], At[m][k], acc[ai][bj][m][n], 0, 0, 0); __builtin_amdgcn_s_setprio(0); } while (0)
#define PG8_WAIT_V(n) asm volatile("s_waitcnt vmcnt(" #n ")" ::: "memory")
#define PG8_WAIT_L(n) asm volatile("s_waitcnt lgkmcnt(" #n ")" ::: "memory")
#define PG8_BAR __builtin_amdgcn_s_barrier()
#define PG8_SCHED __builtin_amdgcn_sched_barrier(0)
    Unit cur, nxt; int ui = 0;
    if (!S.next(0, cur)) return;
    f32x4 acc[2][2][4][2];
#pragma unroll
    for (int a = 0; a < 2; ++a)
#pragma unroll
        for (int b = 0; b < 2; ++b)
#pragma unroll
            for (int m = 0; m < 4; ++m)
#pragma unroll
                for (int n = 0; n < 2; ++n) acc[a][b][m][n] = (f32x4){0.f, 0.f, 0.f, 0.f};
    bf16x8 At[4][2], B0[2][2], B1[2][2];
    const char* cA = (const char*)g.A + (size_t)cur.pm * tstep; const char* cB = (const char*)g.Bt + (size_t)cur.pn * tstep;
    S.a_ready(cur);
    if constexpr (SP2) {
        PG8_STAGE(PG8_SB(0, 0), cB, voffB); PG8_STAGE(PG8_SB(0, 1), cB + hstep, voffB); PG8_STAGE(PG8_SA(0, 0), cA, voffA); PG8_STAGE(PG8_SA(0, 1), cA + hstep, voffA);
        if (wr == 1) PG8_BAR;
        PG8_WAIT_V(2); PG8_BAR;
        PG8_STAGE(PG8_SB(1, 0), cB + kstep, voffB); PG8_STAGE(PG8_SA(1, 0), cA + kstep, voffA); PG8_STAGE(PG8_SB(1, 1), cB + hstep + kstep, voffB);
        PG8_WAIT_V(6); PG8_BAR;
    } else {
        PG8_STAGE(PG8_SB(0, 0), cB, voffB); PG8_STAGE(PG8_SA(0, 0), cA, voffA); PG8_STAGE(PG8_SB(0, 1), cB + hstep, voffB); PG8_STAGE(PG8_SA(0, 1), cA + hstep, voffA);
        if (wr == 1) PG8_BAR;
        PG8_WAIT_V(4); PG8_BAR;
        PG8_STAGE(PG8_SB(1, 0), cB + kstep, voffB); PG8_STAGE(PG8_SA(1, 0), cA + kstep, voffA); PG8_STAGE(PG8_SB(1, 1), cB + hstep + kstep, voffB);
        PG8_WAIT_V(6); PG8_BAR;
    }
    for (;;) {
        const bool has_next = S.next(ui + 1, nxt);
        const char* nA = has_next ? (const char*)g.A + (size_t)nxt.pm * tstep : cA; const char* nB = has_next ? (const char*)g.Bt + (size_t)nxt.pn * tstep : cB;
        for (int t = 0; t < nt; t += 2) {
            const bool last = (t == nt - 2);
            const char* a1 = cA + (size_t)(t + 1) * kstep;
            const char* a2 = last ? nA : cA + (size_t)(t + 2) * kstep; const char* b2 = last ? nB : cB + (size_t)(t + 2) * kstep;
            const char* a3 = a2 + kstep; const char* b3 = b2 + kstep;
            if (last && has_next) S.a_ready(nxt);
            if constexpr (SP2) {
            PG8_LDB(B0, 0, 0); PG8_LDB(B1, 0, 1); PG8_SCHED; PG8_LDA(At, 0, 0); PG8_STAGE(PG8_SA(1, 1), a1 + hstep, voffA);
            PG8_WAIT_V(8); PG8_WAIT_L(0); PG8_BAR; PG8_MMA(0, 0, At, B0); PG8_MMA(0, 1, At, B1); PG8_BAR; PG8_SCHED;
            PG8_LDA(At, 0, 1); PG8_STAGE(PG8_SB(0, 0), b2, voffB); PG8_STAGE(PG8_SB(0, 1), b2 + hstep, voffB); PG8_STAGE(PG8_SA(0, 0), a2, voffA);
            PG8_WAIT_V(8); PG8_WAIT_L(0); PG8_BAR; PG8_MMA(1, 0, At, B0); PG8_MMA(1, 1, At, B1); PG8_BAR; PG8_SCHED;
            PG8_LDB(B0, 1, 0); PG8_LDB(B1, 1, 1); PG8_SCHED; PG8_LDA(At, 1, 0); PG8_STAGE(PG8_SA(0, 1), a2 + hstep, voffA);
            PG8_WAIT_V(8); PG8_WAIT_L(0); PG8_BAR; PG8_MMA(0, 0, At, B0); PG8_MMA(0, 1, At, B1); PG8_BAR; PG8_SCHED;
            PG8_LDA(At, 1, 1); PG8_STAGE(PG8_SB(1, 0), b3, voffB); PG8_STAGE(PG8_SB(1, 1), b3 + hstep, voffB); PG8_STAGE(PG8_SA(1, 0), a3, voffA);
            PG8_WAIT_V(8); PG8_WAIT_L(0); PG8_BAR; PG8_MMA(1, 0, At, B0); PG8_MMA(1, 1, At, B1); PG8_BAR; PG8_SCHED;
            } else {
            PG8_LDB(B0, 0, 0); PG8_SCHED; PG8_LDA(At, 0, 0); PG8_STAGE(PG8_SA(1, 1), a1 + hstep, voffA);
            PG8_WAIT_L(8); PG8_BAR; PG8_WAIT_L(0); PG8_MMA(0, 0, At, B0); PG8_BAR; PG8_SCHED;
            PG8_LDB(B1, 0, 1); PG8_STAGE(PG8_SB(0, 0), b2, voffB);
            PG8_BAR; PG8_WAIT_L(0); PG8_MMA(0, 1, At, B1); PG8_BAR;
            PG8_LDA(At, 0, 1); PG8_STAGE(PG8_SA(0, 0), a2, voffA);
            PG8_BAR; PG8_WAIT_L(0); PG8_MMA(1, 0, At, B0); PG8_BAR; PG8_SCHED;
            PG8_STAGE(PG8_SB(0, 1), b2 + hstep, voffB);
            PG8_WAIT_V(6); PG8_BAR; PG8_MMA(1, 1, At, B1); PG8_BAR;
            PG8_LDB(B0, 1, 0); PG8_SCHED; PG8_LDA(At, 1, 0); PG8_STAGE(PG8_SA(0, 1), a2 + hstep, voffA);
            PG8_WAIT_L(8); PG8_BAR; PG8_WAIT_L(0); PG8_MMA(0, 0, At, B0); PG8_BAR; PG8_SCHED;
            PG8_LDB(B1, 1, 1); PG8_STAGE(PG8_SB(1, 0), b3, voffB);
            PG8_BAR; PG8_WAIT_L(0); PG8_MMA(0, 1, At, B1); PG8_BAR;
            PG8_LDA(At, 1, 1); PG8_STAGE(PG8_SA(1, 0), a3, voffA);
            PG8_BAR; PG8_WAIT_L(0); PG8_MMA(1, 0, At, B0); PG8_BAR; PG8_SCHED;
            PG8_STAGE(PG8_SB(1, 1), b3 + hstep, voffB);
            PG8_WAIT_V(6); PG8_BAR; PG8_MMA(1, 1, At, B1); PG8_BAR;
            }
        }
        if constexpr (ALIGN_EPI) { if (wr == 0) PG8_BAR; }
        if constexpr (!Epi::AFTER_DRAIN) { E(acc, cur, wr, wc, fr, fq); S.done(cur); }
        if (!has_next) break;
#pragma unroll
        for (int a = 0; a < 2; ++a)
#pragma unroll
            for (int b = 0; b < 2; ++b)
#pragma unroll
                for (int m = 0; m < 4; ++m)
#pragma unroll
                    for (int n = 0; n < 2; ++n) acc[a][b][m][n] = (f32x4){0.f, 0.f, 0.f, 0.f};
        cur = nxt; cA = nA; cB = nB; ++ui;
        if constexpr (ALIGN_EPI) { if (wr == 1) PG8_BAR; }
    }
    PG8_WAIT_V(0);
    if constexpr (!ALIGN_EPI) { if (wr == 0) PG8_BAR; }
    PG8_BAR;
    if constexpr (Epi::AFTER_DRAIN) { E.fused(acc, cur, wr, wc, fr, fq, lds, wid, lane); S.done(cur); }
#undef PG8_SA
#undef PG8_SB
#undef PG8_STAGE
#undef PG8_LDA
#undef PG8_LDB
#undef PG8_MMA
#undef PG8_WAIT_V
#undef PG8_WAIT_L
#undef PG8_BAR
#undef PG8_SCHED
}
}

#define GAS __attribute__((address_space(1)))
#define LAS __attribute__((address_space(3)))
typedef unsigned short bf16;
typedef unsigned char uchar;
typedef unsigned v4u __attribute__((ext_vector_type(4)));
typedef unsigned v2u __attribute__((ext_vector_type(2)));
typedef float f32x4 __attribute__((ext_vector_type(4)));
typedef float f32x2 __attribute__((ext_vector_type(2)));
typedef short bf16x8 __attribute__((ext_vector_type(8)));
#define LDS_WAIT() asm volatile("s_waitcnt lgkmcnt(0)" ::: "memory")
#define VM_WAIT() asm volatile("s_waitcnt vmcnt(0)" ::: "memory")

constexpr int NWAVES = 8, NTHR = 512;
constexpr int NB = 8, SEQ = 4096, DM = 1024, CTXL = 256;
constexpr int MROWS = NB * SEQ;
constexpr int CROWS = NB * CTXL;
constexpr int TROWS = MROWS + CROWS;
constexpr int NHEAD = 4, HD = 128, INW = 2064, DFF = 2560, UPW = 5120;
constexpr float EPS = 1e-6f;
constexpr int NUNIT_L = NB * NHEAD * 32, NUNIT_C = NB * NHEAD * 2, NUNIT = NUNIT_L + NUNIT_C;
constexpr int CT_SLOT = 129 * 128;

constexpr size_t MiB = 1u << 20;
constexpr size_t WS_HX = 0, WS_TP = 0, WS_H2 = 0, WS_ACT = 0;
constexpr size_t WS_UF = 68 * MiB, WS_XM = 100 * MiB, WS_CT = 68 * MiB;
constexpr size_t WS_G = 134 * MiB, WS_SC = 137 * MiB, WS_MS = 138 * MiB;
constexpr size_t WS_V = 160 * MiB, WS_Z = 194 * MiB, WS_DC = 226 * MiB, WS_YM = 364 * MiB, WS_U = 160 * MiB;
constexpr size_t WS_WIN = 480 * MiB, WS_WOUT = 484 * MiB, WS_WUP = 486 * MiB, WS_WDN = 496 * MiB, WS_WQ = 501 * MiB, WS_WK = WS_WQ + 131072;
constexpr size_t WS_F1 = 502 * MiB, WS_G2 = WS_F1 + 16384, WS_TW = WS_G2 + 16384;
constexpr size_t WS_MOD = 503 * MiB, WS_CTL = 504 * MiB, WS_ZERO0 = WS_MOD, WS_ZERO_BYTES = 2 * MiB, WS_END = 512 * MiB;
static_assert(WS_DC + (size_t)NUNIT * 2 * CT_SLOT * 4 <= WS_YM && WS_YM + (size_t)MROWS * 1024 * 2 <= WS_U + (size_t)MROWS * UPW * 2 && WS_U + (size_t)MROWS * UPW * 2 <= WS_WIN, "ws map");
static_assert(WS_CT + (size_t)NUNIT_L * 2 * CT_SLOT * 2 <= WS_G && WS_XM + (size_t)TROWS * 512 * 2 <= WS_G && (size_t)MROWS * DFF * 2 <= WS_U, "ws map 2");
constexpr size_t DO_AB = 0, DO_Q = 32 * MiB, DO_K = 64 * MiB;

__device__ __forceinline__ unsigned f2bf(float f) { unsigned u = __builtin_bit_cast(unsigned, f); return (u + 0x7fffu + ((u >> 16) & 1u)) >> 16; }
__device__ __forceinline__ unsigned pk2(float lo, float hi) { return f2bf(lo) | (f2bf(hi) << 16); }
__device__ __forceinline__ float bflo(unsigned w) { return __builtin_bit_cast(float, w << 16); }
__device__ __forceinline__ float bfhi(unsigned w) { return __builtin_bit_cast(float, w & 0xffff0000u); }
__device__ __forceinline__ f32x4 bf4(v2u x) { return (f32x4){bflo(x.x), bfhi(x.x), bflo(x.y), bfhi(x.y)}; }
__device__ __forceinline__ float silu_f(float x) { return x / (1.0f + __expf(-x)); }
__device__ __forceinline__ float logsig_f(float x) { return fminf(x, 0.f) - log1pf(__expf(-fabsf(x))); }
__device__ __forceinline__ float wave_sum(float v) {
#pragma unroll
    for (int o = 1; o < 64; o <<= 1) v += __shfl_xor(v, o);
    return v;
}
__device__ __forceinline__ int img_off(int row, int ch) { return row * 256 + ((ch ^ (row & 15)) << 4); }
struct BFrag { bf16x8 f[4]; };
__device__ __forceinline__ BFrag load_bfrag(const LAS uchar* Bimg, int brow, int kq) { BFrag b;
#pragma unroll
    for (int s = 0; s < 4; ++s) b.f[s] = *(const LAS bf16x8*)(Bimg + img_off(brow, 4 * s + kq));
    return b; }
__device__ __forceinline__ f32x4 mma_a(f32x4 acc, const LAS uchar* Aimg, int arow, const BFrag& b, int kq) {
    bf16x8 a[4];
#pragma unroll
    for (int s = 0; s < 4; ++s) a[s] = *(const LAS bf16x8*)(Aimg + img_off(arow, 4 * s + kq));
#pragma unroll
    for (int s = 0; s < 4; ++s) acc = __builtin_amdgcn_mfma_f32_16x16x32_bf16(a[s], b.f[s], acc, 0, 0, 0);
    return acc; }
#define MEMFENCE() asm volatile("" ::: "memory")


template <int S> __device__ __forceinline__ unsigned tr_lane_off(int lane) { return (unsigned)((8 * (lane >> 4) + ((lane & 15) >> 2)) * S + 8 * (lane & 3)); }
__device__ __forceinline__ unsigned lds_addr(const LAS uchar* p) { return (unsigned)(unsigned long long)p; }
__device__ __forceinline__ bf16x8 pack_frag(v2u lo, v2u hi) { const v4u w = (v4u){lo.x, lo.y, hi.x, hi.y}; return __builtin_bit_cast(bf16x8, w); }
template <int S> __device__ __forceinline__ void tr_load4(unsigned addr, BFrag& f) {
    v2u r0, r1, r2, r3, r4, r5, r6, r7;
    asm volatile("ds_read_b64_tr_b16 %0, %8\n\tds_read_b64_tr_b16 %1, %8 offset:%9\n\tds_read_b64_tr_b16 %2, %8 offset:%10\n\tds_read_b64_tr_b16 %3, %8 offset:%11\n\t"
                 "ds_read_b64_tr_b16 %4, %8 offset:%12\n\tds_read_b64_tr_b16 %5, %8 offset:%13\n\tds_read_b64_tr_b16 %6, %8 offset:%14\n\tds_read_b64_tr_b16 %7, %8 offset:%15\n\ts_waitcnt lgkmcnt(0)"
                 : "=&v"(r0), "=&v"(r1), "=&v"(r2), "=&v"(r3), "=&v"(r4), "=&v"(r5), "=&v"(r6), "=&v"(r7)
                 : "v"(addr), "i"(4 * S), "i"(32 * S), "i"(36 * S), "i"(64 * S), "i"(68 * S), "i"(96 * S), "i"(100 * S) : "memory");
    f.f[0] = pack_frag(r0, r1); f.f[1] = pack_frag(r2, r3); f.f[2] = pack_frag(r4, r5); f.f[3] = pack_frag(r6, r7);
}
template <int S> __device__ __forceinline__ void tr_load2(unsigned addr, bf16x8& f0, bf16x8& f1) {
    v2u r0, r1, r2, r3;
    asm volatile("ds_read_b64_tr_b16 %0, %4\n\tds_read_b64_tr_b16 %1, %4 offset:%5\n\tds_read_b64_tr_b16 %2, %4 offset:%6\n\tds_read_b64_tr_b16 %3, %4 offset:%7\n\ts_waitcnt lgkmcnt(0)"
                 : "=&v"(r0), "=&v"(r1), "=&v"(r2), "=&v"(r3) : "v"(addr), "i"(4 * S), "i"(32 * S), "i"(36 * S) : "memory");
    f0 = pack_frag(r0, r1); f1 = pack_frag(r2, r3);
}
template <int S> __device__ __forceinline__ unsigned tr_lane_off_p(int lane) { return (unsigned)((4 * (lane >> 4) + ((lane & 15) >> 2)) * S + 8 * (lane & 3)); }
template <int S> __device__ __forceinline__ void tr_load4p(unsigned addr, BFrag& f) {
    v2u r0, r1, r2, r3, r4, r5, r6, r7;
    asm volatile("ds_read_b64_tr_b16 %0, %8\n\tds_read_b64_tr_b16 %1, %8 offset:%9\n\tds_read_b64_tr_b16 %2, %8 offset:%10\n\tds_read_b64_tr_b16 %3, %8 offset:%11\n\t"
                 "ds_read_b64_tr_b16 %4, %8 offset:%12\n\tds_read_b64_tr_b16 %5, %8 offset:%13\n\tds_read_b64_tr_b16 %6, %8 offset:%14\n\tds_read_b64_tr_b16 %7, %8 offset:%15\n\ts_waitcnt lgkmcnt(0)"
                 : "=&v"(r0), "=&v"(r1), "=&v"(r2), "=&v"(r3), "=&v"(r4), "=&v"(r5), "=&v"(r6), "=&v"(r7)
                 : "v"(addr), "i"(16 * S), "i"(32 * S), "i"(48 * S), "i"(64 * S), "i"(80 * S), "i"(96 * S), "i"(112 * S) : "memory");
    f.f[0] = pack_frag(r0, r1); f.f[1] = pack_frag(r2, r3); f.f[2] = pack_frag(r4, r5); f.f[3] = pack_frag(r6, r7);
}
__device__ __forceinline__ f32x4 mma_ff(f32x4 acc, const BFrag& a, const BFrag& b) {
#pragma unroll
    for (int s = 0; s < 4; ++s) acc = __builtin_amdgcn_mfma_f32_16x16x32_bf16(a.f[s], b.f[s], acc, 0, 0, 0);
    return acc; }
__device__ __forceinline__ float lane_scan_add(float v, int lane) {
#pragma unroll
    for (int o = 1; o < 64; o <<= 1) { const float t = __shfl_up(v, o); if (lane >= o) v += t; }
    return v; }
__device__ __forceinline__ float lane_scan_max(float v, int lane) {
#pragma unroll
    for (int o = 1; o < 64; o <<= 1) { const float t = __shfl_up(v, o); if (lane >= o) v = fmaxf(v, t); }
    return v; }
__device__ __forceinline__ float wave_max(float v) {
#pragma unroll
    for (int o = 1; o < 64; o <<= 1) v = fmaxf(v, __shfl_xor(v, o));
    return v; }

#define XB_TMO      128
#define XB_XCNT(j)  (256  + 64 * (j))
#define XB_XSUB(j)  (1280 + 64 * (j))
#define XB_XGEN(j)  (2304 + 64 * (j))
#define XB_TOP      3328
#define XB_TOPGEN   3392
#define XCD_BAR_WORDS 3456
#define XB_SPIN_CAP (1u << 18)

__device__ __forceinline__ unsigned xb_ld(unsigned* p)              { return __hip_atomic_load(p, __ATOMIC_RELAXED, __HIP_MEMORY_SCOPE_AGENT); }
__device__ __forceinline__ unsigned xb_add(unsigned* p, unsigned v) { return __hip_atomic_fetch_add(p, v, __ATOMIC_RELAXED, __HIP_MEMORY_SCOPE_AGENT); }
__device__ __forceinline__ unsigned xb_xcc_id() { return (unsigned)__builtin_amdgcn_s_getreg((3 << 11) | 20) & 0xFu; }
#define XB_SPIN(cond, bar) do { unsigned _sp = 0; while (cond) { __builtin_amdgcn_s_sleep(1); \
    if ((++_sp & 255u) == 0u) { if (xb_ld(&(bar)[XB_TMO])) break; if (_sp > XB_SPIN_CAP) { atomicAdd(&(bar)[XB_TMO], 1u); break; } } } } while (0)

struct XcdBarrier {
    unsigned* bar; unsigned x;
    volatile LAS unsigned* st;
};

__device__ __forceinline__ XcdBarrier xcd_barrier_post(unsigned* bar, volatile LAS unsigned* st) {
    XcdBarrier b; b.bar = bar; b.x = xb_xcc_id(); b.st = st;
    if (threadIdx.x == 0) (void)xb_add(&bar[XB_XCNT(b.x)], 1u);
    return b;
}
__device__ __forceinline__ void xcd_barrier_complete(unsigned* bar, unsigned x, unsigned& nloc, unsigned& nx) {
    const unsigned G = gridDim.x * gridDim.y * gridDim.z;
    unsigned sum, cnt, mine, sp = 0u;
    for (;;) {
        sum = 0u; cnt = 0u; mine = 0u;
#pragma unroll
        for (unsigned j = 0; j < 16; ++j) { const unsigned c = xb_ld(&bar[XB_XCNT(j)]); sum += c; cnt += (c > 0u) ? 1u : 0u; mine = (j == x) ? c : mine; }
        if (sum == G) break;
        __builtin_amdgcn_s_sleep(1);
        if ((++sp & 255u) == 0u) { if (xb_ld(&bar[XB_TMO])) break; if (sp > XB_SPIN_CAP) { atomicAdd(&bar[XB_TMO], 1u); break; } }
    }
    nloc = mine > 0u ? mine : 1u; nx = cnt > 0u ? cnt : 1u;
}

__device__ __forceinline__ void xcd_barrier(const XcdBarrier& b) {
    asm volatile("s_waitcnt vmcnt(0)" ::: "memory");
    __syncthreads();
    if (threadIdx.x == 0) {
        unsigned* bar = b.bar;
        __builtin_amdgcn_s_waitcnt(0);
        unsigned nloc = b.st[0], nx = b.st[1];
        if (nloc == 0u) { xcd_barrier_complete(bar, b.x, nloc, nx); b.st[0] = nloc; b.st[1] = nx; }
        const unsigned old = xb_add(&bar[XB_XSUB(b.x)], 1u);
        const unsigned gen = old / nloc;
        if (old + 1u == (gen + 1u) * nloc) {
            __builtin_amdgcn_fence(__ATOMIC_RELEASE, "agent");
            asm volatile("s_waitcnt vmcnt(0)" ::: "memory");
            const unsigned og = xb_add(&bar[XB_TOP], 1u);
            const unsigned tg = og / nx;
            if (og + 1u == (tg + 1u) * nx) xb_add(&bar[XB_TOPGEN], 1u);
            else XB_SPIN(xb_ld(&bar[XB_TOPGEN]) == tg, bar);
            __builtin_amdgcn_fence(__ATOMIC_ACQUIRE, "agent");
            xb_add(&bar[XB_XGEN(b.x)], 1u);
            asm volatile("s_waitcnt vmcnt(0)" ::: "memory");
        } else {
            XB_SPIN(xb_ld(&bar[XB_XGEN(b.x)]) == gen, bar);
            __builtin_amdgcn_fence(__ATOMIC_ACQUIRE, "agent");
            asm volatile("s_waitcnt vmcnt(0)" ::: "memory");
        }
    }
    __syncthreads();
}


struct Args { const float* in[24]; float* out; uchar* ws; int ph_lo, ph_hi; };

template <class F>
__device__ __forceinline__ void tr_item(F src, bf16* WT, size_t drow0, int ldk, int dk0, LAS float* scr, int lane) {
#pragma unroll 4
    for (int i = 0; i < 32; ++i) { const int kk = 2 * i + (lane >> 5); scr[kk * 33 + (lane & 31)] = src(kk, lane & 31); }
    LDS_WAIT(); asm volatile("" ::: "memory");
    const int c = lane & 7;
#pragma unroll
    for (int j = 0; j < 4; ++j) { const int n = (lane >> 3) + 8 * j; const LAS float* s = scr + (8 * c) * 33 + n;
        v4u o; o.x = pk2(s[0 * 33], s[1 * 33]); o.y = pk2(s[2 * 33], s[3 * 33]); o.z = pk2(s[4 * 33], s[5 * 33]); o.w = pk2(s[6 * 33], s[7 * 33]);
        *(v4u*)(WT + (drow0 + n) * ldk + dk0 + 8 * c) = o; }
    LDS_WAIT(); asm volatile("" ::: "memory");
}

constexpr int I_XV = 16 * 32, I_Z = 16 * 16, I_QK = 2 * 4 * 4, I_OF = 8 * 32, I_OM = 8 * 32, I_UP = 16 * 160, I_DN = 40 * 32;
constexpr int TR_EARLY = I_XV + I_Z + 2 * I_QK, TR_ALL = TR_EARLY + I_OF + I_OM + I_UP + I_DN;
__device__ __forceinline__ void tr_items(const Args& a, LAS uchar* lds, int lo, int hi, int gw, int NGW) {
    const int tid = threadIdx.x, lane = tid & 63, wave = __builtin_amdgcn_readfirstlane(tid >> 6);
    uchar* ws = a.ws;
    LAS float* scr = (LAS float*)(lds + wave * 16384);
    const float* w_in = a.in[7]; const float* w_out = a.in[15]; const float* w_up = a.in[17]; const float* w_dn = a.in[21];
    const float* w_q = a.in[10]; const float* w_k = a.in[11];
    bf16* WIN = (bf16*)(ws + WS_WIN); bf16* WOUT = (bf16*)(ws + WS_WOUT); bf16* WUP = (bf16*)(ws + WS_WUP); bf16* WDN = (bf16*)(ws + WS_WDN);
    bf16* WQ = (bf16*)(ws + WS_WQ); bf16* WK = (bf16*)(ws + WS_WK);
    for (int it = lo + gw; it < hi; it += NGW) {
        int r = it;
        if (r < I_XV) { const int kb = r / 32, nb = r % 32, k0 = kb * 64, n0 = nb * 32;
            auto src = [&](int kk, int nn) -> float { return w_in[(size_t)(k0 + kk) * INW + 512 + n0 + nn]; };
            tr_item(src, WIN, (size_t)(512 + n0), DM, k0, scr, lane); continue; } r -= I_XV;
        if (r < I_Z) { const int kb = r / 16, nb = r % 16, k0 = kb * 64, n0 = nb * 32;
            auto src = [&](int kk, int nn) -> float { return w_in[(size_t)(k0 + kk) * INW + 1552 + n0 + nn]; };
            tr_item(src, WIN, (size_t)(1536 + n0), DM, k0, scr, lane); continue; } r -= I_Z;
        if (r < 2 * I_QK) { const bool isk = r >= I_QK; if (isk) r -= I_QK;
            const int h = r / 8, kb = (r % 8) / 4, nb = r % 4, k0 = kb * 64, n0 = nb * 32;
            const float* W = (isk ? w_k : w_q) + (size_t)h * HD * HD; const float sc = isk ? 0.08838834764831845f : 1.0f;
            auto src = [&](int kk, int nn) -> float { return W[(size_t)(k0 + kk) * HD + n0 + nn] * sc; };
            tr_item(src, (isk ? WK : WQ) + (size_t)h * HD * HD, (size_t)n0, HD, k0, scr, lane); continue; } r -= 2 * I_QK;
        if (r < I_OF) { const int kb = r / 32, nb = r % 32, k0 = kb * 64, n0 = nb * 32;
            auto src = [&](int kk, int nn) -> float { const int k = k0 + kk, g = k >> 7, s = k & 127; const float* wo = w_out + (size_t)(g * 128) * DM + n0 + nn;
                if (s == 0 || s == 64) return wo[(size_t)s * DM];
                if (s < 64) return wo[(size_t)s * DM] + wo[(size_t)(128 - s) * DM];
                const int kq = s - 64; return wo[(size_t)(128 - kq) * DM] - wo[(size_t)kq * DM]; };
            tr_item(src, WOUT, (size_t)n0, DM, k0, scr, lane); continue; } r -= I_OF;
        if (r < I_OM) { const int kb = r / 32, nb = r % 32, k0 = kb * 64, n0 = nb * 32;
            auto src = [&](int kk, int nn) -> float { return w_out[(size_t)(512 + k0 + kk) * DM + n0 + nn]; };
            tr_item(src, WOUT, (size_t)n0, DM, 512 + k0, scr, lane); continue; } r -= I_OM;
        if (r < I_UP) { const int kb = r / 160, nb = r % 160, k0 = kb * 64, n0 = nb * 32;
            auto src = [&](int kk, int nn) -> float { return w_up[(size_t)(k0 + kk) * UPW + n0 + nn]; };
            tr_item(src, WUP, (size_t)n0, DM, k0, scr, lane); continue; } r -= I_UP;
        { const int kb = r / 32, nb = r % 32, k0 = kb * 64, n0 = nb * 32;
            auto src = [&](int kk, int nn) -> float { return w_dn[(size_t)(k0 + kk) * DM + n0 + nn]; };
            tr_item(src, WDN, (size_t)n0, DFF, k0, scr, lane); }
    }
}

__device__ __forceinline__ void p0_prologue(const Args& a, LAS uchar* lds, int vcu, int G, size_t mod_off) {
    const int tid = threadIdx.x, lane = tid & 63, wave = __builtin_amdgcn_readfirstlane(tid >> 6);
    uchar* ws = a.ws;
    {
        LAS float* sl = (LAS float*)lds;
        float* MOD = (float*)(ws + mod_off);
        const float* w_ada = a.in[4]; const float* b_ada = a.in[5];
        for (int it = blockIdx.x; it < 32 * 12; it += G) {
            const int kc = it / 12, nb = it % 12;
            __syncthreads();
            if (tid < 288) { const int r = tid >> 5, kk = tid & 31; const float cv = (r < 8) ? a.in[1][r * DM + kc * 32 + kk] : a.in[3][kc * 32 + kk]; sl[tid] = silu_f(cv); }
            __syncthreads();
            const int n = nb * 512 + tid;
            float acc[9];
#pragma unroll
            for (int r = 0; r < 9; ++r) acc[r] = 0.f;
#pragma unroll 8
            for (int kk = 0; kk < 32; ++kk) { const float w = w_ada[(size_t)(kc * 32 + kk) * 6144 + n];
#pragma unroll
                for (int r = 0; r < 9; ++r) acc[r] += sl[r * 32 + kk] * w; }
            const float bb = (kc == 0) ? b_ada[n] : 0.f;
#pragma unroll
            for (int r = 0; r < 9; ++r) atomicAdd(&MOD[r * 6144 + n], acc[r] + bb);
        }
        __syncthreads();
    }
    {
        LAS float* tab = (LAS float*)(lds + 8 * 16384);
        if (tid < 128) tab[tid] = cospif((float)tid * (1.0f / 64.0f)) * 0.08838834764831845f;
        __syncthreads();
        const int gt = blockIdx.x * NTHR + tid;
        bf16* F1 = (bf16*)(ws + WS_F1); bf16* G2 = (bf16*)(ws + WS_G2); float* TW = (float*)(ws + WS_TW);
        if (gt < 8192) { const int row = gt >> 6, n1 = gt & 63, ri = row >> 6, k1 = row & 63; const float ang = (float)((k1 * n1) & 63) * (1.0f / 32.0f);
            F1[gt] = (bf16)f2bf((ri == 0 ? cospif(ang) : -sinpif(ang)) * 0.125f); }
        else if (gt < 16384) { const int i = gt - 8192, k2 = i >> 7, kap = i & 127, n2 = kap & 63; const float ang = (float)((k2 * n2) & 63) * (1.0f / 32.0f);
            G2[i] = (bf16)f2bf((kap < 64 ? cospif(ang) : sinpif(ang)) * 0.125f); }
        else if (gt < 16384 + 4096) { const int i = gt - 16384; TW[i] = cospif((float)i * (1.0f / 2048.0f)); }
    }
    {
        const LAS float* tab = (const LAS float*)(lds + 8 * 16384);
        LAS float* Tm = (LAS float*)lds;
        LAS float* wT = (LAS float*)(lds + 65536);
        const float* w_in = a.in[7]; bf16* WIN = (bf16*)(a.ws + WS_WIN);
        bool have_T = false;
        for (int it = blockIdx.x; it < 64; it += G) {
            const int g = it >> 4, k0 = (it & 15) * 64;
            __syncthreads();
            if (!have_T) { for (int id = tid; id < 128 * 128; id += NTHR) { const int c = id >> 7, s_ = id & 127; const int mult = (s_ <= 64) ? s_ : (s_ - 64), off = (s_ <= 64) ? 0 : 96; Tm[id] = tab[(c * mult + off) & 127]; } have_T = true; }
            for (int id = tid; id < 64 * 32; id += NTHR) { const int kk = id >> 5, c4 = id & 31; const f32x4 v = *(const f32x4*)(w_in + (size_t)(k0 + kk) * INW + g * 128 + 4 * c4);
                wT[(4 * c4 + 0) * 64 + kk] = v.x; wT[(4 * c4 + 1) * 64 + kk] = v.y; wT[(4 * c4 + 2) * 64 + kk] = v.z; wT[(4 * c4 + 3) * 64 + kk] = v.w; }
            __syncthreads();
            const int s4 = (tid & 31) * 4, k4 = (tid >> 5) * 4;
            f32x4 acc[4];
#pragma unroll
            for (int j = 0; j < 4; ++j) acc[j] = (f32x4){0.f, 0.f, 0.f, 0.f};
#pragma unroll 4
            for (int c = 0; c < 128; ++c) { const f32x4 tv = *(const LAS f32x4*)(Tm + c * 128 + s4), wv_ = *(const LAS f32x4*)(wT + c * 64 + k4);
                acc[0] += wv_ * tv.x; acc[1] += wv_ * tv.y; acc[2] += wv_ * tv.z; acc[3] += wv_ * tv.w; }
#pragma unroll
            for (int j = 0; j < 4; ++j) *(v2u*)(WIN + (size_t)(g * 128 + s4 + j) * DM + k0 + k4) = (v2u){pk2(acc[j].x, acc[j].y), pk2(acc[j].z, acc[j].w)};
        }
        __syncthreads();
    }
    tr_items(a, lds, 0, (G > 32) ? TR_EARLY : TR_ALL, vcu * NWAVES + wave, G * NWAVES);
}

__device__ __forceinline__ void p1_rows(const Args& a, LAS uchar* lds, int vcu, int G) {
    const int tid = threadIdx.x, lane = tid & 63, wave = __builtin_amdgcn_readfirstlane(tid >> 6);
    uchar* ws = a.ws;
    {
        LAS f32x4* wg = (LAS f32x4*)lds;
        const float* w_in = a.in[7];
        for (int id = tid; id < 4096; id += NTHR) { const int k = id >> 2, q = id & 3; const int l = (k & 255) >> 2, i = k & 3, j = k >> 8;
            wg[((j * 4 + i) * 4 + q) * 64 + l] = *(const f32x4*)(w_in + (size_t)k * INW + 1536 + 4 * q); }
        __syncthreads();
    }
    const LAS f32x4* wg = (const LAS f32x4*)lds;
    const float* MOD = (const float*)(ws + WS_MOD);
    const float* nw = a.in[6]; const float* bg = a.in[12];
    bf16* HX = (bf16*)(ws + WS_HX); float* GG = (float*)(ws + WS_G);
    const int gw = vcu * NWAVES + wave, NGW = G * NWAVES;
    for (int row = gw; row < TROWS; row += NGW) {
        const float* xr; const float* md;
        if (row < MROWS) { xr = a.in[0] + (size_t)row * DM; md = MOD + (size_t)(row >> 12) * 6144; }
        else { xr = a.in[2] + (size_t)(row - MROWS) * DM; md = MOD + (size_t)8 * 6144; }
        f32x4 v[4]; float s = 0.f;
#pragma unroll
        for (int j = 0; j < 4; ++j) { v[j] = *(const f32x4*)(xr + 4 * lane + 256 * j); s += (v[j].x * v[j].x + v[j].y * v[j].y) + (v[j].z * v[j].z + v[j].w * v[j].w); }
        const float rstd = rsqrtf(wave_sum(s) * (1.0f / DM) + EPS);
        float g[16];
#pragma unroll
        for (int i = 0; i < 16; ++i) g[i] = 0.f;
#pragma unroll
        for (int j = 0; j < 4; ++j) {
            const f32x4 w = *(const f32x4*)(nw + 4 * lane + 256 * j), sh = *(const f32x4*)(md + 4 * lane + 256 * j), sc = *(const f32x4*)(md + 1024 + 4 * lane + 256 * j);
            v[j] = v[j] * rstd * w * (sc + 1.0f) + sh;
            *(v2u*)(HX + (size_t)row * DM + 4 * lane + 256 * j) = (v2u){pk2(v[j].x, v[j].y), pk2(v[j].z, v[j].w)};
        }
#pragma unroll
        for (int j = 0; j < 4; ++j) {
#pragma unroll
            for (int i = 0; i < 4; ++i) {
#pragma unroll
                for (int q = 0; q < 4; ++q) { const f32x4 ww = wg[((j * 4 + i) * 4 + q) * 64 + lane];
                    g[4 * q + 0] += v[j][i] * ww.x; g[4 * q + 1] += v[j][i] * ww.y; g[4 * q + 2] += v[j][i] * ww.z; g[4 * q + 3] += v[j][i] * ww.w; }
                if (i & 1) MEMFENCE(); }
        }
        float g8[8], g4[4], g2[2], g1;
        { const bool hi = (lane & 32) != 0;
#pragma unroll
          for (int i = 0; i < 8; ++i) { const float keep = hi ? g[i + 8] : g[i], send = hi ? g[i] : g[i + 8]; g8[i] = keep + __shfl_xor(send, 32); } }
        { const bool hi = (lane & 16) != 0;
#pragma unroll
          for (int i = 0; i < 4; ++i) { const float keep = hi ? g8[i + 4] : g8[i], send = hi ? g8[i] : g8[i + 4]; g4[i] = keep + __shfl_xor(send, 16); } }
        { const bool hi = (lane & 8) != 0;
#pragma unroll
          for (int i = 0; i < 2; ++i) { const float keep = hi ? g4[i + 2] : g4[i], send = hi ? g4[i] : g4[i + 2]; g2[i] = keep + __shfl_xor(send, 8); } }
        { const bool hi = (lane & 4) != 0; const float keep = hi ? g2[1] : g2[0], send = hi ? g2[0] : g2[1]; g1 = keep + __shfl_xor(send, 4); }
        g1 += __shfl_xor(g1, 2); g1 += __shfl_xor(g1, 1);
        if ((lane & 3) == 0) { const int idx = ((lane & 32) ? 8 : 0) + ((lane & 16) ? 4 : 0) + ((lane & 8) ? 2 : 0) + ((lane & 4) ? 1 : 0); GG[(size_t)row * 16 + idx] = g1 + bg[idx]; }
    }
}
__device__ __forceinline__ void p7_rows(const Args& a, int vcu, int G) {
    const int tid = threadIdx.x, lane = tid & 63, wave = __builtin_amdgcn_readfirstlane(tid >> 6);
    const float* MOD = (const float*)(a.ws + WS_MOD); const float* nw = a.in[16]; bf16* H2 = (bf16*)(a.ws + WS_H2);
    const int gw = vcu * NWAVES + wave, NGW = G * NWAVES;
    for (int row = gw; row < MROWS; row += NGW) {
        const float* xr = a.in[0] + (size_t)row * DM; const float* md = MOD + (size_t)(row >> 12) * 6144; const bf16* y1 = (const bf16*)a.out + (size_t)row * 2048;
        f32x4 v[4]; float s = 0.f;
#pragma unroll
        for (int j = 0; j < 4; ++j) { v[j] = *(const f32x4*)(xr + 4 * lane + 256 * j) + bf4(*(const v2u*)(y1 + 4 * lane + 256 * j)); s += (v[j].x * v[j].x + v[j].y * v[j].y) + (v[j].z * v[j].z + v[j].w * v[j].w); }
        const float rstd = rsqrtf(wave_sum(s) * (1.0f / DM) + EPS);
#pragma unroll
        for (int j = 0; j < 4; ++j) {
            const f32x4 w = *(const f32x4*)(nw + 4 * lane + 256 * j), sh = *(const f32x4*)(md + 3072 + 4 * lane + 256 * j), sc = *(const f32x4*)(md + 4096 + 4 * lane + 256 * j);
            const f32x4 hv = v[j] * rstd * w * (sc + 1.0f) + sh;
            *(v2u*)(H2 + (size_t)row * DM + 4 * lane + 256 * j) = (v2u){pk2(hv.x, hv.y), pk2(hv.z, hv.w)}; }
    }
}
__device__ __forceinline__ void p11_rows(const Args& a, int vcu, int G, float* dst) {
    const int tid = threadIdx.x, lane = tid & 63, wave = __builtin_amdgcn_readfirstlane(tid >> 6);
    const float* nw = a.in[23];
    const int gw = vcu * NWAVES + wave, NGW = G * NWAVES;
    for (int row = gw; row < MROWS; row += NGW) {
        const float* xr = a.in[0] + (size_t)row * DM; const bf16* y1 = (const bf16*)a.out + (size_t)row * 2048; const bf16* d2 = (const bf16*)(a.ws + WS_U) + (size_t)row * DM;
        f32x4 v[4]; float s = 0.f;
#pragma unroll
        for (int j = 0; j < 4; ++j) { v[j] = *(const f32x4*)(xr + 4 * lane + 256 * j) + bf4(*(const v2u*)(y1 + 4 * lane + 256 * j)) + bf4(*(const v2u*)(d2 + 4 * lane + 256 * j)); s += (v[j].x * v[j].x + v[j].y * v[j].y) + (v[j].z * v[j].z + v[j].w * v[j].w); }
        const float rstd = rsqrtf(wave_sum(s) * (1.0f / DM) + EPS);
#pragma unroll
        for (int j = 0; j < 4; ++j) { const f32x4 w = *(const f32x4*)(nw + 4 * lane + 256 * j); *(f32x4*)(dst + (size_t)row * DM + 4 * lane + 256 * j) = v[j] * rstd * w; }
    }
}

struct SchedP2 {
    pg8::StaticOrder so;
    __device__ void init(int G, int c) { so.init(MROWS, 2048, G, c); }
    __device__ bool next(int i, pg8::Unit& u) const {
        const long L = (long)i * so.G + so.c;
        if (L < so.nwg) return so.next(i, u);
        const int r = (int)(L - so.nwg); if (r >= 32) return false;
        u.pm = 128 + (r & 7); u.pn = 2 + (r >> 3); return true;
    }
    __device__ __forceinline__ void a_ready(const pg8::Unit&) const {}
    __device__ __forceinline__ void done(const pg8::Unit&) const {}
};
struct EpiP2 {
    static constexpr bool PERM = true, AFTER_DRAIN = false;
    bf16 *base0, *base1, *base2, *base3;
    __device__ __forceinline__ void operator()(const f32x4 (&acc)[2][2][4][2], const pg8::Unit& u, int wr, int wc, int fr, int fq) const {
        const int row0 = u.pm * 256 + wr * 64 + fr; const int sel = u.pn >> 1; bf16* O = sel == 0 ? base0 : (sel == 1 ? base1 : (sel == 2 ? base2 : base3)); const int col0 = (u.pn & 1) * 256 + wc * 32 + 8 * fq;
#pragma unroll
        for (int ai = 0; ai < 2; ++ai)
#pragma unroll
            for (int m = 0; m < 4; ++m) { bf16* rowp = O + (size_t)(row0 + ai * 128 + m * 16) * 512 + col0;
#pragma unroll
                for (int bj = 0; bj < 2; ++bj) { const f32x4 v0 = acc[ai][bj][m][0], v1 = acc[ai][bj][m][1];
                    v4u w; w.x = pg8::cvt_pk_bf16(v0[0], v0[1]); w.y = pg8::cvt_pk_bf16(v0[2], v0[3]); w.z = pg8::cvt_pk_bf16(v1[0], v1[1]); w.w = pg8::cvt_pk_bf16(v1[2], v1[3]);
                    *(v4u*)(rowp + bj * 128) = w; } }
    }
};
struct EpiBias16 {
    static constexpr bool PERM = true, AFTER_DRAIN = false;
    bf16* O; int ldc; const float* bias;
    __device__ __forceinline__ void operator()(const f32x4 (&acc)[2][2][4][2], const pg8::Unit& u, int wr, int wc, int fr, int fq) const {
        const int row0 = u.pm * 256 + wr * 64 + fr; const int col0 = u.pn * 256 + wc * 32 + 8 * fq;
        f32x4 bv[2][2];
#pragma unroll
        for (int bj = 0; bj < 2; ++bj)
#pragma unroll
            for (int n = 0; n < 2; ++n) bv[bj][n] = *(const f32x4*)(bias + col0 + bj * 128 + 4 * n);
#pragma unroll
        for (int ai = 0; ai < 2; ++ai)
#pragma unroll
            for (int m = 0; m < 4; ++m) { bf16* rowp = O + (size_t)(row0 + ai * 128 + m * 16) * ldc + col0;
#pragma unroll
                for (int bj = 0; bj < 2; ++bj) { const f32x4 v0 = acc[ai][bj][m][0] + bv[bj][0], v1 = acc[ai][bj][m][1] + bv[bj][1];
                    v4u w; w.x = pg8::cvt_pk_bf16(v0[0], v0[1]); w.y = pg8::cvt_pk_bf16(v0[2], v0[3]); w.z = pg8::cvt_pk_bf16(v1[0], v1[1]); w.w = pg8::cvt_pk_bf16(v1[2], v1[3]);
                    *(v4u*)(rowp + bj * 128) = w; } }
    }
};
struct EpiGate16 {
    static constexpr bool PERM = true, AFTER_DRAIN = false;
    bf16* O; int ldc; const float* gate; const float* bias;
    __device__ __forceinline__ void operator()(const f32x4 (&acc)[2][2][4][2], const pg8::Unit& u, int wr, int wc, int fr, int fq) const {
        const int row0 = u.pm * 256 + wr * 64 + fr; const int col0 = u.pn * 256 + wc * 32 + 8 * fq;
        const float* gp = gate + (size_t)((u.pm * 256) >> 12) * 6144 + col0;
        f32x4 gv[2][2], bv[2][2];
#pragma unroll
        for (int bj = 0; bj < 2; ++bj)
#pragma unroll
            for (int n = 0; n < 2; ++n) { gv[bj][n] = *(const f32x4*)(gp + bj * 128 + 4 * n); bv[bj][n] = bias ? *(const f32x4*)(bias + col0 + bj * 128 + 4 * n) : (f32x4){0.f, 0.f, 0.f, 0.f}; }
#pragma unroll
        for (int ai = 0; ai < 2; ++ai)
#pragma unroll
            for (int m = 0; m < 4; ++m) { bf16* rowp = O + (size_t)(row0 + ai * 128 + m * 16) * ldc + col0;
#pragma unroll
                for (int bj = 0; bj < 2; ++bj) { const f32x4 v0 = gv[bj][0] * (acc[ai][bj][m][0] + bv[bj][0]), v1 = gv[bj][1] * (acc[ai][bj][m][1] + bv[bj][1]);
                    v4u w; w.x = pg8::cvt_pk_bf16(v0[0], v0[1]); w.y = pg8::cvt_pk_bf16(v0[2], v0[3]); w.z = pg8::cvt_pk_bf16(v1[0], v1[1]); w.w = pg8::cvt_pk_bf16(v1[2], v1[3]);
                    *(v4u*)(rowp + bj * 128) = w; } }
    }
};
struct EpiRes {
    static constexpr bool PERM = false, AFTER_DRAIN = false;
    const float* res; float* out; const float* gate; const float* bias;
    __device__ __forceinline__ void operator()(const f32x4 (&acc)[2][2][4][2], const pg8::Unit& u, int wr, int wc, int fr, int fq) const {
        const int row0 = u.pm * 256 + wr * 64 + fr, col0 = u.pn * 256 + wc * 32 + 4 * fq;
        const float* gp = gate + (size_t)((u.pm * 256) >> 12) * 6144 + col0;
        f32x4 gv[2][2], bv[2][2];
#pragma unroll
        for (int bj = 0; bj < 2; ++bj)
#pragma unroll
            for (int n = 0; n < 2; ++n) { gv[bj][n] = *(const f32x4*)(gp + bj * 128 + n * 16); bv[bj][n] = bias ? *(const f32x4*)(bias + col0 + bj * 128 + n * 16) : (f32x4){0.f, 0.f, 0.f, 0.f}; }
#pragma unroll
        for (int ai = 0; ai < 2; ++ai)
#pragma unroll
            for (int m = 0; m < 4; ++m) { const size_t off = (size_t)(row0 + ai * 128 + m * 16) * DM + col0;
#pragma unroll
                for (int bj = 0; bj < 2; ++bj)
#pragma unroll
                    for (int n = 0; n < 2; ++n) { const f32x4 r = *(const f32x4*)(res + off + bj * 128 + n * 16);
                        *(f32x4*)(out + off + bj * 128 + n * 16) = r + gv[bj][n] * (acc[ai][bj][m][n] + bv[bj][n]); }
                if (m & 1) asm volatile("" ::: "memory"); }
    }
};

constexpr int PA_WQ = 0, PA_WK = 32768, PA_A = 65536, PA_V = 98304, PA_SM = 135168, VS = 288;
__device__ __forceinline__ void unit_decode(int unit, int& bh, int& row0, int& t0, int& L) {
    if (unit < NUNIT_L) { bh = unit >> 5; const int c = unit & 31; row0 = (bh >> 2) * SEQ + c * 128; t0 = c * 128; L = SEQ; }
    else { const int uc = unit - NUNIT_L; bh = uc >> 1; const int cc = uc & 1; row0 = MROWS + (bh >> 2) * CTXL + cc * 128; t0 = cc * 128; L = CTXL; }
}
__device__ __forceinline__ void stage_v128(const bf16* V, int row0, int h, LAS uchar* img, int tid) {
    const int j = tid >> 2, seg = tid & 3; const bf16* vr = V + (size_t)(row0 + j) * 512 + h * HD + seg * 32;
#pragma unroll
    for (int i = 0; i < 4; ++i) *(LAS v4u*)(img + j * VS + (seg * 32 + 8 * i) * 2) = *(const v4u*)(vr + 8 * i);
}
__device__ __forceinline__ void prep_unit(const Args& a, LAS uchar* lds, int unit, int& cur_h) {
    int tid_ = threadIdx.x; asm volatile("" : "+v"(tid_)); const int tid = tid_, lane = tid & 63, wave = __builtin_amdgcn_readfirstlane(tid >> 6), kq = lane >> 4, fr = lane & 15;
    uchar* ws = a.ws;
    int bh, row0, t0, L; unit_decode(unit, bh, row0, t0, L);
    const int h = bh & 3; const bool latent = unit < NUNIT_L;
    LAS float* sm = (LAS float*)(lds + PA_SM);
    const bf16* XM = (const bf16*)(ws + WS_XM); const bf16* V = (const bf16*)(ws + WS_V);
    bf16* AB = (bf16*)((uchar*)a.out + DO_AB); bf16* Q = (bf16*)((uchar*)a.out + DO_Q); bf16* K = (bf16*)((uchar*)a.out + DO_K);
    __syncthreads();
    if (cur_h != h) {
        const bf16* WQ = (const bf16*)(ws + WS_WQ) + (size_t)h * HD * HD; const bf16* WK = (const bf16*)(ws + WS_WK) + (size_t)h * HD * HD;
#pragma unroll
        for (int i = 0; i < 4; ++i) { const int id = tid + NTHR * i, row = id >> 4, ch = id & 15;
            *(LAS v4u*)(lds + PA_WQ + img_off(row, ch)) = *(const v4u*)(WQ + row * 128 + ch * 8); *(LAS v4u*)(lds + PA_WK + img_off(row, ch)) = *(const v4u*)(WK + row * 128 + ch * 8); }
        cur_h = h;
    }
    if (wave < 2) {
        const float* GG = (const float*)(ws + WS_G) + (size_t)row0 * 16 + wave * 8 + h;
        const int j0 = wave ? 127 - 2 * lane : 2 * lane, j1 = wave ? 126 - 2 * lane : 2 * lane + 1;
        const float li0 = GG[j0 * 16], lf0 = logsig_f(GG[j0 * 16 + 4]), li1 = GG[j1 * 16], lf1 = logsig_f(GG[j1 * 16 + 4]);
        const float incl = lane_scan_add(lf0 + lf1, lane), total = __shfl(incl, 63);
        const float g0 = total - (incl - lf1) + li0, g1 = total - incl + li1;
        const float mx = wave_max(fmaxf(g0, g1));
        sm[wave * 128 + j0] = __expf(g0 - mx); sm[wave * 128 + j1] = __expf(g1 - mx);
        if (lane == 0) { sm[256 + 2 * wave] = total; sm[257 + 2 * wave] = mx; }
    }
    for (int rp_ = 0; rp_ <= ((REP_MASK >> 17) & 1); ++rp_) {
        if (rp_) __syncthreads();
        const int l = tid >> 2, seg = tid & 3, t = t0 + l; const int colg = h * HD + seg * 32;
        const bool hp = t > 0, hn = t + 1 < L;
        const bf16* xc = XM + (size_t)(row0 + l) * 512 + colg;
        const float* cw = a.in[8] + colg; const float* cb = a.in[9] + colg;
#pragma unroll
        for (int i = 0; i < 4; ++i) {
            const v4u c = *(const v4u*)(xc + 8 * i); v4u p = (v4u){0u, 0u, 0u, 0u}, n = (v4u){0u, 0u, 0u, 0u};
            if (hp) p = *(const v4u*)(xc - 512 + 8 * i);
            if (hn) n = *(const v4u*)(xc + 512 + 8 * i);
            float o[8];
#pragma unroll
            for (int hf = 0; hf < 2; ++hf) {
                const f32x4 w0 = *(const f32x4*)(cw + 8 * i + 4 * hf), w1 = *(const f32x4*)(cw + 512 + 8 * i + 4 * hf), w2 = *(const f32x4*)(cw + 1024 + 8 * i + 4 * hf), bb = *(const f32x4*)(cb + 8 * i + 4 * hf);
                const f32x4 xp = bf4((v2u){p[2 * hf], p[2 * hf + 1]}), xcv = bf4((v2u){c[2 * hf], c[2 * hf + 1]}), xn = bf4((v2u){n[2 * hf], n[2 * hf + 1]});
                const f32x4 y = w0 * xp + w1 * xcv + w2 * xn + bb;
#pragma unroll
                for (int e = 0; e < 4; ++e) o[4 * hf + e] = silu_f(y[e]); }
            const v4u w = (v4u){pk2(o[0], o[1]), pk2(o[2], o[3]), pk2(o[4], o[5]), pk2(o[6], o[7])};
            *(LAS v4u*)(lds + PA_A + img_off(l, seg * 4 + i)) = w;
            if (latent) *(v4u*)(AB + (size_t)(row0 + l) * 512 + colg + 8 * i) = w;
        }
    }
    stage_v128(V, row0, h, lds + PA_V, tid);
    __syncthreads();
    if (latent) {
        const BFrag ba = load_bfrag(lds + PA_A, 16 * wave + fr, kq);
        const size_t tok = (size_t)(row0 + 16 * wave + fr);
#pragma unroll 1
        for (int pass = 0; pass < 2; ++pass) {
            const LAS uchar* wimg = lds + (pass ? PA_WK : PA_WQ);
            bf16* dst = (pass ? K : Q) + tok * 512 + h * HD + 4 * kq;
#pragma unroll
            for (int mt = 0; mt < 8; ++mt) { const f32x4 acc = mma_a((f32x4){0.f, 0.f, 0.f, 0.f}, wimg, 16 * mt + fr, ba, kq);
                *(v2u*)(dst + 16 * mt) = (v2u){pk2(acc[0], acc[1]), pk2(acc[2], acc[3])}; if (mt & 1) MEMFENCE(); }
        }
    }
    f32x4 kacc[8];
    { const BFrag bk = load_bfrag(lds + PA_WK, 16 * wave + fr, kq);
#pragma unroll
      for (int mt = 0; mt < 8; ++mt) { kacc[mt] = mma_a((f32x4){0.f, 0.f, 0.f, 0.f}, lds + PA_A, 16 * mt + fr, bk, kq); if (mt & 1) MEMFENCE(); } }
    {
        bf16* DC = (bf16*)(ws + WS_DC); float* SC = (float*)(ws + WS_SC);
        BFrag akf, akb;
#pragma unroll
        for (int ks = 0; ks < 4; ++ks) { unsigned wf_[4], wb_[4];
#pragma unroll
            for (int hh = 0; hh < 2; ++hh) { const int mt = 2 * ks + hh; const f32x4 wf4 = *(const LAS f32x4*)(sm + 16 * mt + 4 * kq), wb4 = *(const LAS f32x4*)(sm + 128 + 16 * mt + 4 * kq);
                const f32x4 kf = kacc[mt] * wf4, kb = kacc[mt] * wb4;
                wf_[2 * hh] = pk2(kf[0], kf[1]); wf_[2 * hh + 1] = pk2(kf[2], kf[3]); wb_[2 * hh] = pk2(kb[0], kb[1]); wb_[2 * hh + 1] = pk2(kb[2], kb[3]); }
            akf.f[ks] = __builtin_bit_cast(bf16x8, (v4u){wf_[0], wf_[1], wf_[2], wf_[3]}); akb.f[ks] = __builtin_bit_cast(bf16x8, (v4u){wb_[0], wb_[1], wb_[2], wb_[3]}); }
        const unsigned vbase = lds_addr(lds + PA_V) + tr_lane_off_p<VS>(lane);
        bf16* df = DC + (size_t)(unit * 2) * CT_SLOT + 16 * wave + 4 * kq; bf16* db = df + CT_SLOT;
#pragma unroll
        for (int c = 0; c < 8; ++c) { BFrag bv; tr_load4p<VS>(vbase + 32 * c, bv);
            const f32x4 af = mma_ff((f32x4){0.f, 0.f, 0.f, 0.f}, akf, bv), ab = mma_ff((f32x4){0.f, 0.f, 0.f, 0.f}, akb, bv);
            *(v2u*)(df + (size_t)(16 * c + fr) * 128) = (v2u){pk2(af[0], af[1]), pk2(af[2], af[3])};
            *(v2u*)(db + (size_t)(16 * c + fr) * 128) = (v2u){pk2(ab[0], ab[1]), pk2(ab[2], ab[3])}; }
        { const unsigned onesw = (fr == 0) ? 0x3f803f80u : 0u; BFrag ones;
#pragma unroll
          for (int s_ = 0; s_ < 4; ++s_) ones.f[s_] = __builtin_bit_cast(bf16x8, (v4u){onesw, onesw, onesw, onesw});
          const f32x4 nf = mma_ff((f32x4){0.f, 0.f, 0.f, 0.f}, akf, ones), nb = mma_ff((f32x4){0.f, 0.f, 0.f, 0.f}, akb, ones);
          if (fr == 0) { *(v2u*)(df + (size_t)128 * 128) = (v2u){pk2(nf[0], nf[1]), pk2(nf[2], nf[3])}; *(v2u*)(db + (size_t)128 * 128) = (v2u){pk2(nb[0], nb[1]), pk2(nb[2], nb[3])}; } }
        if (tid == 0) { SC[(unit * 2) * 2] = sm[256]; SC[(unit * 2) * 2 + 1] = sm[257]; SC[(unit * 2 + 1) * 2] = sm[258]; SC[(unit * 2 + 1) * 2 + 1] = sm[259]; }
    }
}

constexpr int F1S = 144, F2S = 80;
__device__ __forceinline__ void fft1_wave(const Args& a, LAS uchar* wl, int item, const bf16x8 (&bfr)[8][2], int lane) {
    const int kq = lane >> 4, fr = lane & 15;
    const int b = item >> 9, chunk = item & 511, cg0 = chunk * 64, n2 = cg0 >> 9, colb = cg0 & 511;
    const bf16* UF = (const bf16*)(a.ws + WS_UF) + (size_t)b * SEQ * 512 + cg0;
    bf16* TP = (bf16*)(a.ws + WS_TP); const float* TW = (const float*)(a.ws + WS_TW);
    v4u ld[8];
#pragma unroll
    for (int i = 0; i < 8; ++i) ld[i] = *(const v4u*)(UF + (size_t)(i * 8 + (lane >> 3)) * 32768 + (lane & 7) * 8);
#pragma unroll
    for (int i = 0; i < 8; ++i) *(LAS v4u*)(wl + (i * 8 + (lane >> 3)) * F1S + (lane & 7) * 16) = ld[i];
    LDS_WAIT();
    const unsigned base = lds_addr(wl) + tr_lane_off<F1S>(lane);
#pragma unroll 1
    for (int mt = 0; mt < 4; ++mt) {
        bf16x8 a0, a1; tr_load2<F1S>(base + 32 * mt, a0, a1);
        f32x4 acc[8];
#pragma unroll
        for (int nt = 0; nt < 8; ++nt) { acc[nt] = __builtin_amdgcn_mfma_f32_16x16x32_bf16(a0, bfr[nt][0], (f32x4){0.f, 0.f, 0.f, 0.f}, 0, 0, 0); acc[nt] = __builtin_amdgcn_mfma_f32_16x16x32_bf16(a1, bfr[nt][1], acc[nt], 0, 0, 0); }
        const int c0 = 16 * mt + 4 * kq, col0 = colb + c0;
#pragma unroll
        for (int nt = 0; nt < 4; ++nt) { const int k1 = 16 * nt + fr; const int idx = (n2 * k1) & 4095; const float cs = TW[idx], sn = TW[(idx - 1024) & 4095];
            float pr[4], pi[4];
#pragma unroll
            for (int r = 0; r < 4; ++r) { const float tr = acc[nt][r], ti = acc[nt + 4][r]; const float xr = tr * cs + ti * sn, xi = ti * cs - tr * sn;
                const bool st = ((col0 + r) & 127) >= 65; pr[r] = st ? -xi : xr; pi[r] = st ? xr : xi; }
            const size_t o = ((size_t)(b * 2) * 64 + k1) * 32768 + (size_t)cg0 + c0;
            *(v2u*)(TP + o) = (v2u){pk2(pr[0], pr[1]), pk2(pr[2], pr[3])};
            *(v2u*)(TP + o + (size_t)64 * 32768) = (v2u){pk2(pi[0], pi[1]), pk2(pi[2], pi[3])}; }
    }
}
__device__ __forceinline__ void fft2_wave(const Args& a, LAS uchar* wl, int item, const bf16x8 (&bfr)[4][4], int lane) {
    const int kq = lane >> 4, fr = lane & 15;
    const int b = item >> 10, k1 = (item >> 4) & 63, chunk = item & 15;
    const bf16* TP = (const bf16*)(a.ws + WS_TP); bf16* YM = (bf16*)(a.ws + WS_YM);
    v4u ld[8];
#pragma unroll
    for (int i = 0; i < 8; ++i) { const int kap = i * 16 + (lane >> 2), ri = kap >> 6, n2 = kap & 63;
        ld[i] = *(const v4u*)(TP + ((size_t)(b * 2 + ri) * 64 + k1) * 32768 + (size_t)n2 * 512 + chunk * 32 + (lane & 3) * 8); }
#pragma unroll
    for (int i = 0; i < 8; ++i) *(LAS v4u*)(wl + (i * 16 + (lane >> 2)) * F2S + (lane & 3) * 16) = ld[i];
    LDS_WAIT();
    const unsigned base = lds_addr(wl) + tr_lane_off<F2S>(lane);
#pragma unroll
    for (int mt = 0; mt < 2; ++mt) {
        BFrag af; tr_load4<F2S>(base + 32 * mt, af);
#pragma unroll
        for (int nt = 0; nt < 4; ++nt) { f32x4 acc = (f32x4){0.f, 0.f, 0.f, 0.f};
#pragma unroll
            for (int s_ = 0; s_ < 4; ++s_) acc = __builtin_amdgcn_mfma_f32_16x16x32_bf16(af.f[s_], bfr[nt][s_], acc, 0, 0, 0);
            const int k2 = 16 * nt + fr; const size_t row = (size_t)b * SEQ + k1 + 64 * k2;
            *(v2u*)(YM + row * 1024 + chunk * 32 + 16 * mt + 4 * kq) = (v2u){pk2(acc[0], acc[1]), pk2(acc[2], acc[3])}; }
    }
}
__device__ __forceinline__ void fft1_phase(const Args& a, LAS uchar* lds, int vcu, int G) {
    const int tid = threadIdx.x, lane = tid & 63, wave = __builtin_amdgcn_readfirstlane(tid >> 6), kq = lane >> 4, fr = lane & 15;
    const bf16* F1 = (const bf16*)(a.ws + WS_F1);
    bf16x8 bfr[8][2];
#pragma unroll
    for (int nt = 0; nt < 8; ++nt)
#pragma unroll
        for (int s_ = 0; s_ < 2; ++s_) bfr[nt][s_] = *(const bf16x8*)(F1 + (16 * nt + fr) * 64 + 32 * s_ + 8 * kq);
    LAS uchar* wl = lds + wave * 9216;
    for (int it = vcu * NWAVES + wave; it < NB * 512; it += G * NWAVES) fft1_wave(a, wl, it, bfr, lane);
}
__device__ __forceinline__ void fft2_phase(const Args& a, LAS uchar* lds, int vcu, int G) {
    const int tid = threadIdx.x, lane = tid & 63, wave = __builtin_amdgcn_readfirstlane(tid >> 6), kq = lane >> 4, fr = lane & 15;
    const bf16* G2 = (const bf16*)(a.ws + WS_G2);
    bf16x8 bfr[4][4];
#pragma unroll
    for (int nt = 0; nt < 4; ++nt)
#pragma unroll
        for (int s_ = 0; s_ < 4; ++s_) bfr[nt][s_] = *(const bf16x8*)(G2 + (16 * nt + fr) * 128 + 32 * s_ + 8 * kq);
    LAS uchar* wl = lds + wave * 10240;
    for (int it = vcu * NWAVES + wave; it < NB * 1024; it += G * NWAVES) fft2_wave(a, wl, it, bfr, lane);
}

__device__ __forceinline__ void p4_scan(const Args& a, int G) {
    uchar* ws = a.ws;
    const bf16* DC = (const bf16*)(ws + WS_DC); const float* SC = (const float*)(ws + WS_SC);
    bf16* CT = (bf16*)(ws + WS_CT); float* MS = (float*)(ws + WS_MS);
    constexpr int F4 = CT_SLOT / 4;
    const int total = 64 * F4;
    for (int gi = blockIdx.x * NTHR + threadIdx.x; gi < total; gi += G * NTHR) {
        const int seq = gi / F4, i = gi - seq * F4; const int bh = seq >> 1, dir = seq & 1;
        f32x4 s = (f32x4){0.f, 0.f, 0.f, 0.f}; float m = 0.f;
#pragma unroll 2
        for (int step = 0; step < 34; ++step) {
            int unit;
            if (step < 2) unit = NUNIT_L + bh * 2 + (dir ? 1 - step : step);
            else { const int c = dir ? 33 - step : step - 2; unit = bh * 32 + c; }
            const int slot = unit * 2 + dir;
            if (step >= 2) { *(v2u*)(CT + (size_t)slot * CT_SLOT + 4 * i) = (v2u){pk2(s.x, s.y), pk2(s.z, s.w)}; if (i == 0) MS[slot] = m; }
            const float bend = SC[slot * 2], mloc = SC[slot * 2 + 1];
            const float mn = fmaxf(bend + m, mloc), al = __expf(bend + m - mn), be = __expf(mloc - mn);
            const v2u dv = *(const v2u*)(DC + (size_t)slot * CT_SLOT + 4 * i);
            s = s * al + bf4(dv) * be; m = mn;
        }
    }
}

constexpr int OU_CF = 0, OU_CB = 33792, OU_V = 67584, OU_K = 104448, OU_SM = 137216;
__device__ __forceinline__ void out_unit(const Args& a, LAS uchar* lds, int unit) {
    int tid_ = threadIdx.x; asm volatile("" : "+v"(tid_)); const int tid = tid_, lane = tid & 63, wave = __builtin_amdgcn_readfirstlane(tid >> 6), kq = lane >> 4, fr = lane & 15;
    uchar* ws = a.ws;
    const int bh = unit >> 5, c = unit & 31, h = bh & 3, row0 = (bh >> 2) * SEQ + c * 128;
    LAS float* sm = (LAS float*)(lds + OU_SM);
    const bf16* Q = (const bf16*)((const uchar*)a.out + DO_Q); const bf16* K = (const bf16*)((const uchar*)a.out + DO_K); const bf16* AB = (const bf16*)((const uchar*)a.out + DO_AB);
    const bf16* V = (const bf16*)(ws + WS_V); const bf16* Z = (const bf16*)(ws + WS_Z);
    const bf16* CT = (const bf16*)(ws + WS_CT); const float* MS = (const float*)(ws + WS_MS);
    bf16* YM = (bf16*)(ws + WS_YM);
    const float m_f = MS[unit * 2], m_b = MS[unit * 2 + 1];
    __syncthreads();
    if (wave < 2) {
        const float* GG = (const float*)(ws + WS_G) + (size_t)row0 * 16 + wave * 8 + h;
        const int j0 = wave ? 127 - 2 * lane : 2 * lane, j1 = wave ? 126 - 2 * lane : 2 * lane + 1;
        const float li0 = GG[j0 * 16], lf0 = logsig_f(GG[j0 * 16 + 4]), li1 = GG[j1 * 16], lf1 = logsig_f(GG[j1 * 16 + 4]);
        const float incl = lane_scan_add(lf0 + lf1, lane);
        const float b0 = incl - lf1, b1 = incl, r0 = li0 - b0, r1 = li1 - b1;
        const float mi = lane_scan_max(fmaxf(r0, r1), lane); float mprev = __shfl_up(mi, 1); if (lane == 0) mprev = -3.0e38f;
        const float R0 = fmaxf(mprev, r0), R1 = mi, mst = wave ? m_b : m_f;
        LAS float* d = sm + wave * 384;
        d[j0] = r0; d[j1] = r1; d[128 + j0] = fmaxf(mst, R0); d[128 + j1] = fmaxf(mst, R1); d[256 + j0] = b0; d[256 + j1] = b1;
    }
    {
        const bf16* sf = CT + (size_t)(unit * 2) * CT_SLOT; const bf16* sb = sf + CT_SLOT;
#pragma unroll
        for (int i = 0; i < 5; ++i) { const int id = tid + NTHR * i; if (id < 129 * 16) { const int row = id >> 4, ch = id & 15;
            *(LAS v4u*)(lds + OU_CF + img_off(row, ch)) = *(const v4u*)(sf + row * 128 + ch * 8); *(LAS v4u*)(lds + OU_CB + img_off(row, ch)) = *(const v4u*)(sb + row * 128 + ch * 8); } }
#pragma unroll
        for (int i = 0; i < 4; ++i) { const int id = tid + NTHR * i, row = id >> 4, ch = id & 15; *(LAS v4u*)(lds + OU_K + img_off(row, ch)) = *(const v4u*)(K + (size_t)(row0 + row) * 512 + h * HD + ch * 8); }
        stage_v128(V, row0, h, lds + OU_V, tid);
    }
    const int l = 16 * wave + fr; const int tok = row0 + l;
    BFrag bq;
#pragma unroll
    for (int s_ = 0; s_ < 4; ++s_) bq.f[s_] = *(const bf16x8*)(Q + (size_t)tok * 512 + h * HD + 32 * s_ + 8 * kq);
    __syncthreads();
    f32x4 S[8];
#pragma unroll
    for (int mt = 0; mt < 8; ++mt) { S[mt] = mma_a((f32x4){0.f, 0.f, 0.f, 0.f}, lds + OU_K, 16 * mt + fr, bq, kq); if (mt & 1) MEMFENCE(); }
    const unsigned vbase = lds_addr(lds + OU_V) + tr_lane_off_p<VS>(lane);
    const unsigned onesw = (fr == 0) ? 0x3f803f80u : 0u; BFrag ones;
#pragma unroll
    for (int s_ = 0; s_ < 4; ++s_) ones.f[s_] = __builtin_bit_cast(bf16x8, (v4u){onesw, onesw, onesw, onesw});
    f32x4 hs[8];
    for (int dir = 0; dir < 2; ++dir) {
        const LAS float* rr = sm + dir * 384; const LAS float* rho = rr + 128; const LAS float* bl = rr + 256;
        const float rho_l = rho[l], mst = dir ? m_b : m_f;
        BFrag bp;
#pragma unroll
        for (int ks = 0; ks < 4; ++ks) { unsigned w[4];
#pragma unroll
            for (int hh = 0; hh < 2; ++hh) { const int mt = 2 * ks + hh; float p[4]; const f32x4 rv = *(const LAS f32x4*)(rr + 16 * mt + 4 * kq);
#pragma unroll
                for (int r = 0; r < 4; ++r) { const int j = 16 * mt + 4 * kq + r; const bool ok = dir ? (j >= l) : (j <= l); p[r] = ok ? S[mt][r] * __expf(fminf(rv[r] - rho_l, 0.f)) : 0.f; }
                w[2 * hh] = pk2(p[0], p[1]); w[2 * hh + 1] = pk2(p[2], p[3]); }
            bp.f[ks] = __builtin_bit_cast(bf16x8, (v4u){w[0], w[1], w[2], w[3]}); }
        f32x4 acc[9];
        const float wi = __expf(mst - rho_l);
        const LAS uchar* cimg = lds + (dir ? OU_CB : OU_CF);
#pragma unroll
        for (int mt = 0; mt < 9; ++mt) { acc[mt] = mma_a((f32x4){0.f, 0.f, 0.f, 0.f}, cimg, 16 * mt + fr, bq, kq) * wi; if (mt & 1) MEMFENCE(); }
#pragma unroll
        for (int mt = 0; mt < 8; ++mt) { BFrag av; tr_load4p<VS>(vbase + 32 * mt, av); acc[mt] = mma_ff(acc[mt], av, bp); }
        acc[8] = mma_ff(acc[8], ones, bp);
        const float den = __shfl(acc[8][0], fr);
        const float sc = 1.0f / fmaxf(fabsf(den), __expf(-bl[l] - rho_l));
#pragma unroll
        for (int mt = 0; mt < 8; ++mt) hs[mt] = dir ? hs[mt] + acc[mt] * sc : acc[mt] * sc;
    }
    float s1 = 0.f;
#pragma unroll
    for (int mt = 0; mt < 8; ++mt) s1 += (hs[mt][0] + hs[mt][1]) + (hs[mt][2] + hs[mt][3]);
    s1 += __shfl_xor(s1, 16); s1 += __shfl_xor(s1, 32);
    const float mu = s1 * (1.0f / 128.0f); float s2 = 0.f;
#pragma unroll
    for (int mt = 0; mt < 8; ++mt) { const f32x4 d = hs[mt] - mu; s2 += (d[0] * d[0] + d[1] * d[1]) + (d[2] * d[2] + d[3] * d[3]); }
    s2 += __shfl_xor(s2, 16); s2 += __shfl_xor(s2, 32);
    const float rstd = rsqrtf(s2 * (1.0f / 128.0f) + EPS);
    const float* mw = a.in[13] + h * HD; const float* msk = a.in[14] + h * HD;
#pragma unroll
    for (int mt = 0; mt < 8; ++mt) { const int e0 = 16 * mt + 4 * kq;
        const f32x4 w = *(const f32x4*)(mw + e0), k4 = *(const f32x4*)(msk + e0);
        const v2u av = *(const v2u*)(AB + (size_t)tok * 512 + h * HD + e0), zv = *(const v2u*)(Z + (size_t)tok * 512 + h * HD + e0);
        const float a4[4] = {bflo(av.x), bfhi(av.x), bflo(av.y), bfhi(av.y)}, z4[4] = {bflo(zv.x), bfhi(zv.x), bflo(zv.y), bfhi(zv.y)};
        float y[4];
#pragma unroll
        for (int r = 0; r < 4; ++r) y[r] = ((hs[mt][r] - mu) * rstd * w[r] + k4[r] * a4[r]) * silu_f(z4[r]);
        *(v2u*)(YM + (size_t)tok * 1024 + 512 + h * HD + e0) = (v2u){pk2(y[0], y[1]), pk2(y[2], y[3])}; MEMFENCE(); }
}

__device__ __forceinline__ void p9_conv(const Args& a, int vcu, int G) {
    const int tid = threadIdx.x, lane = tid & 63, wave = __builtin_amdgcn_readfirstlane(tid >> 6);
    const bf16* U = (const bf16*)(a.ws + WS_U); bf16* ACT = (bf16*)(a.ws + WS_ACT);
    const float* fw = a.in[19]; const float* fb = a.in[20];
    const int gw = vcu * NWAVES + wave, NGW = G * NWAVES;
    for (int it = gw; it < NB * 64 * 10 * 2; it += NGW) {
        const int half = it & 1, qb = (it >> 1) % 10, br = (it >> 1) / 10, r = br & 63, b = br >> 6;
        const int ch = (qb * 64 + lane) * 4;
        f32x4 wv[9], wg[9];
#pragma unroll
        for (int t = 0; t < 9; ++t) { wv[t] = *(const f32x4*)(fw + t * UPW + ch); wg[t] = *(const f32x4*)(fw + t * UPW + DFF + ch); }
        const f32x4 bv = *(const f32x4*)(fb + ch), bgt = *(const f32x4*)(fb + DFF + ch);
        const bf16* rp = U + (size_t)(b * SEQ + r * 64) * UPW + ch;
        const bool rv0 = r > 0, rv2 = r < 63;
        v2u xv[3][6], xg[3][6];
        const int c0 = half * 32;
#pragma unroll
        for (int i = 0; i < 3; ++i) {
            const bool rvi = (i == 0) ? rv0 : (i == 2 ? rv2 : true);
            const bf16* p = rp + (ptrdiff_t)(i - 1) * 64 * UPW + (ptrdiff_t)(c0 - 1) * UPW;
            xv[i][0] = (v2u){0u, 0u}; xg[i][0] = (v2u){0u, 0u}; xv[i][1] = (v2u){0u, 0u}; xg[i][1] = (v2u){0u, 0u};
            if (rvi) { if (c0 > 0) { xv[i][0] = *(const v2u*)p; xg[i][0] = *(const v2u*)(p + DFF); } xv[i][1] = *(const v2u*)(p + UPW); xg[i][1] = *(const v2u*)(p + UPW + DFF); }
        }
#pragma unroll 1
        for (int cb = 0; cb < 8; ++cb) {
            const int c = c0 + 4 * cb;
#pragma unroll
            for (int i = 0; i < 3; ++i) {
                const bool rvi = (i == 0) ? rv0 : (i == 2 ? rv2 : true);
                const bf16* p = rp + (ptrdiff_t)(i - 1) * 64 * UPW + (ptrdiff_t)(c + 1) * UPW;
#pragma unroll
                for (int j = 0; j < 4; ++j) { xv[i][2 + j] = (v2u){0u, 0u}; xg[i][2 + j] = (v2u){0u, 0u};
                    if (rvi && (c + 1 + j <= 63)) { xv[i][2 + j] = *(const v2u*)(p + j * UPW); xg[i][2 + j] = *(const v2u*)(p + j * UPW + DFF); } }
            }
#pragma unroll
            for (int o = 0; o < 4; ++o) {
                f32x4 av = bv, ag = bgt;
#pragma unroll
                for (int i = 0; i < 3; ++i)
#pragma unroll
                    for (int j = 0; j < 3; ++j) { av += wv[i * 3 + j] * bf4(xv[i][o + j]); ag += wg[i * 3 + j] * bf4(xg[i][o + j]); }
                float ov[4];
#pragma unroll
                for (int e = 0; e < 4; ++e) ov[e] = av[e] * silu_f(ag[e]);
                *(v2u*)(ACT + (size_t)(b * SEQ + r * 64 + c + o) * DFF + ch) = (v2u){pk2(ov[0], ov[1]), pk2(ov[2], ov[3])};
            }
#pragma unroll
            for (int i = 0; i < 3; ++i) { xv[i][0] = xv[i][4]; xv[i][1] = xv[i][5]; xg[i][0] = xg[i][4]; xg[i][1] = xg[i][5]; }
        }
    }
}

constexpr int LDS_BYTES = 147456, MISC_OFF = 147456 - 256;
constexpr int NPHASE = 12;
#ifndef MK_PER_PHASE
#define MK_PER_PHASE 0
#endif
__global__ void __launch_bounds__(NTHR, 2) mk_fwd(Args args) {
    extern __shared__ __attribute__((aligned(16))) uchar lds_raw[];
    LAS uchar* lds = (LAS uchar*)lds_raw;
    const int tid = threadIdx.x;
    const int G = gridDim.x; const int bx = blockIdx.x; const int vcu = (G % 8 == 0) ? (bx % 8) * (G / 8) + bx / 8 : bx;
    volatile LAS unsigned* MISC = (volatile LAS unsigned*)(lds + MISC_OFF);
    if (tid < 64) MISC[tid] = 0u;
    __syncthreads();
    XcdBarrier bar; bar.bar = (unsigned*)(args.ws + WS_CTL); bar.x = 0; bar.st = nullptr;
    if (!MK_PER_PHASE) bar = xcd_barrier_post((unsigned*)(args.ws + WS_CTL), MISC + 8);
    const int lo = args.ph_lo, hi = args.ph_hi;
#ifndef PH_MASK
#define PH_MASK 0xFFF
#endif
#define IN(k) (((PH_MASK >> (k)) & 1) && lo <= (k) && (k) < hi)
#define REP(k) for (int rep_ = 0; rep_ <= ((REP_MASK >> (k)) & 1); ++rep_, __syncthreads())
#define SEAM(k) do { if (IN(k) && IN((k) + 1)) { xcd_barrier(bar); if ((REP_MASK >> 20) & 1) { xcd_barrier(bar); xcd_barrier(bar); } } } while (0)
    uchar* ws = args.ws;
    if (IN(0)) { if ((REP_MASK >> 16) & 1) { p0_prologue(args, lds, vcu, G, WS_MOD + 512 * 1024); __syncthreads(); } p0_prologue(args, lds, vcu, G, WS_MOD); } SEAM(0);
    if (IN(1)) REP(1) { p1_rows(args, lds, vcu, G); } SEAM(1);
    if (IN(2)) REP(2) {
        pg8::Gemm g{(const bf16*)(ws + WS_HX), (const bf16*)(ws + WS_WIN), TROWS, 2048, DM}; SchedP2 S; S.init(G, bx);
        EpiP2 E{(bf16*)(ws + WS_UF), (bf16*)(ws + WS_XM), (bf16*)(ws + WS_V), (bf16*)(ws + WS_Z)};
        pg8::gemm_phase<EpiP2, SchedP2, true, true>(lds, g, S, E);
        if (rep_ == 0 && G > 32 && bx >= 32) tr_items(args, lds, TR_EARLY, TR_ALL, (bx - 32) * NWAVES + (tid >> 6), (G - 32) * NWAVES);
    } SEAM(2);
    if (IN(3)) REP(3) {
        for (int rr_ = 0; rr_ <= ((REP_MASK >> 12) & 1); ++rr_) { int cur_h = -1; for (int it = bx; it < NUNIT; it += G) prep_unit(args, lds, it, cur_h); }
        __syncthreads();
        for (int rr_ = 0; rr_ <= ((REP_MASK >> 13) & 1); ++rr_) fft1_phase(args, lds, vcu, G);
    } SEAM(3);
    if (IN(4)) REP(4) {
        for (int rr_ = 0; rr_ <= ((REP_MASK >> 14) & 1); ++rr_) fft2_phase(args, lds, vcu, G);
        for (int rr_ = 0; rr_ <= ((REP_MASK >> 15) & 1); ++rr_) p4_scan(args, G);
    } SEAM(4);
    if (IN(5)) REP(5) { for (int it = bx; it < NUNIT_L; it += G) out_unit(args, lds, it); __syncthreads(); } SEAM(5);
    if (IN(6)) REP(6) {
        pg8::Gemm g{(const bf16*)(ws + WS_YM), (const bf16*)(ws + WS_WOUT), MROWS, DM, 1024}; pg8::StaticOrder S; S.init(MROWS, DM, G, bx);
        EpiGate16 E{(bf16*)args.out, 2048, (const float*)(ws + WS_MOD) + 2048, nullptr};
        pg8::gemm_phase<EpiGate16, pg8::StaticOrder, true, true>(lds, g, S, E);
    } SEAM(6);
    if (IN(7)) REP(7) { p7_rows(args, vcu, G); } SEAM(7);
    if (IN(8)) REP(8) {
        pg8::Gemm g{(const bf16*)(ws + WS_H2), (const bf16*)(ws + WS_WUP), MROWS, UPW, DM}; pg8::StaticOrder S; S.init(MROWS, UPW, G, bx);
        EpiBias16 E{(bf16*)(ws + WS_U), UPW, args.in[18]};
        pg8::gemm_phase<EpiBias16, pg8::StaticOrder, true, true>(lds, g, S, E);
    } SEAM(8);
    if (IN(9)) REP(9) { p9_conv(args, vcu, G); } SEAM(9);
    if (IN(10)) {
        pg8::Gemm g{(const bf16*)(ws + WS_ACT), (const bf16*)(ws + WS_WDN), MROWS, DM, DFF}; pg8::StaticOrder S; S.init(MROWS, DM, G, bx);
        EpiGate16 E{(bf16*)(ws + WS_U), 1024, (const float*)(ws + WS_MOD) + 5120, args.in[22]};
        for (int rr_ = 0; rr_ <= ((REP_MASK >> 10) & 1); ++rr_) { if (rr_) __syncthreads(); pg8::gemm_phase<EpiGate16, pg8::StaticOrder, true, true>(lds, g, S, E); }
    } SEAM(10);
    if (IN(11)) { if ((REP_MASK >> 11) & 1) p11_rows(args, vcu, G, (float*)(ws + 0)); p11_rows(args, vcu, G, args.out); }
#undef IN
#undef SEAM
}

extern "C" void kernel_launch(void* const* d_in, const int* in_sizes, int n_in, void* d_out, int out_size, void* d_ws, size_t ws_size, hipStream_t stream) {
    static int grid = 0;
    if (grid == 0) {
        if (n_in != 24 || out_size != MROWS * DM || ws_size < WS_END) { fprintf(stderr, "kernel_launch: unexpected problem (n_in %d, out %d, ws %zu); nothing launched\n", n_in, out_size, ws_size); grid = -1; return; }
        int dev = 0, cus = 0, per_cu = 0;
        if (hipGetDevice(&dev) != hipSuccess || hipDeviceGetAttribute(&cus, hipDeviceAttributeMultiprocessorCount, dev) != hipSuccess) { grid = -1; return; }
        if (hipFuncSetAttribute((const void*)mk_fwd, hipFuncAttributeMaxDynamicSharedMemorySize, LDS_BYTES) != hipSuccess) { fprintf(stderr, "kernel_launch: hipFuncSetAttribute failed\n"); grid = -1; return; }
        if (hipOccupancyMaxActiveBlocksPerMultiprocessor(&per_cu, (const void*)mk_fwd, NTHR, LDS_BYTES) != hipSuccess || per_cu < 1) { fprintf(stderr, "kernel_launch: occupancy query says %d blocks per CU\n", per_cu); grid = -1; (void)hipGetLastError(); return; }
        grid = cus;
    }
    if (grid < 0) return;
    (void)hipMemsetAsync((char*)d_ws + WS_ZERO0, 0, WS_ZERO_BYTES, stream);
    Args a{};
    for (int i = 0; i < 24; ++i) a.in[i] = (const float*)d_in[i];
    a.out = (float*)d_out; a.ws = (uchar*)d_ws;
#if MK_PER_PHASE
    for (int p = 0; p < NPHASE; ++p) { a.ph_lo = p; a.ph_hi = p + 1; hipLaunchKernelGGL(mk_fwd, dim3(grid), dim3(NTHR), LDS_BYTES, stream, a); }
#else
    a.ph_lo = 0; a.ph_hi = NPHASE; hipLaunchKernelGGL(mk_fwd, dim3(grid), dim3(NTHR), LDS_BYTES, stream, a);
#endif
}
```

```cpp
#include <hip/hip_runtime.h>
#include <cstdio>
#include <cstdint>
#ifndef REP_MASK
#define REP_MASK 0
#endif
namespace pg8 {
#define PG8_LAS __attribute__((address_space(3)))
typedef unsigned short bf16_t;
typedef short bf16x8 __attribute__((ext_vector_type(8)));
typedef float f32x4 __attribute__((ext_vector_type(4)));
typedef unsigned u32x4 __attribute__((ext_vector_type(4)));
constexpr int BM = 256, BK = 64, HALF = 128, HTB = HALF * BK * 2  , STAGE_BYTES = 8 * HTB, NXCD = 8, WGM = 8;

__host__ __device__ __forceinline__ int lds_byte(int r, int c) { const int st = (r >> 4) * 2 + (c >> 5), rr = r & 15, cc = c & 31, ob = rr * 64 + cc * 2; return st * 1024 + (ob ^ (((ob >> 9) & 1) << 5)); }
__host__ __device__ __forceinline__ void stage_rc(int b, int& R, int& C) { const int st = b / 1024, sb = b % 1024, swz = sb ^ (((sb >> 9) & 1) << 5); R = (st >> 1) * 16 + swz / 64; C = (st & 1) * 32 + (swz % 64) / 2; }
__host__ __device__ __forceinline__ int perm32(int rho) { const int n = rho >> 4, i = rho & 15; return 8 * (i >> 2) + 4 * n + (i & 3); }

struct Unit { int pm, pn; };
struct Gemm { const bf16_t* A; const bf16_t* Bt; int M, N, K; };

struct StaticOrder {
    int nM, nN, nwg, G, c;
    __host__ __device__ void init(int M, int N, int G_, int c_) { nM = M / BM; nN = N / BM; nwg = nM * nN; G = G_; c = c_; }
    __host__ __device__ bool next(int i, Unit& u) const {
        const long L = (long)i * G + c; if (L >= nwg) return false;
        int wgid = (int)L; { const int q = nwg / NXCD, r = nwg % NXCD, xcd = wgid % NXCD, off = wgid / NXCD; wgid = (xcd < r ? xcd * (q + 1) : r * (q + 1) + (xcd - r) * q) + off; }
        const int nig = WGM * nN, gid = wgid / nig, fm = gid * WGM, gsz = (nM - fm) < WGM ? (nM - fm) : WGM;
        u.pm = fm + ((wgid % nig) % gsz); u.pn = (wgid % nig) / gsz; return true;
    }
    __device__ __forceinline__ void a_ready(const Unit&) const {}
    __device__ __forceinline__ void done(const Unit&) const {}
};
__device__ __forceinline__ unsigned cvt_pk_bf16(float lo, float hi) { unsigned r; asm volatile("v_cvt_pk_bf16_f32 %0, %1, %2" : "=v"(r) : "v"(lo), "v"(hi)); return r; }
template <class Epi, class Sched, bool ALIGN_EPI = false, bool SP2 = false>
__device__ __forceinline__ void gemm_phase(PG8_LAS unsigned char* lds, const Gemm g, const Sched& S, const Epi& E) {
    const int tid = threadIdx.x, wid = __builtin_amdgcn_readfirstlane(tid >> 6), lane = tid & 63, wr = wid >> 2, wc = wid & 3, fr = lane & 15, fq = lane >> 4;
    const int K = g.K, nt = K / BK;
    unsigned voffA[2], voffB[2];
#pragma unroll
    for (int i = 0; i < 2; ++i) { int R, C; stage_rc(tid * 16 + i * 8192, R, C); const int Rb = Epi::PERM ? ((R & ~31) + perm32(R & 31)) : R;
        voffA[i] = (unsigned)(R * K + C) * 2u; voffB[i] = (unsigned)(Rb * K + C) * 2u; }
    const size_t kstep = (size_t)(BK * 2);
    const size_t hstep = (size_t)HALF * K * 2;
    const size_t tstep = 2 * hstep;
    const unsigned ldsw = (unsigned)wid * 1024u;
    const int aoff = lds_byte(wr * 64 + fr, fq * 8), boff = lds_byte(wc * 32 + fr, fq * 8);
#define PG8_SA(b, h) (((b) * 2 + (h)) * HTB)
#define PG8_SB(b, h) ((4 + (b) * 2 + (h)) * HTB)
#define PG8_STAGE(bufoff, gbase, voff) do { _Pragma("unroll") for (int _i = 0; _i < 2; ++_i) \
        __builtin_amdgcn_global_load_lds((const unsigned*)((const char*)(gbase) + (voff)[_i]), (PG8_LAS unsigned*)(lds + (bufoff) + ldsw + _i * 8192), 16, 0, 0); } while (0)
#define PG8_LDA(dst, b, h) do { _Pragma("unroll") for (int m = 0; m < 4; ++m) _Pragma("unroll") for (int k = 0; k < 2; ++k) dst[m][k] = *(const PG8_LAS bf16x8*)(lds + PG8_SA(b, h) + aoff + m * 2048 + k * 1024); } while (0)
#define PG8_LDB(dst, b, h) do { _Pragma("unroll") for (int n = 0; n < 2; ++n) _Pragma("unroll") for (int k = 0; k < 2; ++k) dst[n][k] = *(const PG8_LAS bf16x8*)(lds + PG8_SB(b, h) + boff + n * 2048 + k * 1024); } while (0)
#define PG8_MMA(ai, bj, At, Bt) do { __builtin_amdgcn_s_setprio(1); _Pragma("unroll") for (int m = 0; m < 4; ++m) _Pragma("unroll") for (int n = 0; n < 2; ++n) _Pragma("unroll") for (int k = 0; k < 2; ++k) \
        acc[ai][bj][m][n] = __builtin_amdgcn_mfma_f32_16x16x32_bf16(Bt[n][k], At[m][k], acc[ai][bj][m][n], 0, 0, 0); __builtin_amdgcn_s_setprio(0); } while (0)
#define PG8_WAIT_V(n) asm volatile("s_waitcnt vmcnt(" #n ")" ::: "memory")
#define PG8_WAIT_L(n) asm volatile("s_waitcnt lgkmcnt(" #n ")" ::: "memory")
#define PG8_BAR __builtin_amdgcn_s_barrier()
#define PG8_SCHED __builtin_amdgcn_sched_barrier(0)
    Unit cur, nxt; int ui = 0;
    if (!S.next(0, cur)) return;
    f32x4 acc[2][2][4][2];
#pragma unroll
    for (int a = 0; a < 2; ++a)
#pragma unroll
        for (int b = 0; b < 2; ++b)
#pragma unroll
            for (int m = 0; m < 4; ++m)
#pragma unroll
                for (int n = 0; n < 2; ++n) acc[a][b][m][n] = (f32x4){0.f, 0.f, 0.f, 0.f};
    bf16x8 At[4][2], B0[2][2], B1[2][2];
    const char* cA = (const char*)g.A + (size_t)cur.pm * tstep; const char* cB = (const char*)g.Bt + (size_t)cur.pn * tstep;
    S.a_ready(cur);
    if constexpr (SP2) {
        PG8_STAGE(PG8_SB(0, 0), cB, voffB); PG8_STAGE(PG8_SB(0, 1), cB + hstep, voffB); PG8_STAGE(PG8_SA(0, 0), cA, voffA); PG8_STAGE(PG8_SA(0, 1), cA + hstep, voffA);
        if (wr == 1) PG8_BAR;
        PG8_WAIT_V(2); PG8_BAR;
        PG8_STAGE(PG8_SB(1, 0), cB + kstep, voffB); PG8_STAGE(PG8_SA(1, 0), cA + kstep, voffA); PG8_STAGE(PG8_SB(1, 1), cB + hstep + kstep, voffB);
        PG8_WAIT_V(6); PG8_BAR;
    } else {
        PG8_STAGE(PG8_SB(0, 0), cB, voffB); PG8_STAGE(PG8_SA(0, 0), cA, voffA); PG8_STAGE(PG8_SB(0, 1), cB + hstep, voffB); PG8_STAGE(PG8_SA(0, 1), cA + hstep, voffA);
        if (wr == 1) PG8_BAR;
        PG8_WAIT_V(4); PG8_BAR;
        PG8_STAGE(PG8_SB(1, 0), cB + kstep, voffB); PG8_STAGE(PG8_SA(1, 0), cA + kstep, voffA); PG8_STAGE(PG8_SB(1, 1), cB + hstep + kstep, voffB);
        PG8_WAIT_V(6); PG8_BAR;
    }
    for (;;) {
        const bool has_next = S.next(ui + 1, nxt);
        const char* nA = has_next ? (const char*)g.A + (size_t)nxt.pm * tstep : cA; const char* nB = has_next ? (const char*)g.Bt + (size_t)nxt.pn * tstep : cB;
        for (int t = 0; t < nt; t += 2) {
            const bool last = (t == nt - 2);
            const char* a1 = cA + (size_t)(t + 1) * kstep;
            const char* a2 = last ? nA : cA + (size_t)(t + 2) * kstep; const char* b2 = last ? nB : cB + (size_t)(t + 2) * kstep;
            const char* a3 = a2 + kstep; const char* b3 = b2 + kstep;
            if (last && has_next) S.a_ready(nxt);
            if constexpr (SP2) {
            PG8_LDB(B0, 0, 0); PG8_LDB(B1, 0, 1); PG8_SCHED; PG8_LDA(At, 0, 0); PG8_STAGE(PG8_SA(1, 1), a1 + hstep, voffA);
            PG8_WAIT_V(8); PG8_WAIT_L(0); PG8_BAR; PG8_MMA(0, 0, At, B0); PG8_MMA(0, 1, At, B1); PG8_BAR; PG8_SCHED;
            PG8_LDA(At, 0, 1); PG8_STAGE(PG8_SB(0, 0), b2, voffB); PG8_STAGE(PG8_SB(0, 1), b2 + hstep, voffB); PG8_STAGE(PG8_SA(0, 0), a2, voffA);
            PG8_WAIT_V(8); PG8_WAIT_L(0); PG8_BAR; PG8_MMA(1, 0, At, B0); PG8_MMA(1, 1, At, B1); PG8_BAR; PG8_SCHED;
            PG8_LDB(B0, 1, 0); PG8_LDB(B1, 1, 1); PG8_SCHED; PG8_LDA(At, 1, 0); PG8_STAGE(PG8_SA(0, 1), a2 + hstep, voffA);
            PG8_WAIT_V(8); PG8_WAIT_L(0); PG8_BAR; PG8_MMA(0, 0, At, B0); PG8_MMA(0, 1, At, B1); PG8_BAR; PG8_SCHED;
            PG8_LDA(At, 1, 1); PG8_STAGE(PG8_SB(1, 0), b3, voffB); PG8_STAGE(PG8_SB(1, 1), b3 + hstep, voffB); PG8_STAGE(PG8_SA(1, 0), a3, voffA);
            PG8_WAIT_V(8); PG8_WAIT_L(0); PG8_BAR; PG8_MMA(1, 0, At, B0); PG8_MMA(1, 1, At, B1); PG8_BAR; PG8_SCHED;
            } else {
            PG8_LDB(B0, 0, 0); PG8_SCHED; PG8_LDA(At, 0, 0); PG8_STAGE(PG8_SA(1, 1), a1 + hstep, voffA);
            PG8_WAIT_L(8); PG8_BAR; PG8_WAIT_L(0); PG8_MMA(0, 0, At, B0); PG8_BAR; PG8_SCHED;
            PG8_LDB(B1, 0, 1); PG8_STAGE(PG8_SB(0, 0), b2, voffB);
            PG8_BAR; PG8_WAIT_L(0); PG8_MMA(0, 1, At, B1); PG8_BAR;
            PG8_LDA(At, 0, 1); PG8_STAGE(PG8_SA(0, 0), a2, voffA);
            PG8_BAR; PG8_WAIT_L(0); PG8_MMA(1, 0, At, B0); PG8_BAR; PG8_SCHED;
            PG8_STAGE(PG8_SB(0, 1), b2 + hstep, voffB);
            PG8_WAIT_V(6); PG8_BAR; PG8_MMA(1, 1, At, B1); PG8_BAR;
            PG8_LDB(B0, 1, 0); PG8_SCHED; PG8_LDA(At, 1, 0); PG8_STAGE(PG8_SA(0, 1), a2 + hstep, voffA);
            PG8_WAIT_L(8); PG8_BAR; PG8_WAIT_L(0); PG8_MMA(0, 0, At, B0); PG8_BAR; PG8_SCHED;
            PG8_LDB(B1, 1, 1); PG8_STAGE(PG8_SB(1, 0), b3, voffB);
            PG8_BAR; PG8_WAIT_L(0); PG8_MMA(0, 1, At, B1); PG8_BAR;
            PG8_LDA(At, 1, 1); PG8_STAGE(PG8_SA(1, 0), a3, voffA);
            PG8_BAR; PG8_WAIT_L(0); PG8_MMA(1, 0, At, B0); PG8_BAR; PG8_SCHED;
            PG8_STAGE(PG8_SB(1, 1), b3 + hstep, voffB);
            PG8_WAIT_V(6); PG8_BAR; PG8_MMA(1, 1, At, B1); PG8_BAR;
            }
        }
        if constexpr (ALIGN_EPI) { if (wr == 0) PG8_BAR; }
        if constexpr (!Epi::AFTER_DRAIN) { E(acc, cur, wr, wc, fr, fq); S.done(cur); }
        if (!has_next) break;
#pragma unroll
        for (int a = 0; a < 2; ++a)
#pragma unroll
            for (int b = 0; b < 2; ++b)
#pragma unroll
                for (int m = 0; m < 4; ++m)
#pragma unroll
                    for (int n = 0; n < 2; ++n) acc[a][b][m][n] = (f32x4){0.f, 0.f, 0.f, 0.f};
        cur = nxt; cA = nA; cB = nB; ++ui;
        if constexpr (ALIGN_EPI) { if (wr == 1) PG8_BAR; }
    }
    PG8_WAIT_V(0);
    if constexpr (!ALIGN_EPI) { if (wr == 0) PG8_BAR; }
    PG8_BAR;
    if constexpr (Epi::AFTER_DRAIN) { E.fused(acc, cur, wr, wc, fr, fq, lds, wid, lane); S.done(cur); }
#undef PG8_SA
#undef PG8_SB
#undef PG8_STAGE
#undef PG8_LDA
#undef PG8_LDB
#undef PG8_MMA
#undef PG8_WAIT_V
#undef PG8_WAIT_L
#undef PG8_BAR
#undef PG8_SCHED
}
}

#define GAS __attribute__((address_space(1)))
#define LAS __attribute__((address_space(3)))
typedef unsigned short bf16;
typedef unsigned char uchar;
typedef unsigned v4u __attribute__((ext_vector_type(4)));
typedef unsigned v2u __attribute__((ext_vector_type(2)));
typedef float f32x4 __attribute__((ext_vector_type(4)));
typedef float f32x2 __attribute__((ext_vector_type(2)));
typedef short bf16x8 __attribute__((ext_vector_type(8)));
#define LDS_WAIT() asm volatile("s_waitcnt lgkmcnt(0)" ::: "memory")
#define VM_WAIT() asm volatile("s_waitcnt vmcnt(0)" ::: "memory")

constexpr int NWAVES = 8, NTHR = 512;
constexpr int NB = 8, SEQ = 4096, DM = 1024, CTXL = 256;
constexpr int MROWS = NB * SEQ;
constexpr int CROWS = NB * CTXL;
constexpr int TROWS = MROWS + CROWS;
constexpr int NHEAD = 4, HD = 128, INW = 2064, DFF = 2560, UPW = 5120;
constexpr float EPS = 1e-6f;
constexpr int NUNIT_L = NB * NHEAD * 32, NUNIT_C = NB * NHEAD * 2, NUNIT = NUNIT_L + NUNIT_C;
constexpr int CT_SLOT = 129 * 128;

constexpr size_t MiB = 1u << 20;
constexpr size_t WS_HX = 0, WS_TP = 0, WS_H2 = 0, WS_ACT = 0;
constexpr size_t WS_UF = 68 * MiB, WS_XM = 100 * MiB, WS_CT = 68 * MiB;
constexpr size_t WS_G = 134 * MiB, WS_SC = 137 * MiB, WS_MS = 138 * MiB;
constexpr size_t WS_V = 160 * MiB, WS_Z = 194 * MiB, WS_DC = 226 * MiB, WS_YM = 364 * MiB, WS_U = 160 * MiB;
constexpr size_t WS_WIN = 480 * MiB, WS_WOUT = 484 * MiB, WS_WUP = 486 * MiB, WS_WDN = 496 * MiB, WS_WQ = 501 * MiB, WS_WK = WS_WQ + 131072;
constexpr size_t WS_F1 = 502 * MiB, WS_G2 = WS_F1 + 16384, WS_TW = WS_G2 + 16384;
constexpr size_t WS_MOD = 503 * MiB, WS_CTL = 504 * MiB, WS_ZERO0 = WS_MOD, WS_ZERO_BYTES = 2 * MiB, WS_END = 512 * MiB;
static_assert(WS_DC + (size_t)NUNIT * 2 * CT_SLOT * 4 <= WS_YM && WS_YM + (size_t)MROWS * 1024 * 2 <= WS_U + (size_t)MROWS * UPW * 2 && WS_U + (size_t)MROWS * UPW * 2 <= WS_WIN, "ws map");
static_assert(WS_CT + (size_t)NUNIT_L * 2 * CT_SLOT * 2 <= WS_G && WS_XM + (size_t)TROWS * 512 * 2 <= WS_G && (size_t)MROWS * DFF * 2 <= WS_U, "ws map 2");
constexpr size_t DO_AB = 0, DO_Q = 32 * MiB, DO_K = 64 * MiB;

__device__ __forceinline__ unsigned f2bf(float f) { unsigned u = __builtin_bit_cast(unsigned, f); return (u + 0x7fffu + ((u >> 16) & 1u)) >> 16; }
__device__ __forceinline__ unsigned pk2(float lo, float hi) { return f2bf(lo) | (f2bf(hi) << 16); }
__device__ __forceinline__ float bflo(unsigned w) { return __builtin_bit_cast(float, w << 16); }
__device__ __forceinline__ float bfhi(unsigned w) { return __builtin_bit_cast(float, w & 0xffff0000u); }
__device__ __forceinline__ f32x4 bf4(v2u x) { return (f32x4){bflo(x.x), bfhi(x.x), bflo(x.y), bfhi(x.y)}; }
__device__ __forceinline__ float silu_f(float x) { return x * __builtin_amdgcn_rcpf(1.0f + __expf(-x)); }
__device__ __forceinline__ float logsig_f(float x) { return fminf(x, 0.f) - log1pf(__expf(-fabsf(x))); }
__device__ __forceinline__ float wave_sum(float v) {
#pragma unroll
    for (int o = 1; o < 64; o <<= 1) v += __shfl_xor(v, o);
    return v;
}
__device__ __forceinline__ int img_off(int row, int ch) { return row * 256 + ((ch ^ (row & 15)) << 4); }
struct BFrag { bf16x8 f[4]; };
__device__ __forceinline__ BFrag load_bfrag(const LAS uchar* Bimg, int brow, int kq) { BFrag b;
#pragma unroll
    for (int s = 0; s < 4; ++s) b.f[s] = *(const LAS bf16x8*)(Bimg + img_off(brow, 4 * s + kq));
    return b; }
__device__ __forceinline__ f32x4 mma_a(f32x4 acc, const LAS uchar* Aimg, int arow, const BFrag& b, int kq) {
    bf16x8 a[4];
#pragma unroll
    for (int s = 0; s < 4; ++s) a[s] = *(const LAS bf16x8*)(Aimg + img_off(arow, 4 * s + kq));
#pragma unroll
    for (int s = 0; s < 4; ++s) acc = __builtin_amdgcn_mfma_f32_16x16x32_bf16(a[s], b.f[s], acc, 0, 0, 0);
    return acc; }
#define MEMFENCE() asm volatile("" ::: "memory")


template <int S> __device__ __forceinline__ unsigned tr_lane_off(int lane) { return (unsigned)((8 * (lane >> 4) + ((lane & 15) >> 2)) * S + 8 * (lane & 3)); }
__device__ __forceinline__ unsigned lds_addr(const LAS uchar* p) { return (unsigned)(unsigned long long)p; }
__device__ __forceinline__ bf16x8 pack_frag(v2u lo, v2u hi) { const v4u w = (v4u){lo.x, lo.y, hi.x, hi.y}; return __builtin_bit_cast(bf16x8, w); }
template <int S> __device__ __forceinline__ void tr_load4(unsigned addr, BFrag& f) {
    v2u r0, r1, r2, r3, r4, r5, r6, r7;
    asm volatile("ds_read_b64_tr_b16 %0, %8\n\tds_read_b64_tr_b16 %1, %8 offset:%9\n\tds_read_b64_tr_b16 %2, %8 offset:%10\n\tds_read_b64_tr_b16 %3, %8 offset:%11\n\t"
                 "ds_read_b64_tr_b16 %4, %8 offset:%12\n\tds_read_b64_tr_b16 %5, %8 offset:%13\n\tds_read_b64_tr_b16 %6, %8 offset:%14\n\tds_read_b64_tr_b16 %7, %8 offset:%15\n\ts_waitcnt lgkmcnt(0)"
                 : "=&v"(r0), "=&v"(r1), "=&v"(r2), "=&v"(r3), "=&v"(r4), "=&v"(r5), "=&v"(r6), "=&v"(r7)
                 : "v"(addr), "i"(4 * S), "i"(32 * S), "i"(36 * S), "i"(64 * S), "i"(68 * S), "i"(96 * S), "i"(100 * S) : "memory");
    f.f[0] = pack_frag(r0, r1); f.f[1] = pack_frag(r2, r3); f.f[2] = pack_frag(r4, r5); f.f[3] = pack_frag(r6, r7);
}
template <int S> __device__ __forceinline__ void tr_load2(unsigned addr, bf16x8& f0, bf16x8& f1) {
    v2u r0, r1, r2, r3;
    asm volatile("ds_read_b64_tr_b16 %0, %4\n\tds_read_b64_tr_b16 %1, %4 offset:%5\n\tds_read_b64_tr_b16 %2, %4 offset:%6\n\tds_read_b64_tr_b16 %3, %4 offset:%7\n\ts_waitcnt lgkmcnt(0)"
                 : "=&v"(r0), "=&v"(r1), "=&v"(r2), "=&v"(r3) : "v"(addr), "i"(4 * S), "i"(32 * S), "i"(36 * S) : "memory");
    f0 = pack_frag(r0, r1); f1 = pack_frag(r2, r3);
}
template <int S> __device__ __forceinline__ unsigned tr_lane_off_p(int lane) { return (unsigned)((4 * (lane >> 4) + ((lane & 15) >> 2)) * S + 8 * (lane & 3)); }
template <int S> __device__ __forceinline__ void tr_load4p(unsigned addr, BFrag& f) {
    v2u r0, r1, r2, r3, r4, r5, r6, r7;
    asm volatile("ds_read_b64_tr_b16 %0, %8\n\tds_read_b64_tr_b16 %1, %8 offset:%9\n\tds_read_b64_tr_b16 %2, %8 offset:%10\n\tds_read_b64_tr_b16 %3, %8 offset:%11\n\t"
                 "ds_read_b64_tr_b16 %4, %8 offset:%12\n\tds_read_b64_tr_b16 %5, %8 offset:%13\n\tds_read_b64_tr_b16 %6, %8 offset:%14\n\tds_read_b64_tr_b16 %7, %8 offset:%15\n\ts_waitcnt lgkmcnt(0)"
                 : "=&v"(r0), "=&v"(r1), "=&v"(r2), "=&v"(r3), "=&v"(r4), "=&v"(r5), "=&v"(r6), "=&v"(r7)
                 : "v"(addr), "i"(16 * S), "i"(32 * S), "i"(48 * S), "i"(64 * S), "i"(80 * S), "i"(96 * S), "i"(112 * S) : "memory");
    f.f[0] = pack_frag(r0, r1); f.f[1] = pack_frag(r2, r3); f.f[2] = pack_frag(r4, r5); f.f[3] = pack_frag(r6, r7);
}
__device__ __forceinline__ f32x4 mma_ff(f32x4 acc, const BFrag& a, const BFrag& b) {
#pragma unroll
    for (int s = 0; s < 4; ++s) acc = __builtin_amdgcn_mfma_f32_16x16x32_bf16(a.f[s], b.f[s], acc, 0, 0, 0);
    return acc; }
__device__ __forceinline__ float lane_scan_add(float v, int lane) {
#pragma unroll
    for (int o = 1; o < 64; o <<= 1) { const float t = __shfl_up(v, o); if (lane >= o) v += t; }
    return v; }
__device__ __forceinline__ float lane_scan_max(float v, int lane) {
#pragma unroll
    for (int o = 1; o < 64; o <<= 1) { const float t = __shfl_up(v, o); if (lane >= o) v = fmaxf(v, t); }
    return v; }
__device__ __forceinline__ float wave_max(float v) {
#pragma unroll
    for (int o = 1; o < 64; o <<= 1) v = fmaxf(v, __shfl_xor(v, o));
    return v; }

#define XB_TMO      128
#define XB_XCNT(j)  (256  + 64 * (j))
#define XB_XSUB(j)  (1280 + 64 * (j))
#define XB_XGEN(j)  (2304 + 64 * (j))
#define XB_TOP      3328
#define XB_TOPGEN   3392
#define XCD_BAR_WORDS 3456
#define XB_SPIN_CAP (1u << 18)

__device__ __forceinline__ unsigned xb_ld(unsigned* p)              { return __hip_atomic_load(p, __ATOMIC_RELAXED, __HIP_MEMORY_SCOPE_AGENT); }
__device__ __forceinline__ unsigned xb_add(unsigned* p, unsigned v) { return __hip_atomic_fetch_add(p, v, __ATOMIC_RELAXED, __HIP_MEMORY_SCOPE_AGENT); }
__device__ __forceinline__ unsigned xb_xcc_id() { return (unsigned)__builtin_amdgcn_s_getreg((3 << 11) | 20) & 0xFu; }
#define XB_SPIN(cond, bar) do { unsigned _sp = 0; while (cond) { __builtin_amdgcn_s_sleep(1); \
    if ((++_sp & 255u) == 0u) { if (xb_ld(&(bar)[XB_TMO])) break; if (_sp > XB_SPIN_CAP) { atomicAdd(&(bar)[XB_TMO], 1u); break; } } } } while (0)

struct XcdBarrier {
    unsigned* bar; unsigned x;
    volatile LAS unsigned* st;
};

__device__ __forceinline__ XcdBarrier xcd_barrier_post(unsigned* bar, volatile LAS unsigned* st) {
    XcdBarrier b; b.bar = bar; b.x = xb_xcc_id(); b.st = st;
    if (threadIdx.x == 0) (void)xb_add(&bar[XB_XCNT(b.x)], 1u);
    return b;
}
__device__ __forceinline__ void xcd_barrier_complete(unsigned* bar, unsigned x, unsigned& nloc, unsigned& nx) {
    const unsigned G = gridDim.x * gridDim.y * gridDim.z;
    unsigned sum, cnt, mine, sp = 0u;
    for (;;) {
        sum = 0u; cnt = 0u; mine = 0u;
#pragma unroll
        for (unsigned j = 0; j < 16; ++j) { const unsigned c = xb_ld(&bar[XB_XCNT(j)]); sum += c; cnt += (c > 0u) ? 1u : 0u; mine = (j == x) ? c : mine; }
        if (sum == G) break;
        __builtin_amdgcn_s_sleep(1);
        if ((++sp & 255u) == 0u) { if (xb_ld(&bar[XB_TMO])) break; if (sp > XB_SPIN_CAP) { atomicAdd(&bar[XB_TMO], 1u); break; } }
    }
    nloc = mine > 0u ? mine : 1u; nx = cnt > 0u ? cnt : 1u;
}

__device__ __forceinline__ void xcd_barrier(const XcdBarrier& b) {
    asm volatile("s_waitcnt vmcnt(0)" ::: "memory");
    __syncthreads();
    if (threadIdx.x == 0) {
        unsigned* bar = b.bar;
        __builtin_amdgcn_s_waitcnt(0);
        unsigned nloc = b.st[0], nx = b.st[1];
        if (nloc == 0u) { xcd_barrier_complete(bar, b.x, nloc, nx); b.st[0] = nloc; b.st[1] = nx; }
        const unsigned old = xb_add(&bar[XB_XSUB(b.x)], 1u);
        const unsigned gen = old / nloc;
        if (old + 1u == (gen + 1u) * nloc) {
            __builtin_amdgcn_fence(__ATOMIC_RELEASE, "agent");
            asm volatile("s_waitcnt vmcnt(0)" ::: "memory");
            const unsigned og = xb_add(&bar[XB_TOP], 1u);
            const unsigned tg = og / nx;
            if (og + 1u == (tg + 1u) * nx) xb_add(&bar[XB_TOPGEN], 1u);
            else XB_SPIN(xb_ld(&bar[XB_TOPGEN]) == tg, bar);
            __builtin_amdgcn_fence(__ATOMIC_ACQUIRE, "agent");
            xb_add(&bar[XB_XGEN(b.x)], 1u);
            asm volatile("s_waitcnt vmcnt(0)" ::: "memory");
        } else {
            XB_SPIN(xb_ld(&bar[XB_XGEN(b.x)]) == gen, bar);
            __builtin_amdgcn_fence(__ATOMIC_ACQUIRE, "agent");
            asm volatile("s_waitcnt vmcnt(0)" ::: "memory");
        }
    }
    __syncthreads();
}


struct Args { const float* in[24]; float* out; uchar* ws; int ph_lo, ph_hi; };

template <class F>
__device__ __forceinline__ void tr_item(F src, bf16* WT, size_t drow0, int ldk, int dk0, LAS float* scr, int lane) {
#pragma unroll 4
    for (int i = 0; i < 32; ++i) { const int kk = 2 * i + (lane >> 5); scr[kk * 33 + (lane & 31)] = src(kk, lane & 31); }
    LDS_WAIT(); asm volatile("" ::: "memory");
    const int c = lane & 7;
#pragma unroll
    for (int j = 0; j < 4; ++j) { const int n = (lane >> 3) + 8 * j; const LAS float* s = scr + (8 * c) * 33 + n;
        v4u o; o.x = pk2(s[0 * 33], s[1 * 33]); o.y = pk2(s[2 * 33], s[3 * 33]); o.z = pk2(s[4 * 33], s[5 * 33]); o.w = pk2(s[6 * 33], s[7 * 33]);
        *(v4u*)(WT + (drow0 + n) * ldk + dk0 + 8 * c) = o; }
    LDS_WAIT(); asm volatile("" ::: "memory");
}

constexpr int I_XV = 16 * 32, I_Z = 16 * 16, I_QK = 2 * 4 * 4, I_OF = 8 * 32, I_OM = 8 * 32, I_UP = 16 * 160, I_DN = 40 * 32;
constexpr int TR_EARLY = I_XV + I_Z + 2 * I_QK, TR_ALL = TR_EARLY + I_OF + I_OM + I_UP + I_DN;
__device__ __forceinline__ void tr_items(const Args& a, LAS uchar* lds, int lo, int hi, int gw, int NGW) {
    const int tid = threadIdx.x, lane = tid & 63, wave = __builtin_amdgcn_readfirstlane(tid >> 6);
    uchar* ws = a.ws;
    LAS float* scr = (LAS float*)(lds + wave * 16384);
    const float* w_in = a.in[7]; const float* w_out = a.in[15]; const float* w_up = a.in[17]; const float* w_dn = a.in[21];
    const float* w_q = a.in[10]; const float* w_k = a.in[11];
    bf16* WIN = (bf16*)(ws + WS_WIN); bf16* WOUT = (bf16*)(ws + WS_WOUT); bf16* WUP = (bf16*)(ws + WS_WUP); bf16* WDN = (bf16*)(ws + WS_WDN);
    bf16* WQ = (bf16*)(ws + WS_WQ); bf16* WK = (bf16*)(ws + WS_WK);
    for (int it = lo + gw; it < hi; it += NGW) {
        int r = it;
        if (r < I_XV) { const int kb = r / 32, nb = r % 32, k0 = kb * 64, n0 = nb * 32;
            auto src = [&](int kk, int nn) -> float { return w_in[(size_t)(k0 + kk) * INW + 512 + n0 + nn]; };
            tr_item(src, WIN, (size_t)(512 + n0), DM, k0, scr, lane); continue; } r -= I_XV;
        if (r < I_Z) { const int kb = r / 16, nb = r % 16, k0 = kb * 64, n0 = nb * 32;
            auto src = [&](int kk, int nn) -> float { return w_in[(size_t)(k0 + kk) * INW + 1552 + n0 + nn]; };
            tr_item(src, WIN, (size_t)(1536 + n0), DM, k0, scr, lane); continue; } r -= I_Z;
        if (r < 2 * I_QK) { const bool isk = r >= I_QK; if (isk) r -= I_QK;
            const int h = r / 8, kb = (r % 8) / 4, nb = r % 4, k0 = kb * 64, n0 = nb * 32;
            const float* W = (isk ? w_k : w_q) + (size_t)h * HD * HD; const float sc = isk ? 0.08838834764831845f : 1.0f;
            auto src = [&](int kk, int nn) -> float { return W[(size_t)(k0 + kk) * HD + n0 + nn] * sc; };
            tr_item(src, (isk ? WK : WQ) + (size_t)h * HD * HD, (size_t)n0, HD, k0, scr, lane); continue; } r -= 2 * I_QK;
        if (r < I_OF) { const int kb = r / 32, nb = r % 32, k0 = kb * 64, n0 = nb * 32;
            auto src = [&](int kk, int nn) -> float { const int k = k0 + kk, g = k >> 7, s = k & 127; const float* wo = w_out + (size_t)(g * 128) * DM + n0 + nn;
                if (s == 0 || s == 64) return wo[(size_t)s * DM];
                if (s < 64) return wo[(size_t)s * DM] + wo[(size_t)(128 - s) * DM];
                const int kq = s - 64; return wo[(size_t)(128 - kq) * DM] - wo[(size_t)kq * DM]; };
            tr_item(src, WOUT, (size_t)n0, DM, k0, scr, lane); continue; } r -= I_OF;
        if (r < I_OM) { const int kb = r / 32, nb = r % 32, k0 = kb * 64, n0 = nb * 32;
            auto src = [&](int kk, int nn) -> float { return w_out[(size_t)(512 + k0 + kk) * DM + n0 + nn]; };
            tr_item(src, WOUT, (size_t)n0, DM, 512 + k0, scr, lane); continue; } r -= I_OM;
        if (r < I_UP) { const int kb = r / 160, nb = r % 160, k0 = kb * 64, n0 = nb * 32;
            auto src = [&](int kk, int nn) -> float { return w_up[(size_t)(k0 + kk) * UPW + n0 + nn]; };
            tr_item(src, WUP, (size_t)n0, DM, k0, scr, lane); continue; } r -= I_UP;
        { const int kb = r / 32, nb = r % 32, k0 = kb * 64, n0 = nb * 32;
            auto src = [&](int kk, int nn) -> float { return w_dn[(size_t)(k0 + kk) * DM + n0 + nn]; };
            tr_item(src, WDN, (size_t)n0, DFF, k0, scr, lane); }
    }
}

__device__ __forceinline__ void p0_prologue(const Args& a, LAS uchar* lds, int vcu, int G, size_t mod_off) {
    const int tid = threadIdx.x, lane = tid & 63, wave = __builtin_amdgcn_readfirstlane(tid >> 6);
    uchar* ws = a.ws;
    {
        LAS float* sl = (LAS float*)lds;
        float* MOD = (float*)(ws + mod_off);
        const float* w_ada = a.in[4]; const float* b_ada = a.in[5];
        for (int it = blockIdx.x; it < 32 * 12; it += G) {
            const int kc = it / 12, nb = it % 12;
            __syncthreads();
            if (tid < 288) { const int r = tid >> 5, kk = tid & 31; const float cv = (r < 8) ? a.in[1][r * DM + kc * 32 + kk] : a.in[3][kc * 32 + kk]; sl[tid] = silu_f(cv); }
            __syncthreads();
            const int n = nb * 512 + tid;
            float acc[9];
#pragma unroll
            for (int r = 0; r < 9; ++r) acc[r] = 0.f;
#pragma unroll 8
            for (int kk = 0; kk < 32; ++kk) { const float w = w_ada[(size_t)(kc * 32 + kk) * 6144 + n];
#pragma unroll
                for (int r = 0; r < 9; ++r) acc[r] += sl[r * 32 + kk] * w; }
            const float bb = (kc == 0) ? b_ada[n] : 0.f;
#pragma unroll
            for (int r = 0; r < 9; ++r) atomicAdd(&MOD[r * 6144 + n], acc[r] + bb);
        }
        __syncthreads();
    }
    {
        LAS float* tab = (LAS float*)(lds + 8 * 16384);
        if (tid < 128) tab[tid] = cospif((float)tid * (1.0f / 64.0f)) * 0.08838834764831845f;
        __syncthreads();
        const int gt = blockIdx.x * NTHR + tid;
        bf16* F1 = (bf16*)(ws + WS_F1); bf16* G2 = (bf16*)(ws + WS_G2); float* TW = (float*)(ws + WS_TW);
        if (gt < 8192) { const int row = gt >> 6, n1 = gt & 63, ri = row >> 6, k1 = row & 63; const float ang = (float)((k1 * n1) & 63) * (1.0f / 32.0f);
            F1[gt] = (bf16)f2bf((ri == 0 ? cospif(ang) : -sinpif(ang)) * 0.125f); }
        else if (gt < 16384) { const int i = gt - 8192, k2 = i >> 7, kap = i & 127, n2 = kap & 63; const float ang = (float)((k2 * n2) & 63) * (1.0f / 32.0f);
            G2[i] = (bf16)f2bf((kap < 64 ? cospif(ang) : sinpif(ang)) * 0.125f); }
        else if (gt < 16384 + 4096) { const int i = gt - 16384; TW[i] = cospif((float)i * (1.0f / 2048.0f)); }
    }
    {
        const LAS float* tab = (const LAS float*)(lds + 8 * 16384);
        LAS float* Tm = (LAS float*)lds;
        LAS float* wT = (LAS float*)(lds + 65536);
        const float* w_in = a.in[7]; bf16* WIN = (bf16*)(a.ws + WS_WIN);
        bool have_T = false;
        for (int it = blockIdx.x; it < 64; it += G) {
            const int g = it >> 4, k0 = (it & 15) * 64;
            __syncthreads();
            if (!have_T) { for (int id = tid; id < 128 * 128; id += NTHR) { const int c = id >> 7, s_ = id & 127; const int mult = (s_ <= 64) ? s_ : (s_ - 64), off = (s_ <= 64) ? 0 : 96; Tm[id] = tab[(c * mult + off) & 127]; } have_T = true; }
            for (int id = tid; id < 64 * 32; id += NTHR) { const int kk = id >> 5, c4 = id & 31; const f32x4 v = *(const f32x4*)(w_in + (size_t)(k0 + kk) * INW + g * 128 + 4 * c4);
                wT[(4 * c4 + 0) * 64 + kk] = v.x; wT[(4 * c4 + 1) * 64 + kk] = v.y; wT[(4 * c4 + 2) * 64 + kk] = v.z; wT[(4 * c4 + 3) * 64 + kk] = v.w; }
            __syncthreads();
            const int s4 = (tid & 31) * 4, k4 = (tid >> 5) * 4;
            f32x4 acc[4];
#pragma unroll
            for (int j = 0; j < 4; ++j) acc[j] = (f32x4){0.f, 0.f, 0.f, 0.f};
#pragma unroll 4
            for (int c = 0; c < 128; ++c) { const f32x4 tv = *(const LAS f32x4*)(Tm + c * 128 + s4), wv_ = *(const LAS f32x4*)(wT + c * 64 + k4);
                acc[0] += wv_ * tv.x; acc[1] += wv_ * tv.y; acc[2] += wv_ * tv.z; acc[3] += wv_ * tv.w; }
#pragma unroll
            for (int j = 0; j < 4; ++j) *(v2u*)(WIN + (size_t)(g * 128 + s4 + j) * DM + k0 + k4) = (v2u){pk2(acc[j].x, acc[j].y), pk2(acc[j].z, acc[j].w)};
        }
        __syncthreads();
    }
    tr_items(a, lds, 0, (G > 32) ? TR_EARLY : TR_ALL, vcu * NWAVES + wave, G * NWAVES);
}

__device__ __forceinline__ void p1_rows(const Args& a, LAS uchar* lds, int vcu, int G) {
    const int tid = threadIdx.x, lane = tid & 63, wave = __builtin_amdgcn_readfirstlane(tid >> 6);
    uchar* ws = a.ws;
    {
        LAS f32x4* wg = (LAS f32x4*)lds;
        const float* w_in = a.in[7];
        for (int id = tid; id < 4096; id += NTHR) { const int k = id >> 2, q = id & 3; const int l = (k & 255) >> 2, i = k & 3, j = k >> 8;
            wg[((j * 4 + i) * 4 + q) * 64 + l] = *(const f32x4*)(w_in + (size_t)k * INW + 1536 + 4 * q); }
        __syncthreads();
    }
    const LAS f32x4* wg = (const LAS f32x4*)lds;
    const float* MOD = (const float*)(ws + WS_MOD);
    const float* nw = a.in[6]; const float* bg = a.in[12];
    bf16* HX = (bf16*)(ws + WS_HX); float* GG = (float*)(ws + WS_G);
    const int gw = vcu * NWAVES + wave, NGW = G * NWAVES;
    for (int row = gw; row < TROWS; row += NGW) {
        const float* xr; const float* md;
        if (row < MROWS) { xr = a.in[0] + (size_t)row * DM; md = MOD + (size_t)(row >> 12) * 6144; }
        else { xr = a.in[2] + (size_t)(row - MROWS) * DM; md = MOD + (size_t)8 * 6144; }
        f32x4 v[4]; float s = 0.f;
#pragma unroll
        for (int j = 0; j < 4; ++j) { v[j] = *(const f32x4*)(xr + 4 * lane + 256 * j); s += (v[j].x * v[j].x + v[j].y * v[j].y) + (v[j].z * v[j].z + v[j].w * v[j].w); }
        const float rstd = rsqrtf(wave_sum(s) * (1.0f / DM) + EPS);
        float g[16];
#pragma unroll
        for (int i = 0; i < 16; ++i) g[i] = 0.f;
#pragma unroll
        for (int j = 0; j < 4; ++j) {
            const f32x4 w = *(const f32x4*)(nw + 4 * lane + 256 * j), sh = *(const f32x4*)(md + 4 * lane + 256 * j), sc = *(const f32x4*)(md + 1024 + 4 * lane + 256 * j);
            v[j] = v[j] * rstd * w * (sc + 1.0f) + sh;
            *(v2u*)(HX + (size_t)row * DM + 4 * lane + 256 * j) = (v2u){pk2(v[j].x, v[j].y), pk2(v[j].z, v[j].w)};
        }
#pragma unroll
        for (int j = 0; j < 4; ++j) {
#pragma unroll
            for (int i = 0; i < 4; ++i) {
#pragma unroll
                for (int q = 0; q < 4; ++q) { const f32x4 ww = wg[((j * 4 + i) * 4 + q) * 64 + lane];
                    g[4 * q + 0] += v[j][i] * ww.x; g[4 * q + 1] += v[j][i] * ww.y; g[4 * q + 2] += v[j][i] * ww.z; g[4 * q + 3] += v[j][i] * ww.w; }
                if (i & 1) MEMFENCE(); }
        }
        float g8[8], g4[4], g2[2], g1;
        { const bool hi = (lane & 32) != 0;
#pragma unroll
          for (int i = 0; i < 8; ++i) { const float keep = hi ? g[i + 8] : g[i], send = hi ? g[i] : g[i + 8]; g8[i] = keep + __shfl_xor(send, 32); } }
        { const bool hi = (lane & 16) != 0;
#pragma unroll
          for (int i = 0; i < 4; ++i) { const float keep = hi ? g8[i + 4] : g8[i], send = hi ? g8[i] : g8[i + 4]; g4[i] = keep + __shfl_xor(send, 16); } }
        { const bool hi = (lane & 8) != 0;
#pragma unroll
          for (int i = 0; i < 2; ++i) { const float keep = hi ? g4[i + 2] : g4[i], send = hi ? g4[i] : g4[i + 2]; g2[i] = keep + __shfl_xor(send, 8); } }
        { const bool hi = (lane & 4) != 0; const float keep = hi ? g2[1] : g2[0], send = hi ? g2[0] : g2[1]; g1 = keep + __shfl_xor(send, 4); }
        g1 += __shfl_xor(g1, 2); g1 += __shfl_xor(g1, 1);
        if ((lane & 3) == 0) { const int idx = ((lane & 32) ? 8 : 0) + ((lane & 16) ? 4 : 0) + ((lane & 8) ? 2 : 0) + ((lane & 4) ? 1 : 0); GG[(size_t)row * 16 + idx] = g1 + bg[idx]; }
    }
}
__device__ __forceinline__ void p7_rows(const Args& a, int vcu, int G) {
    const int tid = threadIdx.x, lane = tid & 63, wave = __builtin_amdgcn_readfirstlane(tid >> 6);
    const float* MOD = (const float*)(a.ws + WS_MOD); const float* nw = a.in[16]; bf16* H2 = (bf16*)(a.ws + WS_H2);
    const int gw = vcu * NWAVES + wave, NGW = G * NWAVES;
    for (int row = gw; row < MROWS; row += NGW) {
        const float* xr = a.in[0] + (size_t)row * DM; const float* md = MOD + (size_t)(row >> 12) * 6144; const bf16* y1 = (const bf16*)a.out + (size_t)row * 2048;
        f32x4 v[4]; float s = 0.f;
#pragma unroll
        for (int j = 0; j < 4; ++j) { v[j] = *(const f32x4*)(xr + 4 * lane + 256 * j) + bf4(*(const v2u*)(y1 + 4 * lane + 256 * j)); s += (v[j].x * v[j].x + v[j].y * v[j].y) + (v[j].z * v[j].z + v[j].w * v[j].w); }
        const float rstd = rsqrtf(wave_sum(s) * (1.0f / DM) + EPS);
#pragma unroll
        for (int j = 0; j < 4; ++j) {
            const f32x4 w = *(const f32x4*)(nw + 4 * lane + 256 * j), sh = *(const f32x4*)(md + 3072 + 4 * lane + 256 * j), sc = *(const f32x4*)(md + 4096 + 4 * lane + 256 * j);
            const f32x4 hv = v[j] * rstd * w * (sc + 1.0f) + sh;
            *(v2u*)(H2 + (size_t)row * DM + 4 * lane + 256 * j) = (v2u){pk2(hv.x, hv.y), pk2(hv.z, hv.w)}; }
    }
}
__device__ __forceinline__ void p11_rows(const Args& a, int vcu, int G, float* dst) {
    const int tid = threadIdx.x, lane = tid & 63, wave = __builtin_amdgcn_readfirstlane(tid >> 6);
    const float* nw = a.in[23];
    const int gw = vcu * NWAVES + wave, NGW = G * NWAVES;
    for (int row = gw; row < MROWS; row += NGW) {
        const float* xr = a.in[0] + (size_t)row * DM; const bf16* y1 = (const bf16*)a.out + (size_t)row * 2048; const bf16* d2 = (const bf16*)(a.ws + WS_U) + (size_t)row * DM;
        f32x4 v[4]; float s = 0.f;
#pragma unroll
        for (int j = 0; j < 4; ++j) { v[j] = *(const f32x4*)(xr + 4 * lane + 256 * j) + bf4(*(const v2u*)(y1 + 4 * lane + 256 * j)) + bf4(*(const v2u*)(d2 + 4 * lane + 256 * j)); s += (v[j].x * v[j].x + v[j].y * v[j].y) + (v[j].z * v[j].z + v[j].w * v[j].w); }
        const float rstd = rsqrtf(wave_sum(s) * (1.0f / DM) + EPS);
#pragma unroll
        for (int j = 0; j < 4; ++j) { const f32x4 w = *(const f32x4*)(nw + 4 * lane + 256 * j); *(f32x4*)(dst + (size_t)row * DM + 4 * lane + 256 * j) = v[j] * rstd * w; }
    }
}

struct SchedP2 {
    pg8::StaticOrder so;
    __device__ void init(int G, int c) { so.init(MROWS, 2048, G, c); }
    __device__ bool next(int i, pg8::Unit& u) const {
        const long L = (long)i * so.G + so.c;
        if (L < so.nwg) return so.next(i, u);
        const int r = (int)(L - so.nwg); if (r >= 32) return false;
        u.pm = 128 + (r & 7); u.pn = 2 + (r >> 3); return true;
    }
    __device__ __forceinline__ void a_ready(const pg8::Unit&) const {}
    __device__ __forceinline__ void done(const pg8::Unit&) const {}
};
struct EpiP2 {
    static constexpr bool PERM = true, AFTER_DRAIN = false;
    bf16 *base0, *base1, *base2, *base3;
    __device__ __forceinline__ void operator()(const f32x4 (&acc)[2][2][4][2], const pg8::Unit& u, int wr, int wc, int fr, int fq) const {
        const int row0 = u.pm * 256 + wr * 64 + fr; const int sel = u.pn >> 1; bf16* O = sel == 0 ? base0 : (sel == 1 ? base1 : (sel == 2 ? base2 : base3)); const int col0 = (u.pn & 1) * 256 + wc * 32 + 8 * fq;
#pragma unroll
        for (int ai = 0; ai < 2; ++ai)
#pragma unroll
            for (int m = 0; m < 4; ++m) { bf16* rowp = O + (size_t)(row0 + ai * 128 + m * 16) * 512 + col0;
#pragma unroll
                for (int bj = 0; bj < 2; ++bj) { const f32x4 v0 = acc[ai][bj][m][0], v1 = acc[ai][bj][m][1];
                    v4u w; w.x = pg8::cvt_pk_bf16(v0[0], v0[1]); w.y = pg8::cvt_pk_bf16(v0[2], v0[3]); w.z = pg8::cvt_pk_bf16(v1[0], v1[1]); w.w = pg8::cvt_pk_bf16(v1[2], v1[3]);
                    *(v4u*)(rowp + bj * 128) = w; } }
    }
};
struct EpiBias16 {
    static constexpr bool PERM = true, AFTER_DRAIN = false;
    bf16* O; int ldc; const float* bias;
    __device__ __forceinline__ void operator()(const f32x4 (&acc)[2][2][4][2], const pg8::Unit& u, int wr, int wc, int fr, int fq) const {
        const int row0 = u.pm * 256 + wr * 64 + fr; const int col0 = u.pn * 256 + wc * 32 + 8 * fq;
        f32x4 bv[2][2];
#pragma unroll
        for (int bj = 0; bj < 2; ++bj)
#pragma unroll
            for (int n = 0; n < 2; ++n) bv[bj][n] = *(const f32x4*)(bias + col0 + bj * 128 + 4 * n);
#pragma unroll
        for (int ai = 0; ai < 2; ++ai)
#pragma unroll
            for (int m = 0; m < 4; ++m) { bf16* rowp = O + (size_t)(row0 + ai * 128 + m * 16) * ldc + col0;
#pragma unroll
                for (int bj = 0; bj < 2; ++bj) { const f32x4 v0 = acc[ai][bj][m][0] + bv[bj][0], v1 = acc[ai][bj][m][1] + bv[bj][1];
                    v4u w; w.x = pg8::cvt_pk_bf16(v0[0], v0[1]); w.y = pg8::cvt_pk_bf16(v0[2], v0[3]); w.z = pg8::cvt_pk_bf16(v1[0], v1[1]); w.w = pg8::cvt_pk_bf16(v1[2], v1[3]);
                    *(v4u*)(rowp + bj * 128) = w; } }
    }
};
struct EpiUp {
    static constexpr bool PERM = true, AFTER_DRAIN = false;
    bf16* O; const float* bias;
    __device__ __forceinline__ void operator()(const f32x4 (&acc)[2][2][4][2], const pg8::Unit& u, int wr, int wc, int fr, int fq) const {
        const int row0 = u.pm * 256 + wr * 64 + fr; const int col0 = u.pn * 256 + wc * 32 + 8 * fq;
        const int isg = u.pn >= 10 ? 1 : 0, qb = u.pn - 10 * isg, b = row0 >> 12;
        bf16* base = O + ((size_t)(b * 10 + qb) * SEQ) * 512 + isg * 256 + wc * 32 + 8 * fq;
        f32x4 bv[2][2];
#pragma unroll
        for (int bj = 0; bj < 2; ++bj)
#pragma unroll
            for (int n = 0; n < 2; ++n) bv[bj][n] = *(const f32x4*)(bias + col0 + bj * 128 + 4 * n);
#pragma unroll
        for (int ai = 0; ai < 2; ++ai)
#pragma unroll
            for (int m = 0; m < 4; ++m) { bf16* rowp = base + (size_t)((row0 + ai * 128 + m * 16) & (SEQ - 1)) * 512;
#pragma unroll
                for (int bj = 0; bj < 2; ++bj) { const f32x4 v0 = acc[ai][bj][m][0] + bv[bj][0], v1 = acc[ai][bj][m][1] + bv[bj][1];
                    v4u w; w.x = pg8::cvt_pk_bf16(v0[0], v0[1]); w.y = pg8::cvt_pk_bf16(v0[2], v0[3]); w.z = pg8::cvt_pk_bf16(v1[0], v1[1]); w.w = pg8::cvt_pk_bf16(v1[2], v1[3]);
                    *(v4u*)(rowp + bj * 128) = w; } }
    }
};
struct EpiGate16 {
    static constexpr bool PERM = true, AFTER_DRAIN = false;
    bf16* O; int ldc; const float* gate; const float* bias;
    __device__ __forceinline__ void operator()(const f32x4 (&acc)[2][2][4][2], const pg8::Unit& u, int wr, int wc, int fr, int fq) const {
        const int row0 = u.pm * 256 + wr * 64 + fr; const int col0 = u.pn * 256 + wc * 32 + 8 * fq;
        const float* gp = gate + (size_t)((u.pm * 256) >> 12) * 6144 + col0;
        f32x4 gv[2][2], bv[2][2];
#pragma unroll
        for (int bj = 0; bj < 2; ++bj)
#pragma unroll
            for (int n = 0; n < 2; ++n) { gv[bj][n] = *(const f32x4*)(gp + bj * 128 + 4 * n); bv[bj][n] = bias ? *(const f32x4*)(bias + col0 + bj * 128 + 4 * n) : (f32x4){0.f, 0.f, 0.f, 0.f}; }
#pragma unroll
        for (int ai = 0; ai < 2; ++ai)
#pragma unroll
            for (int m = 0; m < 4; ++m) { bf16* rowp = O + (size_t)(row0 + ai * 128 + m * 16) * ldc + col0;
#pragma unroll
                for (int bj = 0; bj < 2; ++bj) { const f32x4 v0 = gv[bj][0] * (acc[ai][bj][m][0] + bv[bj][0]), v1 = gv[bj][1] * (acc[ai][bj][m][1] + bv[bj][1]);
                    v4u w; w.x = pg8::cvt_pk_bf16(v0[0], v0[1]); w.y = pg8::cvt_pk_bf16(v0[2], v0[3]); w.z = pg8::cvt_pk_bf16(v1[0], v1[1]); w.w = pg8::cvt_pk_bf16(v1[2], v1[3]);
                    *(v4u*)(rowp + bj * 128) = w; } }
    }
};
struct EpiRes {
    static constexpr bool PERM = false, AFTER_DRAIN = false;
    const float* res; float* out; const float* gate; const float* bias;
    __device__ __forceinline__ void operator()(const f32x4 (&acc)[2][2][4][2], const pg8::Unit& u, int wr, int wc, int fr, int fq) const {
        const int row0 = u.pm * 256 + wr * 64 + fr, col0 = u.pn * 256 + wc * 32 + 4 * fq;
        const float* gp = gate + (size_t)((u.pm * 256) >> 12) * 6144 + col0;
        f32x4 gv[2][2], bv[2][2];
#pragma unroll
        for (int bj = 0; bj < 2; ++bj)
#pragma unroll
            for (int n = 0; n < 2; ++n) { gv[bj][n] = *(const f32x4*)(gp + bj * 128 + n * 16); bv[bj][n] = bias ? *(const f32x4*)(bias + col0 + bj * 128 + n * 16) : (f32x4){0.f, 0.f, 0.f, 0.f}; }
#pragma unroll
        for (int ai = 0; ai < 2; ++ai)
#pragma unroll
            for (int m = 0; m < 4; ++m) { const size_t off = (size_t)(row0 + ai * 128 + m * 16) * DM + col0;
#pragma unroll
                for (int bj = 0; bj < 2; ++bj)
#pragma unroll
                    for (int n = 0; n < 2; ++n) { const f32x4 r = *(const f32x4*)(res + off + bj * 128 + n * 16);
                        *(f32x4*)(out + off + bj * 128 + n * 16) = r + gv[bj][n] * (acc[ai][bj][m][n] + bv[bj][n]); }
                if (m & 1) asm volatile("" ::: "memory"); }
    }
};

constexpr int PA_WQ = 0, PA_WK = 32768, PA_A = 65536, PA_V = 98304, PA_SM = 135168, VS = 288;
__device__ __forceinline__ void unit_decode(int unit, int& bh, int& row0, int& t0, int& L) {
    if (unit < NUNIT_L) { bh = unit >> 5; const int c = unit & 31; row0 = (bh >> 2) * SEQ + c * 128; t0 = c * 128; L = SEQ; }
    else { const int uc = unit - NUNIT_L; bh = uc >> 1; const int cc = uc & 1; row0 = MROWS + (bh >> 2) * CTXL + cc * 128; t0 = cc * 128; L = CTXL; }
}
__device__ __forceinline__ void stage_v128(const bf16* V, int row0, int h, LAS uchar* img, int tid) {
    const int j = tid >> 2, seg = tid & 3; const bf16* vr = V + (size_t)(row0 + j) * 512 + h * HD + seg * 32;
#pragma unroll
    for (int i = 0; i < 4; ++i) *(LAS v4u*)(img + j * VS + (seg * 32 + 8 * i) * 2) = *(const v4u*)(vr + 8 * i);
}
__device__ __forceinline__ void prep_unit(const Args& a, LAS uchar* lds, int unit, int& cur_h) {
    int tid_ = threadIdx.x; asm volatile("" : "+v"(tid_)); const int tid = tid_, lane = tid & 63, wave = __builtin_amdgcn_readfirstlane(tid >> 6), kq = lane >> 4, fr = lane & 15;
    uchar* ws = a.ws;
    int bh, row0, t0, L; unit_decode(unit, bh, row0, t0, L);
    const int h = bh & 3; const bool latent = unit < NUNIT_L;
    LAS float* sm = (LAS float*)(lds + PA_SM);
    const bf16* XM = (const bf16*)(ws + WS_XM); const bf16* V = (const bf16*)(ws + WS_V);
    bf16* AB = (bf16*)((uchar*)a.out + DO_AB); bf16* Q = (bf16*)((uchar*)a.out + DO_Q); bf16* K = (bf16*)((uchar*)a.out + DO_K);
    __syncthreads();
    if (cur_h != h) {
        const bf16* WQ = (const bf16*)(ws + WS_WQ) + (size_t)h * HD * HD; const bf16* WK = (const bf16*)(ws + WS_WK) + (size_t)h * HD * HD;
#pragma unroll
        for (int i = 0; i < 4; ++i) { const int id = tid + NTHR * i, row = id >> 4, ch = id & 15;
            *(LAS v4u*)(lds + PA_WQ + img_off(row, ch)) = *(const v4u*)(WQ + row * 128 + ch * 8); *(LAS v4u*)(lds + PA_WK + img_off(row, ch)) = *(const v4u*)(WK + row * 128 + ch * 8); }
        cur_h = h;
    }
    if (wave < 2) {
        const float* GG = (const float*)(ws + WS_G) + (size_t)row0 * 16 + wave * 8 + h;
        const int j0 = wave ? 127 - 2 * lane : 2 * lane, j1 = wave ? 126 - 2 * lane : 2 * lane + 1;
        const float li0 = GG[j0 * 16], lf0 = logsig_f(GG[j0 * 16 + 4]), li1 = GG[j1 * 16], lf1 = logsig_f(GG[j1 * 16 + 4]);
        const float incl = lane_scan_add(lf0 + lf1, lane), total = __shfl(incl, 63);
        const float g0 = total - (incl - lf1) + li0, g1 = total - incl + li1;
        const float mx = wave_max(fmaxf(g0, g1));
        sm[wave * 128 + j0] = __expf(g0 - mx); sm[wave * 128 + j1] = __expf(g1 - mx);
        if (lane == 0) { sm[256 + 2 * wave] = total; sm[257 + 2 * wave] = mx; }
    }
    for (int rp_ = 0; rp_ <= ((REP_MASK >> 17) & 1); ++rp_) {
        if (rp_) __syncthreads();
        const int l = tid >> 2, seg = tid & 3, t = t0 + l; const int colg = h * HD + seg * 32;
        const bool hp = t > 0, hn = t + 1 < L;
        const bf16* xc = XM + (size_t)(row0 + l) * 512 + colg;
        const float* cw = a.in[8] + colg; const float* cb = a.in[9] + colg;
#pragma unroll
        for (int i = 0; i < 4; ++i) {
            const v4u c = *(const v4u*)(xc + 8 * i); v4u p = (v4u){0u, 0u, 0u, 0u}, n = (v4u){0u, 0u, 0u, 0u};
            if (hp) p = *(const v4u*)(xc - 512 + 8 * i);
            if (hn) n = *(const v4u*)(xc + 512 + 8 * i);
            float o[8];
#pragma unroll
            for (int hf = 0; hf < 2; ++hf) {
                const f32x4 w0 = *(const f32x4*)(cw + 8 * i + 4 * hf), w1 = *(const f32x4*)(cw + 512 + 8 * i + 4 * hf), w2 = *(const f32x4*)(cw + 1024 + 8 * i + 4 * hf), bb = *(const f32x4*)(cb + 8 * i + 4 * hf);
                const f32x4 xp = bf4((v2u){p[2 * hf], p[2 * hf + 1]}), xcv = bf4((v2u){c[2 * hf], c[2 * hf + 1]}), xn = bf4((v2u){n[2 * hf], n[2 * hf + 1]});
                const f32x4 y = w0 * xp + w1 * xcv + w2 * xn + bb;
#pragma unroll
                for (int e = 0; e < 4; ++e) o[4 * hf + e] = silu_f(y[e]); }
            const v4u w = (v4u){pk2(o[0], o[1]), pk2(o[2], o[3]), pk2(o[4], o[5]), pk2(o[6], o[7])};
            *(LAS v4u*)(lds + PA_A + img_off(l, seg * 4 + i)) = w;
            if (latent) *(v4u*)(AB + (size_t)(row0 + l) * 512 + colg + 8 * i) = w;
        }
    }
    stage_v128(V, row0, h, lds + PA_V, tid);
    __syncthreads();
    if (latent) {
        const BFrag ba = load_bfrag(lds + PA_A, 16 * wave + fr, kq);
        const size_t tok = (size_t)(row0 + 16 * wave + fr);
#pragma unroll 1
        for (int pass = 0; pass < 2; ++pass) {
            const LAS uchar* wimg = lds + (pass ? PA_WK : PA_WQ);
            bf16* dst = (pass ? K : Q) + tok * 512 + h * HD + 4 * kq;
#pragma unroll
            for (int mt = 0; mt < 8; ++mt) { const f32x4 acc = mma_a((f32x4){0.f, 0.f, 0.f, 0.f}, wimg, 16 * mt + fr, ba, kq);
                *(v2u*)(dst + 16 * mt) = (v2u){pk2(acc[0], acc[1]), pk2(acc[2], acc[3])}; if (mt & 1) MEMFENCE(); }
        }
    }
    f32x4 kacc[8];
    { const BFrag bk = load_bfrag(lds + PA_WK, 16 * wave + fr, kq);
#pragma unroll
      for (int mt = 0; mt < 8; ++mt) { kacc[mt] = mma_a((f32x4){0.f, 0.f, 0.f, 0.f}, lds + PA_A, 16 * mt + fr, bk, kq); if (mt & 1) MEMFENCE(); } }
    {
        bf16* DC = (bf16*)(ws + WS_DC); float* SC = (float*)(ws + WS_SC);
        BFrag akf, akb;
#pragma unroll
        for (int ks = 0; ks < 4; ++ks) { unsigned wf_[4], wb_[4];
#pragma unroll
            for (int hh = 0; hh < 2; ++hh) { const int mt = 2 * ks + hh; const f32x4 wf4 = *(const LAS f32x4*)(sm + 16 * mt + 4 * kq), wb4 = *(const LAS f32x4*)(sm + 128 + 16 * mt + 4 * kq);
                const f32x4 kf = kacc[mt] * wf4, kb = kacc[mt] * wb4;
                wf_[2 * hh] = pk2(kf[0], kf[1]); wf_[2 * hh + 1] = pk2(kf[2], kf[3]); wb_[2 * hh] = pk2(kb[0], kb[1]); wb_[2 * hh + 1] = pk2(kb[2], kb[3]); }
            akf.f[ks] = __builtin_bit_cast(bf16x8, (v4u){wf_[0], wf_[1], wf_[2], wf_[3]}); akb.f[ks] = __builtin_bit_cast(bf16x8, (v4u){wb_[0], wb_[1], wb_[2], wb_[3]}); }
        const unsigned vbase = lds_addr(lds + PA_V) + tr_lane_off_p<VS>(lane);
        bf16* df = DC + (size_t)(unit * 2) * CT_SLOT + 16 * wave + 4 * kq; bf16* db = df + CT_SLOT;
#pragma unroll
        for (int c = 0; c < 8; ++c) { BFrag bv; tr_load4p<VS>(vbase + 32 * c, bv);
            const f32x4 af = mma_ff((f32x4){0.f, 0.f, 0.f, 0.f}, akf, bv), ab = mma_ff((f32x4){0.f, 0.f, 0.f, 0.f}, akb, bv);
            *(v2u*)(df + (size_t)(16 * c + fr) * 128) = (v2u){pk2(af[0], af[1]), pk2(af[2], af[3])};
            *(v2u*)(db + (size_t)(16 * c + fr) * 128) = (v2u){pk2(ab[0], ab[1]), pk2(ab[2], ab[3])}; }
        { const unsigned onesw = (fr == 0) ? 0x3f803f80u : 0u; BFrag ones;
#pragma unroll
          for (int s_ = 0; s_ < 4; ++s_) ones.f[s_] = __builtin_bit_cast(bf16x8, (v4u){onesw, onesw, onesw, onesw});
          const f32x4 nf = mma_ff((f32x4){0.f, 0.f, 0.f, 0.f}, akf, ones), nb = mma_ff((f32x4){0.f, 0.f, 0.f, 0.f}, akb, ones);
          if (fr == 0) { *(v2u*)(df + (size_t)128 * 128) = (v2u){pk2(nf[0], nf[1]), pk2(nf[2], nf[3])}; *(v2u*)(db + (size_t)128 * 128) = (v2u){pk2(nb[0], nb[1]), pk2(nb[2], nb[3])}; } }
        if (tid == 0) { SC[(unit * 2) * 2] = sm[256]; SC[(unit * 2) * 2 + 1] = sm[257]; SC[(unit * 2 + 1) * 2] = sm[258]; SC[(unit * 2 + 1) * 2 + 1] = sm[259]; }
    }
}

constexpr int F1S = 144, F2S = 80;
__device__ __forceinline__ void fft1_wave(const Args& a, LAS uchar* wl, int item, const bf16x8 (&bfr)[8][2], int lane) {
    const int kq = lane >> 4, fr = lane & 15;
    const int b = item >> 9, chunk = item & 511, cg0 = chunk * 64, n2 = cg0 >> 9, colb = cg0 & 511;
    const bf16* UF = (const bf16*)(a.ws + WS_UF) + (size_t)b * SEQ * 512 + cg0;
    bf16* TP = (bf16*)(a.ws + WS_TP); const float* TW = (const float*)(a.ws + WS_TW);
    v4u ld[8];
#pragma unroll
    for (int i = 0; i < 8; ++i) ld[i] = *(const v4u*)(UF + (size_t)(i * 8 + (lane >> 3)) * 32768 + (lane & 7) * 8);
#pragma unroll
    for (int i = 0; i < 8; ++i) *(LAS v4u*)(wl + (i * 8 + (lane >> 3)) * F1S + (lane & 7) * 16) = ld[i];
    LDS_WAIT();
    const unsigned base = lds_addr(wl) + tr_lane_off<F1S>(lane);
#pragma unroll 1
    for (int mt = 0; mt < 4; ++mt) {
        bf16x8 a0, a1; tr_load2<F1S>(base + 32 * mt, a0, a1);
        f32x4 acc[8];
#pragma unroll
        for (int nt = 0; nt < 8; ++nt) { acc[nt] = __builtin_amdgcn_mfma_f32_16x16x32_bf16(a0, bfr[nt][0], (f32x4){0.f, 0.f, 0.f, 0.f}, 0, 0, 0); acc[nt] = __builtin_amdgcn_mfma_f32_16x16x32_bf16(a1, bfr[nt][1], acc[nt], 0, 0, 0); }
        const int c0 = 16 * mt + 4 * kq, col0 = colb + c0;
#pragma unroll
        for (int nt = 0; nt < 4; ++nt) { const int k1 = 16 * nt + fr; const int idx = (n2 * k1) & 4095; const float cs = TW[idx], sn = TW[(idx - 1024) & 4095];
            float pr[4], pi[4];
#pragma unroll
            for (int r = 0; r < 4; ++r) { const float tr = acc[nt][r], ti = acc[nt + 4][r]; const float xr = tr * cs + ti * sn, xi = ti * cs - tr * sn;
                const bool st = ((col0 + r) & 127) >= 65; pr[r] = st ? -xi : xr; pi[r] = st ? xr : xi; }
            const size_t o = ((size_t)(b * 2) * 64 + k1) * 32768 + (size_t)cg0 + c0;
            *(v2u*)(TP + o) = (v2u){pk2(pr[0], pr[1]), pk2(pr[2], pr[3])};
            *(v2u*)(TP + o + (size_t)64 * 32768) = (v2u){pk2(pi[0], pi[1]), pk2(pi[2], pi[3])}; }
    }
}
__device__ __forceinline__ void fft2_wave(const Args& a, LAS uchar* wl, int item, const bf16x8 (&bfr)[4][4], int lane) {
    const int kq = lane >> 4, fr = lane & 15;
    const int b = item >> 10, k1 = (item >> 4) & 63, chunk = item & 15;
    const bf16* TP = (const bf16*)(a.ws + WS_TP); bf16* YM = (bf16*)(a.ws + WS_YM);
    v4u ld[8];
#pragma unroll
    for (int i = 0; i < 8; ++i) { const int kap = i * 16 + (lane >> 2), ri = kap >> 6, n2 = kap & 63;
        ld[i] = *(const v4u*)(TP + ((size_t)(b * 2 + ri) * 64 + k1) * 32768 + (size_t)n2 * 512 + chunk * 32 + (lane & 3) * 8); }
#pragma unroll
    for (int i = 0; i < 8; ++i) *(LAS v4u*)(wl + (i * 16 + (lane >> 2)) * F2S + (lane & 3) * 16) = ld[i];
    LDS_WAIT();
    const unsigned base = lds_addr(wl) + tr_lane_off<F2S>(lane);
#pragma unroll
    for (int mt = 0; mt < 2; ++mt) {
        BFrag af; tr_load4<F2S>(base + 32 * mt, af);
#pragma unroll
        for (int nt = 0; nt < 4; ++nt) { f32x4 acc = (f32x4){0.f, 0.f, 0.f, 0.f};
#pragma unroll
            for (int s_ = 0; s_ < 4; ++s_) acc = __builtin_amdgcn_mfma_f32_16x16x32_bf16(af.f[s_], bfr[nt][s_], acc, 0, 0, 0);
            const int k2 = 16 * nt + fr; const size_t row = (size_t)b * SEQ + k1 + 64 * k2;
            *(v2u*)(YM + row * 1024 + chunk * 32 + 16 * mt + 4 * kq) = (v2u){pk2(acc[0], acc[1]), pk2(acc[2], acc[3])}; }
    }
}
__device__ __forceinline__ void fft1_phase(const Args& a, LAS uchar* lds, int vcu, int G) {
    const int tid = threadIdx.x, lane = tid & 63, wave = __builtin_amdgcn_readfirstlane(tid >> 6), kq = lane >> 4, fr = lane & 15;
    const bf16* F1 = (const bf16*)(a.ws + WS_F1);
    bf16x8 bfr[8][2];
#pragma unroll
    for (int nt = 0; nt < 8; ++nt)
#pragma unroll
        for (int s_ = 0; s_ < 2; ++s_) bfr[nt][s_] = *(const bf16x8*)(F1 + (16 * nt + fr) * 64 + 32 * s_ + 8 * kq);
    LAS uchar* wl = lds + wave * 9216;
    if (G == 256) {
        const int bx = blockIdx.x;
        if (bx < 64) fft1_wave(a, wl, bx * NWAVES + wave, bfr, lane);
        else for (int it = 512 + (bx - 64) * NWAVES + wave; it < NB * 512; it += 192 * NWAVES) fft1_wave(a, wl, it, bfr, lane);
    } else for (int it = vcu * NWAVES + wave; it < NB * 512; it += G * NWAVES) fft1_wave(a, wl, it, bfr, lane);
}
__device__ __forceinline__ void fft2_phase(const Args& a, LAS uchar* lds, int vcu, int G) {
    const int tid = threadIdx.x, lane = tid & 63, wave = __builtin_amdgcn_readfirstlane(tid >> 6), kq = lane >> 4, fr = lane & 15;
    const bf16* G2 = (const bf16*)(a.ws + WS_G2);
    bf16x8 bfr[4][4];
#pragma unroll
    for (int nt = 0; nt < 4; ++nt)
#pragma unroll
        for (int s_ = 0; s_ < 4; ++s_) bfr[nt][s_] = *(const bf16x8*)(G2 + (16 * nt + fr) * 128 + 32 * s_ + 8 * kq);
    LAS uchar* wl = lds + wave * 10240;
    for (int it = vcu * NWAVES + wave; it < NB * 1024; it += G * NWAVES) fft2_wave(a, wl, it, bfr, lane);
}

__device__ __forceinline__ void p4_scan(const Args& a, int G) {
    uchar* ws = a.ws;
    const bf16* DC = (const bf16*)(ws + WS_DC); const float* SC = (const float*)(ws + WS_SC);
    bf16* CT = (bf16*)(ws + WS_CT); float* MS = (float*)(ws + WS_MS);
    constexpr int F4 = CT_SLOT / 4;
    const int total = 64 * F4;
    for (int gi = blockIdx.x * NTHR + threadIdx.x; gi < total; gi += G * NTHR) {
        const int seq = gi / F4, i = gi - seq * F4; const int bh = seq >> 1, dir = seq & 1;
        v2u dv[34]; f32x2 sc[34];
#pragma unroll
        for (int step = 0; step < 34; ++step) {
            const int unit = (step < 2) ? NUNIT_L + bh * 2 + (dir ? 1 - step : step) : bh * 32 + (dir ? 33 - step : step - 2);
            const int slot = unit * 2 + dir;
            dv[step] = *(const v2u*)(DC + (size_t)slot * CT_SLOT + 4 * i); sc[step] = *(const f32x2*)(SC + slot * 2);
        }
        f32x4 s = (f32x4){0.f, 0.f, 0.f, 0.f}; float m = 0.f;
#pragma unroll
        for (int step = 0; step < 34; ++step) {
            const int unit = (step < 2) ? NUNIT_L + bh * 2 + (dir ? 1 - step : step) : bh * 32 + (dir ? 33 - step : step - 2);
            const int slot = unit * 2 + dir;
            if (step >= 2) { *(v2u*)(CT + (size_t)slot * CT_SLOT + 4 * i) = (v2u){pk2(s.x, s.y), pk2(s.z, s.w)}; if (i == 0) MS[slot] = m; }
            const float bend = sc[step].x, mloc = sc[step].y;
            const float mn = fmaxf(bend + m, mloc), al = __expf(bend + m - mn), be = __expf(mloc - mn);
            s = s * al + bf4(dv[step]) * be; m = mn;
        }
    }
}

constexpr int OU_CF = 0, OU_CB = 33792, OU_V = 67584, OU_K = 104448, OU_SM = 137216;
__device__ __forceinline__ void out_unit(const Args& a, LAS uchar* lds, int unit) {
    int tid_ = threadIdx.x; asm volatile("" : "+v"(tid_)); const int tid = tid_, lane = tid & 63, wave = __builtin_amdgcn_readfirstlane(tid >> 6), kq = lane >> 4, fr = lane & 15;
    uchar* ws = a.ws;
    const int bh = unit >> 5, c = unit & 31, h = bh & 3, row0 = (bh >> 2) * SEQ + c * 128;
    LAS float* sm = (LAS float*)(lds + OU_SM);
    const bf16* Q = (const bf16*)((const uchar*)a.out + DO_Q); const bf16* K = (const bf16*)((const uchar*)a.out + DO_K); const bf16* AB = (const bf16*)((const uchar*)a.out + DO_AB);
    const bf16* V = (const bf16*)(ws + WS_V); const bf16* Z = (const bf16*)(ws + WS_Z);
    const bf16* CT = (const bf16*)(ws + WS_CT); const float* MS = (const float*)(ws + WS_MS);
    bf16* YM = (bf16*)(ws + WS_YM);
    const float m_f = MS[unit * 2], m_b = MS[unit * 2 + 1];
    __syncthreads();
    if (wave < 2) {
        const float* GG = (const float*)(ws + WS_G) + (size_t)row0 * 16 + wave * 8 + h;
        const int j0 = wave ? 127 - 2 * lane : 2 * lane, j1 = wave ? 126 - 2 * lane : 2 * lane + 1;
        const float li0 = GG[j0 * 16], lf0 = logsig_f(GG[j0 * 16 + 4]), li1 = GG[j1 * 16], lf1 = logsig_f(GG[j1 * 16 + 4]);
        const float incl = lane_scan_add(lf0 + lf1, lane);
        const float b0 = incl - lf1, b1 = incl, r0 = li0 - b0, r1 = li1 - b1;
        const float mi = lane_scan_max(fmaxf(r0, r1), lane); float mprev = __shfl_up(mi, 1); if (lane == 0) mprev = -3.0e38f;
        const float R0 = fmaxf(mprev, r0), R1 = mi, mst = wave ? m_b : m_f;
        LAS float* d = sm + wave * 384;
        d[j0] = r0; d[j1] = r1; d[128 + j0] = fmaxf(mst, R0); d[128 + j1] = fmaxf(mst, R1); d[256 + j0] = b0; d[256 + j1] = b1;
    }
    {
        const bf16* sf = CT + (size_t)(unit * 2) * CT_SLOT; const bf16* sb = sf + CT_SLOT;
#pragma unroll
        for (int i = 0; i < 5; ++i) { const int id = tid + NTHR * i; if (id < 129 * 16) { const int row = id >> 4, ch = id & 15;
            *(LAS v4u*)(lds + OU_CF + img_off(row, ch)) = *(const v4u*)(sf + row * 128 + ch * 8); *(LAS v4u*)(lds + OU_CB + img_off(row, ch)) = *(const v4u*)(sb + row * 128 + ch * 8); } }
#pragma unroll
        for (int i = 0; i < 4; ++i) { const int id = tid + NTHR * i, row = id >> 4, ch = id & 15; *(LAS v4u*)(lds + OU_K + img_off(row, ch)) = *(const v4u*)(K + (size_t)(row0 + row) * 512 + h * HD + ch * 8); }
        stage_v128(V, row0, h, lds + OU_V, tid);
    }
    const int l = 16 * wave + fr; const int tok = row0 + l;
    BFrag bq;
#pragma unroll
    for (int s_ = 0; s_ < 4; ++s_) bq.f[s_] = *(const bf16x8*)(Q + (size_t)tok * 512 + h * HD + 32 * s_ + 8 * kq);
    __syncthreads();
    f32x4 S[8];
#pragma unroll
    for (int mt = 0; mt < 8; ++mt) { S[mt] = mma_a((f32x4){0.f, 0.f, 0.f, 0.f}, lds + OU_K, 16 * mt + fr, bq, kq); if (mt & 1) MEMFENCE(); }
    const unsigned vbase = lds_addr(lds + OU_V) + tr_lane_off_p<VS>(lane);
    const unsigned onesw = (fr == 0) ? 0x3f803f80u : 0u; BFrag ones;
#pragma unroll
    for (int s_ = 0; s_ < 4; ++s_) ones.f[s_] = __builtin_bit_cast(bf16x8, (v4u){onesw, onesw, onesw, onesw});
    f32x4 hs[8];
    for (int dir = 0; dir < 2; ++dir) {
        const LAS float* rr = sm + dir * 384; const LAS float* rho = rr + 128; const LAS float* bl = rr + 256;
        const float rho_l = rho[l], mst = dir ? m_b : m_f;
        BFrag bp;
#pragma unroll
        for (int ks = 0; ks < 4; ++ks) { unsigned w[4];
#pragma unroll
            for (int hh = 0; hh < 2; ++hh) { const int mt = 2 * ks + hh; float p[4]; const f32x4 rv = *(const LAS f32x4*)(rr + 16 * mt + 4 * kq);
#pragma unroll
                for (int r = 0; r < 4; ++r) { const int j = 16 * mt + 4 * kq + r; const bool ok = dir ? (j >= l) : (j <= l); p[r] = ok ? S[mt][r] * __expf(fminf(rv[r] - rho_l, 0.f)) : 0.f; }
                w[2 * hh] = pk2(p[0], p[1]); w[2 * hh + 1] = pk2(p[2], p[3]); }
            bp.f[ks] = __builtin_bit_cast(bf16x8, (v4u){w[0], w[1], w[2], w[3]}); }
        f32x4 acc[9];
        const float wi = __expf(mst - rho_l);
        const LAS uchar* cimg = lds + (dir ? OU_CB : OU_CF);
#pragma unroll
        for (int mt = 0; mt < 9; ++mt) { acc[mt] = mma_a((f32x4){0.f, 0.f, 0.f, 0.f}, cimg, 16 * mt + fr, bq, kq) * wi; if (mt & 1) MEMFENCE(); }
#pragma unroll
        for (int mt = 0; mt < 8; ++mt) { BFrag av; tr_load4p<VS>(vbase + 32 * mt, av); acc[mt] = mma_ff(acc[mt], av, bp); }
        acc[8] = mma_ff(acc[8], ones, bp);
        const float den = __shfl(acc[8][0], fr);
        const float sc = 1.0f / fmaxf(fabsf(den), __expf(-bl[l] - rho_l));
#pragma unroll
        for (int mt = 0; mt < 8; ++mt) hs[mt] = dir ? hs[mt] + acc[mt] * sc : acc[mt] * sc;
    }
    float s1 = 0.f;
#pragma unroll
    for (int mt = 0; mt < 8; ++mt) s1 += (hs[mt][0] + hs[mt][1]) + (hs[mt][2] + hs[mt][3]);
    s1 += __shfl_xor(s1, 16); s1 += __shfl_xor(s1, 32);
    const float mu = s1 * (1.0f / 128.0f); float s2 = 0.f;
#pragma unroll
    for (int mt = 0; mt < 8; ++mt) { const f32x4 d = hs[mt] - mu; s2 += (d[0] * d[0] + d[1] * d[1]) + (d[2] * d[2] + d[3] * d[3]); }
    s2 += __shfl_xor(s2, 16); s2 += __shfl_xor(s2, 32);
    const float rstd = rsqrtf(s2 * (1.0f / 128.0f) + EPS);
    const float* mw = a.in[13] + h * HD; const float* msk = a.in[14] + h * HD;
#pragma unroll
    for (int mt = 0; mt < 8; ++mt) { const int e0 = 16 * mt + 4 * kq;
        const f32x4 w = *(const f32x4*)(mw + e0), k4 = *(const f32x4*)(msk + e0);
        const v2u av = *(const v2u*)(AB + (size_t)tok * 512 + h * HD + e0), zv = *(const v2u*)(Z + (size_t)tok * 512 + h * HD + e0);
        const float a4[4] = {bflo(av.x), bfhi(av.x), bflo(av.y), bfhi(av.y)}, z4[4] = {bflo(zv.x), bfhi(zv.x), bflo(zv.y), bfhi(zv.y)};
        float y[4];
#pragma unroll
        for (int r = 0; r < 4; ++r) y[r] = ((hs[mt][r] - mu) * rstd * w[r] + k4[r] * a4[r]) * silu_f(z4[r]);
        *(v2u*)(YM + (size_t)tok * 1024 + 512 + h * HD + e0) = (v2u){pk2(y[0], y[1]), pk2(y[2], y[3])}; MEMFENCE(); }
}

__device__ __forceinline__ void p9_conv(const Args& a, int vcu, int G) {
    const int tid = threadIdx.x, lane = tid & 63, wave = __builtin_amdgcn_readfirstlane(tid >> 6);
    const bf16* U = (const bf16*)(a.ws + WS_U); bf16* ACT = (bf16*)(a.ws + WS_ACT);
    const float* fw = a.in[19]; const float* fb = a.in[20];
    const int gw = vcu * NWAVES + wave, NGW = G * NWAVES;
    const bool xmap = (G == 256);
    for (int k = 0; k < (xmap ? 5 : (NB * 64 * 10 * 2 + NGW - 1) / NGW); ++k) {
        int half, qb, r, b;
        if (xmap) { const int idx = (vcu & 31) * NWAVES + wave + 256 * k; b = vcu >> 5; qb = idx >> 7; r = (idx & 127) >> 1; half = idx & 1; }
        else { const int it = gw + k * NGW; if (it >= NB * 64 * 10 * 2) break; half = it & 1; qb = (it >> 1) % 10; const int br = (it >> 1) / 10; r = br & 63; b = br >> 6; }
        const int ch = (qb * 64 + lane) * 4;
        const float z0 = (r > 0) ? 1.f : 0.f, z2 = (r < 63) ? 1.f : 0.f;
        f32x4 wv[9], wg[9];
#pragma unroll
        for (int t = 0; t < 9; ++t) { const float zz = (t < 3) ? z0 : (t >= 6 ? z2 : 1.f); wv[t] = *(const f32x4*)(fw + t * UPW + ch) * zz; wg[t] = *(const f32x4*)(fw + t * UPW + DFF + ch) * zz; }
        const f32x4 bv = *(const f32x4*)(fb + ch), bgt = *(const f32x4*)(fb + DFF + ch);
        const bf16* rp[3];
        rp[1] = U + ((size_t)(b * 10 + qb) * SEQ + r * 64) * 512 + lane * 4;
        rp[0] = (r > 0) ? rp[1] - (size_t)64 * 512 : rp[1];
        rp[2] = (r < 63) ? rp[1] + (size_t)64 * 512 : rp[1];
        v2u xv[3][6], xg[3][6];
        const int c0 = half * 32;
        { const int cm = (c0 > 0) ? c0 - 1 : 0;
#pragma unroll
          for (int i = 0; i < 3; ++i) { xv[i][0] = *(const v2u*)(rp[i] + (size_t)cm * 512); xg[i][0] = *(const v2u*)(rp[i] + (size_t)cm * 512 + 256);
              xv[i][1] = *(const v2u*)(rp[i] + (size_t)c0 * 512); xg[i][1] = *(const v2u*)(rp[i] + (size_t)c0 * 512 + 256); }
          if (c0 == 0) {
#pragma unroll
              for (int i = 0; i < 3; ++i) { xv[i][0] = (v2u){0u, 0u}; xg[i][0] = (v2u){0u, 0u}; } } }
#pragma unroll 1
        for (int cb = 0; cb < 8; ++cb) {
            const int c = c0 + 4 * cb;
            const int cl = (c + 4 <= 63) ? c + 4 : 63;
#pragma unroll
            for (int i = 0; i < 3; ++i) {
#pragma unroll
                for (int j = 0; j < 3; ++j) { const bf16* p = rp[i] + (size_t)(c + 1 + j) * 512; xv[i][2 + j] = *(const v2u*)p; xg[i][2 + j] = *(const v2u*)(p + 256); }
                const bf16* p = rp[i] + (size_t)cl * 512; xv[i][5] = *(const v2u*)p; xg[i][5] = *(const v2u*)(p + 256);
            }
            if (c + 4 > 63) {
#pragma unroll
                for (int i = 0; i < 3; ++i) { xv[i][5] = (v2u){0u, 0u}; xg[i][5] = (v2u){0u, 0u}; } }
            for (int rp2_ = 0; rp2_ <= ((REP_MASK >> 21) & 1); ++rp2_)
#pragma unroll
            for (int o = 0; o < 4; ++o) {
                f32x4 av = bv, ag = bgt;
#pragma unroll
                for (int i = 0; i < 3; ++i)
#pragma unroll
                    for (int j = 0; j < 3; ++j) { av += wv[i * 3 + j] * bf4(xv[i][o + j]); ag += wg[i * 3 + j] * bf4(xg[i][o + j]); }
                float ov[4];
#pragma unroll
                for (int e = 0; e < 4; ++e) ov[e] = av[e] * silu_f(ag[e]);
                *(v2u*)(ACT + (size_t)(b * SEQ + r * 64 + c + o) * DFF + ch) = (v2u){pk2(ov[0], ov[1]), pk2(ov[2], ov[3])};
            }
#pragma unroll
            for (int i = 0; i < 3; ++i) { xv[i][0] = xv[i][4]; xv[i][1] = xv[i][5]; xg[i][0] = xg[i][4]; xg[i][1] = xg[i][5]; }
        }
    }
}

constexpr int LDS_BYTES = 147456, MISC_OFF = 147456 - 256;
constexpr int NPHASE = 12;
#ifndef MK_PER_PHASE
#define MK_PER_PHASE 0
#endif
__global__ void __launch_bounds__(NTHR, 2) mk_fwd(Args args) {
    extern __shared__ __attribute__((aligned(16))) uchar lds_raw[];
    LAS uchar* lds = (LAS uchar*)lds_raw;
    const int tid = threadIdx.x;
    const int G = gridDim.x; const int bx = blockIdx.x; const int vcu = (G % 8 == 0) ? (bx % 8) * (G / 8) + bx / 8 : bx;
    volatile LAS unsigned* MISC = (volatile LAS unsigned*)(lds + MISC_OFF);
    if (tid < 64) MISC[tid] = 0u;
    __syncthreads();
    XcdBarrier bar; bar.bar = (unsigned*)(args.ws + WS_CTL); bar.x = 0; bar.st = nullptr;
    if (!MK_PER_PHASE) bar = xcd_barrier_post((unsigned*)(args.ws + WS_CTL), MISC + 8);
    const int lo = args.ph_lo, hi = args.ph_hi;
#ifndef PH_MASK
#define PH_MASK 0xFFF
#endif
#define IN(k) (((PH_MASK >> (k)) & 1) && lo <= (k) && (k) < hi)
#define REP(k) for (int rep_ = 0; rep_ <= ((REP_MASK >> (k)) & 1); ++rep_, __syncthreads())
#define SEAM(k) do { if (IN(k) && IN((k) + 1)) { xcd_barrier(bar); if ((REP_MASK >> 20) & 1) { xcd_barrier(bar); xcd_barrier(bar); } } } while (0)
    uchar* ws = args.ws;
    if (IN(0)) { if ((REP_MASK >> 16) & 1) { p0_prologue(args, lds, vcu, G, WS_MOD + 512 * 1024); __syncthreads(); } p0_prologue(args, lds, vcu, G, WS_MOD); } SEAM(0);
    if (IN(1)) REP(1) { p1_rows(args, lds, vcu, G); } SEAM(1);
    if (IN(2)) REP(2) {
        pg8::Gemm g{(const bf16*)(ws + WS_HX), (const bf16*)(ws + WS_WIN), TROWS, 2048, DM}; SchedP2 S; S.init(G, bx);
        EpiP2 E{(bf16*)(ws + WS_UF), (bf16*)(ws + WS_XM), (bf16*)(ws + WS_V), (bf16*)(ws + WS_Z)};
        pg8::gemm_phase<EpiP2, SchedP2, true, true>(lds, g, S, E);
        if (rep_ == 0 && G > 32 && bx >= 32) tr_items(args, lds, TR_EARLY, TR_ALL, (bx - 32) * NWAVES + (tid >> 6), (G - 32) * NWAVES);
    } SEAM(2);
    if (IN(3)) REP(3) {
        for (int rr_ = 0; rr_ <= ((REP_MASK >> 12) & 1); ++rr_) { int cur_h = -1; for (int it = bx; it < NUNIT; it += G) prep_unit(args, lds, it, cur_h); }
        __syncthreads();
        for (int rr_ = 0; rr_ <= ((REP_MASK >> 13) & 1); ++rr_) fft1_phase(args, lds, vcu, G);
    } SEAM(3);
    if (IN(4)) REP(4) {
        for (int rr_ = 0; rr_ <= ((REP_MASK >> 14) & 1); ++rr_) fft2_phase(args, lds, vcu, G);
        for (int rr_ = 0; rr_ <= ((REP_MASK >> 15) & 1); ++rr_) p4_scan(args, G);
    } SEAM(4);
    if (IN(5)) REP(5) { for (int it = bx; it < NUNIT_L; it += G) out_unit(args, lds, it); __syncthreads(); } SEAM(5);
    if (IN(6)) REP(6) {
        pg8::Gemm g{(const bf16*)(ws + WS_YM), (const bf16*)(ws + WS_WOUT), MROWS, DM, 1024}; pg8::StaticOrder S; S.init(MROWS, DM, G, bx);
        EpiGate16 E{(bf16*)args.out, 2048, (const float*)(ws + WS_MOD) + 2048, nullptr};
        pg8::gemm_phase<EpiGate16, pg8::StaticOrder, true, true>(lds, g, S, E);
    } SEAM(6);
    if (IN(7)) REP(7) { p7_rows(args, vcu, G); } SEAM(7);
    if (IN(8)) REP(8) {
        pg8::Gemm g{(const bf16*)(ws + WS_H2), (const bf16*)(ws + WS_WUP), MROWS, UPW, DM}; pg8::StaticOrder S; S.init(MROWS, UPW, G, bx);
        EpiUp E{(bf16*)(ws + WS_U), args.in[18]};
        pg8::gemm_phase<EpiUp, pg8::StaticOrder, true, true>(lds, g, S, E);
    } SEAM(8);
    if (IN(9)) REP(9) { p9_conv(args, vcu, G); } SEAM(9);
    if (IN(10)) {
        pg8::Gemm g{(const bf16*)(ws + WS_ACT), (const bf16*)(ws + WS_WDN), MROWS, DM, DFF}; pg8::StaticOrder S; S.init(MROWS, DM, G, bx);
        EpiGate16 E{(bf16*)(ws + WS_U), 1024, (const float*)(ws + WS_MOD) + 5120, args.in[22]};
        for (int rr_ = 0; rr_ <= ((REP_MASK >> 10) & 1); ++rr_) { if (rr_) __syncthreads(); pg8::gemm_phase<EpiGate16, pg8::StaticOrder, true, true>(lds, g, S, E); }
    } SEAM(10);
    if (IN(11)) { if ((REP_MASK >> 11) & 1) p11_rows(args, vcu, G, (float*)(ws + 0)); p11_rows(args, vcu, G, args.out); }
#undef IN
#undef SEAM
}

extern "C" void kernel_launch(void* const* d_in, const int* in_sizes, int n_in, void* d_out, int out_size, void* d_ws, size_t ws_size, hipStream_t stream) {
    static int grid = 0;
    if (grid == 0) {
        if (n_in != 24 || out_size != MROWS * DM || ws_size < WS_END) { fprintf(stderr, "kernel_launch: unexpected problem (n_in %d, out %d, ws %zu); nothing launched\n", n_in, out_size, ws_size); grid = -1; return; }
        int dev = 0, cus = 0, per_cu = 0;
        if (hipGetDevice(&dev) != hipSuccess || hipDeviceGetAttribute(&cus, hipDeviceAttributeMultiprocessorCount, dev) != hipSuccess) { grid = -1; return; }
        if (hipFuncSetAttribute((const void*)mk_fwd, hipFuncAttributeMaxDynamicSharedMemorySize, LDS_BYTES) != hipSuccess) { fprintf(stderr, "kernel_launch: hipFuncSetAttribute failed\n"); grid = -1; return; }
        if (hipOccupancyMaxActiveBlocksPerMultiprocessor(&per_cu, (const void*)mk_fwd, NTHR, LDS_BYTES) != hipSuccess || per_cu < 1) { fprintf(stderr, "kernel_launch: occupancy query says %d blocks per CU\n", per_cu); grid = -1; (void)hipGetLastError(); return; }
        grid = cus;
    }
    if (grid < 0) return;
    (void)hipMemsetAsync((char*)d_ws + WS_ZERO0, 0, WS_ZERO_BYTES, stream);
    Args a{};
    for (int i = 0; i < 24; ++i) a.in[i] = (const float*)d_in[i];
    a.out = (float*)d_out; a.ws = (uchar*)d_ws;
#if MK_PER_PHASE
    for (int p = 0; p < NPHASE; ++p) { a.ph_lo = p; a.ph_hi = p + 1; hipLaunchKernelGGL(mk_fwd, dim3(grid), dim3(NTHR), LDS_BYTES, stream, a); }
#else
    a.ph_lo = 0; a.ph_hi = NPHASE; hipLaunchKernelGGL(mk_fwd, dim3(grid), dim3(NTHR), LDS_BYTES, stream, a);
#endif
}
```

```cpp
#include <hip/hip_runtime.h>
#include <cstdio>
#include <cstdint>
#ifndef REP_MASK
#define REP_MASK 0
#endif
namespace pg8 {
#define PG8_LAS __attribute__((address_space(3)))
typedef unsigned short bf16_t;
typedef short bf16x8 __attribute__((ext_vector_type(8)));
typedef float f32x4 __attribute__((ext_vector_type(4)));
typedef unsigned u32x4 __attribute__((ext_vector_type(4)));
constexpr int BM = 256, BK = 64, HALF = 128, HTB = HALF * BK * 2  , STAGE_BYTES = 8 * HTB, NXCD = 8, WGM = 8;

__host__ __device__ __forceinline__ int lds_byte(int r, int c) { const int st = (r >> 4) * 2 + (c >> 5), rr = r & 15, cc = c & 31, ob = rr * 64 + cc * 2; return st * 1024 + (ob ^ (((ob >> 9) & 1) << 5)); }
__host__ __device__ __forceinline__ void stage_rc(int b, int& R, int& C) { const int st = b / 1024, sb = b % 1024, swz = sb ^ (((sb >> 9) & 1) << 5); R = (st >> 1) * 16 + swz / 64; C = (st & 1) * 32 + (swz % 64) / 2; }
__host__ __device__ __forceinline__ int perm32(int rho) { const int n = rho >> 4, i = rho & 15; return 8 * (i >> 2) + 4 * n + (i & 3); }

struct Unit { int pm, pn; };
struct Gemm { const bf16_t* A; const bf16_t* Bt; int M, N, K; };

struct StaticOrder {
    int nM, nN, nwg, G, c;
    __host__ __device__ void init(int M, int N, int G_, int c_) { nM = M / BM; nN = N / BM; nwg = nM * nN; G = G_; c = c_; }
    __host__ __device__ bool next(int i, Unit& u) const {
        const long L = (long)i * G + c; if (L >= nwg) return false;
        int wgid = (int)L; { const int q = nwg / NXCD, r = nwg % NXCD, xcd = wgid % NXCD, off = wgid / NXCD; wgid = (xcd < r ? xcd * (q + 1) : r * (q + 1) + (xcd - r) * q) + off; }
        const int nig = WGM * nN, gid = wgid / nig, fm = gid * WGM, gsz = (nM - fm) < WGM ? (nM - fm) : WGM;
        u.pm = fm + ((wgid % nig) % gsz); u.pn = (wgid % nig) / gsz; return true;
    }
    __device__ __forceinline__ void a_ready(const Unit&) const {}
    __device__ __forceinline__ void done(const Unit&) const {}
};
__device__ __forceinline__ unsigned cvt_pk_bf16(float lo, float hi) { unsigned r; asm volatile("v_cvt_pk_bf16_f32 %0, %1, %2" : "=v"(r) : "v"(lo), "v"(hi)); return r; }
template <class Epi, class Sched, bool ALIGN_EPI = false, bool SP2 = false>
__device__ __forceinline__ void gemm_phase(PG8_LAS unsigned char* lds, const Gemm g, const Sched& S, const Epi& E) {
    const int tid = threadIdx.x, wid = __builtin_amdgcn_readfirstlane(tid >> 6), lane = tid & 63, wr = wid >> 2, wc = wid & 3, fr = lane & 15, fq = lane >> 4;
    const int K = g.K, nt = K / BK;
    unsigned voffA[2], voffB[2];
#pragma unroll
    for (int i = 0; i < 2; ++i) { int R, C; stage_rc(tid * 16 + i * 8192, R, C); const int Rb = Epi::PERM ? ((R & ~31) + perm32(R & 31)) : R;
        voffA[i] = (unsigned)(R * K + C) * 2u; voffB[i] = (unsigned)(Rb * K + C) * 2u; }
    const size_t kstep = (size_t)(BK * 2);
    const size_t hstep = (size_t)HALF * K * 2;
    const size_t tstep = 2 * hstep;
    const unsigned ldsw = (unsigned)wid * 1024u;
    const int aoff = lds_byte(wr * 64 + fr, fq * 8), boff = lds_byte(wc * 32 + fr, fq * 8);
#define PG8_SA(b, h) (((b) * 2 + (h)) * HTB)
#define PG8_SB(b, h) ((4 + (b) * 2 + (h)) * HTB)
#define PG8_STAGE(bufoff, gbase, voff) do { _Pragma("unroll") for (int _i = 0; _i < 2; ++_i) \
        __builtin_amdgcn_global_load_lds((const unsigned*)((const char*)(gbase) + (voff)[_i]), (PG8_LAS unsigned*)(lds + (bufoff) + ldsw + _i * 8192), 16, 0, 0); } while (0)
#define PG8_LDA(dst, b, h) do { _Pragma("unroll") for (int m = 0; m < 4; ++m) _Pragma("unroll") for (int k = 0; k < 2; ++k) dst[m][k] = *(const PG8_LAS bf16x8*)(lds + PG8_SA(b, h) + aoff + m * 2048 + k * 1024); } while (0)
#define PG8_LDB(dst, b, h) do { _Pragma("unroll") for (int n = 0; n < 2; ++n) _Pragma("unroll") for (int k = 0; k < 2; ++k) dst[n][k] = *(const PG8_LAS bf16x8*)(lds + PG8_SB(b, h) + boff + n * 2048 + k * 1024); } while (0)
#define PG8_MMA(ai, bj, At, Bt) do { __builtin_amdgcn_s_setprio(1); _Pragma("unroll") for (int m = 0; m < 4; ++m) _Pragma("unroll") for (int n = 0; n < 2; ++n) _Pragma("unroll") for (int k = 0; k < 2; ++k) \
        acc[ai][bj][m][n] = __builtin_amdgcn_mfma_f32_16x16x32_bf16(Bt[n][k], At[m][k], acc[ai][bj][m][n], 0, 0, 0); __builtin_amdgcn_s_setprio(0); } while (0)
#define PG8_WAIT_V(n) asm volatile("s_waitcnt vmcnt(" #n ")" ::: "memory")
#define PG8_WAIT_L(n) asm volatile("s_waitcnt lgkmcnt(" #n ")" ::: "memory")
#define PG8_BAR __builtin_amdgcn_s_barrier()
#define PG8_SCHED __builtin_amdgcn_sched_barrier(0)
    Unit cur, nxt; int ui = 0;
    if (!S.next(0, cur)) return;
    f32x4 acc[2][2][4][2];
#pragma unroll
    for (int a = 0; a < 2; ++a)
#pragma unroll
        for (int b = 0; b < 2; ++b)
#pragma unroll
            for (int m = 0; m < 4; ++m)
#pragma unroll
                for (int n = 0; n < 2; ++n) acc[a][b][m][n] = (f32x4){0.f, 0.f, 0.f, 0.f};
    bf16x8 At[4][2], B0[2][2], B1[2][2];
    const char* cA = (const char*)g.A + (size_t)cur.pm * tstep; const char* cB = (const char*)g.Bt + (size_t)cur.pn * tstep;
    S.a_ready(cur);
    if constexpr (SP2) {
        PG8_STAGE(PG8_SB(0, 0), cB, voffB); PG8_STAGE(PG8_SB(0, 1), cB + hstep, voffB); PG8_STAGE(PG8_SA(0, 0), cA, voffA); PG8_STAGE(PG8_SA(0, 1), cA + hstep, voffA);
        if (wr == 1) PG8_BAR;
        PG8_WAIT_V(2); PG8_BAR;
        PG8_STAGE(PG8_SB(1, 0), cB + kstep, voffB); PG8_STAGE(PG8_SA(1, 0), cA + kstep, voffA); PG8_STAGE(PG8_SB(1, 1), cB + hstep + kstep, voffB);
        PG8_WAIT_V(6); PG8_BAR;
    } else {
        PG8_STAGE(PG8_SB(0, 0), cB, voffB); PG8_STAGE(PG8_SA(0, 0), cA, voffA); PG8_STAGE(PG8_SB(0, 1), cB + hstep, voffB); PG8_STAGE(PG8_SA(0, 1), cA + hstep, voffA);
        if (wr == 1) PG8_BAR;
        PG8_WAIT_V(4); PG8_BAR;
        PG8_STAGE(PG8_SB(1, 0), cB + kstep, voffB); PG8_STAGE(PG8_SA(1, 0), cA + kstep, voffA); PG8_STAGE(PG8_SB(1, 1), cB + hstep + kstep, voffB);
        PG8_WAIT_V(6); PG8_BAR;
    }
    for (;;) {
        const bool has_next = S.next(ui + 1, nxt);
        const char* nA = has_next ? (const char*)g.A + (size_t)nxt.pm * tstep : cA; const char* nB = has_next ? (const char*)g.Bt + (size_t)nxt.pn * tstep : cB;
        for (int t = 0; t < nt; t += 2) {
            const bool last = (t == nt - 2);
            const char* a1 = cA + (size_t)(t + 1) * kstep;
            const char* a2 = last ? nA : cA + (size_t)(t + 2) * kstep; const char* b2 = last ? nB : cB + (size_t)(t + 2) * kstep;
            const char* a3 = a2 + kstep; const char* b3 = b2 + kstep;
            if (last && has_next) S.a_ready(nxt);
            if constexpr (SP2) {
            PG8_LDB(B0, 0, 0); PG8_LDB(B1, 0, 1); PG8_SCHED; PG8_LDA(At, 0, 0); PG8_STAGE(PG8_SA(1, 1), a1 + hstep, voffA);
            PG8_WAIT_V(8); PG8_WAIT_L(0); PG8_BAR; PG8_MMA(0, 0, At, B0); PG8_MMA(0, 1, At, B1); PG8_BAR; PG8_SCHED;
            PG8_LDA(At, 0, 1); PG8_STAGE(PG8_SB(0, 0), b2, voffB); PG8_STAGE(PG8_SB(0, 1), b2 + hstep, voffB); PG8_STAGE(PG8_SA(0, 0), a2, voffA);
            PG8_WAIT_V(8); PG8_WAIT_L(0); PG8_BAR; PG8_MMA(1, 0, At, B0); PG8_MMA(1, 1, At, B1); PG8_BAR; PG8_SCHED;
            PG8_LDB(B0, 1, 0); PG8_LDB(B1, 1, 1); PG8_SCHED; PG8_LDA(At, 1, 0); PG8_STAGE(PG8_SA(0, 1), a2 + hstep, voffA);
            PG8_WAIT_V(8); PG8_WAIT_L(0); PG8_BAR; PG8_MMA(0, 0, At, B0); PG8_MMA(0, 1, At, B1); PG8_BAR; PG8_SCHED;
            PG8_LDA(At, 1, 1); PG8_STAGE(PG8_SB(1, 0), b3, voffB); PG8_STAGE(PG8_SB(1, 1), b3 + hstep, voffB); PG8_STAGE(PG8_SA(1, 0), a3, voffA);
            PG8_WAIT_V(8); PG8_WAIT_L(0); PG8_BAR; PG8_MMA(1, 0, At, B0); PG8_MMA(1, 1, At, B1); PG8_BAR; PG8_SCHED;
            } else {
            PG8_LDB(B0, 0, 0); PG8_SCHED; PG8_LDA(At, 0, 0); PG8_STAGE(PG8_SA(1, 1), a1 + hstep, voffA);
            PG8_WAIT_L(8); PG8_BAR; PG8_WAIT_L(0); PG8_MMA(0, 0, At, B0); PG8_BAR; PG8_SCHED;
            PG8_LDB(B1, 0, 1); PG8_STAGE(PG8_SB(0, 0), b2, voffB);
            PG8_BAR; PG8_WAIT_L(0); PG8_MMA(0, 1, At, B1); PG8_BAR;
            PG8_LDA(At, 0, 1); PG8_STAGE(PG8_SA(0, 0), a2, voffA);
            PG8_BAR; PG8_WAIT_L(0); PG8_MMA(1, 0, At, B0); PG8_BAR; PG8_SCHED;
            PG8_STAGE(PG8_SB(0, 1), b2 + hstep, voffB);
            PG8_WAIT_V(6); PG8_BAR; PG8_MMA(1, 1, At, B1); PG8_BAR;
            PG8_LDB(B0, 1, 0); PG8_SCHED; PG8_LDA(At, 1, 0); PG8_STAGE(PG8_SA(0, 1), a2 + hstep, voffA);
            PG8_WAIT_L(8); PG8_BAR; PG8_WAIT_L(0); PG8_MMA(0, 0, At, B0); PG8_BAR; PG8_SCHED;
            PG8_LDB(B1, 1, 1); PG8_STAGE(PG8_SB(1, 0), b3, voffB);
            PG8_BAR; PG8_WAIT_L(0); PG8_MMA(0, 1, At, B1); PG8_BAR;
            PG8_LDA(At, 1, 1); PG8_STAGE(PG8_SA(1, 0), a3, voffA);
            PG8_BAR; PG8_WAIT_L(0); PG8_MMA(1, 0, At, B0); PG8_BAR; PG8_SCHED;
            PG8_STAGE(PG8_SB(1, 1), b3 + hstep, voffB);
            PG8_WAIT_V(6); PG8_BAR; PG8_MMA(1, 1, At, B1); PG8_BAR;
            }
        }
        if constexpr (ALIGN_EPI) { if (wr == 0) PG8_BAR; }
        if constexpr (!Epi::AFTER_DRAIN) { E(acc, cur, wr, wc, fr, fq); S.done(cur); }
        if (!has_next) break;
#pragma unroll
        for (int a = 0; a < 2; ++a)
#pragma unroll
            for (int b = 0; b < 2; ++b)
#pragma unroll
                for (int m = 0; m < 4; ++m)
#pragma unroll
                    for (int n = 0; n < 2; ++n) acc[a][b][m][n] = (f32x4){0.f, 0.f, 0.f, 0.f};
        cur = nxt; cA = nA; cB = nB; ++ui;
        if constexpr (ALIGN_EPI) { if (wr == 1) PG8_BAR; }
    }
    PG8_WAIT_V(0);
    if constexpr (!ALIGN_EPI) { if (wr == 0) PG8_BAR; }
    PG8_BAR;
    if constexpr (Epi::AFTER_DRAIN) { E.fused(acc, cur, wr, wc, fr, fq, lds, wid, lane); S.done(cur); }
#undef PG8_SA
#undef PG8_SB
#undef PG8_STAGE
#undef PG8_LDA
#undef PG8_LDB
#undef PG8_MMA
#undef PG8_WAIT_V
#undef PG8_WAIT_L
#undef PG8_BAR
#undef PG8_SCHED
}
}

#define GAS __attribute__((address_space(1)))
#define LAS __attribute__((address_space(3)))
typedef unsigned short bf16;
typedef unsigned char uchar;
typedef unsigned v4u __attribute__((ext_vector_type(4)));
typedef unsigned v2u __attribute__((ext_vector_type(2)));
typedef float f32x4 __attribute__((ext_vector_type(4)));
typedef float f32x2 __attribute__((ext_vector_type(2)));
typedef short bf16x8 __attribute__((ext_vector_type(8)));
#define LDS_WAIT() asm volatile("s_waitcnt lgkmcnt(0)" ::: "memory")
#define VM_WAIT() asm volatile("s_waitcnt vmcnt(0)" ::: "memory")

constexpr int NWAVES = 8, NTHR = 512;
constexpr int NB = 8, SEQ = 4096, DM = 1024, CTXL = 256;
constexpr int MROWS = NB * SEQ;
constexpr int CROWS = NB * CTXL;
constexpr int TROWS = MROWS + CROWS;
constexpr int NHEAD = 4, HD = 128, INW = 2064, DFF = 2560, UPW = 5120;
constexpr float EPS = 1e-6f;
constexpr int NUNIT_L = NB * NHEAD * 32, NUNIT_C = NB * NHEAD * 2, NUNIT = NUNIT_L + NUNIT_C;
constexpr int CT_SLOT = 129 * 128;

constexpr size_t MiB = 1u << 20;
constexpr size_t WS_HX = 0, WS_TP = 0, WS_H2 = 0, WS_ACT = 0;
constexpr size_t WS_UF = 68 * MiB, WS_XM = 100 * MiB, WS_CT = 68 * MiB;
constexpr size_t WS_G = 134 * MiB, WS_SC = 137 * MiB, WS_MS = 138 * MiB;
constexpr size_t WS_V = 160 * MiB, WS_Z = 194 * MiB, WS_DC = 226 * MiB, WS_YM = 364 * MiB, WS_U = 160 * MiB;
constexpr size_t WS_WIN = 480 * MiB, WS_WOUT = 484 * MiB, WS_WUP = 486 * MiB, WS_WDN = 496 * MiB, WS_WQ = 501 * MiB, WS_WK = WS_WQ + 131072;
constexpr size_t WS_F1 = 502 * MiB, WS_G2 = WS_F1 + 16384, WS_TW = WS_G2 + 16384;
constexpr size_t WS_MOD = 503 * MiB, WS_CTL = 504 * MiB, WS_ZERO0 = WS_MOD, WS_ZERO_BYTES = 2 * MiB, WS_END = 512 * MiB;
static_assert(WS_DC + (size_t)NUNIT * 2 * CT_SLOT * 4 <= WS_YM && WS_YM + (size_t)MROWS * 1024 * 2 <= WS_U + (size_t)MROWS * UPW * 2 && WS_U + (size_t)MROWS * UPW * 2 <= WS_WIN, "ws map");
static_assert(WS_CT + (size_t)NUNIT_L * 2 * CT_SLOT * 2 <= WS_G && WS_XM + (size_t)TROWS * 512 * 2 <= WS_G && (size_t)MROWS * DFF * 2 <= WS_U, "ws map 2");
constexpr size_t DO_AB = 0, DO_Q = 32 * MiB, DO_K = 64 * MiB;

__device__ __forceinline__ unsigned f2bf(float f) { unsigned u = __builtin_bit_cast(unsigned, f); return (u + 0x7fffu + ((u >> 16) & 1u)) >> 16; }
__device__ __forceinline__ unsigned pk2(float lo, float hi) { return f2bf(lo) | (f2bf(hi) << 16); }
__device__ __forceinline__ float bflo(unsigned w) { return __builtin_bit_cast(float, w << 16); }
__device__ __forceinline__ float bfhi(unsigned w) { return __builtin_bit_cast(float, w & 0xffff0000u); }
__device__ __forceinline__ f32x4 bf4(v2u x) { return (f32x4){bflo(x.x), bfhi(x.x), bflo(x.y), bfhi(x.y)}; }
__device__ __forceinline__ float silu_f(float x) { return x * __builtin_amdgcn_rcpf(1.0f + __expf(-x)); }
__device__ __forceinline__ float logsig_f(float x) { return fminf(x, 0.f) - log1pf(__expf(-fabsf(x))); }
__device__ __forceinline__ float wave_sum(float v) {
#pragma unroll
    for (int o = 1; o < 64; o <<= 1) v += __shfl_xor(v, o);
    return v;
}
__device__ __forceinline__ int img_off(int row, int ch) { return row * 256 + ((ch ^ (row & 15)) << 4); }
struct BFrag { bf16x8 f[4]; };
__device__ __forceinline__ BFrag load_bfrag(const LAS uchar* Bimg, int brow, int kq) { BFrag b;
#pragma unroll
    for (int s = 0; s < 4; ++s) b.f[s] = *(const LAS bf16x8*)(Bimg + img_off(brow, 4 * s + kq));
    return b; }
__device__ __forceinline__ f32x4 mma_a(f32x4 acc, const LAS uchar* Aimg, int arow, const BFrag& b, int kq) {
    bf16x8 a[4];
#pragma unroll
    for (int s = 0; s < 4; ++s) a[s] = *(const LAS bf16x8*)(Aimg + img_off(arow, 4 * s + kq));
#pragma unroll
    for (int s = 0; s < 4; ++s) acc = __builtin_amdgcn_mfma_f32_16x16x32_bf16(a[s], b.f[s], acc, 0, 0, 0);
    return acc; }
#define MEMFENCE() asm volatile("" ::: "memory")


template <int S> __device__ __forceinline__ unsigned tr_lane_off(int lane) { return (unsigned)((8 * (lane >> 4) + ((lane & 15) >> 2)) * S + 8 * (lane & 3)); }
__device__ __forceinline__ unsigned lds_addr(const LAS uchar* p) { return (unsigned)(unsigned long long)p; }
__device__ __forceinline__ bf16x8 pack_frag(v2u lo, v2u hi) { const v4u w = (v4u){lo.x, lo.y, hi.x, hi.y}; return __builtin_bit_cast(bf16x8, w); }
template <int S> __device__ __forceinline__ void tr_load4(unsigned addr, BFrag& f) {
    v2u r0, r1, r2, r3, r4, r5, r6, r7;
    asm volatile("ds_read_b64_tr_b16 %0, %8\n\tds_read_b64_tr_b16 %1, %8 offset:%9\n\tds_read_b64_tr_b16 %2, %8 offset:%10\n\tds_read_b64_tr_b16 %3, %8 offset:%11\n\t"
                 "ds_read_b64_tr_b16 %4, %8 offset:%12\n\tds_read_b64_tr_b16 %5, %8 offset:%13\n\tds_read_b64_tr_b16 %6, %8 offset:%14\n\tds_read_b64_tr_b16 %7, %8 offset:%15\n\ts_waitcnt lgkmcnt(0)"
                 : "=&v"(r0), "=&v"(r1), "=&v"(r2), "=&v"(r3), "=&v"(r4), "=&v"(r5), "=&v"(r6), "=&v"(r7)
                 : "v"(addr), "i"(4 * S), "i"(32 * S), "i"(36 * S), "i"(64 * S), "i"(68 * S), "i"(96 * S), "i"(100 * S) : "memory");
    f.f[0] = pack_frag(r0, r1); f.f[1] = pack_frag(r2, r3); f.f[2] = pack_frag(r4, r5); f.f[3] = pack_frag(r6, r7);
}
template <int S> __device__ __forceinline__ void tr_load2(unsigned addr, bf16x8& f0, bf16x8& f1) {
    v2u r0, r1, r2, r3;
    asm volatile("ds_read_b64_tr_b16 %0, %4\n\tds_read_b64_tr_b16 %1, %4 offset:%5\n\tds_read_b64_tr_b16 %2, %4 offset:%6\n\tds_read_b64_tr_b16 %3, %4 offset:%7\n\ts_waitcnt lgkmcnt(0)"
                 : "=&v"(r0), "=&v"(r1), "=&v"(r2), "=&v"(r3) : "v"(addr), "i"(4 * S), "i"(32 * S), "i"(36 * S) : "memory");
    f0 = pack_frag(r0, r1); f1 = pack_frag(r2, r3);
}
template <int S> __device__ __forceinline__ unsigned tr_lane_off_p(int lane) { return (unsigned)((4 * (lane >> 4) + ((lane & 15) >> 2)) * S + 8 * (lane & 3)); }
template <int S> __device__ __forceinline__ void tr_load4p(unsigned addr, BFrag& f) {
    v2u r0, r1, r2, r3, r4, r5, r6, r7;
    asm volatile("ds_read_b64_tr_b16 %0, %8\n\tds_read_b64_tr_b16 %1, %8 offset:%9\n\tds_read_b64_tr_b16 %2, %8 offset:%10\n\tds_read_b64_tr_b16 %3, %8 offset:%11\n\t"
                 "ds_read_b64_tr_b16 %4, %8 offset:%12\n\tds_read_b64_tr_b16 %5, %8 offset:%13\n\tds_read_b64_tr_b16 %6, %8 offset:%14\n\tds_read_b64_tr_b16 %7, %8 offset:%15\n\ts_waitcnt lgkmcnt(0)"
                 : "=&v"(r0), "=&v"(r1), "=&v"(r2), "=&v"(r3), "=&v"(r4), "=&v"(r5), "=&v"(r6), "=&v"(r7)
                 : "v"(addr), "i"(16 * S), "i"(32 * S), "i"(48 * S), "i"(64 * S), "i"(80 * S), "i"(96 * S), "i"(112 * S) : "memory");
    f.f[0] = pack_frag(r0, r1); f.f[1] = pack_frag(r2, r3); f.f[2] = pack_frag(r4, r5); f.f[3] = pack_frag(r6, r7);
}
__device__ __forceinline__ f32x4 mma_ff(f32x4 acc, const BFrag& a, const BFrag& b) {
#pragma unroll
    for (int s = 0; s < 4; ++s) acc = __builtin_amdgcn_mfma_f32_16x16x32_bf16(a.f[s], b.f[s], acc, 0, 0, 0);
    return acc; }
__device__ __forceinline__ float lane_scan_add(float v, int lane) {
#pragma unroll
    for (int o = 1; o < 64; o <<= 1) { const float t = __shfl_up(v, o); if (lane >= o) v += t; }
    return v; }
__device__ __forceinline__ float lane_scan_max(float v, int lane) {
#pragma unroll
    for (int o = 1; o < 64; o <<= 1) { const float t = __shfl_up(v, o); if (lane >= o) v = fmaxf(v, t); }
    return v; }
__device__ __forceinline__ float wave_max(float v) {
#pragma unroll
    for (int o = 1; o < 64; o <<= 1) v = fmaxf(v, __shfl_xor(v, o));
    return v; }

#define XB_TMO      128
#define XB_XCNT(j)  (256  + 64 * (j))
#define XB_XSUB(j)  (1280 + 64 * (j))
#define XB_XGEN(j)  (2304 + 64 * (j))
#define XB_TOP      3328
#define XB_TOPGEN   3392
#define XCD_BAR_WORDS 3456
#define XB_SPIN_CAP (1u << 18)

__device__ __forceinline__ unsigned xb_ld(unsigned* p)              { return __hip_atomic_load(p, __ATOMIC_RELAXED, __HIP_MEMORY_SCOPE_AGENT); }
__device__ __forceinline__ unsigned xb_add(unsigned* p, unsigned v) { return __hip_atomic_fetch_add(p, v, __ATOMIC_RELAXED, __HIP_MEMORY_SCOPE_AGENT); }
__device__ __forceinline__ unsigned xb_xcc_id() { return (unsigned)__builtin_amdgcn_s_getreg((3 << 11) | 20) & 0xFu; }
#define XB_SPIN(cond, bar) do { unsigned _sp = 0; while (cond) { __builtin_amdgcn_s_sleep(1); \
    if ((++_sp & 255u) == 0u) { if (xb_ld(&(bar)[XB_TMO])) break; if (_sp > XB_SPIN_CAP) { atomicAdd(&(bar)[XB_TMO], 1u); break; } } } } while (0)

struct XcdBarrier {
    unsigned* bar; unsigned x;
    volatile LAS unsigned* st;
};

__device__ __forceinline__ XcdBarrier xcd_barrier_post(unsigned* bar, volatile LAS unsigned* st) {
    XcdBarrier b; b.bar = bar; b.x = xb_xcc_id(); b.st = st;
    if (threadIdx.x == 0) (void)xb_add(&bar[XB_XCNT(b.x)], 1u);
    return b;
}
__device__ __forceinline__ void xcd_barrier_complete(unsigned* bar, unsigned x, unsigned& nloc, unsigned& nx) {
    const unsigned G = gridDim.x * gridDim.y * gridDim.z;
    unsigned sum, cnt, mine, sp = 0u;
    for (;;) {
        sum = 0u; cnt = 0u; mine = 0u;
#pragma unroll
        for (unsigned j = 0; j < 16; ++j) { const unsigned c = xb_ld(&bar[XB_XCNT(j)]); sum += c; cnt += (c > 0u) ? 1u : 0u; mine = (j == x) ? c : mine; }
        if (sum == G) break;
        __builtin_amdgcn_s_sleep(1);
        if ((++sp & 255u) == 0u) { if (xb_ld(&bar[XB_TMO])) break; if (sp > XB_SPIN_CAP) { atomicAdd(&bar[XB_TMO], 1u); break; } }
    }
    nloc = mine > 0u ? mine : 1u; nx = cnt > 0u ? cnt : 1u;
}

__device__ __forceinline__ void xcd_barrier(const XcdBarrier& b) {
    asm volatile("s_waitcnt vmcnt(0)" ::: "memory");
    __syncthreads();
    if (threadIdx.x == 0) {
        unsigned* bar = b.bar;
        __builtin_amdgcn_s_waitcnt(0);
        unsigned nloc = b.st[0], nx = b.st[1];
        if (nloc == 0u) { xcd_barrier_complete(bar, b.x, nloc, nx); b.st[0] = nloc; b.st[1] = nx; }
        const unsigned old = xb_add(&bar[XB_XSUB(b.x)], 1u);
        const unsigned gen = old / nloc;
        if (old + 1u == (gen + 1u) * nloc) {
            __builtin_amdgcn_fence(__ATOMIC_RELEASE, "agent");
            asm volatile("s_waitcnt vmcnt(0)" ::: "memory");
            const unsigned og = xb_add(&bar[XB_TOP], 1u);
            const unsigned tg = og / nx;
            if (og + 1u == (tg + 1u) * nx) xb_add(&bar[XB_TOPGEN], 1u);
            else XB_SPIN(xb_ld(&bar[XB_TOPGEN]) == tg, bar);
            __builtin_amdgcn_fence(__ATOMIC_ACQUIRE, "agent");
            xb_add(&bar[XB_XGEN(b.x)], 1u);
            asm volatile("s_waitcnt vmcnt(0)" ::: "memory");
        } else {
            XB_SPIN(xb_ld(&bar[XB_XGEN(b.x)]) == gen, bar);
            __builtin_amdgcn_fence(__ATOMIC_ACQUIRE, "agent");
            asm volatile("s_waitcnt vmcnt(0)" ::: "memory");
        }
    }
    __syncthreads();
}


struct Args { const float* in[24]; float* out; uchar* ws; int ph_lo, ph_hi; };

template <class F>
__device__ __forceinline__ void tr_item(F src, bf16* WT, size_t drow0, int ldk, int dk0, LAS float* scr, int lane) {
#pragma unroll 4
    for (int i = 0; i < 32; ++i) { const int kk = 2 * i + (lane >> 5); scr[kk * 33 + (lane & 31)] = src(kk, lane & 31); }
    LDS_WAIT(); asm volatile("" ::: "memory");
    const int c = lane & 7;
#pragma unroll
    for (int j = 0; j < 4; ++j) { const int n = (lane >> 3) + 8 * j; const LAS float* s = scr + (8 * c) * 33 + n;
        v4u o; o.x = pk2(s[0 * 33], s[1 * 33]); o.y = pk2(s[2 * 33], s[3 * 33]); o.z = pk2(s[4 * 33], s[5 * 33]); o.w = pk2(s[6 * 33], s[7 * 33]);
        *(v4u*)(WT + (drow0 + n) * ldk + dk0 + 8 * c) = o; }
    LDS_WAIT(); asm volatile("" ::: "memory");
}

constexpr int I_XV = 16 * 32, I_Z = 16 * 16, I_QK = 2 * 4 * 4, I_OF = 8 * 32, I_OM = 8 * 32, I_UP = 16 * 160, I_DN = 40 * 32;
constexpr int TR_EARLY = I_XV + I_Z + 2 * I_QK, TR_ALL = TR_EARLY + I_OF + I_OM + I_UP + I_DN;
__device__ __forceinline__ void tr_items(const Args& a, LAS uchar* lds, int lo, int hi, int gw, int NGW) {
    const int tid = threadIdx.x, lane = tid & 63, wave = __builtin_amdgcn_readfirstlane(tid >> 6);
    uchar* ws = a.ws;
    LAS float* scr = (LAS float*)(lds + wave * 16384);
    const float* w_in = a.in[7]; const float* w_out = a.in[15]; const float* w_up = a.in[17]; const float* w_dn = a.in[21];
    const float* w_q = a.in[10]; const float* w_k = a.in[11];
    bf16* WIN = (bf16*)(ws + WS_WIN); bf16* WOUT = (bf16*)(ws + WS_WOUT); bf16* WUP = (bf16*)(ws + WS_WUP); bf16* WDN = (bf16*)(ws + WS_WDN);
    bf16* WQ = (bf16*)(ws + WS_WQ); bf16* WK = (bf16*)(ws + WS_WK);
    for (int it = lo + gw; it < hi; it += NGW) {
        int r = it;
        if (r < I_XV) { const int kb = r / 32, nb = r % 32, k0 = kb * 64, n0 = nb * 32;
            auto src = [&](int kk, int nn) -> float { return w_in[(size_t)(k0 + kk) * INW + 512 + n0 + nn]; };
            tr_item(src, WIN, (size_t)(512 + n0), DM, k0, scr, lane); continue; } r -= I_XV;
        if (r < I_Z) { const int kb = r / 16, nb = r % 16, k0 = kb * 64, n0 = nb * 32;
            auto src = [&](int kk, int nn) -> float { return w_in[(size_t)(k0 + kk) * INW + 1552 + n0 + nn]; };
            tr_item(src, WIN, (size_t)(1536 + n0), DM, k0, scr, lane); continue; } r -= I_Z;
        if (r < 2 * I_QK) { const bool isk = r >= I_QK; if (isk) r -= I_QK;
            const int h = r / 8, kb = (r % 8) / 4, nb = r % 4, k0 = kb * 64, n0 = nb * 32;
            const float* W = (isk ? w_k : w_q) + (size_t)h * HD * HD; const float sc = isk ? 0.08838834764831845f : 1.0f;
            auto src = [&](int kk, int nn) -> float { return W[(size_t)(k0 + kk) * HD + n0 + nn] * sc; };
            tr_item(src, (isk ? WK : WQ) + (size_t)h * HD * HD, (size_t)n0, HD, k0, scr, lane); continue; } r -= 2 * I_QK;
        if (r < I_OF) { const int kb = r / 32, nb = r % 32, k0 = kb * 64, n0 = nb * 32;
            auto src = [&](int kk, int nn) -> float { const int k = k0 + kk, g = k >> 7, s = k & 127; const float* wo = w_out + (size_t)(g * 128) * DM + n0 + nn;
                if (s == 0 || s == 64) return wo[(size_t)s * DM];
                if (s < 64) return wo[(size_t)s * DM] + wo[(size_t)(128 - s) * DM];
                const int kq = s - 64; return wo[(size_t)(128 - kq) * DM] - wo[(size_t)kq * DM]; };
            tr_item(src, WOUT, (size_t)n0, DM, k0, scr, lane); continue; } r -= I_OF;
        if (r < I_OM) { const int kb = r / 32, nb = r % 32, k0 = kb * 64, n0 = nb * 32;
            auto src = [&](int kk, int nn) -> float { return w_out[(size_t)(512 + k0 + kk) * DM + n0 + nn]; };
            tr_item(src, WOUT, (size_t)n0, DM, 512 + k0, scr, lane); continue; } r -= I_OM;
        if (r < I_UP) { const int kb = r / 160, nb = r % 160, k0 = kb * 64, n0 = nb * 32;
            auto src = [&](int kk, int nn) -> float { return w_up[(size_t)(k0 + kk) * UPW + n0 + nn]; };
            tr_item(src, WUP, (size_t)n0, DM, k0, scr, lane); continue; } r -= I_UP;
        { const int kb = r / 32, nb = r % 32, k0 = kb * 64, n0 = nb * 32;
            auto src = [&](int kk, int nn) -> float { return w_dn[(size_t)(k0 + kk) * DM + n0 + nn]; };
            tr_item(src, WDN, (size_t)n0, DFF, k0, scr, lane); }
    }
}

__device__ __forceinline__ void p0_prologue(const Args& a, LAS uchar* lds, int vcu, int G, size_t mod_off) {
    const int tid = threadIdx.x, lane = tid & 63, wave = __builtin_amdgcn_readfirstlane(tid >> 6);
    uchar* ws = a.ws;
    {
        LAS float* sl = (LAS float*)lds;
        float* MOD = (float*)(ws + mod_off);
        const float* w_ada = a.in[4]; const float* b_ada = a.in[5];
        for (int it = blockIdx.x; it < 32 * 12; it += G) {
            const int kc = it / 12, nb = it % 12;
            __syncthreads();
            if (tid < 288) { const int r = tid >> 5, kk = tid & 31; const float cv = (r < 8) ? a.in[1][r * DM + kc * 32 + kk] : a.in[3][kc * 32 + kk]; sl[tid] = silu_f(cv); }
            __syncthreads();
            const int n = nb * 512 + tid;
            float acc[9];
#pragma unroll
            for (int r = 0; r < 9; ++r) acc[r] = 0.f;
#pragma unroll 8
            for (int kk = 0; kk < 32; ++kk) { const float w = w_ada[(size_t)(kc * 32 + kk) * 6144 + n];
#pragma unroll
                for (int r = 0; r < 9; ++r) acc[r] += sl[r * 32 + kk] * w; }
            const float bb = (kc == 0) ? b_ada[n] : 0.f;
#pragma unroll
            for (int r = 0; r < 9; ++r) atomicAdd(&MOD[r * 6144 + n], acc[r] + bb);
        }
        __syncthreads();
    }
    {
        LAS float* tab = (LAS float*)(lds + 8 * 16384);
        if (tid < 128) tab[tid] = cospif((float)tid * (1.0f / 64.0f)) * 0.08838834764831845f;
        __syncthreads();
        const int gt = blockIdx.x * NTHR + tid;
        bf16* F1 = (bf16*)(ws + WS_F1); bf16* G2 = (bf16*)(ws + WS_G2); float* TW = (float*)(ws + WS_TW);
        if (gt < 8192) { const int row = gt >> 6, n1 = gt & 63, ri = row >> 6, k1 = row & 63; const float ang = (float)((k1 * n1) & 63) * (1.0f / 32.0f);
            F1[gt] = (bf16)f2bf((ri == 0 ? cospif(ang) : -sinpif(ang)) * 0.125f); }
        else if (gt < 16384) { const int i = gt - 8192, k2 = i >> 7, kap = i & 127, n2 = kap & 63; const float ang = (float)((k2 * n2) & 63) * (1.0f / 32.0f);
            G2[i] = (bf16)f2bf((kap < 64 ? cospif(ang) : sinpif(ang)) * 0.125f); }
        else if (gt < 16384 + 4096) { const int i = gt - 16384; TW[i] = cospif((float)i * (1.0f / 2048.0f)); }
    }
    {
        const LAS float* tab = (const LAS float*)(lds + 8 * 16384);
        LAS float* Tm = (LAS float*)lds;
        LAS float* wT = (LAS float*)(lds + 65536);
        const float* w_in = a.in[7]; bf16* WIN = (bf16*)(a.ws + WS_WIN);
        bool have_T = false;
        for (int it = blockIdx.x; it < 64; it += G) {
            const int g = it >> 4, k0 = (it & 15) * 64;
            __syncthreads();
            if (!have_T) { for (int id = tid; id < 128 * 128; id += NTHR) { const int c = id >> 7, s_ = id & 127; const int mult = (s_ <= 64) ? s_ : (s_ - 64), off = (s_ <= 64) ? 0 : 96; Tm[id] = tab[(c * mult + off) & 127]; } have_T = true; }
            for (int id = tid; id < 64 * 32; id += NTHR) { const int kk = id >> 5, c4 = id & 31; const f32x4 v = *(const f32x4*)(w_in + (size_t)(k0 + kk) * INW + g * 128 + 4 * c4);
                wT[(4 * c4 + 0) * 64 + kk] = v.x; wT[(4 * c4 + 1) * 64 + kk] = v.y; wT[(4 * c4 + 2) * 64 + kk] = v.z; wT[(4 * c4 + 3) * 64 + kk] = v.w; }
            __syncthreads();
            const int s4 = (tid & 31) * 4, k4 = (tid >> 5) * 4;
            f32x4 acc[4];
#pragma unroll
            for (int j = 0; j < 4; ++j) acc[j] = (f32x4){0.f, 0.f, 0.f, 0.f};
#pragma unroll 4
            for (int c = 0; c < 128; ++c) { const f32x4 tv = *(const LAS f32x4*)(Tm + c * 128 + s4), wv_ = *(const LAS f32x4*)(wT + c * 64 + k4);
                acc[0] += wv_ * tv.x; acc[1] += wv_ * tv.y; acc[2] += wv_ * tv.z; acc[3] += wv_ * tv.w; }
#pragma unroll
            for (int j = 0; j < 4; ++j) *(v2u*)(WIN + (size_t)(g * 128 + s4 + j) * DM + k0 + k4) = (v2u){pk2(acc[j].x, acc[j].y), pk2(acc[j].z, acc[j].w)};
        }
        __syncthreads();
    }
    tr_items(a, lds, 0, (G > 32) ? TR_EARLY : TR_ALL, vcu * NWAVES + wave, G * NWAVES);
}

__device__ __forceinline__ void p1_rows(const Args& a, LAS uchar* lds, int vcu, int G) {
    const int tid = threadIdx.x, lane = tid & 63, wave = __builtin_amdgcn_readfirstlane(tid >> 6);
    uchar* ws = a.ws;
    {
        LAS f32x4* wg = (LAS f32x4*)lds;
        const float* w_in = a.in[7];
        for (int id = tid; id < 4096; id += NTHR) { const int k = id >> 2, q = id & 3; const int l = (k & 255) >> 2, i = k & 3, j = k >> 8;
            wg[((j * 4 + i) * 4 + q) * 64 + l] = *(const f32x4*)(w_in + (size_t)k * INW + 1536 + 4 * q); }
        __syncthreads();
    }
    const LAS f32x4* wg = (const LAS f32x4*)lds;
    const float* MOD = (const float*)(ws + WS_MOD);
    const float* nw = a.in[6]; const float* bg = a.in[12];
    bf16* HX = (bf16*)(ws + WS_HX); float* GG = (float*)(ws + WS_G);
    const int gw = vcu * NWAVES + wave, NGW = G * NWAVES;
    for (int row = gw; row < TROWS; row += NGW) {
        const float* xr; const float* md;
        if (row < MROWS) { xr = a.in[0] + (size_t)row * DM; md = MOD + (size_t)(row >> 12) * 6144; }
        else { xr = a.in[2] + (size_t)(row - MROWS) * DM; md = MOD + (size_t)8 * 6144; }
        f32x4 v[4]; float s = 0.f;
#pragma unroll
        for (int j = 0; j < 4; ++j) { v[j] = *(const f32x4*)(xr + 4 * lane + 256 * j); s += (v[j].x * v[j].x + v[j].y * v[j].y) + (v[j].z * v[j].z + v[j].w * v[j].w); }
        const float rstd = rsqrtf(wave_sum(s) * (1.0f / DM) + EPS);
        float g[16];
#pragma unroll
        for (int i = 0; i < 16; ++i) g[i] = 0.f;
#pragma unroll
        for (int j = 0; j < 4; ++j) {
            const f32x4 w = *(const f32x4*)(nw + 4 * lane + 256 * j), sh = *(const f32x4*)(md + 4 * lane + 256 * j), sc = *(const f32x4*)(md + 1024 + 4 * lane + 256 * j);
            v[j] = v[j] * rstd * w * (sc + 1.0f) + sh;
            *(v2u*)(HX + (size_t)row * DM + 4 * lane + 256 * j) = (v2u){pk2(v[j].x, v[j].y), pk2(v[j].z, v[j].w)};
        }
#pragma unroll
        for (int j = 0; j < 4; ++j) {
#pragma unroll
            for (int i = 0; i < 4; ++i) {
#pragma unroll
                for (int q = 0; q < 4; ++q) { const f32x4 ww = wg[((j * 4 + i) * 4 + q) * 64 + lane];
                    g[4 * q + 0] += v[j][i] * ww.x; g[4 * q + 1] += v[j][i] * ww.y; g[4 * q + 2] += v[j][i] * ww.z; g[4 * q + 3] += v[j][i] * ww.w; }
                if (i & 1) MEMFENCE(); }
        }
        float g8[8], g4[4], g2[2], g1;
        { const bool hi = (lane & 32) != 0;
#pragma unroll
          for (int i = 0; i < 8; ++i) { const float keep = hi ? g[i + 8] : g[i], send = hi ? g[i] : g[i + 8]; g8[i] = keep + __shfl_xor(send, 32); } }
        { const bool hi = (lane & 16) != 0;
#pragma unroll
          for (int i = 0; i < 4; ++i) { const float keep = hi ? g8[i + 4] : g8[i], send = hi ? g8[i] : g8[i + 4]; g4[i] = keep + __shfl_xor(send, 16); } }
        { const bool hi = (lane & 8) != 0;
#pragma unroll
          for (int i = 0; i < 2; ++i) { const float keep = hi ? g4[i + 2] : g4[i], send = hi ? g4[i] : g4[i + 2]; g2[i] = keep + __shfl_xor(send, 8); } }
        { const bool hi = (lane & 4) != 0; const float keep = hi ? g2[1] : g2[0], send = hi ? g2[0] : g2[1]; g1 = keep + __shfl_xor(send, 4); }
        g1 += __shfl_xor(g1, 2); g1 += __shfl_xor(g1, 1);
        if ((lane & 3) == 0) { const int idx = ((lane & 32) ? 8 : 0) + ((lane & 16) ? 4 : 0) + ((lane & 8) ? 2 : 0) + ((lane & 4) ? 1 : 0); GG[(size_t)row * 16 + idx] = g1 + bg[idx]; }
    }
}
__device__ __forceinline__ void p7_rows(const Args& a, int vcu, int G) {
    const int tid = threadIdx.x, lane = tid & 63, wave = __builtin_amdgcn_readfirstlane(tid >> 6);
    const float* MOD = (const float*)(a.ws + WS_MOD); const float* nw = a.in[16]; bf16* H2 = (bf16*)(a.ws + WS_H2);
    const int gw = vcu * NWAVES + wave, NGW = G * NWAVES;
    for (int row = gw; row < MROWS; row += NGW) {
        const float* xr = a.in[0] + (size_t)row * DM; const float* md = MOD + (size_t)(row >> 12) * 6144; const bf16* y1 = (const bf16*)a.out + (size_t)row * 2048;
        f32x4 v[4]; float s = 0.f;
#pragma unroll
        for (int j = 0; j < 4; ++j) { v[j] = *(const f32x4*)(xr + 4 * lane + 256 * j) + bf4(*(const v2u*)(y1 + 4 * lane + 256 * j)); s += (v[j].x * v[j].x + v[j].y * v[j].y) + (v[j].z * v[j].z + v[j].w * v[j].w); }
        const float rstd = rsqrtf(wave_sum(s) * (1.0f / DM) + EPS);
#pragma unroll
        for (int j = 0; j < 4; ++j) {
            const f32x4 w = *(const f32x4*)(nw + 4 * lane + 256 * j), sh = *(const f32x4*)(md + 3072 + 4 * lane + 256 * j), sc = *(const f32x4*)(md + 4096 + 4 * lane + 256 * j);
            const f32x4 hv = v[j] * rstd * w * (sc + 1.0f) + sh;
            *(v2u*)(H2 + (size_t)row * DM + 4 * lane + 256 * j) = (v2u){pk2(hv.x, hv.y), pk2(hv.z, hv.w)}; }
    }
}
__device__ __forceinline__ void p11_rows(const Args& a, int vcu, int G, float* dst) {
    const int tid = threadIdx.x, lane = tid & 63, wave = __builtin_amdgcn_readfirstlane(tid >> 6);
    const float* nw = a.in[23];
    const int gw = vcu * NWAVES + wave, NGW = G * NWAVES;
    for (int row = gw; row < MROWS; row += NGW) {
        const float* xr = a.in[0] + (size_t)row * DM; const bf16* y1 = (const bf16*)a.out + (size_t)row * 2048; const bf16* d2 = (const bf16*)(a.ws + WS_U) + (size_t)row * DM;
        f32x4 v[4]; float s = 0.f;
#pragma unroll
        for (int j = 0; j < 4; ++j) { v[j] = *(const f32x4*)(xr + 4 * lane + 256 * j) + bf4(*(const v2u*)(y1 + 4 * lane + 256 * j)) + bf4(*(const v2u*)(d2 + 4 * lane + 256 * j)); s += (v[j].x * v[j].x + v[j].y * v[j].y) + (v[j].z * v[j].z + v[j].w * v[j].w); }
        const float rstd = rsqrtf(wave_sum(s) * (1.0f / DM) + EPS);
#pragma unroll
        for (int j = 0; j < 4; ++j) { const f32x4 w = *(const f32x4*)(nw + 4 * lane + 256 * j); *(f32x4*)(dst + (size_t)row * DM + 4 * lane + 256 * j) = v[j] * rstd * w; }
    }
}

struct SchedP2 {
    pg8::StaticOrder so;
    __device__ void init(int G, int c) { so.init(MROWS, 2048, G, c); }
    __device__ bool next(int i, pg8::Unit& u) const {
        const long L = (long)i * so.G + so.c;
        if (L < so.nwg) return so.next(i, u);
        const int r = (int)(L - so.nwg); if (r >= 32) return false;
        u.pm = 128 + (r & 7); u.pn = 2 + (r >> 3); return true;
    }
    __device__ __forceinline__ void a_ready(const pg8::Unit&) const {}
    __device__ __forceinline__ void done(const pg8::Unit&) const {}
};
struct EpiP2 {
    static constexpr bool PERM = true, AFTER_DRAIN = false;
    bf16 *base0, *base1, *base2, *base3;
    __device__ __forceinline__ void operator()(const f32x4 (&acc)[2][2][4][2], const pg8::Unit& u, int wr, int wc, int fr, int fq) const {
        const int row0 = u.pm * 256 + wr * 64 + fr; const int sel = u.pn >> 1; bf16* O = sel == 0 ? base0 : (sel == 1 ? base1 : (sel == 2 ? base2 : base3)); const int col0 = (u.pn & 1) * 256 + wc * 32 + 8 * fq;
#pragma unroll
        for (int ai = 0; ai < 2; ++ai)
#pragma unroll
            for (int m = 0; m < 4; ++m) { bf16* rowp = O + (size_t)(row0 + ai * 128 + m * 16) * 512 + col0;
#pragma unroll
                for (int bj = 0; bj < 2; ++bj) { const f32x4 v0 = acc[ai][bj][m][0], v1 = acc[ai][bj][m][1];
                    v4u w; w.x = pg8::cvt_pk_bf16(v0[0], v0[1]); w.y = pg8::cvt_pk_bf16(v0[2], v0[3]); w.z = pg8::cvt_pk_bf16(v1[0], v1[1]); w.w = pg8::cvt_pk_bf16(v1[2], v1[3]);
                    *(v4u*)(rowp + bj * 128) = w; } }
    }
};
struct EpiBias16 {
    static constexpr bool PERM = true, AFTER_DRAIN = false;
    bf16* O; int ldc; const float* bias;
    __device__ __forceinline__ void operator()(const f32x4 (&acc)[2][2][4][2], const pg8::Unit& u, int wr, int wc, int fr, int fq) const {
        const int row0 = u.pm * 256 + wr * 64 + fr; const int col0 = u.pn * 256 + wc * 32 + 8 * fq;
        f32x4 bv[2][2];
#pragma unroll
        for (int bj = 0; bj < 2; ++bj)
#pragma unroll
            for (int n = 0; n < 2; ++n) bv[bj][n] = *(const f32x4*)(bias + col0 + bj * 128 + 4 * n);
#pragma unroll
        for (int ai = 0; ai < 2; ++ai)
#pragma unroll
            for (int m = 0; m < 4; ++m) { bf16* rowp = O + (size_t)(row0 + ai * 128 + m * 16) * ldc + col0;
#pragma unroll
                for (int bj = 0; bj < 2; ++bj) { const f32x4 v0 = acc[ai][bj][m][0] + bv[bj][0], v1 = acc[ai][bj][m][1] + bv[bj][1];
                    v4u w; w.x = pg8::cvt_pk_bf16(v0[0], v0[1]); w.y = pg8::cvt_pk_bf16(v0[2], v0[3]); w.z = pg8::cvt_pk_bf16(v1[0], v1[1]); w.w = pg8::cvt_pk_bf16(v1[2], v1[3]);
                    *(v4u*)(rowp + bj * 128) = w; } }
    }
};
struct EpiUp {
    static constexpr bool PERM = true, AFTER_DRAIN = false;
    bf16* O; const float* bias;
    __device__ __forceinline__ void operator()(const f32x4 (&acc)[2][2][4][2], const pg8::Unit& u, int wr, int wc, int fr, int fq) const {
        const int row0 = u.pm * 256 + wr * 64 + fr; const int col0 = u.pn * 256 + wc * 32 + 8 * fq;
        const int isg = u.pn >= 10 ? 1 : 0, qb = u.pn - 10 * isg, b = row0 >> 12;
        bf16* base = O + ((size_t)(b * 10 + qb) * SEQ) * 512 + isg * 256 + wc * 32 + 8 * fq;
        f32x4 bv[2][2];
#pragma unroll
        for (int bj = 0; bj < 2; ++bj)
#pragma unroll
            for (int n = 0; n < 2; ++n) bv[bj][n] = *(const f32x4*)(bias + col0 + bj * 128 + 4 * n);
#pragma unroll
        for (int ai = 0; ai < 2; ++ai)
#pragma unroll
            for (int m = 0; m < 4; ++m) { bf16* rowp = base + (size_t)((row0 + ai * 128 + m * 16) & (SEQ - 1)) * 512;
#pragma unroll
                for (int bj = 0; bj < 2; ++bj) { const f32x4 v0 = acc[ai][bj][m][0] + bv[bj][0], v1 = acc[ai][bj][m][1] + bv[bj][1];
                    v4u w; w.x = pg8::cvt_pk_bf16(v0[0], v0[1]); w.y = pg8::cvt_pk_bf16(v0[2], v0[3]); w.z = pg8::cvt_pk_bf16(v1[0], v1[1]); w.w = pg8::cvt_pk_bf16(v1[2], v1[3]);
                    *(v4u*)(rowp + bj * 128) = w; } }
    }
};
struct EpiGate16 {
    static constexpr bool PERM = true, AFTER_DRAIN = false;
    bf16* O; int ldc; const float* gate; const float* bias;
    __device__ __forceinline__ void operator()(const f32x4 (&acc)[2][2][4][2], const pg8::Unit& u, int wr, int wc, int fr, int fq) const {
        const int row0 = u.pm * 256 + wr * 64 + fr; const int col0 = u.pn * 256 + wc * 32 + 8 * fq;
        const float* gp = gate + (size_t)((u.pm * 256) >> 12) * 6144 + col0;
        f32x4 gv[2][2], bv[2][2];
#pragma unroll
        for (int bj = 0; bj < 2; ++bj)
#pragma unroll
            for (int n = 0; n < 2; ++n) { gv[bj][n] = *(const f32x4*)(gp + bj * 128 + 4 * n); bv[bj][n] = bias ? *(const f32x4*)(bias + col0 + bj * 128 + 4 * n) : (f32x4){0.f, 0.f, 0.f, 0.f}; }
#pragma unroll
        for (int ai = 0; ai < 2; ++ai)
#pragma unroll
            for (int m = 0; m < 4; ++m) { bf16* rowp = O + (size_t)(row0 + ai * 128 + m * 16) * ldc + col0;
#pragma unroll
                for (int bj = 0; bj < 2; ++bj) { const f32x4 v0 = gv[bj][0] * (acc[ai][bj][m][0] + bv[bj][0]), v1 = gv[bj][1] * (acc[ai][bj][m][1] + bv[bj][1]);
                    v4u w; w.x = pg8::cvt_pk_bf16(v0[0], v0[1]); w.y = pg8::cvt_pk_bf16(v0[2], v0[3]); w.z = pg8::cvt_pk_bf16(v1[0], v1[1]); w.w = pg8::cvt_pk_bf16(v1[2], v1[3]);
                    *(v4u*)(rowp + bj * 128) = w; } }
    }
};
struct EpiRes {
    static constexpr bool PERM = false, AFTER_DRAIN = false;
    const float* res; float* out; const float* gate; const float* bias;
    __device__ __forceinline__ void operator()(const f32x4 (&acc)[2][2][4][2], const pg8::Unit& u, int wr, int wc, int fr, int fq) const {
        const int row0 = u.pm * 256 + wr * 64 + fr, col0 = u.pn * 256 + wc * 32 + 4 * fq;
        const float* gp = gate + (size_t)((u.pm * 256) >> 12) * 6144 + col0;
        f32x4 gv[2][2], bv[2][2];
#pragma unroll
        for (int bj = 0; bj < 2; ++bj)
#pragma unroll
            for (int n = 0; n < 2; ++n) { gv[bj][n] = *(const f32x4*)(gp + bj * 128 + n * 16); bv[bj][n] = bias ? *(const f32x4*)(bias + col0 + bj * 128 + n * 16) : (f32x4){0.f, 0.f, 0.f, 0.f}; }
#pragma unroll
        for (int ai = 0; ai < 2; ++ai)
#pragma unroll
            for (int m = 0; m < 4; ++m) { const size_t off = (size_t)(row0 + ai * 128 + m * 16) * DM + col0;
#pragma unroll
                for (int bj = 0; bj < 2; ++bj)
#pragma unroll
                    for (int n = 0; n < 2; ++n) { const f32x4 r = *(const f32x4*)(res + off + bj * 128 + n * 16);
                        *(f32x4*)(out + off + bj * 128 + n * 16) = r + gv[bj][n] * (acc[ai][bj][m][n] + bv[bj][n]); }
                if (m & 1) asm volatile("" ::: "memory"); }
    }
};

constexpr int PA_WQ = 0, PA_WK = 32768, PA_A = 65536, PA_V = 98304, PA_SM = 135168, VS = 288;
__device__ __forceinline__ void unit_decode(int unit, int& bh, int& row0, int& t0, int& L) {
    if (unit < NUNIT_L) { bh = unit >> 5; const int c = unit & 31; row0 = (bh >> 2) * SEQ + c * 128; t0 = c * 128; L = SEQ; }
    else { const int uc = unit - NUNIT_L; bh = uc >> 1; const int cc = uc & 1; row0 = MROWS + (bh >> 2) * CTXL + cc * 128; t0 = cc * 128; L = CTXL; }
}
__device__ __forceinline__ void stage_v128(const bf16* V, int row0, int h, LAS uchar* img, int tid) {
    const int j = tid >> 2, seg = tid & 3; const bf16* vr = V + (size_t)(row0 + j) * 512 + h * HD + seg * 32;
#pragma unroll
    for (int i = 0; i < 4; ++i) *(LAS v4u*)(img + j * VS + (seg * 32 + 8 * i) * 2) = *(const v4u*)(vr + 8 * i);
}
__device__ __forceinline__ void prep_unit(const Args& a, LAS uchar* lds, int unit, int& cur_h) {
    int tid_ = threadIdx.x; asm volatile("" : "+v"(tid_)); const int tid = tid_, lane = tid & 63, wave = __builtin_amdgcn_readfirstlane(tid >> 6), kq = lane >> 4, fr = lane & 15;
    uchar* ws = a.ws;
    int bh, row0, t0, L; unit_decode(unit, bh, row0, t0, L);
    const int h = bh & 3; const bool latent = unit < NUNIT_L;
    LAS float* sm = (LAS float*)(lds + PA_SM);
    const bf16* XM = (const bf16*)(ws + WS_XM); const bf16* V = (const bf16*)(ws + WS_V);
    bf16* AB = (bf16*)((uchar*)a.out + DO_AB); bf16* Q = (bf16*)((uchar*)a.out + DO_Q); bf16* K = (bf16*)((uchar*)a.out + DO_K);
    __syncthreads();
    if (cur_h != h) {
        const bf16* WQ = (const bf16*)(ws + WS_WQ) + (size_t)h * HD * HD; const bf16* WK = (const bf16*)(ws + WS_WK) + (size_t)h * HD * HD;
#pragma unroll
        for (int i = 0; i < 4; ++i) { const int id = tid + NTHR * i, row = id >> 4, ch = id & 15;
            *(LAS v4u*)(lds + PA_WQ + img_off(row, ch)) = *(const v4u*)(WQ + row * 128 + ch * 8); *(LAS v4u*)(lds + PA_WK + img_off(row, ch)) = *(const v4u*)(WK + row * 128 + ch * 8); }
        cur_h = h;
    }
    if (wave < 2) {
        const float* GG = (const float*)(ws + WS_G) + (size_t)row0 * 16 + wave * 8 + h;
        const int j0 = wave ? 127 - 2 * lane : 2 * lane, j1 = wave ? 126 - 2 * lane : 2 * lane + 1;
        const float li0 = GG[j0 * 16], lf0 = logsig_f(GG[j0 * 16 + 4]), li1 = GG[j1 * 16], lf1 = logsig_f(GG[j1 * 16 + 4]);
        const float incl = lane_scan_add(lf0 + lf1, lane), total = __shfl(incl, 63);
        const float g0 = total - (incl - lf1) + li0, g1 = total - incl + li1;
        const float mx = wave_max(fmaxf(g0, g1));
        sm[wave * 128 + j0] = __expf(g0 - mx); sm[wave * 128 + j1] = __expf(g1 - mx);
        if (lane == 0) { sm[256 + 2 * wave] = total; sm[257 + 2 * wave] = mx; }
    }
    for (int rp_ = 0; rp_ <= ((REP_MASK >> 17) & 1); ++rp_) {
        if (rp_) __syncthreads();
        const int l = tid >> 2, seg = tid & 3, t = t0 + l; const int colg = h * HD + seg * 32;
        const bool hp = t > 0, hn = t + 1 < L;
        const bf16* xc = XM + (size_t)(row0 + l) * 512 + colg;
        const float* cw = a.in[8] + colg; const float* cb = a.in[9] + colg;
#pragma unroll
        for (int i = 0; i < 4; ++i) {
            const v4u c = *(const v4u*)(xc + 8 * i); v4u p = (v4u){0u, 0u, 0u, 0u}, n = (v4u){0u, 0u, 0u, 0u};
            if (hp) p = *(const v4u*)(xc - 512 + 8 * i);
            if (hn) n = *(const v4u*)(xc + 512 + 8 * i);
            float o[8];
#pragma unroll
            for (int hf = 0; hf < 2; ++hf) {
                const f32x4 w0 = *(const f32x4*)(cw + 8 * i + 4 * hf), w1 = *(const f32x4*)(cw + 512 + 8 * i + 4 * hf), w2 = *(const f32x4*)(cw + 1024 + 8 * i + 4 * hf), bb = *(const f32x4*)(cb + 8 * i + 4 * hf);
                const f32x4 xp = bf4((v2u){p[2 * hf], p[2 * hf + 1]}), xcv = bf4((v2u){c[2 * hf], c[2 * hf + 1]}), xn = bf4((v2u){n[2 * hf], n[2 * hf + 1]});
                const f32x4 y = w0 * xp + w1 * xcv + w2 * xn + bb;
#pragma unroll
                for (int e = 0; e < 4; ++e) o[4 * hf + e] = silu_f(y[e]); }
            const v4u w = (v4u){pk2(o[0], o[1]), pk2(o[2], o[3]), pk2(o[4], o[5]), pk2(o[6], o[7])};
            *(LAS v4u*)(lds + PA_A + img_off(l, seg * 4 + i)) = w;
            if (latent) *(v4u*)(AB + (size_t)(row0 + l) * 512 + colg + 8 * i) = w;
        }
    }
    stage_v128(V, row0, h, lds + PA_V, tid);
    __syncthreads();
    if (latent) {
        const BFrag ba = load_bfrag(lds + PA_A, 16 * wave + fr, kq);
        const size_t tok = (size_t)(row0 + 16 * wave + fr);
#pragma unroll 1
        for (int pass = 0; pass < 2; ++pass) {
            const LAS uchar* wimg = lds + (pass ? PA_WK : PA_WQ);
            bf16* dst = (pass ? K : Q) + tok * 512 + h * HD + 4 * kq;
#pragma unroll
            for (int mt = 0; mt < 8; ++mt) { const f32x4 acc = mma_a((f32x4){0.f, 0.f, 0.f, 0.f}, wimg, 16 * mt + fr, ba, kq);
                *(v2u*)(dst + 16 * mt) = (v2u){pk2(acc[0], acc[1]), pk2(acc[2], acc[3])}; if (mt & 1) MEMFENCE(); }
        }
    }
    f32x4 kacc[8];
    { const BFrag bk = load_bfrag(lds + PA_WK, 16 * wave + fr, kq);
#pragma unroll
      for (int mt = 0; mt < 8; ++mt) { kacc[mt] = mma_a((f32x4){0.f, 0.f, 0.f, 0.f}, lds + PA_A, 16 * mt + fr, bk, kq); if (mt & 1) MEMFENCE(); } }
    {
        bf16* DC = (bf16*)(ws + WS_DC); float* SC = (float*)(ws + WS_SC);
        BFrag akf, akb;
#pragma unroll
        for (int ks = 0; ks < 4; ++ks) { unsigned wf_[4], wb_[4];
#pragma unroll
            for (int hh = 0; hh < 2; ++hh) { const int mt = 2 * ks + hh; const f32x4 wf4 = *(const LAS f32x4*)(sm + 16 * mt + 4 * kq), wb4 = *(const LAS f32x4*)(sm + 128 + 16 * mt + 4 * kq);
                const f32x4 kf = kacc[mt] * wf4, kb = kacc[mt] * wb4;
                wf_[2 * hh] = pk2(kf[0], kf[1]); wf_[2 * hh + 1] = pk2(kf[2], kf[3]); wb_[2 * hh] = pk2(kb[0], kb[1]); wb_[2 * hh + 1] = pk2(kb[2], kb[3]); }
            akf.f[ks] = __builtin_bit_cast(bf16x8, (v4u){wf_[0], wf_[1], wf_[2], wf_[3]}); akb.f[ks] = __builtin_bit_cast(bf16x8, (v4u){wb_[0], wb_[1], wb_[2], wb_[3]}); }
        const unsigned vbase = lds_addr(lds + PA_V) + tr_lane_off_p<VS>(lane);
        bf16* df = DC + (size_t)(unit * 2) * CT_SLOT + 16 * wave + 4 * kq; bf16* db = df + CT_SLOT;
#pragma unroll
        for (int c = 0; c < 8; ++c) { BFrag bv; tr_load4p<VS>(vbase + 32 * c, bv);
            const f32x4 af = mma_ff((f32x4){0.f, 0.f, 0.f, 0.f}, akf, bv), ab = mma_ff((f32x4){0.f, 0.f, 0.f, 0.f}, akb, bv);
            *(v2u*)(df + (size_t)(16 * c + fr) * 128) = (v2u){pk2(af[0], af[1]), pk2(af[2], af[3])};
            *(v2u*)(db + (size_t)(16 * c + fr) * 128) = (v2u){pk2(ab[0], ab[1]), pk2(ab[2], ab[3])}; }
        { const unsigned onesw = (fr == 0) ? 0x3f803f80u : 0u; BFrag ones;
#pragma unroll
          for (int s_ = 0; s_ < 4; ++s_) ones.f[s_] = __builtin_bit_cast(bf16x8, (v4u){onesw, onesw, onesw, onesw});
          const f32x4 nf = mma_ff((f32x4){0.f, 0.f, 0.f, 0.f}, akf, ones), nb = mma_ff((f32x4){0.f, 0.f, 0.f, 0.f}, akb, ones);
          if (fr == 0) { *(v2u*)(df + (size_t)128 * 128) = (v2u){pk2(nf[0], nf[1]), pk2(nf[2], nf[3])}; *(v2u*)(db + (size_t)128 * 128) = (v2u){pk2(nb[0], nb[1]), pk2(nb[2], nb[3])}; } }
        if (tid == 0) { SC[(unit * 2) * 2] = sm[256]; SC[(unit * 2) * 2 + 1] = sm[257]; SC[(unit * 2 + 1) * 2] = sm[258]; SC[(unit * 2 + 1) * 2 + 1] = sm[259]; }
    }
}

constexpr int F1S = 144, F2S = 80;
__device__ __forceinline__ void fft1_wave(const Args& a, LAS uchar* wl, int item, const bf16x8 (&bfr)[8][2], int lane) {
    const int kq = lane >> 4, fr = lane & 15;
    const int b = item >> 9, chunk = item & 511, cg0 = chunk * 64, n2 = cg0 >> 9, colb = cg0 & 511;
    const bf16* UF = (const bf16*)(a.ws + WS_UF) + (size_t)b * SEQ * 512 + cg0;
    bf16* TP = (bf16*)(a.ws + WS_TP); const float* TW = (const float*)(a.ws + WS_TW);
    v4u ld[8];
#pragma unroll
    for (int i = 0; i < 8; ++i) ld[i] = *(const v4u*)(UF + (size_t)(i * 8 + (lane >> 3)) * 32768 + (lane & 7) * 8);
#pragma unroll
    for (int i = 0; i < 8; ++i) *(LAS v4u*)(wl + (i * 8 + (lane >> 3)) * F1S + (lane & 7) * 16) = ld[i];
    LDS_WAIT();
    const unsigned base = lds_addr(wl) + tr_lane_off<F1S>(lane);
#pragma unroll 1
    for (int mt = 0; mt < 4; ++mt) {
        bf16x8 a0, a1; tr_load2<F1S>(base + 32 * mt, a0, a1);
        f32x4 acc[8];
#pragma unroll
        for (int nt = 0; nt < 8; ++nt) { acc[nt] = __builtin_amdgcn_mfma_f32_16x16x32_bf16(a0, bfr[nt][0], (f32x4){0.f, 0.f, 0.f, 0.f}, 0, 0, 0); acc[nt] = __builtin_amdgcn_mfma_f32_16x16x32_bf16(a1, bfr[nt][1], acc[nt], 0, 0, 0); }
        const int c0 = 16 * mt + 4 * kq, col0 = colb + c0;
#pragma unroll
        for (int nt = 0; nt < 4; ++nt) { const int k1 = 16 * nt + fr; const int idx = (n2 * k1) & 4095; const float cs = TW[idx], sn = TW[(idx - 1024) & 4095];
            float pr[4], pi[4];
#pragma unroll
            for (int r = 0; r < 4; ++r) { const float tr = acc[nt][r], ti = acc[nt + 4][r]; const float xr = tr * cs + ti * sn, xi = ti * cs - tr * sn;
                const bool st = ((col0 + r) & 127) >= 65; pr[r] = st ? -xi : xr; pi[r] = st ? xr : xi; }
            const size_t o = ((size_t)(b * 2) * 64 + k1) * 32768 + (size_t)cg0 + c0;
            *(v2u*)(TP + o) = (v2u){pk2(pr[0], pr[1]), pk2(pr[2], pr[3])};
            *(v2u*)(TP + o + (size_t)64 * 32768) = (v2u){pk2(pi[0], pi[1]), pk2(pi[2], pi[3])}; }
    }
}
__device__ __forceinline__ void fft2_wave(const Args& a, LAS uchar* wl, int item, const bf16x8 (&bfr)[4][4], int lane) {
    const int kq = lane >> 4, fr = lane & 15;
    const int b = item >> 10, k1 = (item >> 4) & 63, chunk = item & 15;
    const bf16* TP = (const bf16*)(a.ws + WS_TP); bf16* YM = (bf16*)(a.ws + WS_YM);
    v4u ld[8];
#pragma unroll
    for (int i = 0; i < 8; ++i) { const int kap = i * 16 + (lane >> 2), ri = kap >> 6, n2 = kap & 63;
        ld[i] = *(const v4u*)(TP + ((size_t)(b * 2 + ri) * 64 + k1) * 32768 + (size_t)n2 * 512 + chunk * 32 + (lane & 3) * 8); }
#pragma unroll
    for (int i = 0; i < 8; ++i) *(LAS v4u*)(wl + (i * 16 + (lane >> 2)) * F2S + (lane & 3) * 16) = ld[i];
    LDS_WAIT();
    const unsigned base = lds_addr(wl) + tr_lane_off<F2S>(lane);
#pragma unroll
    for (int mt = 0; mt < 2; ++mt) {
        BFrag af; tr_load4<F2S>(base + 32 * mt, af);
#pragma unroll
        for (int nt = 0; nt < 4; ++nt) { f32x4 acc = (f32x4){0.f, 0.f, 0.f, 0.f};
#pragma unroll
            for (int s_ = 0; s_ < 4; ++s_) acc = __builtin_amdgcn_mfma_f32_16x16x32_bf16(af.f[s_], bfr[nt][s_], acc, 0, 0, 0);
            const int k2 = 16 * nt + fr; const size_t row = (size_t)b * SEQ + k1 + 64 * k2;
            *(v2u*)(YM + row * 1024 + chunk * 32 + 16 * mt + 4 * kq) = (v2u){pk2(acc[0], acc[1]), pk2(acc[2], acc[3])}; }
    }
}
__device__ __forceinline__ void fft1_phase(const Args& a, LAS uchar* lds, int vcu, int G) {
    const int tid = threadIdx.x, lane = tid & 63, wave = __builtin_amdgcn_readfirstlane(tid >> 6), kq = lane >> 4, fr = lane & 15;
    const bf16* F1 = (const bf16*)(a.ws + WS_F1);
    bf16x8 bfr[8][2];
#pragma unroll
    for (int nt = 0; nt < 8; ++nt)
#pragma unroll
        for (int s_ = 0; s_ < 2; ++s_) bfr[nt][s_] = *(const bf16x8*)(F1 + (16 * nt + fr) * 64 + 32 * s_ + 8 * kq);
    LAS uchar* wl = lds + wave * 9216;
    if (G == 256) {
        const int bx = blockIdx.x;
        if (bx < 64) fft1_wave(a, wl, bx * NWAVES + wave, bfr, lane);
        else for (int it = 512 + (bx - 64) * NWAVES + wave; it < NB * 512; it += 192 * NWAVES) fft1_wave(a, wl, it, bfr, lane);
    } else for (int it = vcu * NWAVES + wave; it < NB * 512; it += G * NWAVES) fft1_wave(a, wl, it, bfr, lane);
}
__device__ __forceinline__ void fft2_phase(const Args& a, LAS uchar* lds, int vcu, int G) {
    const int tid = threadIdx.x, lane = tid & 63, wave = __builtin_amdgcn_readfirstlane(tid >> 6), kq = lane >> 4, fr = lane & 15;
    const bf16* G2 = (const bf16*)(a.ws + WS_G2);
    bf16x8 bfr[4][4];
#pragma unroll
    for (int nt = 0; nt < 4; ++nt)
#pragma unroll
        for (int s_ = 0; s_ < 4; ++s_) bfr[nt][s_] = *(const bf16x8*)(G2 + (16 * nt + fr) * 128 + 32 * s_ + 8 * kq);
    LAS uchar* wl = lds + wave * 10240;
    for (int it = vcu * NWAVES + wave; it < NB * 1024; it += G * NWAVES) fft2_wave(a, wl, it, bfr, lane);
}

__device__ __forceinline__ void p4_scan(const Args& a, int G) {
    uchar* ws = a.ws;
    const bf16* DC = (const bf16*)(ws + WS_DC); const float* SC = (const float*)(ws + WS_SC);
    bf16* CT = (bf16*)(ws + WS_CT); float* MS = (float*)(ws + WS_MS);
    constexpr int F4 = CT_SLOT / 4;
    const int total = 64 * F4;
    for (int gi = blockIdx.x * NTHR + threadIdx.x; gi < total; gi += G * NTHR) {
        const int seq = gi / F4, i = gi - seq * F4; const int bh = seq >> 1, dir = seq & 1;
        v2u dv[34]; f32x2 sc[34];
#pragma unroll
        for (int step = 0; step < 34; ++step) {
            const int unit = (step < 2) ? NUNIT_L + bh * 2 + (dir ? 1 - step : step) : bh * 32 + (dir ? 33 - step : step - 2);
            const int slot = unit * 2 + dir;
            dv[step] = *(const v2u*)(DC + (size_t)slot * CT_SLOT + 4 * i); sc[step] = *(const f32x2*)(SC + slot * 2);
        }
        f32x4 s = (f32x4){0.f, 0.f, 0.f, 0.f}; float m = 0.f;
#pragma unroll
        for (int step = 0; step < 34; ++step) {
            const int unit = (step < 2) ? NUNIT_L + bh * 2 + (dir ? 1 - step : step) : bh * 32 + (dir ? 33 - step : step - 2);
            const int slot = unit * 2 + dir;
            if (step >= 2) { *(v2u*)(CT + (size_t)slot * CT_SLOT + 4 * i) = (v2u){pk2(s.x, s.y), pk2(s.z, s.w)}; if (i == 0) MS[slot] = m; }
            const float bend = sc[step].x, mloc = sc[step].y;
            const float mn = fmaxf(bend + m, mloc), al = __expf(bend + m - mn), be = __expf(mloc - mn);
            s = s * al + bf4(dv[step]) * be; m = mn;
        }
    }
}

constexpr int OU_CF = 0, OU_CB = 33792, OU_V = 67584, OU_K = 104448, OU_SM = 137216;
__device__ __forceinline__ void out_unit(const Args& a, LAS uchar* lds, int unit) {
    int tid_ = threadIdx.x; asm volatile("" : "+v"(tid_)); const int tid = tid_, lane = tid & 63, wave = __builtin_amdgcn_readfirstlane(tid >> 6), kq = lane >> 4, fr = lane & 15;
    uchar* ws = a.ws;
    const int bh = unit >> 5, c = unit & 31, h = bh & 3, row0 = (bh >> 2) * SEQ + c * 128;
    LAS float* sm = (LAS float*)(lds + OU_SM);
    const bf16* Q = (const bf16*)((const uchar*)a.out + DO_Q); const bf16* K = (const bf16*)((const uchar*)a.out + DO_K); const bf16* AB = (const bf16*)((const uchar*)a.out + DO_AB);
    const bf16* V = (const bf16*)(ws + WS_V); const bf16* Z = (const bf16*)(ws + WS_Z);
    const bf16* CT = (const bf16*)(ws + WS_CT); const float* MS = (const float*)(ws + WS_MS);
    bf16* YM = (bf16*)(ws + WS_YM);
    const float m_f = MS[unit * 2], m_b = MS[unit * 2 + 1];
    __syncthreads();
    if (wave < 2) {
        const float* GG = (const float*)(ws + WS_G) + (size_t)row0 * 16 + wave * 8 + h;
        const int j0 = wave ? 127 - 2 * lane : 2 * lane, j1 = wave ? 126 - 2 * lane : 2 * lane + 1;
        const float li0 = GG[j0 * 16], lf0 = logsig_f(GG[j0 * 16 + 4]), li1 = GG[j1 * 16], lf1 = logsig_f(GG[j1 * 16 + 4]);
        const float incl = lane_scan_add(lf0 + lf1, lane);
        const float b0 = incl - lf1, b1 = incl, r0 = li0 - b0, r1 = li1 - b1;
        const float mi = lane_scan_max(fmaxf(r0, r1), lane); float mprev = __shfl_up(mi, 1); if (lane == 0) mprev = -3.0e38f;
        const float R0 = fmaxf(mprev, r0), R1 = mi, mst = wave ? m_b : m_f;
        LAS float* d = sm + wave * 384;
        d[j0] = r0; d[j1] = r1; d[128 + j0] = fmaxf(mst, R0); d[128 + j1] = fmaxf(mst, R1); d[256 + j0] = b0; d[256 + j1] = b1;
    }
    {
        const bf16* sf = CT + (size_t)(unit * 2) * CT_SLOT; const bf16* sb = sf + CT_SLOT;
#pragma unroll
        for (int i = 0; i < 5; ++i) { const int id = tid + NTHR * i; if (id < 129 * 16) { const int row = id >> 4, ch = id & 15;
            *(LAS v4u*)(lds + OU_CF + img_off(row, ch)) = *(const v4u*)(sf + row * 128 + ch * 8); *(LAS v4u*)(lds + OU_CB + img_off(row, ch)) = *(const v4u*)(sb + row * 128 + ch * 8); } }
#pragma unroll
        for (int i = 0; i < 4; ++i) { const int id = tid + NTHR * i, row = id >> 4, ch = id & 15; *(LAS v4u*)(lds + OU_K + img_off(row, ch)) = *(const v4u*)(K + (size_t)(row0 + row) * 512 + h * HD + ch * 8); }
        stage_v128(V, row0, h, lds + OU_V, tid);
    }
    const int l = 16 * wave + fr; const int tok = row0 + l;
    BFrag bq;
#pragma unroll
    for (int s_ = 0; s_ < 4; ++s_) bq.f[s_] = *(const bf16x8*)(Q + (size_t)tok * 512 + h * HD + 32 * s_ + 8 * kq);
    __syncthreads();
    f32x4 S[8];
#pragma unroll
    for (int mt = 0; mt < 8; ++mt) { S[mt] = mma_a((f32x4){0.f, 0.f, 0.f, 0.f}, lds + OU_K, 16 * mt + fr, bq, kq); if (mt & 1) MEMFENCE(); }
    const unsigned vbase = lds_addr(lds + OU_V) + tr_lane_off_p<VS>(lane);
    const unsigned onesw = (fr == 0) ? 0x3f803f80u : 0u; BFrag ones;
#pragma unroll
    for (int s_ = 0; s_ < 4; ++s_) ones.f[s_] = __builtin_bit_cast(bf16x8, (v4u){onesw, onesw, onesw, onesw});
    f32x4 hs[8];
    for (int dir = 0; dir < 2; ++dir) {
        const LAS float* rr = sm + dir * 384; const LAS float* rho = rr + 128; const LAS float* bl = rr + 256;
        const float rho_l = rho[l], mst = dir ? m_b : m_f;
        BFrag bp;
#pragma unroll
        for (int ks = 0; ks < 4; ++ks) { unsigned w[4];
#pragma unroll
            for (int hh = 0; hh < 2; ++hh) { const int mt = 2 * ks + hh; float p[4]; const f32x4 rv = *(const LAS f32x4*)(rr + 16 * mt + 4 * kq);
#pragma unroll
                for (int r = 0; r < 4; ++r) { const int j = 16 * mt + 4 * kq + r; const bool ok = dir ? (j >= l) : (j <= l); p[r] = ok ? S[mt][r] * __expf(fminf(rv[r] - rho_l, 0.f)) : 0.f; }
                w[2 * hh] = pk2(p[0], p[1]); w[2 * hh + 1] = pk2(p[2], p[3]); }
            bp.f[ks] = __builtin_bit_cast(bf16x8, (v4u){w[0], w[1], w[2], w[3]}); }
        f32x4 acc[9];
        const float wi = __expf(mst - rho_l);
        const LAS uchar* cimg = lds + (dir ? OU_CB : OU_CF);
#pragma unroll
        for (int mt = 0; mt < 9; ++mt) { acc[mt] = mma_a((f32x4){0.f, 0.f, 0.f, 0.f}, cimg, 16 * mt + fr, bq, kq) * wi; if (mt & 1) MEMFENCE(); }
#pragma unroll
        for (int mt = 0; mt < 8; ++mt) { BFrag av; tr_load4p<VS>(vbase + 32 * mt, av); acc[mt] = mma_ff(acc[mt], av, bp); }
        acc[8] = mma_ff(acc[8], ones, bp);
        const float den = __shfl(acc[8][0], fr);
        const float sc = 1.0f / fmaxf(fabsf(den), __expf(-bl[l] - rho_l));
#pragma unroll
        for (int mt = 0; mt < 8; ++mt) hs[mt] = dir ? hs[mt] + acc[mt] * sc : acc[mt] * sc;
    }
    float s1 = 0.f;
#pragma unroll
    for (int mt = 0; mt < 8; ++mt) s1 += (hs[mt][0] + hs[mt][1]) + (hs[mt][2] + hs[mt][3]);
    s1 += __shfl_xor(s1, 16); s1 += __shfl_xor(s1, 32);
    const float mu = s1 * (1.0f / 128.0f); float s2 = 0.f;
#pragma unroll
    for (int mt = 0; mt < 8; ++mt) { const f32x4 d = hs[mt] - mu; s2 += (d[0] * d[0] + d[1] * d[1]) + (d[2] * d[2] + d[3] * d[3]); }
    s2 += __shfl_xor(s2, 16); s2 += __shfl_xor(s2, 32);
    const float rstd = rsqrtf(s2 * (1.0f / 128.0f) + EPS);
    const float* mw = a.in[13] + h * HD; const float* msk = a.in[14] + h * HD;
#pragma unroll
    for (int mt = 0; mt < 8; ++mt) { const int e0 = 16 * mt + 4 * kq;
        const f32x4 w = *(const f32x4*)(mw + e0), k4 = *(const f32x4*)(msk + e0);
        const v2u av = *(const v2u*)(AB + (size_t)tok * 512 + h * HD + e0), zv = *(const v2u*)(Z + (size_t)tok * 512 + h * HD + e0);
        const float a4[4] = {bflo(av.x), bfhi(av.x), bflo(av.y), bfhi(av.y)}, z4[4] = {bflo(zv.x), bfhi(zv.x), bflo(zv.y), bfhi(zv.y)};
        float y[4];
#pragma unroll
        for (int r = 0; r < 4; ++r) y[r] = ((hs[mt][r] - mu) * rstd * w[r] + k4[r] * a4[r]) * silu_f(z4[r]);
        *(v2u*)(YM + (size_t)tok * 1024 + 512 + h * HD + e0) = (v2u){pk2(y[0], y[1]), pk2(y[2], y[3])}; MEMFENCE(); }
}

__device__ __forceinline__ void p9_conv(const Args& a, int vcu, int G) {
    const int tid = threadIdx.x, lane = tid & 63, wave = __builtin_amdgcn_readfirstlane(tid >> 6);
    const bf16* U = (const bf16*)(a.ws + WS_U); bf16* ACT = (bf16*)(a.ws + WS_ACT);
    const float* fw = a.in[19]; const float* fb = a.in[20];
    const int gw = vcu * NWAVES + wave, NGW = G * NWAVES;
    const int hk = lane >> 5, li = lane & 31;
    const bool xmap = (G == 256);
    for (int k = 0; k < (xmap ? 5 : (NB * 64 * 10 * 2 + NGW - 1) / NGW); ++k) {
        int half, qb, r, b;
        if (xmap) { const int idx = (vcu & 31) * NWAVES + wave + 256 * k; b = vcu >> 5; qb = idx >> 7; r = (idx & 127) >> 1; half = idx & 1; }
        else { const int it = gw + k * NGW; if (it >= NB * 64 * 10 * 2) break; half = it & 1; qb = (it >> 1) % 10; const int br = (it >> 1) / 10; r = br & 63; b = br >> 6; }
        const int ch = hk * DFF + qb * 256 + 8 * li;
        const float z0 = (r > 0) ? 1.f : 0.f, z2 = (r < 63) ? 1.f : 0.f;
        f32x4 w0[9], w1[9];
#pragma unroll
        for (int t = 0; t < 9; ++t) { const float zz = (t < 3) ? z0 : (t >= 6 ? z2 : 1.f); w0[t] = *(const f32x4*)(fw + t * UPW + ch) * zz; w1[t] = *(const f32x4*)(fw + t * UPW + ch + 4) * zz; }
        const f32x4 b0 = *(const f32x4*)(fb + ch), b1 = *(const f32x4*)(fb + ch + 4);
        const bf16* rp[3];
        rp[1] = U + ((size_t)(b * 10 + qb) * SEQ + r * 64) * 512 + lane * 8;
        rp[0] = (r > 0) ? rp[1] - (size_t)64 * 512 : rp[1];
        rp[2] = (r < 63) ? rp[1] + (size_t)64 * 512 : rp[1];
        v4u x[3][6];
        const int c0 = half * 32;
        { const int cm = (c0 > 0) ? c0 - 1 : 0;
#pragma unroll
          for (int i = 0; i < 3; ++i) { x[i][0] = *(const v4u*)(rp[i] + (size_t)cm * 512); x[i][1] = *(const v4u*)(rp[i] + (size_t)c0 * 512); }
          if (c0 == 0) {
#pragma unroll
              for (int i = 0; i < 3; ++i) x[i][0] = (v4u){0u, 0u, 0u, 0u}; } }
        bf16* orow = ACT + (size_t)(b * SEQ + r * 64) * DFF + qb * 256 + 8 * li + 4 * hk;
#pragma unroll 1
        for (int cb = 0; cb < 8; ++cb) {
            const int c = c0 + 4 * cb;
            const int cl = (c + 4 <= 63) ? c + 4 : 63;
#pragma unroll
            for (int i = 0; i < 3; ++i) {
#pragma unroll
                for (int j = 0; j < 3; ++j) x[i][2 + j] = *(const v4u*)(rp[i] + (size_t)(c + 1 + j) * 512);
                x[i][5] = *(const v4u*)(rp[i] + (size_t)cl * 512);
            }
            if (c + 4 > 63) {
#pragma unroll
                for (int i = 0; i < 3; ++i) x[i][5] = (v4u){0u, 0u, 0u, 0u}; }
#pragma unroll
            for (int o = 0; o < 4; ++o) {
                f32x4 a0 = b0, a1 = b1;
#pragma unroll
                for (int i = 0; i < 3; ++i)
#pragma unroll
                    for (int j = 0; j < 3; ++j) { const v4u xx = x[i][o + j]; a0 += w0[i * 3 + j] * bf4((v2u){xx.x, xx.y}); a1 += w1[i * 3 + j] * bf4((v2u){xx.z, xx.w}); }
                f32x4 snd = hk ? a0 : a1, rcv;
#pragma unroll
                for (int e = 0; e < 4; ++e) rcv[e] = __shfl_xor(snd[e], 32);
                float ov[4];
#pragma unroll
                for (int e = 0; e < 4; ++e) ov[e] = hk ? rcv[e] * silu_f(a1[e]) : a0[e] * silu_f(rcv[e]);
                *(v2u*)(orow + (size_t)(c + o) * DFF) = (v2u){pk2(ov[0], ov[1]), pk2(ov[2], ov[3])};
            }
#pragma unroll
            for (int i = 0; i < 3; ++i) { x[i][0] = x[i][4]; x[i][1] = x[i][5]; }
        }
    }
}

constexpr int LDS_BYTES = 147456, MISC_OFF = 147456 - 256;
constexpr int NPHASE = 12;
#ifndef MK_PER_PHASE
#define MK_PER_PHASE 0
#endif
__global__ void __launch_bounds__(NTHR, 2) mk_fwd(Args args) {
    extern __shared__ __attribute__((aligned(16))) uchar lds_raw[];
    LAS uchar* lds = (LAS uchar*)lds_raw;
    const int tid = threadIdx.x;
    const int G = gridDim.x; const int bx = blockIdx.x; const int vcu = (G % 8 == 0) ? (bx % 8) * (G / 8) + bx / 8 : bx;
    volatile LAS unsigned* MISC = (volatile LAS unsigned*)(lds + MISC_OFF);
    if (tid < 64) MISC[tid] = 0u;
    __syncthreads();
    XcdBarrier bar; bar.bar = (unsigned*)(args.ws + WS_CTL); bar.x = 0; bar.st = nullptr;
    if (!MK_PER_PHASE) bar = xcd_barrier_post((unsigned*)(args.ws + WS_CTL), MISC + 8);
    const int lo = args.ph_lo, hi = args.ph_hi;
#ifndef PH_MASK
#define PH_MASK 0xFFF
#endif
#define IN(k) (((PH_MASK >> (k)) & 1) && lo <= (k) && (k) < hi)
#define REP(k) for (int rep_ = 0; rep_ <= ((REP_MASK >> (k)) & 1); ++rep_, __syncthreads())
#define SEAM(k) do { if (IN(k) && IN((k) + 1)) { xcd_barrier(bar); if ((REP_MASK >> 20) & 1) { xcd_barrier(bar); xcd_barrier(bar); } } } while (0)
    uchar* ws = args.ws;
    if (IN(0)) { if ((REP_MASK >> 16) & 1) { p0_prologue(args, lds, vcu, G, WS_MOD + 512 * 1024); __syncthreads(); } p0_prologue(args, lds, vcu, G, WS_MOD); } SEAM(0);
    if (IN(1)) REP(1) { p1_rows(args, lds, vcu, G); } SEAM(1);
    if (IN(2)) REP(2) {
        pg8::Gemm g{(const bf16*)(ws + WS_HX), (const bf16*)(ws + WS_WIN), TROWS, 2048, DM}; SchedP2 S; S.init(G, bx);
        EpiP2 E{(bf16*)(ws + WS_UF), (bf16*)(ws + WS_XM), (bf16*)(ws + WS_V), (bf16*)(ws + WS_Z)};
        pg8::gemm_phase<EpiP2, SchedP2, true, true>(lds, g, S, E);
        if (rep_ == 0 && G > 32 && bx >= 32) tr_items(args, lds, TR_EARLY, TR_ALL, (bx - 32) * NWAVES + (tid >> 6), (G - 32) * NWAVES);
    } SEAM(2);
    if (IN(3)) REP(3) {
        for (int rr_ = 0; rr_ <= ((REP_MASK >> 12) & 1); ++rr_) { int cur_h = -1; for (int it = bx; it < NUNIT; it += G) prep_unit(args, lds, it, cur_h); }
        __syncthreads();
        for (int rr_ = 0; rr_ <= ((REP_MASK >> 13) & 1); ++rr_) fft1_phase(args, lds, vcu, G);
    } SEAM(3);
    if (IN(4)) REP(4) {
        for (int rr_ = 0; rr_ <= ((REP_MASK >> 14) & 1); ++rr_) fft2_phase(args, lds, vcu, G);
        for (int rr_ = 0; rr_ <= ((REP_MASK >> 15) & 1); ++rr_) p4_scan(args, G);
    } SEAM(4);
    if (IN(5)) REP(5) { for (int it = bx; it < NUNIT_L; it += G) out_unit(args, lds, it); __syncthreads(); } SEAM(5);
    if (IN(6)) REP(6) {
        pg8::Gemm g{(const bf16*)(ws + WS_YM), (const bf16*)(ws + WS_WOUT), MROWS, DM, 1024}; pg8::StaticOrder S; S.init(MROWS, DM, G, bx);
        EpiGate16 E{(bf16*)args.out, 2048, (const float*)(ws + WS_MOD) + 2048, nullptr};
        pg8::gemm_phase<EpiGate16, pg8::StaticOrder, true, true>(lds, g, S, E);
    } SEAM(6);
    if (IN(7)) REP(7) { p7_rows(args, vcu, G); } SEAM(7);
    if (IN(8)) REP(8) {
        pg8::Gemm g{(const bf16*)(ws + WS_H2), (const bf16*)(ws + WS_WUP), MROWS, UPW, DM}; pg8::StaticOrder S; S.init(MROWS, UPW, G, bx);
        EpiUp E{(bf16*)(ws + WS_U), args.in[18]};
        pg8::gemm_phase<EpiUp, pg8::StaticOrder, true, true>(lds, g, S, E);
    } SEAM(8);
    if (IN(9)) REP(9) { p9_conv(args, vcu, G); } SEAM(9);
    if (IN(10)) {
        pg8::Gemm g{(const bf16*)(ws + WS_ACT), (const bf16*)(ws + WS_WDN), MROWS, DM, DFF}; pg8::StaticOrder S; S.init(MROWS, DM, G, bx);
        EpiGate16 E{(bf16*)(ws + WS_U), 1024, (const float*)(ws + WS_MOD) + 5120, args.in[22]};
        for (int rr_ = 0; rr_ <= ((REP_MASK >> 10) & 1); ++rr_) { if (rr_) __syncthreads(); pg8::gemm_phase<EpiGate16, pg8::StaticOrder, true, true>(lds, g, S, E); }
    } SEAM(10);
    if (IN(11)) { if ((REP_MASK >> 11) & 1) p11_rows(args, vcu, G, (float*)(ws + 0)); p11_rows(args, vcu, G, args.out); }
#undef IN
#undef SEAM
}

extern "C" void kernel_launch(void* const* d_in, const int* in_sizes, int n_in, void* d_out, int out_size, void* d_ws, size_t ws_size, hipStream_t stream) {
    static int grid = 0;
    if (grid == 0) {
        if (n_in != 24 || out_size != MROWS * DM || ws_size < WS_END) { fprintf(stderr, "kernel_launch: unexpected problem (n_in %d, out %d, ws %zu); nothing launched\n", n_in, out_size, ws_size); grid = -1; return; }
        int dev = 0, cus = 0, per_cu = 0;
        if (hipGetDevice(&dev) != hipSuccess || hipDeviceGetAttribute(&cus, hipDeviceAttributeMultiprocessorCount, dev) != hipSuccess) { grid = -1; return; }
        if (hipFuncSetAttribute((const void*)mk_fwd, hipFuncAttributeMaxDynamicSharedMemorySize, LDS_BYTES) != hipSuccess) { fprintf(stderr, "kernel_launch: hipFuncSetAttribute failed\n"); grid = -1; return; }
        if (hipOccupancyMaxActiveBlocksPerMultiprocessor(&per_cu, (const void*)mk_fwd, NTHR, LDS_BYTES) != hipSuccess || per_cu < 1) { fprintf(stderr, "kernel_launch: occupancy query says %d blocks per CU\n", per_cu); grid = -1; (void)hipGetLastError(); return; }
        grid = cus;
    }
    if (grid < 0) return;
    (void)hipMemsetAsync((char*)d_ws + WS_ZERO0, 0, WS_ZERO_BYTES, stream);
    Args a{};
    for (int i = 0; i < 24; ++i) a.in[i] = (const float*)d_in[i];
    a.out = (float*)d_out; a.ws = (uchar*)d_ws;
#if MK_PER_PHASE
    for (int p = 0; p < NPHASE; ++p) { a.ph_lo = p; a.ph_hi = p + 1; hipLaunchKernelGGL(mk_fwd, dim3(grid), dim3(NTHR), LDS_BYTES, stream, a); }
#else
    a.ph_lo = 0; a.ph_hi = NPHASE; hipLaunchKernelGGL(mk_fwd, dim3(grid), dim3(NTHR), LDS_BYTES, stream, a);
#endif
}
```

```cpp
#include <hip/hip_runtime.h>
#include <cstdio>
#include <cstdint>
#ifndef REP_MASK
#define REP_MASK 0
#endif
#ifndef TP_SEL
#define TP_SEL 0
#endif
namespace pg8 {
#define PG8_LAS __attribute__((address_space(3)))
typedef unsigned short bf16_t;
typedef short bf16x8 __attribute__((ext_vector_type(8)));
typedef float f32x4 __attribute__((ext_vector_type(4)));
typedef unsigned u32x4 __attribute__((ext_vector_type(4)));
constexpr int BM = 256, BK = 64, HALF = 128, HTB = HALF * BK * 2  , STAGE_BYTES = 8 * HTB, NXCD = 8, WGM = 8;

__host__ __device__ __forceinline__ int lds_byte(int r, int c) { const int st = (r >> 4) * 2 + (c >> 5), rr = r & 15, cc = c & 31, ob = rr * 64 + cc * 2; return st * 1024 + (ob ^ (((ob >> 9) & 1) << 5)); }
__host__ __device__ __forceinline__ void stage_rc(int b, int& R, int& C) { const int st = b / 1024, sb = b % 1024, swz = sb ^ (((sb >> 9) & 1) << 5); R = (st >> 1) * 16 + swz / 64; C = (st & 1) * 32 + (swz % 64) / 2; }
__host__ __device__ __forceinline__ int perm32(int rho) { const int n = rho >> 4, i = rho & 15; return 8 * (i >> 2) + 4 * n + (i & 3); }

struct Unit { int pm, pn; };
struct Gemm { const bf16_t* A; const bf16_t* Bt; int M, N, K; };

struct StaticOrder {
    int nM, nN, nwg, G, c;
    __host__ __device__ void init(int M, int N, int G_, int c_) { nM = M / BM; nN = N / BM; nwg = nM * nN; G = G_; c = c_; }
    __host__ __device__ bool next(int i, Unit& u) const {
        const long L = (long)i * G + c; if (L >= nwg) return false;
        int wgid = (int)L; { const int q = nwg / NXCD, r = nwg % NXCD, xcd = wgid % NXCD, off = wgid / NXCD; wgid = (xcd < r ? xcd * (q + 1) : r * (q + 1) + (xcd - r) * q) + off; }
        const int nig = WGM * nN, gid = wgid / nig, fm = gid * WGM, gsz = (nM - fm) < WGM ? (nM - fm) : WGM;
        u.pm = fm + ((wgid % nig) % gsz); u.pn = (wgid % nig) / gsz; return true;
    }
    __device__ __forceinline__ void a_ready(const Unit&) const {}
    __device__ __forceinline__ void done(const Unit&) const {}
};
__device__ __forceinline__ unsigned cvt_pk_bf16(float lo, float hi) { unsigned r; asm volatile("v_cvt_pk_bf16_f32 %0, %1, %2" : "=v"(r) : "v"(lo), "v"(hi)); return r; }
template <class Epi, class Sched, bool ALIGN_EPI = false, bool SP2 = false>
__device__ __forceinline__ void gemm_phase(PG8_LAS unsigned char* lds, const Gemm g, const Sched& S, const Epi& E) {
    const int tid = threadIdx.x, wid = __builtin_amdgcn_readfirstlane(tid >> 6), lane = tid & 63, wr = wid >> 2, wc = wid & 3, fr = lane & 15, fq = lane >> 4;
    const int K = g.K, nt = K / BK;
    unsigned voffA[2], voffB[2];
#pragma unroll
    for (int i = 0; i < 2; ++i) { int R, C; stage_rc(tid * 16 + i * 8192, R, C); const int Rb = Epi::PERM ? ((R & ~31) + perm32(R & 31)) : R;
        voffA[i] = (unsigned)(R * K + C) * 2u; voffB[i] = (unsigned)(Rb * K + C) * 2u; }
    const size_t kstep = (size_t)(BK * 2);
    const size_t hstep = (size_t)HALF * K * 2;
    const size_t tstep = 2 * hstep;
    const unsigned ldsw = (unsigned)wid * 1024u;
    const int aoff = lds_byte(wr * 64 + fr, fq * 8), boff = lds_byte(wc * 32 + fr, fq * 8);
#define PG8_SA(b, h) (((b) * 2 + (h)) * HTB)
#define PG8_SB(b, h) ((4 + (b) * 2 + (h)) * HTB)
#define PG8_STAGE(bufoff, gbase, voff) do { _Pragma("unroll") for (int _i = 0; _i < 2; ++_i) \
        __builtin_amdgcn_global_load_lds((const unsigned*)((const char*)(gbase) + (voff)[_i]), (PG8_LAS unsigned*)(lds + (bufoff) + ldsw + _i * 8192), 16, 0, 0); } while (0)
#define PG8_LDA(dst, b, h) do { _Pragma("unroll") for (int m = 0; m < 4; ++m) _Pragma("unroll") for (int k = 0; k < 2; ++k) dst[m][k] = *(const PG8_LAS bf16x8*)(lds + PG8_SA(b, h) + aoff + m * 2048 + k * 1024); } while (0)
#define PG8_LDB(dst, b, h) do { _Pragma("unroll") for (int n = 0; n < 2; ++n) _Pragma("unroll") for (int k = 0; k < 2; ++k) dst[n][k] = *(const PG8_LAS bf16x8*)(lds + PG8_SB(b, h) + boff + n * 2048 + k * 1024); } while (0)
#define PG8_MMA(ai, bj, At, Bt) do { __builtin_amdgcn_s_setprio(1); _Pragma("unroll") for (int m = 0; m < 4; ++m) _Pragma("unroll") for (int n = 0; n < 2; ++n) _Pragma("unroll") for (int k = 0; k < 2; ++k) \
        acc[ai][bj][m][n] = __builtin_amdgcn_mfma_f32_16x16x32_bf16(Bt[n][k], At[m][k], acc[ai][bj][m][n], 0, 0, 0); __builtin_amdgcn_s_setprio(0); } while (0)
#define PG8_WAIT_V(n) asm volatile("s_waitcnt vmcnt(" #n ")" ::: "memory")
#define PG8_WAIT_L(n) asm volatile("s_waitcnt lgkmcnt(" #n ")" ::: "memory")
#define PG8_BAR __builtin_amdgcn_s_barrier()
#define PG8_SCHED __builtin_amdgcn_sched_barrier(0)
    Unit cur, nxt; int ui = 0;
    if (!S.next(0, cur)) return;
    f32x4 acc[2][2][4][2];
#pragma unroll
    for (int a = 0; a < 2; ++a)
#pragma unroll
        for (int b = 0; b < 2; ++b)
#pragma unroll
            for (int m = 0; m < 4; ++m)
#pragma unroll
                for (int n = 0; n < 2; ++n) acc[a][b][m][n] = (f32x4){0.f, 0.f, 0.f, 0.f};
    bf16x8 At[4][2], B0[2][2], B1[2][2];
    const char* cA = (const char*)g.A + (size_t)cur.pm * tstep; const char* cB = (const char*)g.Bt + (size_t)cur.pn * tstep;
    S.a_ready(cur);
    if constexpr (SP2) {
        PG8_STAGE(PG8_SB(0, 0), cB, voffB); PG8_STAGE(PG8_SB(0, 1), cB + hstep, voffB); PG8_STAGE(PG8_SA(0, 0), cA, voffA); PG8_STAGE(PG8_SA(0, 1), cA + hstep, voffA);
        if (wr == 1) PG8_BAR;
        PG8_WAIT_V(2); PG8_BAR;
        PG8_STAGE(PG8_SB(1, 0), cB + kstep, voffB); PG8_STAGE(PG8_SA(1, 0), cA + kstep, voffA); PG8_STAGE(PG8_SB(1, 1), cB + hstep + kstep, voffB);
        PG8_WAIT_V(6); PG8_BAR;
    } else {
        PG8_STAGE(PG8_SB(0, 0), cB, voffB); PG8_STAGE(PG8_SA(0, 0), cA, voffA); PG8_STAGE(PG8_SB(0, 1), cB + hstep, voffB); PG8_STAGE(PG8_SA(0, 1), cA + hstep, voffA);
        if (wr == 1) PG8_BAR;
        PG8_WAIT_V(4); PG8_BAR;
        PG8_STAGE(PG8_SB(1, 0), cB + kstep, voffB); PG8_STAGE(PG8_SA(1, 0), cA + kstep, voffA); PG8_STAGE(PG8_SB(1, 1), cB + hstep + kstep, voffB);
        PG8_WAIT_V(6); PG8_BAR;
    }
    for (;;) {
        const bool has_next = S.next(ui + 1, nxt);
        const char* nA = has_next ? (const char*)g.A + (size_t)nxt.pm * tstep : cA; const char* nB = has_next ? (const char*)g.Bt + (size_t)nxt.pn * tstep : cB;
        for (int t = 0; t < nt; t += 2) {
            const bool last = (t == nt - 2);
            const char* a1 = cA + (size_t)(t + 1) * kstep;
            const char* a2 = last ? nA : cA + (size_t)(t + 2) * kstep; const char* b2 = last ? nB : cB + (size_t)(t + 2) * kstep;
            const char* a3 = a2 + kstep; const char* b3 = b2 + kstep;
            if (last && has_next) S.a_ready(nxt);
            if constexpr (SP2) {
            PG8_LDB(B0, 0, 0); PG8_LDB(B1, 0, 1); PG8_SCHED; PG8_LDA(At, 0, 0); PG8_STAGE(PG8_SA(1, 1), a1 + hstep, voffA);
            PG8_WAIT_V(8); PG8_WAIT_L(0); PG8_BAR; PG8_MMA(0, 0, At, B0); PG8_MMA(0, 1, At, B1); PG8_BAR; PG8_SCHED;
            PG8_LDA(At, 0, 1); PG8_STAGE(PG8_SB(0, 0), b2, voffB); PG8_STAGE(PG8_SB(0, 1), b2 + hstep, voffB); PG8_STAGE(PG8_SA(0, 0), a2, voffA);
            PG8_WAIT_V(8); PG8_WAIT_L(0); PG8_BAR; PG8_MMA(1, 0, At, B0); PG8_MMA(1, 1, At, B1); PG8_BAR; PG8_SCHED;
            PG8_LDB(B0, 1, 0); PG8_LDB(B1, 1, 1); PG8_SCHED; PG8_LDA(At, 1, 0); PG8_STAGE(PG8_SA(0, 1), a2 + hstep, voffA);
            PG8_WAIT_V(8); PG8_WAIT_L(0); PG8_BAR; PG8_MMA(0, 0, At, B0); PG8_MMA(0, 1, At, B1); PG8_BAR; PG8_SCHED;
            PG8_LDA(At, 1, 1); PG8_STAGE(PG8_SB(1, 0), b3, voffB); PG8_STAGE(PG8_SB(1, 1), b3 + hstep, voffB); PG8_STAGE(PG8_SA(1, 0), a3, voffA);
            PG8_WAIT_V(8); PG8_WAIT_L(0); PG8_BAR; PG8_MMA(1, 0, At, B0); PG8_MMA(1, 1, At, B1); PG8_BAR; PG8_SCHED;
            } else {
            PG8_LDB(B0, 0, 0); PG8_SCHED; PG8_LDA(At, 0, 0); PG8_STAGE(PG8_SA(1, 1), a1 + hstep, voffA);
            PG8_WAIT_L(8); PG8_BAR; PG8_WAIT_L(0); PG8_MMA(0, 0, At, B0); PG8_BAR; PG8_SCHED;
            PG8_LDB(B1, 0, 1); PG8_STAGE(PG8_SB(0, 0), b2, voffB);
            PG8_BAR; PG8_WAIT_L(0); PG8_MMA(0, 1, At, B1); PG8_BAR;
            PG8_LDA(At, 0, 1); PG8_STAGE(PG8_SA(0, 0), a2, voffA);
            PG8_BAR; PG8_WAIT_L(0); PG8_MMA(1, 0, At, B0); PG8_BAR; PG8_SCHED;
            PG8_STAGE(PG8_SB(0, 1), b2 + hstep, voffB);
            PG8_WAIT_V(6); PG8_BAR; PG8_MMA(1, 1, At, B1); PG8_BAR;
            PG8_LDB(B0, 1, 0); PG8_SCHED; PG8_LDA(At, 1, 0); PG8_STAGE(PG8_SA(0, 1), a2 + hstep, voffA);
            PG8_WAIT_L(8); PG8_BAR; PG8_WAIT_L(0); PG8_MMA(0, 0, At, B0); PG8_BAR; PG8_SCHED;
            PG8_LDB(B1, 1, 1); PG8_STAGE(PG8_SB(1, 0), b3, voffB);
            PG8_BAR; PG8_WAIT_L(0); PG8_MMA(0, 1, At, B1); PG8_BAR;
            PG8_LDA(At, 1, 1); PG8_STAGE(PG8_SA(1, 0), a3, voffA);
            PG8_BAR; PG8_WAIT_L(0); PG8_MMA(1, 0, At, B0); PG8_BAR; PG8_SCHED;
            PG8_STAGE(PG8_SB(1, 1), b3 + hstep, voffB);
            PG8_WAIT_V(6); PG8_BAR; PG8_MMA(1, 1, At, B1); PG8_BAR;
            }
        }
        if constexpr (ALIGN_EPI) { if (wr == 0) PG8_BAR; }
        if constexpr (!Epi::AFTER_DRAIN) { E(acc, cur, wr, wc, fr, fq); S.done(cur); }
        if (!has_next) break;
#pragma unroll
        for (int a = 0; a < 2; ++a)
#pragma unroll
            for (int b = 0; b < 2; ++b)
#pragma unroll
                for (int m = 0; m < 4; ++m)
#pragma unroll
                    for (int n = 0; n < 2; ++n) acc[a][b][m][n] = (f32x4){0.f, 0.f, 0.f, 0.f};
        cur = nxt; cA = nA; cB = nB; ++ui;
        if constexpr (ALIGN_EPI) { if (wr == 1) PG8_BAR; }
    }
    PG8_WAIT_V(0);
    if constexpr (!ALIGN_EPI) { if (wr == 0) PG8_BAR; }
    PG8_BAR;
    if constexpr (Epi::AFTER_DRAIN) { E.fused(acc, cur, wr, wc, fr, fq, lds, wid, lane); S.done(cur); }
#undef PG8_SA
#undef PG8_SB
#undef PG8_STAGE
#undef PG8_LDA
#undef PG8_LDB
#undef PG8_MMA
#undef PG8_WAIT_V
#undef PG8_WAIT_L
#undef PG8_BAR
#undef PG8_SCHED
}
}

#define GAS __attribute__((address_space(1)))
#define LAS __attribute__((address_space(3)))
typedef unsigned short bf16;
typedef unsigned char uchar;
typedef unsigned v4u __attribute__((ext_vector_type(4)));
typedef unsigned v2u __attribute__((ext_vector_type(2)));
typedef float f32x4 __attribute__((ext_vector_type(4)));
typedef float f32x2 __attribute__((ext_vector_type(2)));
typedef short bf16x8 __attribute__((ext_vector_type(8)));
#define LDS_WAIT() asm volatile("s_waitcnt lgkmcnt(0)" ::: "memory")
#define VM_WAIT() asm volatile("s_waitcnt vmcnt(0)" ::: "memory")

constexpr int NWAVES = 8, NTHR = 512;
constexpr int NB = 8, SEQ = 4096, DM = 1024, CTXL = 256;
constexpr int MROWS = NB * SEQ;
constexpr int CROWS = NB * CTXL;
constexpr int TROWS = MROWS + CROWS;
constexpr int NHEAD = 4, HD = 128, INW = 2064, DFF = 2560, UPW = 5120;
constexpr float EPS = 1e-6f;
constexpr int NUNIT_L = NB * NHEAD * 32, NUNIT_C = NB * NHEAD * 2, NUNIT = NUNIT_L + NUNIT_C;
constexpr int CT_SLOT = 129 * 128;

constexpr size_t MiB = 1u << 20;
constexpr size_t WS_HX = 0, WS_TP = 0, WS_H2 = 0, WS_ACT = 0;
constexpr size_t WS_UF = 68 * MiB, WS_XM = 100 * MiB, WS_CT = 68 * MiB;
constexpr size_t WS_G = 134 * MiB, WS_SC = 137 * MiB, WS_MS = 138 * MiB;
constexpr size_t WS_V = 160 * MiB, WS_Z = 194 * MiB, WS_DC = 226 * MiB, WS_YM = 364 * MiB, WS_U = 160 * MiB;
constexpr size_t WS_WIN = 480 * MiB  , WS_WOUT = 485 * MiB, WS_WUP = 487 * MiB, WS_WDN = 497 * MiB, WS_WQ = 502 * MiB, WS_WK = WS_WQ + 131072;
constexpr size_t WS_F1 = WS_WQ + 512 * 1024, WS_G2 = WS_F1 + 16384, WS_TW = WS_G2 + 16384;
constexpr size_t WS_MOD = 503 * MiB, WS_CTL = 504 * MiB, WS_ZERO0 = WS_MOD, WS_ZERO_BYTES = 2 * MiB, WS_END = 512 * MiB;
static_assert(WS_DC + (size_t)NUNIT * 2 * CT_SLOT * 4 <= WS_YM && WS_YM + (size_t)MROWS * 1024 * 2 <= WS_U + (size_t)MROWS * UPW * 2 && WS_U + (size_t)MROWS * UPW * 2 <= WS_WIN, "ws map");
static_assert(WS_CT + (size_t)NUNIT_L * 2 * CT_SLOT * 2 <= WS_G && WS_XM + (size_t)TROWS * 512 * 2 <= WS_G && (size_t)MROWS * DFF * 2 <= WS_U, "ws map 2");
constexpr size_t DO_AB = 0, DO_Q = 32 * MiB, DO_K = 64 * MiB;

__device__ __forceinline__ unsigned f2bf(float f) { unsigned u = __builtin_bit_cast(unsigned, f); return (u + 0x7fffu + ((u >> 16) & 1u)) >> 16; }
__device__ __forceinline__ unsigned pk2(float lo, float hi) { return f2bf(lo) | (f2bf(hi) << 16); }
__device__ __forceinline__ float bflo(unsigned w) { return __builtin_bit_cast(float, w << 16); }
__device__ __forceinline__ float bfhi(unsigned w) { return __builtin_bit_cast(float, w & 0xffff0000u); }
__device__ __forceinline__ f32x4 bf4(v2u x) { return (f32x4){bflo(x.x), bfhi(x.x), bflo(x.y), bfhi(x.y)}; }
__device__ __forceinline__ float silu_f(float x) { return x * __builtin_amdgcn_rcpf(1.0f + __expf(-x)); }
__device__ __forceinline__ float logsig_f(float x) { return fminf(x, 0.f) - log1pf(__expf(-fabsf(x))); }
__device__ __forceinline__ float wave_sum(float v) {
#pragma unroll
    for (int o = 1; o < 64; o <<= 1) v += __shfl_xor(v, o);
    return v;
}
__device__ __forceinline__ int img_off(int row, int ch) { return row * 256 + ((ch ^ (row & 15)) << 4); }
struct BFrag { bf16x8 f[4]; };
__device__ __forceinline__ BFrag load_bfrag(const LAS uchar* Bimg, int brow, int kq) { BFrag b;
#pragma unroll
    for (int s = 0; s < 4; ++s) b.f[s] = *(const LAS bf16x8*)(Bimg + img_off(brow, 4 * s + kq));
    return b; }
__device__ __forceinline__ f32x4 mma_a(f32x4 acc, const LAS uchar* Aimg, int arow, const BFrag& b, int kq) {
    bf16x8 a[4];
#pragma unroll
    for (int s = 0; s < 4; ++s) a[s] = *(const LAS bf16x8*)(Aimg + img_off(arow, 4 * s + kq));
#pragma unroll
    for (int s = 0; s < 4; ++s) acc = __builtin_amdgcn_mfma_f32_16x16x32_bf16(a[s], b.f[s], acc, 0, 0, 0);
    return acc; }
#define MEMFENCE() asm volatile("" ::: "memory")


template <int S> __device__ __forceinline__ unsigned tr_lane_off(int lane) { return (unsigned)((8 * (lane >> 4) + ((lane & 15) >> 2)) * S + 8 * (lane & 3)); }
__device__ __forceinline__ unsigned lds_addr(const LAS uchar* p) { return (unsigned)(unsigned long long)p; }
__device__ __forceinline__ bf16x8 pack_frag(v2u lo, v2u hi) { const v4u w = (v4u){lo.x, lo.y, hi.x, hi.y}; return __builtin_bit_cast(bf16x8, w); }
template <int S> __device__ __forceinline__ void tr_load4(unsigned addr, BFrag& f) {
    v2u r0, r1, r2, r3, r4, r5, r6, r7;
    asm volatile("ds_read_b64_tr_b16 %0, %8\n\tds_read_b64_tr_b16 %1, %8 offset:%9\n\tds_read_b64_tr_b16 %2, %8 offset:%10\n\tds_read_b64_tr_b16 %3, %8 offset:%11\n\t"
                 "ds_read_b64_tr_b16 %4, %8 offset:%12\n\tds_read_b64_tr_b16 %5, %8 offset:%13\n\tds_read_b64_tr_b16 %6, %8 offset:%14\n\tds_read_b64_tr_b16 %7, %8 offset:%15\n\ts_waitcnt lgkmcnt(0)"
                 : "=&v"(r0), "=&v"(r1), "=&v"(r2), "=&v"(r3), "=&v"(r4), "=&v"(r5), "=&v"(r6), "=&v"(r7)
                 : "v"(addr), "i"(4 * S), "i"(32 * S), "i"(36 * S), "i"(64 * S), "i"(68 * S), "i"(96 * S), "i"(100 * S) : "memory");
    f.f[0] = pack_frag(r0, r1); f.f[1] = pack_frag(r2, r3); f.f[2] = pack_frag(r4, r5); f.f[3] = pack_frag(r6, r7);
}
template <int S> __device__ __forceinline__ void tr_load2(unsigned addr, bf16x8& f0, bf16x8& f1) {
    v2u r0, r1, r2, r3;
    asm volatile("ds_read_b64_tr_b16 %0, %4\n\tds_read_b64_tr_b16 %1, %4 offset:%5\n\tds_read_b64_tr_b16 %2, %4 offset:%6\n\tds_read_b64_tr_b16 %3, %4 offset:%7\n\ts_waitcnt lgkmcnt(0)"
                 : "=&v"(r0), "=&v"(r1), "=&v"(r2), "=&v"(r3) : "v"(addr), "i"(4 * S), "i"(32 * S), "i"(36 * S) : "memory");
    f0 = pack_frag(r0, r1); f1 = pack_frag(r2, r3);
}
template <int S> __device__ __forceinline__ unsigned tr_lane_off_p(int lane) { return (unsigned)((4 * (lane >> 4) + ((lane & 15) >> 2)) * S + 8 * (lane & 3)); }
template <int S> __device__ __forceinline__ void tr_load4p(unsigned addr, BFrag& f) {
    v2u r0, r1, r2, r3, r4, r5, r6, r7;
    asm volatile("ds_read_b64_tr_b16 %0, %8\n\tds_read_b64_tr_b16 %1, %8 offset:%9\n\tds_read_b64_tr_b16 %2, %8 offset:%10\n\tds_read_b64_tr_b16 %3, %8 offset:%11\n\t"
                 "ds_read_b64_tr_b16 %4, %8 offset:%12\n\tds_read_b64_tr_b16 %5, %8 offset:%13\n\tds_read_b64_tr_b16 %6, %8 offset:%14\n\tds_read_b64_tr_b16 %7, %8 offset:%15\n\ts_waitcnt lgkmcnt(0)"
                 : "=&v"(r0), "=&v"(r1), "=&v"(r2), "=&v"(r3), "=&v"(r4), "=&v"(r5), "=&v"(r6), "=&v"(r7)
                 : "v"(addr), "i"(16 * S), "i"(32 * S), "i"(48 * S), "i"(64 * S), "i"(80 * S), "i"(96 * S), "i"(112 * S) : "memory");
    f.f[0] = pack_frag(r0, r1); f.f[1] = pack_frag(r2, r3); f.f[2] = pack_frag(r4, r5); f.f[3] = pack_frag(r6, r7);
}
__device__ __forceinline__ f32x4 mma_ff(f32x4 acc, const BFrag& a, const BFrag& b) {
#pragma unroll
    for (int s = 0; s < 4; ++s) acc = __builtin_amdgcn_mfma_f32_16x16x32_bf16(a.f[s], b.f[s], acc, 0, 0, 0);
    return acc; }
__device__ __forceinline__ float lane_scan_add(float v, int lane) {
#pragma unroll
    for (int o = 1; o < 64; o <<= 1) { const float t = __shfl_up(v, o); if (lane >= o) v += t; }
    return v; }
__device__ __forceinline__ float lane_scan_max(float v, int lane) {
#pragma unroll
    for (int o = 1; o < 64; o <<= 1) { const float t = __shfl_up(v, o); if (lane >= o) v = fmaxf(v, t); }
    return v; }
__device__ __forceinline__ float wave_max(float v) {
#pragma unroll
    for (int o = 1; o < 64; o <<= 1) v = fmaxf(v, __shfl_xor(v, o));
    return v; }

#define XB_TMO      128
#define XB_XCNT(j)  (256  + 64 * (j))
#define XB_XSUB(j)  (1280 + 64 * (j))
#define XB_XGEN(j)  (2304 + 64 * (j))
#define XB_TOP      3328
#define XB_TOPGEN   3392
#define XCD_BAR_WORDS 3456
#define XB_SPIN_CAP (1u << 18)

__device__ __forceinline__ unsigned xb_ld(unsigned* p)              { return __hip_atomic_load(p, __ATOMIC_RELAXED, __HIP_MEMORY_SCOPE_AGENT); }
__device__ __forceinline__ unsigned xb_add(unsigned* p, unsigned v) { return __hip_atomic_fetch_add(p, v, __ATOMIC_RELAXED, __HIP_MEMORY_SCOPE_AGENT); }
__device__ __forceinline__ unsigned xb_xcc_id() { return (unsigned)__builtin_amdgcn_s_getreg((3 << 11) | 20) & 0xFu; }
#define XB_SPIN(cond, bar) do { unsigned _sp = 0; while (cond) { __builtin_amdgcn_s_sleep(1); \
    if ((++_sp & 255u) == 0u) { if (xb_ld(&(bar)[XB_TMO])) break; if (_sp > XB_SPIN_CAP) { atomicAdd(&(bar)[XB_TMO], 1u); break; } } } } while (0)

struct XcdBarrier {
    unsigned* bar; unsigned x;
    volatile LAS unsigned* st;
};

__device__ __forceinline__ XcdBarrier xcd_barrier_post(unsigned* bar, volatile LAS unsigned* st) {
    XcdBarrier b; b.bar = bar; b.x = xb_xcc_id(); b.st = st;
    if (threadIdx.x == 0) (void)xb_add(&bar[XB_XCNT(b.x)], 1u);
    return b;
}
__device__ __forceinline__ void xcd_barrier_complete(unsigned* bar, unsigned x, unsigned& nloc, unsigned& nx) {
    const unsigned G = gridDim.x * gridDim.y * gridDim.z;
    unsigned sum, cnt, mine, sp = 0u;
    for (;;) {
        sum = 0u; cnt = 0u; mine = 0u;
#pragma unroll
        for (unsigned j = 0; j < 16; ++j) { const unsigned c = xb_ld(&bar[XB_XCNT(j)]); sum += c; cnt += (c > 0u) ? 1u : 0u; mine = (j == x) ? c : mine; }
        if (sum == G) break;
        __builtin_amdgcn_s_sleep(1);
        if ((++sp & 255u) == 0u) { if (xb_ld(&bar[XB_TMO])) break; if (sp > XB_SPIN_CAP) { atomicAdd(&bar[XB_TMO], 1u); break; } }
    }
    nloc = mine > 0u ? mine : 1u; nx = cnt > 0u ? cnt : 1u;
}

__device__ __forceinline__ void xcd_barrier(const XcdBarrier& b) {
    asm volatile("s_waitcnt vmcnt(0)" ::: "memory");
    __syncthreads();
    if (threadIdx.x == 0) {
        unsigned* bar = b.bar;
        __builtin_amdgcn_s_waitcnt(0);
        unsigned nloc = b.st[0], nx = b.st[1];
        if (nloc == 0u) { xcd_barrier_complete(bar, b.x, nloc, nx); b.st[0] = nloc; b.st[1] = nx; }
        const unsigned old = xb_add(&bar[XB_XSUB(b.x)], 1u);
        const unsigned gen = old / nloc;
        if (old + 1u == (gen + 1u) * nloc) {
            __builtin_amdgcn_fence(__ATOMIC_RELEASE, "agent");
            asm volatile("s_waitcnt vmcnt(0)" ::: "memory");
            const unsigned og = xb_add(&bar[XB_TOP], 1u);
            const unsigned tg = og / nx;
            if (og + 1u == (tg + 1u) * nx) xb_add(&bar[XB_TOPGEN], 1u);
            else XB_SPIN(xb_ld(&bar[XB_TOPGEN]) == tg, bar);
            __builtin_amdgcn_fence(__ATOMIC_ACQUIRE, "agent");
            xb_add(&bar[XB_XGEN(b.x)], 1u);
            asm volatile("s_waitcnt vmcnt(0)" ::: "memory");
        } else {
            XB_SPIN(xb_ld(&bar[XB_XGEN(b.x)]) == gen, bar);
            __builtin_amdgcn_fence(__ATOMIC_ACQUIRE, "agent");
            asm volatile("s_waitcnt vmcnt(0)" ::: "memory");
        }
    }
    __syncthreads();
}


struct TProbe { unsigned long long t[8]; unsigned long long last; unsigned long long ph; };
#define TP_MARK(tp, i) do { if (TP_SEL) { const unsigned long long n_ = __builtin_amdgcn_s_memrealtime(); (tp).t[i] += n_ - (tp).last; (tp).last = n_; } } while (0)
#define TP_P (TP_SEL && !(TP_SEL & 8))
#define TP_O (TP_SEL & 8)
#define TP_START(tp) do { if (TP_SEL) (tp).last = __builtin_amdgcn_s_memrealtime(); } while (0)
struct Args { const float* in[24]; float* out; uchar* ws; int ph_lo, ph_hi; };

template <class F>
__device__ __forceinline__ void tr_item(F src, bf16* WT, size_t drow0, int ldk, int dk0, LAS float* scr, int lane) {
#pragma unroll 4
    for (int i = 0; i < 32; ++i) { const int kk = 2 * i + (lane >> 5); scr[kk * 33 + (lane & 31)] = src(kk, lane & 31); }
    LDS_WAIT(); asm volatile("" ::: "memory");
    const int c = lane & 7;
#pragma unroll
    for (int j = 0; j < 4; ++j) { const int n = (lane >> 3) + 8 * j; const LAS float* s = scr + (8 * c) * 33 + n;
        v4u o; o.x = pk2(s[0 * 33], s[1 * 33]); o.y = pk2(s[2 * 33], s[3 * 33]); o.z = pk2(s[4 * 33], s[5 * 33]); o.w = pk2(s[6 * 33], s[7 * 33]);
        *(v4u*)(WT + (drow0 + n) * ldk + dk0 + 8 * c) = o; }
    LDS_WAIT(); asm volatile("" ::: "memory");
}

constexpr int I_XV = 16 * 32, I_Z = 16 * 16, I_QK = 2 * 4 * 4, I_G = 16 * 8, I_OF = 8 * 32, I_OM = 8 * 32, I_UP = 16 * 160, I_DN = 40 * 32;
constexpr int TR_EARLY = I_XV + I_Z + 2 * I_QK + I_G, TR_ALL = TR_EARLY + I_OF + I_OM + I_UP + I_DN;
__device__ __forceinline__ void tr_items(const Args& a, LAS uchar* lds, int lo, int hi, int gw, int NGW) {
    const int tid = threadIdx.x, lane = tid & 63, wave = __builtin_amdgcn_readfirstlane(tid >> 6);
    uchar* ws = a.ws;
    LAS float* scr = (LAS float*)(lds + wave * 16384);
    const float* w_in = a.in[7]; const float* w_out = a.in[15]; const float* w_up = a.in[17]; const float* w_dn = a.in[21];
    const float* w_q = a.in[10]; const float* w_k = a.in[11];
    bf16* WIN = (bf16*)(ws + WS_WIN); bf16* WOUT = (bf16*)(ws + WS_WOUT); bf16* WUP = (bf16*)(ws + WS_WUP); bf16* WDN = (bf16*)(ws + WS_WDN);
    bf16* WQ = (bf16*)(ws + WS_WQ); bf16* WK = (bf16*)(ws + WS_WK);
    for (int it = lo + gw; it < hi; it += NGW) {
        int r = it;
        if (r < I_XV) { const int kb = r / 32, nb = r % 32, k0 = kb * 64, n0 = nb * 32;
            auto src = [&](int kk, int nn) -> float { return w_in[(size_t)(k0 + kk) * INW + 512 + n0 + nn]; };
            tr_item(src, WIN, (size_t)(512 + n0), DM, k0, scr, lane); continue; } r -= I_XV;
        if (r < I_Z) { const int kb = r / 16, nb = r % 16, k0 = kb * 64, n0 = nb * 32;
            auto src = [&](int kk, int nn) -> float { return w_in[(size_t)(k0 + kk) * INW + 1552 + n0 + nn]; };
            tr_item(src, WIN, (size_t)(1536 + n0), DM, k0, scr, lane); continue; } r -= I_Z;
        if (r < 2 * I_QK) { const bool isk = r >= I_QK; if (isk) r -= I_QK;
            const int h = r / 8, kb = (r % 8) / 4, nb = r % 4, k0 = kb * 64, n0 = nb * 32;
            const float* W = (isk ? w_k : w_q) + (size_t)h * HD * HD; const float sc = isk ? 0.08838834764831845f : 1.0f;
            auto src = [&](int kk, int nn) -> float { return W[(size_t)(k0 + kk) * HD + n0 + nn] * sc; };
            tr_item(src, (isk ? WK : WQ) + (size_t)h * HD * HD, (size_t)n0, HD, k0, scr, lane); continue; } r -= 2 * I_QK;
        if (r < I_G) { const int kb = r / 8, nb = r % 8, k0 = kb * 64, n0 = nb * 32;
            auto src = [&](int kk, int nn) -> float { return (n0 + nn < 16) ? w_in[(size_t)(k0 + kk) * INW + 1536 + n0 + nn] : 0.f; };
            tr_item(src, WIN, (size_t)(2048 + n0), DM, k0, scr, lane); continue; } r -= I_G;
        if (r < I_OF) { const int kb = r / 32, nb = r % 32, k0 = kb * 64, n0 = nb * 32;
            auto src = [&](int kk, int nn) -> float { const int k = k0 + kk, g = k >> 7, s = k & 127; const float* wo = w_out + (size_t)(g * 128) * DM + n0 + nn;
                if (s == 0 || s == 64) return wo[(size_t)s * DM];
                if (s < 64) return wo[(size_t)s * DM] + wo[(size_t)(128 - s) * DM];
                const int kq = s - 64; return wo[(size_t)(128 - kq) * DM] - wo[(size_t)kq * DM]; };
            tr_item(src, WOUT, (size_t)n0, DM, k0, scr, lane); continue; } r -= I_OF;
        if (r < I_OM) { const int kb = r / 32, nb = r % 32, k0 = kb * 64, n0 = nb * 32;
            auto src = [&](int kk, int nn) -> float { return w_out[(size_t)(512 + k0 + kk) * DM + n0 + nn]; };
            tr_item(src, WOUT, (size_t)n0, DM, 512 + k0, scr, lane); continue; } r -= I_OM;
        if (r < I_UP) { const int kb = r / 160, nb = r % 160, k0 = kb * 64, n0 = nb * 32;
            auto src = [&](int kk, int nn) -> float { return w_up[(size_t)(k0 + kk) * UPW + n0 + nn]; };
            tr_item(src, WUP, (size_t)n0, DM, k0, scr, lane); continue; } r -= I_UP;
        { const int kb = r / 32, nb = r % 32, k0 = kb * 64, n0 = nb * 32;
            auto src = [&](int kk, int nn) -> float { return w_dn[(size_t)(k0 + kk) * DM + n0 + nn]; };
            tr_item(src, WDN, (size_t)n0, DFF, k0, scr, lane); }
    }
}

__device__ __forceinline__ void p0_prologue(const Args& a, LAS uchar* lds, int vcu, int G, size_t mod_off) {
    const int tid = threadIdx.x, lane = tid & 63, wave = __builtin_amdgcn_readfirstlane(tid >> 6);
    uchar* ws = a.ws;
    {
        LAS float* sl = (LAS float*)lds;
        float* MOD = (float*)(ws + mod_off);
        const float* w_ada = a.in[4]; const float* b_ada = a.in[5];
        for (int it = blockIdx.x; it < 32 * 12; it += G) {
            const int kc = it / 12, nb = it % 12;
            __syncthreads();
            if (tid < 288) { const int r = tid >> 5, kk = tid & 31; const float cv = (r < 8) ? a.in[1][r * DM + kc * 32 + kk] : a.in[3][kc * 32 + kk]; sl[tid] = silu_f(cv); }
            __syncthreads();
            const int n = nb * 512 + tid;
            float acc[9];
#pragma unroll
            for (int r = 0; r < 9; ++r) acc[r] = 0.f;
#pragma unroll 8
            for (int kk = 0; kk < 32; ++kk) { const float w = w_ada[(size_t)(kc * 32 + kk) * 6144 + n];
#pragma unroll
                for (int r = 0; r < 9; ++r) acc[r] += sl[r * 32 + kk] * w; }
            const float bb = (kc == 0) ? b_ada[n] : 0.f;
#pragma unroll
            for (int r = 0; r < 9; ++r) atomicAdd(&MOD[r * 6144 + n], acc[r] + bb);
        }
        __syncthreads();
    }
    {
        LAS float* tab = (LAS float*)(lds + 8 * 16384);
        if (tid < 128) tab[tid] = cospif((float)tid * (1.0f / 64.0f)) * 0.08838834764831845f;
        __syncthreads();
        const int gt = blockIdx.x * NTHR + tid;
        bf16* F1 = (bf16*)(ws + WS_F1); bf16* G2 = (bf16*)(ws + WS_G2); float* TW = (float*)(ws + WS_TW);
        if (gt < 8192) { const int row = gt >> 6, n1 = gt & 63, ri = row >> 6, k1 = row & 63; const float ang = (float)((k1 * n1) & 63) * (1.0f / 32.0f);
            F1[gt] = (bf16)f2bf((ri == 0 ? cospif(ang) : -sinpif(ang)) * 0.125f); }
        else if (gt < 16384) { const int i = gt - 8192, k2 = i >> 7, kap = i & 127, n2 = kap & 63; const float ang = (float)((k2 * n2) & 63) * (1.0f / 32.0f);
            G2[i] = (bf16)f2bf((kap < 64 ? cospif(ang) : sinpif(ang)) * 0.125f); }
        else if (gt < 16384 + 4096) { const int i = gt - 16384; TW[i] = cospif((float)i * (1.0f / 2048.0f)); }
    }
    {
        const LAS float* tab = (const LAS float*)(lds + 8 * 16384);
        LAS float* Tm = (LAS float*)lds;
        LAS float* wT = (LAS float*)(lds + 65536);
        const float* w_in = a.in[7]; bf16* WIN = (bf16*)(a.ws + WS_WIN);
        bool have_T = false;
        for (int it = blockIdx.x; it < 64; it += G) {
            const int g = it >> 4, k0 = (it & 15) * 64;
            __syncthreads();
            if (!have_T) { for (int id = tid; id < 128 * 128; id += NTHR) { const int c = id >> 7, s_ = id & 127; const int mult = (s_ <= 64) ? s_ : (s_ - 64), off = (s_ <= 64) ? 0 : 96; Tm[id] = tab[(c * mult + off) & 127]; } have_T = true; }
            for (int id = tid; id < 64 * 32; id += NTHR) { const int kk = id >> 5, c4 = id & 31; const f32x4 v = *(const f32x4*)(w_in + (size_t)(k0 + kk) * INW + g * 128 + 4 * c4);
                wT[(4 * c4 + 0) * 64 + kk] = v.x; wT[(4 * c4 + 1) * 64 + kk] = v.y; wT[(4 * c4 + 2) * 64 + kk] = v.z; wT[(4 * c4 + 3) * 64 + kk] = v.w; }
            __syncthreads();
            const int s4 = (tid & 31) * 4, k4 = (tid >> 5) * 4;
            f32x4 acc[4];
#pragma unroll
            for (int j = 0; j < 4; ++j) acc[j] = (f32x4){0.f, 0.f, 0.f, 0.f};
#pragma unroll 4
            for (int c = 0; c < 128; ++c) { const f32x4 tv = *(const LAS f32x4*)(Tm + c * 128 + s4), wv_ = *(const LAS f32x4*)(wT + c * 64 + k4);
                acc[0] += wv_ * tv.x; acc[1] += wv_ * tv.y; acc[2] += wv_ * tv.z; acc[3] += wv_ * tv.w; }
#pragma unroll
            for (int j = 0; j < 4; ++j) *(v2u*)(WIN + (size_t)(g * 128 + s4 + j) * DM + k0 + k4) = (v2u){pk2(acc[j].x, acc[j].y), pk2(acc[j].z, acc[j].w)};
        }
        __syncthreads();
    }
    tr_items(a, lds, 0, (G > 168) ? TR_EARLY : TR_ALL, vcu * NWAVES + wave, G * NWAVES);
}

__device__ __forceinline__ void p1_rows(const Args& a, LAS uchar* lds, int vcu, int G) {
    const int tid = threadIdx.x, lane = tid & 63, wave = __builtin_amdgcn_readfirstlane(tid >> 6);
    uchar* ws = a.ws;
    const float* MOD = (const float*)(ws + WS_MOD);
    const float* nw = a.in[6];
    bf16* HX = (bf16*)(ws + WS_HX);
    const int gw = vcu * NWAVES + wave, NGW = G * NWAVES;
    for (int row = gw; row < TROWS; row += NGW) {
        const float* xr; const float* md;
        if (row < MROWS) { xr = a.in[0] + (size_t)row * DM; md = MOD + (size_t)(row >> 12) * 6144; }
        else { xr = a.in[2] + (size_t)(row - MROWS) * DM; md = MOD + (size_t)8 * 6144; }
        f32x4 v[4]; float s = 0.f;
#pragma unroll
        for (int j = 0; j < 4; ++j) { v[j] = *(const f32x4*)(xr + 4 * lane + 256 * j); s += (v[j].x * v[j].x + v[j].y * v[j].y) + (v[j].z * v[j].z + v[j].w * v[j].w); }
        const float rstd = rsqrtf(wave_sum(s) * (1.0f / DM) + EPS);
#pragma unroll
        for (int j = 0; j < 4; ++j) {
            const f32x4 w = *(const f32x4*)(nw + 4 * lane + 256 * j), sh = *(const f32x4*)(md + 4 * lane + 256 * j), sc = *(const f32x4*)(md + 1024 + 4 * lane + 256 * j);
            const f32x4 hv = v[j] * rstd * w * (sc + 1.0f) + sh;
            *(v2u*)(HX + (size_t)row * DM + 4 * lane + 256 * j) = (v2u){pk2(hv.x, hv.y), pk2(hv.z, hv.w)};
        }
    }
}
__device__ __forceinline__ void p7_rows(const Args& a, int vcu, int G) {
    const int tid = threadIdx.x, lane = tid & 63, wave = __builtin_amdgcn_readfirstlane(tid >> 6);
    const float* MOD = (const float*)(a.ws + WS_MOD); const float* nw = a.in[16]; bf16* H2 = (bf16*)(a.ws + WS_H2);
    const int gw = vcu * NWAVES + wave, NGW = G * NWAVES;
    for (int row = gw; row < MROWS; row += NGW) {
        const float* xr = a.in[0] + (size_t)row * DM; const float* md = MOD + (size_t)(row >> 12) * 6144; const bf16* y1 = (const bf16*)a.out + (size_t)row * 2048;
        f32x4 v[4]; float s = 0.f;
#pragma unroll
        for (int j = 0; j < 4; ++j) { v[j] = *(const f32x4*)(xr + 4 * lane + 256 * j) + bf4(*(const v2u*)(y1 + 4 * lane + 256 * j)); s += (v[j].x * v[j].x + v[j].y * v[j].y) + (v[j].z * v[j].z + v[j].w * v[j].w); }
        const float rstd = rsqrtf(wave_sum(s) * (1.0f / DM) + EPS);
#pragma unroll
        for (int j = 0; j < 4; ++j) {
            const f32x4 w = *(const f32x4*)(nw + 4 * lane + 256 * j), sh = *(const f32x4*)(md + 3072 + 4 * lane + 256 * j), sc = *(const f32x4*)(md + 4096 + 4 * lane + 256 * j);
            const f32x4 hv = v[j] * rstd * w * (sc + 1.0f) + sh;
            *(v2u*)(H2 + (size_t)row * DM + 4 * lane + 256 * j) = (v2u){pk2(hv.x, hv.y), pk2(hv.z, hv.w)}; }
    }
}
__device__ __forceinline__ void p11_rows(const Args& a, int vcu, int G, float* dst) {
    const int tid = threadIdx.x, lane = tid & 63, wave = __builtin_amdgcn_readfirstlane(tid >> 6);
    const float* nw = a.in[23];
    const int gw = vcu * NWAVES + wave, NGW = G * NWAVES;
    for (int row = gw; row < MROWS; row += NGW) {
        const float* xr = a.in[0] + (size_t)row * DM; const bf16* y1 = (const bf16*)a.out + (size_t)row * 2048; const bf16* d2 = (const bf16*)(a.ws + WS_U) + (size_t)row * DM;
        f32x4 v[4]; float s = 0.f;
#pragma unroll
        for (int j = 0; j < 4; ++j) { v[j] = *(const f32x4*)(xr + 4 * lane + 256 * j) + bf4(*(const v2u*)(y1 + 4 * lane + 256 * j)) + bf4(*(const v2u*)(d2 + 4 * lane + 256 * j)); s += (v[j].x * v[j].x + v[j].y * v[j].y) + (v[j].z * v[j].z + v[j].w * v[j].w); }
        const float rstd = rsqrtf(wave_sum(s) * (1.0f / DM) + EPS);
#pragma unroll
        for (int j = 0; j < 4; ++j) { const f32x4 w = *(const f32x4*)(nw + 4 * lane + 256 * j); *(f32x4*)(dst + (size_t)row * DM + 4 * lane + 256 * j) = v[j] * rstd * w; }
    }
}

struct SchedP2 {
    pg8::StaticOrder so;
    __device__ void init(int G, int c) { so.init(MROWS, 2048, G, c); }
    __device__ bool next(int i, pg8::Unit& u) const {
        const long L = (long)i * so.G + so.c;
        if (L < so.nwg) return so.next(i, u);
        const int r = (int)(L - so.nwg); if (r >= 32 + 136) return false;
        if (r < 32) { u.pm = 128 + (r & 7); u.pn = 2 + (r >> 3); }
        else { u.pm = r - 32; u.pn = 8; }
        return true;
    }
    __device__ __forceinline__ void a_ready(const pg8::Unit&) const {}
    __device__ __forceinline__ void done(const pg8::Unit&) const {}
};
struct EpiP2 {
    static constexpr bool PERM = true, AFTER_DRAIN = false;
    bf16 *base0, *base1, *base2, *base3;
    float* gates; const float* bgate;
    __device__ __forceinline__ void operator()(const f32x4 (&acc)[2][2][4][2], const pg8::Unit& u, int wr, int wc, int fr, int fq) const {
        if (u.pn == 8) {
            if (wc == 0 && fq < 2) { const int row0 = u.pm * 256 + wr * 64 + fr; const f32x4 b0 = *(const f32x4*)(bgate + 8 * fq), b1 = *(const f32x4*)(bgate + 8 * fq + 4);
#pragma unroll
                for (int ai = 0; ai < 2; ++ai)
#pragma unroll
                    for (int m = 0; m < 4; ++m) { float* gp = gates + (size_t)(row0 + ai * 128 + m * 16) * 16 + 8 * fq; *(f32x4*)gp = acc[ai][0][m][0] + b0; *(f32x4*)(gp + 4) = acc[ai][0][m][1] + b1; } }
            return; }
        const int row0 = u.pm * 256 + wr * 64 + fr; const int sel = u.pn >> 1; bf16* O = sel == 0 ? base0 : (sel == 1 ? base1 : (sel == 2 ? base2 : base3)); const int col0 = (u.pn & 1) * 256 + wc * 32 + 8 * fq;
#pragma unroll
        for (int ai = 0; ai < 2; ++ai)
#pragma unroll
            for (int m = 0; m < 4; ++m) { bf16* rowp = O + (size_t)(row0 + ai * 128 + m * 16) * 512 + col0;
#pragma unroll
                for (int bj = 0; bj < 2; ++bj) { const f32x4 v0 = acc[ai][bj][m][0], v1 = acc[ai][bj][m][1];
                    v4u w; w.x = pg8::cvt_pk_bf16(v0[0], v0[1]); w.y = pg8::cvt_pk_bf16(v0[2], v0[3]); w.z = pg8::cvt_pk_bf16(v1[0], v1[1]); w.w = pg8::cvt_pk_bf16(v1[2], v1[3]);
                    *(v4u*)(rowp + bj * 128) = w; } }
    }
};
struct EpiBias16 {
    static constexpr bool PERM = true, AFTER_DRAIN = false;
    bf16* O; int ldc; const float* bias;
    __device__ __forceinline__ void operator()(const f32x4 (&acc)[2][2][4][2], const pg8::Unit& u, int wr, int wc, int fr, int fq) const {
        const int row0 = u.pm * 256 + wr * 64 + fr; const int col0 = u.pn * 256 + wc * 32 + 8 * fq;
        f32x4 bv[2][2];
#pragma unroll
        for (int bj = 0; bj < 2; ++bj)
#pragma unroll
            for (int n = 0; n < 2; ++n) bv[bj][n] = *(const f32x4*)(bias + col0 + bj * 128 + 4 * n);
#pragma unroll
        for (int ai = 0; ai < 2; ++ai)
#pragma unroll
            for (int m = 0; m < 4; ++m) { bf16* rowp = O + (size_t)(row0 + ai * 128 + m * 16) * ldc + col0;
#pragma unroll
                for (int bj = 0; bj < 2; ++bj) { const f32x4 v0 = acc[ai][bj][m][0] + bv[bj][0], v1 = acc[ai][bj][m][1] + bv[bj][1];
                    v4u w; w.x = pg8::cvt_pk_bf16(v0[0], v0[1]); w.y = pg8::cvt_pk_bf16(v0[2], v0[3]); w.z = pg8::cvt_pk_bf16(v1[0], v1[1]); w.w = pg8::cvt_pk_bf16(v1[2], v1[3]);
                    *(v4u*)(rowp + bj * 128) = w; } }
    }
};
struct EpiUp {
    static constexpr bool PERM = true, AFTER_DRAIN = false;
    bf16* O; const float* bias;
    __device__ __forceinline__ void operator()(const f32x4 (&acc)[2][2][4][2], const pg8::Unit& u, int wr, int wc, int fr, int fq) const {
        const int row0 = u.pm * 256 + wr * 64 + fr; const int col0 = u.pn * 256 + wc * 32 + 8 * fq;
        const int isg = u.pn >= 10 ? 1 : 0, qb = u.pn - 10 * isg, b = row0 >> 12;
        bf16* base = O + ((size_t)(b * 10 + qb) * SEQ) * 512 + isg * 256 + wc * 32 + 8 * fq;
        f32x4 bv[2][2];
#pragma unroll
        for (int bj = 0; bj < 2; ++bj)
#pragma unroll
            for (int n = 0; n < 2; ++n) bv[bj][n] = *(const f32x4*)(bias + col0 + bj * 128 + 4 * n);
#pragma unroll
        for (int ai = 0; ai < 2; ++ai)
#pragma unroll
            for (int m = 0; m < 4; ++m) { bf16* rowp = base + (size_t)((row0 + ai * 128 + m * 16) & (SEQ - 1)) * 512;
#pragma unroll
                for (int bj = 0; bj < 2; ++bj) { const f32x4 v0 = acc[ai][bj][m][0] + bv[bj][0], v1 = acc[ai][bj][m][1] + bv[bj][1];
                    v4u w; w.x = pg8::cvt_pk_bf16(v0[0], v0[1]); w.y = pg8::cvt_pk_bf16(v0[2], v0[3]); w.z = pg8::cvt_pk_bf16(v1[0], v1[1]); w.w = pg8::cvt_pk_bf16(v1[2], v1[3]);
                    *(v4u*)(rowp + bj * 128) = w; } }
    }
};
struct EpiGate16 {
    static constexpr bool PERM = true, AFTER_DRAIN = false;
    bf16* O; int ldc; const float* gate; const float* bias;
    __device__ __forceinline__ void operator()(const f32x4 (&acc)[2][2][4][2], const pg8::Unit& u, int wr, int wc, int fr, int fq) const {
        const int row0 = u.pm * 256 + wr * 64 + fr; const int col0 = u.pn * 256 + wc * 32 + 8 * fq;
        const float* gp = gate + (size_t)((u.pm * 256) >> 12) * 6144 + col0;
        f32x4 gv[2][2], bv[2][2];
#pragma unroll
        for (int bj = 0; bj < 2; ++bj)
#pragma unroll
            for (int n = 0; n < 2; ++n) { gv[bj][n] = *(const f32x4*)(gp + bj * 128 + 4 * n); bv[bj][n] = bias ? *(const f32x4*)(bias + col0 + bj * 128 + 4 * n) : (f32x4){0.f, 0.f, 0.f, 0.f}; }
#pragma unroll
        for (int ai = 0; ai < 2; ++ai)
#pragma unroll
            for (int m = 0; m < 4; ++m) { bf16* rowp = O + (size_t)(row0 + ai * 128 + m * 16) * ldc + col0;
#pragma unroll
                for (int bj = 0; bj < 2; ++bj) { const f32x4 v0 = gv[bj][0] * (acc[ai][bj][m][0] + bv[bj][0]), v1 = gv[bj][1] * (acc[ai][bj][m][1] + bv[bj][1]);
                    v4u w; w.x = pg8::cvt_pk_bf16(v0[0], v0[1]); w.y = pg8::cvt_pk_bf16(v0[2], v0[3]); w.z = pg8::cvt_pk_bf16(v1[0], v1[1]); w.w = pg8::cvt_pk_bf16(v1[2], v1[3]);
                    *(v4u*)(rowp + bj * 128) = w; } }
    }
};
struct EpiRes {
    static constexpr bool PERM = false, AFTER_DRAIN = false;
    const float* res; float* out; const float* gate; const float* bias;
    __device__ __forceinline__ void operator()(const f32x4 (&acc)[2][2][4][2], const pg8::Unit& u, int wr, int wc, int fr, int fq) const {
        const int row0 = u.pm * 256 + wr * 64 + fr, col0 = u.pn * 256 + wc * 32 + 4 * fq;
        const float* gp = gate + (size_t)((u.pm * 256) >> 12) * 6144 + col0;
        f32x4 gv[2][2], bv[2][2];
#pragma unroll
        for (int bj = 0; bj < 2; ++bj)
#pragma unroll
            for (int n = 0; n < 2; ++n) { gv[bj][n] = *(const f32x4*)(gp + bj * 128 + n * 16); bv[bj][n] = bias ? *(const f32x4*)(bias + col0 + bj * 128 + n * 16) : (f32x4){0.f, 0.f, 0.f, 0.f}; }
#pragma unroll
        for (int ai = 0; ai < 2; ++ai)
#pragma unroll
            for (int m = 0; m < 4; ++m) { const size_t off = (size_t)(row0 + ai * 128 + m * 16) * DM + col0;
#pragma unroll
                for (int bj = 0; bj < 2; ++bj)
#pragma unroll
                    for (int n = 0; n < 2; ++n) { const f32x4 r = *(const f32x4*)(res + off + bj * 128 + n * 16);
                        *(f32x4*)(out + off + bj * 128 + n * 16) = r + gv[bj][n] * (acc[ai][bj][m][n] + bv[bj][n]); }
                if (m & 1) asm volatile("" ::: "memory"); }
    }
};

__device__ __forceinline__ void lds_barrier() { asm volatile("s_waitcnt lgkmcnt(0)" ::: "memory"); __builtin_amdgcn_s_barrier(); asm volatile("" ::: "memory"); }
constexpr int PA_WQ = 0, PA_WK = 32768, PA_A = 65536, PA_V = 98304, PA_SM = 135168, VS = 288;
__device__ __forceinline__ void unit_decode(int unit, int& bh, int& row0, int& t0, int& L) {
    if (unit < NUNIT_L) { bh = unit >> 5; const int c = unit & 31; row0 = (bh >> 2) * SEQ + c * 128; t0 = c * 128; L = SEQ; }
    else { const int uc = unit - NUNIT_L; bh = uc >> 1; const int cc = uc & 1; row0 = MROWS + (bh >> 2) * CTXL + cc * 128; t0 = cc * 128; L = CTXL; }
}
__device__ __forceinline__ void stage_v128(const bf16* V, int row0, int h, LAS uchar* img, int tid) {
    const int j = tid >> 2, seg = tid & 3; const bf16* vr = V + (size_t)(row0 + j) * 512 + h * HD + seg * 32;
#pragma unroll
    for (int i = 0; i < 4; ++i) *(LAS v4u*)(img + j * VS + (seg * 32 + 8 * i) * 2) = *(const v4u*)(vr + 8 * i);
}
struct PrepLd { v4u xp[4], xc[4], xn[4], vv[4]; float g[4]; };
__device__ __forceinline__ void prep_issue(const Args& a, int unit, int tid, PrepLd& ld) {
    int bh, row0, t0, L; unit_decode(unit, bh, row0, t0, L);
    const int h = bh & 3, lane = tid & 63, wave = tid >> 6;
    const bf16* XM = (const bf16*)(a.ws + WS_XM); const bf16* V = (const bf16*)(a.ws + WS_V);
    { const int l = tid >> 2, seg = tid & 3, t = t0 + l; const bf16* xc = XM + (size_t)(row0 + l) * 512 + h * HD + seg * 32; const bool hp = t > 0, hn = t + 1 < L;
#pragma unroll
      for (int i = 0; i < 4; ++i) { ld.xc[i] = *(const v4u*)(xc + 8 * i); ld.xp[i] = (v4u){0u, 0u, 0u, 0u}; ld.xn[i] = (v4u){0u, 0u, 0u, 0u};
          if (hp) ld.xp[i] = *(const v4u*)(xc - 512 + 8 * i);
          if (hn) ld.xn[i] = *(const v4u*)(xc + 512 + 8 * i); }
      const bf16* vr = V + (size_t)(row0 + l) * 512 + h * HD + seg * 32;
#pragma unroll
      for (int i = 0; i < 4; ++i) ld.vv[i] = *(const v4u*)(vr + 8 * i); }
    if (wave < 2) { const float* GG = (const float*)(a.ws + WS_G) + (size_t)row0 * 16 + wave * 8 + h;
        const int j0 = wave ? 127 - 2 * lane : 2 * lane, j1 = wave ? 126 - 2 * lane : 2 * lane + 1;
        ld.g[0] = GG[j0 * 16]; ld.g[1] = GG[j0 * 16 + 4]; ld.g[2] = GG[j1 * 16]; ld.g[3] = GG[j1 * 16 + 4]; }
}
constexpr int PA_CW = PA_SM + 2048;
__device__ __forceinline__ void prep_unit(const Args& a, LAS uchar* lds, int unit, int next_unit, int& cur_h, PrepLd& ld, TProbe& tp) {
    int tid_ = threadIdx.x; asm volatile("" : "+v"(tid_)); const int tid = tid_, lane = tid & 63, wave = __builtin_amdgcn_readfirstlane(tid >> 6), kq = lane >> 4, fr = lane & 15;
    uchar* ws = a.ws;
    int bh, row0, t0, L; unit_decode(unit, bh, row0, t0, L);
    const int h = bh & 3; const bool latent = unit < NUNIT_L;
    LAS float* sm = (LAS float*)(lds + PA_SM);
    bf16* AB = (bf16*)((uchar*)a.out + DO_AB); bf16* Q = (bf16*)((uchar*)a.out + DO_Q); bf16* K = (bf16*)((uchar*)a.out + DO_K);
    lds_barrier();
    if (TP_P) TP_START(tp);
    if (cur_h != h) {
        const bf16* WQ = (const bf16*)(ws + WS_WQ) + (size_t)h * HD * HD; const bf16* WK = (const bf16*)(ws + WS_WK) + (size_t)h * HD * HD;
#pragma unroll
        for (int i = 0; i < 4; ++i) { const int id = tid + NTHR * i, row = id >> 4, ch = id & 15;
            *(LAS v4u*)(lds + PA_WQ + img_off(row, ch)) = *(const v4u*)(WQ + row * 128 + ch * 8); *(LAS v4u*)(lds + PA_WK + img_off(row, ch)) = *(const v4u*)(WK + row * 128 + ch * 8); }
        { const int arr = tid >> 7, cidx = tid & 127; ((LAS float*)(lds + PA_CW))[tid] = (arr < 3) ? a.in[8][arr * 512 + h * HD + cidx] : a.in[9][h * HD + cidx]; }
        cur_h = h;
        lds_barrier();
    }
    if (wave < 2) {
        const int j0 = wave ? 127 - 2 * lane : 2 * lane, j1 = wave ? 126 - 2 * lane : 2 * lane + 1;
        const float li0 = ld.g[0], lf0 = logsig_f(ld.g[1]), li1 = ld.g[2], lf1 = logsig_f(ld.g[3]);
        const float incl = lane_scan_add(lf0 + lf1, lane), total = __shfl(incl, 63);
        const float g0 = total - (incl - lf1) + li0, g1 = total - incl + li1;
        const float mx = wave_max(fmaxf(g0, g1));
        sm[wave * 128 + j0] = __expf(g0 - mx); sm[wave * 128 + j1] = __expf(g1 - mx);
        if (lane == 0) { sm[256 + 2 * wave] = total; sm[257 + 2 * wave] = mx; }
    }
    {
        const int l = tid >> 2, seg = tid & 3; const int colg = h * HD + seg * 32;
        const LAS float* cw = (const LAS float*)(lds + PA_CW) + seg * 32;
#pragma unroll
        for (int i = 0; i < 4; ++i) {
            const v4u c = ld.xc[i], p = ld.xp[i], n = ld.xn[i];
            float o[8];
#pragma unroll
            for (int hf = 0; hf < 2; ++hf) {
                const f32x4 w0 = *(const LAS f32x4*)(cw + 8 * i + 4 * hf), w1 = *(const LAS f32x4*)(cw + 128 + 8 * i + 4 * hf), w2 = *(const LAS f32x4*)(cw + 256 + 8 * i + 4 * hf), bb = *(const LAS f32x4*)(cw + 384 + 8 * i + 4 * hf);
                const f32x4 xp = bf4((v2u){p[2 * hf], p[2 * hf + 1]}), xcv = bf4((v2u){c[2 * hf], c[2 * hf + 1]}), xn = bf4((v2u){n[2 * hf], n[2 * hf + 1]});
                const f32x4 y = w0 * xp + w1 * xcv + w2 * xn + bb;
#pragma unroll
                for (int e = 0; e < 4; ++e) o[4 * hf + e] = silu_f(y[e]); }
            const v4u w = (v4u){pk2(o[0], o[1]), pk2(o[2], o[3]), pk2(o[4], o[5]), pk2(o[6], o[7])};
            *(LAS v4u*)(lds + PA_A + img_off(l, seg * 4 + i)) = w;
            if (latent) *(v4u*)(AB + (size_t)(row0 + l) * 512 + colg + 8 * i) = w;
            *(LAS v4u*)(lds + PA_V + l * VS + (seg * 32 + 8 * i) * 2) = ld.vv[i];
        }
    }
    if (TP_P) TP_MARK(tp, 0);
    lds_barrier();
    if (TP_P) TP_MARK(tp, 1);
    { int tid2 = tid; asm volatile("" : "+v"(tid2)); if (next_unit >= 0) prep_issue(a, next_unit, tid2, ld); }
    if (latent) {
        const BFrag ba = load_bfrag(lds + PA_A, 16 * wave + fr, kq);
        const size_t tok = (size_t)(row0 + 16 * wave + fr);
#pragma unroll 1
        for (int pass = 0; pass < 2; ++pass) {
            const LAS uchar* wimg = lds + (pass ? PA_WK : PA_WQ);
            bf16* dst = (pass ? K : Q) + tok * 512 + h * HD + 4 * kq;
#pragma unroll
            for (int mt = 0; mt < 8; ++mt) { const f32x4 acc = mma_a((f32x4){0.f, 0.f, 0.f, 0.f}, wimg, 16 * mt + fr, ba, kq);
                *(v2u*)(dst + 16 * mt) = (v2u){pk2(acc[0], acc[1]), pk2(acc[2], acc[3])}; if (mt & 1) MEMFENCE(); }
        }
    }
    if (TP_P) TP_MARK(tp, 2);
    f32x4 kacc[8];
    { const BFrag bk = load_bfrag(lds + PA_WK, 16 * wave + fr, kq);
#pragma unroll
      for (int mt = 0; mt < 8; ++mt) { kacc[mt] = mma_a((f32x4){0.f, 0.f, 0.f, 0.f}, lds + PA_A, 16 * mt + fr, bk, kq); if (mt & 1) MEMFENCE(); } }
    if (TP_P) TP_MARK(tp, 3);
    {
        bf16* DC = (bf16*)(ws + WS_DC); float* SC = (float*)(ws + WS_SC);
        BFrag akf, akb;
#pragma unroll
        for (int ks = 0; ks < 4; ++ks) { unsigned wf_[4], wb_[4];
#pragma unroll
            for (int hh = 0; hh < 2; ++hh) { const int mt = 2 * ks + hh; const f32x4 wf4 = *(const LAS f32x4*)(sm + 16 * mt + 4 * kq), wb4 = *(const LAS f32x4*)(sm + 128 + 16 * mt + 4 * kq);
                const f32x4 kf = kacc[mt] * wf4, kb = kacc[mt] * wb4;
                wf_[2 * hh] = pk2(kf[0], kf[1]); wf_[2 * hh + 1] = pk2(kf[2], kf[3]); wb_[2 * hh] = pk2(kb[0], kb[1]); wb_[2 * hh + 1] = pk2(kb[2], kb[3]); }
            akf.f[ks] = __builtin_bit_cast(bf16x8, (v4u){wf_[0], wf_[1], wf_[2], wf_[3]}); akb.f[ks] = __builtin_bit_cast(bf16x8, (v4u){wb_[0], wb_[1], wb_[2], wb_[3]}); }
        const unsigned vbase = lds_addr(lds + PA_V) + tr_lane_off_p<VS>(lane);
        bf16* df = DC + (size_t)(unit * 2) * CT_SLOT + 16 * wave + 4 * kq; bf16* db = df + CT_SLOT;
#pragma unroll
        for (int c = 0; c < 8; ++c) { BFrag bv; tr_load4p<VS>(vbase + 32 * c, bv);
            const f32x4 af = mma_ff((f32x4){0.f, 0.f, 0.f, 0.f}, akf, bv), ab = mma_ff((f32x4){0.f, 0.f, 0.f, 0.f}, akb, bv);
            *(v2u*)(df + (size_t)(16 * c + fr) * 128) = (v2u){pk2(af[0], af[1]), pk2(af[2], af[3])};
            *(v2u*)(db + (size_t)(16 * c + fr) * 128) = (v2u){pk2(ab[0], ab[1]), pk2(ab[2], ab[3])}; }
        { const unsigned onesw = (fr == 0) ? 0x3f803f80u : 0u; BFrag ones;
#pragma unroll
          for (int s_ = 0; s_ < 4; ++s_) ones.f[s_] = __builtin_bit_cast(bf16x8, (v4u){onesw, onesw, onesw, onesw});
          const f32x4 nf = mma_ff((f32x4){0.f, 0.f, 0.f, 0.f}, akf, ones), nb = mma_ff((f32x4){0.f, 0.f, 0.f, 0.f}, akb, ones);
          if (fr == 0) { *(v2u*)(df + (size_t)128 * 128) = (v2u){pk2(nf[0], nf[1]), pk2(nf[2], nf[3])}; *(v2u*)(db + (size_t)128 * 128) = (v2u){pk2(nb[0], nb[1]), pk2(nb[2], nb[3])}; } }
        if (TP_P) TP_MARK(tp, 4);
        if (tid == 0) { SC[(unit * 2) * 2] = sm[256]; SC[(unit * 2) * 2 + 1] = sm[257]; SC[(unit * 2 + 1) * 2] = sm[258]; SC[(unit * 2 + 1) * 2 + 1] = sm[259]; }
    }
}

constexpr int F1S = 144, F2S = 80;
__device__ __forceinline__ void fft1_wave(const Args& a, LAS uchar* wl, int item, const bf16x8 (&bfr)[8][2], int lane) {
    const int kq = lane >> 4, fr = lane & 15;
    const int b = item >> 9, chunk = item & 511, cg0 = chunk * 64, n2 = cg0 >> 9, colb = cg0 & 511;
    const bf16* UF = (const bf16*)(a.ws + WS_UF) + (size_t)b * SEQ * 512 + cg0;
    bf16* TP = (bf16*)(a.ws + WS_TP); const float* TW = (const float*)(a.ws + WS_TW);
    v4u ld[8];
#pragma unroll
    for (int i = 0; i < 8; ++i) ld[i] = *(const v4u*)(UF + (size_t)(i * 8 + (lane >> 3)) * 32768 + (lane & 7) * 8);
#pragma unroll
    for (int i = 0; i < 8; ++i) *(LAS v4u*)(wl + (i * 8 + (lane >> 3)) * F1S + (lane & 7) * 16) = ld[i];
    LDS_WAIT();
    const unsigned base = lds_addr(wl) + tr_lane_off<F1S>(lane);
#pragma unroll 1
    for (int mt = 0; mt < 4; ++mt) {
        bf16x8 a0, a1; tr_load2<F1S>(base + 32 * mt, a0, a1);
        f32x4 acc[8];
#pragma unroll
        for (int nt = 0; nt < 8; ++nt) { acc[nt] = __builtin_amdgcn_mfma_f32_16x16x32_bf16(a0, bfr[nt][0], (f32x4){0.f, 0.f, 0.f, 0.f}, 0, 0, 0); acc[nt] = __builtin_amdgcn_mfma_f32_16x16x32_bf16(a1, bfr[nt][1], acc[nt], 0, 0, 0); }
        const int c0 = 16 * mt + 4 * kq, col0 = colb + c0;
#pragma unroll
        for (int nt = 0; nt < 4; ++nt) { const int k1 = 16 * nt + fr; const int idx = (n2 * k1) & 4095; const float cs = TW[idx], sn = TW[(idx - 1024) & 4095];
            float pr[4], pi[4];
#pragma unroll
            for (int r = 0; r < 4; ++r) { const float tr = acc[nt][r], ti = acc[nt + 4][r]; const float xr = tr * cs + ti * sn, xi = ti * cs - tr * sn;
                const bool st = ((col0 + r) & 127) >= 65; pr[r] = st ? -xi : xr; pi[r] = st ? xr : xi; }
            const size_t o = ((size_t)(b * 2) * 64 + k1) * 32768 + (size_t)cg0 + c0;
            *(v2u*)(TP + o) = (v2u){pk2(pr[0], pr[1]), pk2(pr[2], pr[3])};
            *(v2u*)(TP + o + (size_t)64 * 32768) = (v2u){pk2(pi[0], pi[1]), pk2(pi[2], pi[3])}; }
    }
}
__device__ __forceinline__ void fft2_wave(const Args& a, LAS uchar* wl, int item, const bf16x8 (&bfr)[4][4], int lane) {
    const int kq = lane >> 4, fr = lane & 15;
    const int b = item >> 10, k1 = (item >> 4) & 63, chunk = item & 15;
    const bf16* TP = (const bf16*)(a.ws + WS_TP); bf16* YM = (bf16*)(a.ws + WS_YM);
    v4u ld[8];
#pragma unroll
    for (int i = 0; i < 8; ++i) { const int kap = i * 16 + (lane >> 2), ri = kap >> 6, n2 = kap & 63;
        ld[i] = *(const v4u*)(TP + ((size_t)(b * 2 + ri) * 64 + k1) * 32768 + (size_t)n2 * 512 + chunk * 32 + (lane & 3) * 8); }
#pragma unroll
    for (int i = 0; i < 8; ++i) *(LAS v4u*)(wl + (i * 16 + (lane >> 2)) * F2S + (lane & 3) * 16) = ld[i];
    LDS_WAIT();
    const unsigned base = lds_addr(wl) + tr_lane_off<F2S>(lane);
#pragma unroll
    for (int mt = 0; mt < 2; ++mt) {
        BFrag af; tr_load4<F2S>(base + 32 * mt, af);
#pragma unroll
        for (int nt = 0; nt < 4; ++nt) { f32x4 acc = (f32x4){0.f, 0.f, 0.f, 0.f};
#pragma unroll
            for (int s_ = 0; s_ < 4; ++s_) acc = __builtin_amdgcn_mfma_f32_16x16x32_bf16(af.f[s_], bfr[nt][s_], acc, 0, 0, 0);
            const int k2 = 16 * nt + fr; const size_t row = (size_t)b * SEQ + k1 + 64 * k2;
            *(v2u*)(YM + row * 1024 + chunk * 32 + 16 * mt + 4 * kq) = (v2u){pk2(acc[0], acc[1]), pk2(acc[2], acc[3])}; }
    }
}
__device__ __forceinline__ void fft1_phase(const Args& a, LAS uchar* lds, int vcu, int G) {
    const int tid = threadIdx.x, lane = tid & 63, wave = __builtin_amdgcn_readfirstlane(tid >> 6), kq = lane >> 4, fr = lane & 15;
    const bf16* F1 = (const bf16*)(a.ws + WS_F1);
    bf16x8 bfr[8][2];
#pragma unroll
    for (int nt = 0; nt < 8; ++nt)
#pragma unroll
        for (int s_ = 0; s_ < 2; ++s_) bfr[nt][s_] = *(const bf16x8*)(F1 + (16 * nt + fr) * 64 + 32 * s_ + 8 * kq);
    LAS uchar* wl = lds + wave * 9216;
    if (G == 256) {
        const int bx = blockIdx.x;
        if (bx < 64) fft1_wave(a, wl, bx * NWAVES + wave, bfr, lane);
        else for (int it = 512 + (bx - 64) * NWAVES + wave; it < NB * 512; it += 192 * NWAVES) fft1_wave(a, wl, it, bfr, lane);
    } else for (int it = vcu * NWAVES + wave; it < NB * 512; it += G * NWAVES) fft1_wave(a, wl, it, bfr, lane);
}
__device__ __forceinline__ void fft2_phase(const Args& a, LAS uchar* lds, int vcu, int G) {
    const int tid = threadIdx.x, lane = tid & 63, wave = __builtin_amdgcn_readfirstlane(tid >> 6), kq = lane >> 4, fr = lane & 15;
    const bf16* G2 = (const bf16*)(a.ws + WS_G2);
    bf16x8 bfr[4][4];
#pragma unroll
    for (int nt = 0; nt < 4; ++nt)
#pragma unroll
        for (int s_ = 0; s_ < 4; ++s_) bfr[nt][s_] = *(const bf16x8*)(G2 + (16 * nt + fr) * 128 + 32 * s_ + 8 * kq);
    LAS uchar* wl = lds + wave * 10240;
    for (int it = vcu * NWAVES + wave; it < NB * 1024; it += G * NWAVES) fft2_wave(a, wl, it, bfr, lane);
}

__device__ __forceinline__ void p4_scan(const Args& a, int G) {
    uchar* ws = a.ws;
    const bf16* DC = (const bf16*)(ws + WS_DC); const float* SC = (const float*)(ws + WS_SC);
    bf16* CT = (bf16*)(ws + WS_CT); float* MS = (float*)(ws + WS_MS);
    constexpr int F4 = CT_SLOT / 4;
    const int total = 64 * F4;
    for (int gi = blockIdx.x * NTHR + threadIdx.x; gi < total; gi += G * NTHR) {
        const int seq = gi / F4, i = gi - seq * F4; const int bh = seq >> 1, dir = seq & 1;
        v2u dv[34]; f32x2 sc[34];
#pragma unroll
        for (int step = 0; step < 34; ++step) {
            const int unit = (step < 2) ? NUNIT_L + bh * 2 + (dir ? 1 - step : step) : bh * 32 + (dir ? 33 - step : step - 2);
            const int slot = unit * 2 + dir;
            dv[step] = *(const v2u*)(DC + (size_t)slot * CT_SLOT + 4 * i); sc[step] = *(const f32x2*)(SC + slot * 2);
        }
        f32x4 s = (f32x4){0.f, 0.f, 0.f, 0.f}; float m = 0.f;
#pragma unroll
        for (int step = 0; step < 34; ++step) {
            const int unit = (step < 2) ? NUNIT_L + bh * 2 + (dir ? 1 - step : step) : bh * 32 + (dir ? 33 - step : step - 2);
            const int slot = unit * 2 + dir;
            if (step >= 2) { *(v2u*)(CT + (size_t)slot * CT_SLOT + 4 * i) = (v2u){pk2(s.x, s.y), pk2(s.z, s.w)}; if (i == 0) MS[slot] = m; }
            const float bend = sc[step].x, mloc = sc[step].y;
            const float mn = fmaxf(bend + m, mloc), al = __expf(bend + m - mn), be = __expf(mloc - mn);
            s = s * al + bf4(dv[step]) * be; m = mn;
        }
    }
}

constexpr int OU_CF = 0, OU_CB = 33792, OU_V = 67584, OU_K = 104448, OU_SM = 137216;
struct OutLd { v4u cf[4], cb[4], kk[4], vv[4]; BFrag bq; float g[4], mf, mb; };
__device__ __forceinline__ void out_issue(const Args& a, int unit, int tid, OutLd& ld) {
    const int bh = unit >> 5, c = unit & 31, h = bh & 3, row0 = (bh >> 2) * SEQ + c * 128, lane = tid & 63, wave = tid >> 6, kq = lane >> 4, fr = lane & 15;
    const bf16* Q = (const bf16*)((const uchar*)a.out + DO_Q); const bf16* K = (const bf16*)((const uchar*)a.out + DO_K);
    const bf16* V = (const bf16*)(a.ws + WS_V); const bf16* CT = (const bf16*)(a.ws + WS_CT); const float* MS = (const float*)(a.ws + WS_MS);
    const bf16* sf = CT + (size_t)(unit * 2) * CT_SLOT; const bf16* sb = sf + CT_SLOT;
#pragma unroll
    for (int i = 0; i < 4; ++i) { const int id = tid + NTHR * i; ld.cf[i] = *(const v4u*)(sf + id * 8); ld.cb[i] = *(const v4u*)(sb + id * 8); }
#pragma unroll
    for (int i = 0; i < 4; ++i) { const int id = tid + NTHR * i, row = id >> 4, ch = id & 15; ld.kk[i] = *(const v4u*)(K + (size_t)(row0 + row) * 512 + h * HD + ch * 8); }
    { const int j = tid >> 2, seg = tid & 3; const bf16* vr = V + (size_t)(row0 + j) * 512 + h * HD + seg * 32;
#pragma unroll
      for (int i = 0; i < 4; ++i) ld.vv[i] = *(const v4u*)(vr + 8 * i); }
    { const size_t tok = (size_t)(row0 + 16 * wave + fr);
#pragma unroll
      for (int s_ = 0; s_ < 4; ++s_) ld.bq.f[s_] = *(const bf16x8*)(Q + tok * 512 + h * HD + 32 * s_ + 8 * kq); }
    if (wave < 2) { const float* GG = (const float*)(a.ws + WS_G) + (size_t)row0 * 16 + wave * 8 + h;
        const int j0 = wave ? 127 - 2 * lane : 2 * lane, j1 = wave ? 126 - 2 * lane : 2 * lane + 1;
        ld.g[0] = GG[j0 * 16]; ld.g[1] = GG[j0 * 16 + 4]; ld.g[2] = GG[j1 * 16]; ld.g[3] = GG[j1 * 16 + 4]; }
    ld.mf = MS[unit * 2]; ld.mb = MS[unit * 2 + 1];
}
__device__ __forceinline__ void out_unit(const Args& a, LAS uchar* lds, int unit, int next_unit, OutLd& ld, TProbe& tp) {
    int tid_ = threadIdx.x; asm volatile("" : "+v"(tid_)); const int tid = tid_, lane = tid & 63, wave = __builtin_amdgcn_readfirstlane(tid >> 6), kq = lane >> 4, fr = lane & 15;
    uchar* ws = a.ws;
    const int bh = unit >> 5, c = unit & 31, h = bh & 3, row0 = (bh >> 2) * SEQ + c * 128;
    LAS float* sm = (LAS float*)(lds + OU_SM);
    const bf16* AB = (const bf16*)((const uchar*)a.out + DO_AB); const bf16* Z = (const bf16*)(ws + WS_Z);
    bf16* YM = (bf16*)(ws + WS_YM);
    const float m_f = ld.mf, m_b = ld.mb;
    lds_barrier();
    if (TP_O) TP_START(tp);
    if (wave < 2) {
        const int j0 = wave ? 127 - 2 * lane : 2 * lane, j1 = wave ? 126 - 2 * lane : 2 * lane + 1;
        const float li0 = ld.g[0], lf0 = logsig_f(ld.g[1]), li1 = ld.g[2], lf1 = logsig_f(ld.g[3]);
        const float incl = lane_scan_add(lf0 + lf1, lane);
        const float b0 = incl - lf1, b1 = incl, r0 = li0 - b0, r1 = li1 - b1;
        const float mi = lane_scan_max(fmaxf(r0, r1), lane); float mprev = __shfl_up(mi, 1); if (lane == 0) mprev = -3.0e38f;
        const float R0 = fmaxf(mprev, r0), R1 = mi, mst = wave ? m_b : m_f;
        LAS float* d = sm + wave * 384;
        d[j0] = r0; d[j1] = r1; d[128 + j0] = fmaxf(mst, R0); d[128 + j1] = fmaxf(mst, R1); d[256 + j0] = b0; d[256 + j1] = b1;
    }
    {
        if (tid < 256) sm[768 + tid] = (tid < 128) ? a.in[13][h * HD + tid] : a.in[14][h * HD + tid - 128];
#pragma unroll
        for (int i = 0; i < 4; ++i) { const int id = tid + NTHR * i, row = id >> 4, ch = id & 15;
            *(LAS v4u*)(lds + OU_CF + img_off(row, ch)) = ld.cf[i]; *(LAS v4u*)(lds + OU_CB + img_off(row, ch)) = ld.cb[i]; }
        if (tid < 32) { const int dirn = tid >> 4, ch = tid & 15; const bf16* sn = (const bf16*)(ws + WS_CT) + (size_t)(unit * 2 + dirn) * CT_SLOT + 128 * 128 + ch * 8;
            *(LAS v4u*)(lds + (dirn ? OU_CB : OU_CF) + img_off(128, ch)) = *(const v4u*)sn; }
#pragma unroll
        for (int i = 0; i < 4; ++i) { const int id = tid + NTHR * i, row = id >> 4, ch = id & 15; *(LAS v4u*)(lds + OU_K + img_off(row, ch)) = ld.kk[i]; }
        { const int j = tid >> 2, seg = tid & 3;
#pragma unroll
          for (int i = 0; i < 4; ++i) *(LAS v4u*)(lds + OU_V + j * VS + (seg * 32 + 8 * i) * 2) = ld.vv[i]; }
    }
    const int l = 16 * wave + fr; const int tok = row0 + l;
    const BFrag bq = ld.bq;
    if (TP_O) TP_MARK(tp, 0);
    lds_barrier();
    if (TP_O) TP_MARK(tp, 1);
    f32x4 S[8];
#pragma unroll
    for (int mt = 0; mt < 8; ++mt) { S[mt] = mma_a((f32x4){0.f, 0.f, 0.f, 0.f}, lds + OU_K, 16 * mt + fr, bq, kq); if (mt & 1) MEMFENCE(); }
    if (TP_O) TP_MARK(tp, 2);
    const unsigned vbase = lds_addr(lds + OU_V) + tr_lane_off_p<VS>(lane);
    const unsigned onesw = (fr == 0) ? 0x3f803f80u : 0u; BFrag ones;
#pragma unroll
    for (int s_ = 0; s_ < 4; ++s_) ones.f[s_] = __builtin_bit_cast(bf16x8, (v4u){onesw, onesw, onesw, onesw});
    f32x4 hs[8];
    for (int dir = 0; dir < 2; ++dir) {
        const LAS float* rr = sm + dir * 384; const LAS float* rho = rr + 128; const LAS float* bl = rr + 256;
        const float rho_l = rho[l], mst = dir ? m_b : m_f;
        BFrag bp;
#pragma unroll
        for (int ks = 0; ks < 4; ++ks) { unsigned w[4];
#pragma unroll
            for (int hh = 0; hh < 2; ++hh) { const int mt = 2 * ks + hh; float p[4]; const f32x4 rv = *(const LAS f32x4*)(rr + 16 * mt + 4 * kq);
#pragma unroll
                for (int r = 0; r < 4; ++r) { const int j = 16 * mt + 4 * kq + r; const bool ok = dir ? (j >= l) : (j <= l); p[r] = ok ? S[mt][r] * __expf(fminf(rv[r] - rho_l, 0.f)) : 0.f; }
                w[2 * hh] = pk2(p[0], p[1]); w[2 * hh + 1] = pk2(p[2], p[3]); }
            bp.f[ks] = __builtin_bit_cast(bf16x8, (v4u){w[0], w[1], w[2], w[3]}); }
        f32x4 acc[9];
        const float wi = __expf(mst - rho_l);
        const LAS uchar* cimg = lds + (dir ? OU_CB : OU_CF);
#pragma unroll
        for (int mt = 0; mt < 9; ++mt) { acc[mt] = mma_a((f32x4){0.f, 0.f, 0.f, 0.f}, cimg, 16 * mt + fr, bq, kq) * wi; if (mt & 1) MEMFENCE(); }
#pragma unroll
        for (int mt = 0; mt < 8; ++mt) { BFrag av; tr_load4p<VS>(vbase + 32 * mt, av); acc[mt] = mma_ff(acc[mt], av, bp); }
        acc[8] = mma_ff(acc[8], ones, bp);
        const float den = __shfl(acc[8][0], fr);
        const float sc = 1.0f / fmaxf(fabsf(den), __expf(-bl[l] - rho_l));
#pragma unroll
        for (int mt = 0; mt < 8; ++mt) hs[mt] = dir ? hs[mt] + acc[mt] * sc : acc[mt] * sc;
    }
    if (TP_O) TP_MARK(tp, 3);
    v2u av8[8], zv8[8];
#pragma unroll
    for (int mt = 0; mt < 8; ++mt) { const int e0 = 16 * mt + 4 * kq; av8[mt] = *(const v2u*)(AB + (size_t)tok * 512 + h * HD + e0); zv8[mt] = *(const v2u*)(Z + (size_t)tok * 512 + h * HD + e0); }
    MEMFENCE();
    { int tid2 = tid; asm volatile("" : "+v"(tid2)); if (next_unit >= 0) out_issue(a, next_unit, tid2, ld); }
    float s1 = 0.f;
#pragma unroll
    for (int mt = 0; mt < 8; ++mt) s1 += (hs[mt][0] + hs[mt][1]) + (hs[mt][2] + hs[mt][3]);
    s1 += __shfl_xor(s1, 16); s1 += __shfl_xor(s1, 32);
    const float mu = s1 * (1.0f / 128.0f); float s2 = 0.f;
#pragma unroll
    for (int mt = 0; mt < 8; ++mt) { const f32x4 d = hs[mt] - mu; s2 += (d[0] * d[0] + d[1] * d[1]) + (d[2] * d[2] + d[3] * d[3]); }
    s2 += __shfl_xor(s2, 16); s2 += __shfl_xor(s2, 32);
    const float rstd = rsqrtf(s2 * (1.0f / 128.0f) + EPS);
    const LAS float* mw = sm + 768; const LAS float* msk = sm + 896;
#pragma unroll
    for (int mt = 0; mt < 8; ++mt) { const int e0 = 16 * mt + 4 * kq;
        const f32x4 w = *(const LAS f32x4*)(mw + e0), k4 = *(const LAS f32x4*)(msk + e0);
        const f32x4 a4 = bf4(av8[mt]), z4 = bf4(zv8[mt]);
        float y[4];
#pragma unroll
        for (int r = 0; r < 4; ++r) y[r] = ((hs[mt][r] - mu) * rstd * w[r] + k4[r] * a4[r]) * silu_f(z4[r]);
        *(v2u*)(YM + (size_t)tok * 1024 + 512 + h * HD + e0) = (v2u){pk2(y[0], y[1]), pk2(y[2], y[3])}; }
    if (TP_O) TP_MARK(tp, 4);
}

__device__ __forceinline__ void p9_conv(const Args& a, int vcu, int G) {
    const int tid = threadIdx.x, lane = tid & 63, wave = __builtin_amdgcn_readfirstlane(tid >> 6);
    const bf16* U = (const bf16*)(a.ws + WS_U); bf16* ACT = (bf16*)(a.ws + WS_ACT);
    const float* fw = a.in[19]; const float* fb = a.in[20];
    const int gw = vcu * NWAVES + wave, NGW = G * NWAVES;
    const int hk = lane >> 5, li = lane & 31;
    const bool xmap = (G == 256);
    for (int k = 0; k < (xmap ? 5 : (NB * 64 * 10 * 2 + NGW - 1) / NGW); ++k) {
        int half, qb, r, b;
        if (xmap) { const int idx = (vcu & 31) * NWAVES + wave + 256 * k; b = vcu >> 5; qb = idx >> 7; r = (idx & 127) >> 1; half = idx & 1; }
        else { const int it = gw + k * NGW; if (it >= NB * 64 * 10 * 2) break; half = it & 1; qb = (it >> 1) % 10; const int br = (it >> 1) / 10; r = br & 63; b = br >> 6; }
        const int ch = hk * DFF + qb * 256 + 8 * li;
        const float z0 = (r > 0) ? 1.f : 0.f, z2 = (r < 63) ? 1.f : 0.f;
        f32x4 w0[9], w1[9];
#pragma unroll
        for (int t = 0; t < 9; ++t) { const float zz = (t < 3) ? z0 : (t >= 6 ? z2 : 1.f); w0[t] = *(const f32x4*)(fw + t * UPW + ch) * zz; w1[t] = *(const f32x4*)(fw + t * UPW + ch + 4) * zz; }
        const f32x4 b0 = *(const f32x4*)(fb + ch), b1 = *(const f32x4*)(fb + ch + 4);
        const bf16* rp[3];
        rp[1] = U + ((size_t)(b * 10 + qb) * SEQ + r * 64) * 512 + lane * 8;
        rp[0] = (r > 0) ? rp[1] - (size_t)64 * 512 : rp[1];
        rp[2] = (r < 63) ? rp[1] + (size_t)64 * 512 : rp[1];
        v4u x[3][6];
        const int c0 = half * 32;
        { const int cm = (c0 > 0) ? c0 - 1 : 0;
#pragma unroll
          for (int i = 0; i < 3; ++i) { x[i][0] = *(const v4u*)(rp[i] + (size_t)cm * 512); x[i][1] = *(const v4u*)(rp[i] + (size_t)c0 * 512); }
          if (c0 == 0) {
#pragma unroll
              for (int i = 0; i < 3; ++i) x[i][0] = (v4u){0u, 0u, 0u, 0u}; } }
        bf16* orow = ACT + (size_t)(b * SEQ + r * 64) * DFF + qb * 256 + 8 * li + 4 * hk;
#pragma unroll 1
        for (int cb = 0; cb < 8; ++cb) {
            const int c = c0 + 4 * cb;
            const int cl = (c + 4 <= 63) ? c + 4 : 63;
#pragma unroll
            for (int i = 0; i < 3; ++i) {
#pragma unroll
                for (int j = 0; j < 3; ++j) x[i][2 + j] = *(const v4u*)(rp[i] + (size_t)(c + 1 + j) * 512);
                x[i][5] = *(const v4u*)(rp[i] + (size_t)cl * 512);
            }
            if (c + 4 > 63) {
#pragma unroll
                for (int i = 0; i < 3; ++i) x[i][5] = (v4u){0u, 0u, 0u, 0u}; }
#pragma unroll
            for (int o = 0; o < 4; ++o) {
                f32x4 a0 = b0, a1 = b1;
#pragma unroll
                for (int i = 0; i < 3; ++i)
#pragma unroll
                    for (int j = 0; j < 3; ++j) { const v4u xx = x[i][o + j]; a0 += w0[i * 3 + j] * bf4((v2u){xx.x, xx.y}); a1 += w1[i * 3 + j] * bf4((v2u){xx.z, xx.w}); }
                f32x4 snd = hk ? a0 : a1, rcv;
#pragma unroll
                for (int e = 0; e < 4; ++e) rcv[e] = __shfl_xor(snd[e], 32);
                float ov[4];
#pragma unroll
                for (int e = 0; e < 4; ++e) ov[e] = hk ? rcv[e] * silu_f(a1[e]) : a0[e] * silu_f(rcv[e]);
                *(v2u*)(orow + (size_t)(c + o) * DFF) = (v2u){pk2(ov[0], ov[1]), pk2(ov[2], ov[3])};
            }
#pragma unroll
            for (int i = 0; i < 3; ++i) { x[i][0] = x[i][4]; x[i][1] = x[i][5]; }
        }
    }
}

constexpr int LDS_BYTES = 147456, MISC_OFF = 147456 - 256;
constexpr int NPHASE = 12;
#ifndef MK_PER_PHASE
#define MK_PER_PHASE 0
#endif
__global__ void __launch_bounds__(NTHR, 2) mk_fwd(Args args) {
    extern __shared__ __attribute__((aligned(16))) uchar lds_raw[];
    LAS uchar* lds = (LAS uchar*)lds_raw;
    const int tid = threadIdx.x;
    const int G = gridDim.x; const int bx = blockIdx.x; const int vcu = (G % 8 == 0) ? (bx % 8) * (G / 8) + bx / 8 : bx;
    volatile LAS unsigned* MISC = (volatile LAS unsigned*)(lds + MISC_OFF);
    if (tid < 64) MISC[tid] = 0u;
    __syncthreads();
    XcdBarrier bar; bar.bar = (unsigned*)(args.ws + WS_CTL); bar.x = 0; bar.st = nullptr;
    if (!MK_PER_PHASE) bar = xcd_barrier_post((unsigned*)(args.ws + WS_CTL), MISC + 8);
    TProbe tp; for (int i_ = 0; i_ < 8; ++i_) tp.t[i_] = 0; tp.last = 0; tp.ph = 0;
    const int lo = args.ph_lo, hi = args.ph_hi;
#ifndef PH_MASK
#define PH_MASK 0xFFF
#endif
#define IN(k) (((PH_MASK >> (k)) & 1) && lo <= (k) && (k) < hi)
#define REP(k) for (int rep_ = 0; rep_ <= ((REP_MASK >> (k)) & 1); ++rep_, __syncthreads())
#define PH_T0(k) do { if (TP_SEL == 32 + (k)) tp.ph = __builtin_amdgcn_s_memrealtime(); } while (0)
#define PH_T1(k) do { if (TP_SEL == 32 + (k)) tp.t[0] = __builtin_amdgcn_s_memrealtime() - tp.ph; } while (0)
#define SEAM(k) do { if (IN(k) && IN((k) + 1)) { xcd_barrier(bar); if ((REP_MASK >> 20) & 1) { xcd_barrier(bar); xcd_barrier(bar); } } } while (0)
    uchar* ws = args.ws;
    PH_T0(0); if (IN(0)) { if ((REP_MASK >> 16) & 1) { p0_prologue(args, lds, vcu, G, WS_MOD + 512 * 1024); __syncthreads(); } p0_prologue(args, lds, vcu, G, WS_MOD); } SEAM(0); PH_T1(0);
    PH_T0(1); if (IN(1)) REP(1) { p1_rows(args, lds, vcu, G); } SEAM(1); PH_T1(1);
    PH_T0(2); if (IN(2)) REP(2) {
        pg8::Gemm g{(const bf16*)(ws + WS_HX), (const bf16*)(ws + WS_WIN), TROWS, 2304, DM}; SchedP2 S; S.init(G, bx);
        EpiP2 E{(bf16*)(ws + WS_UF), (bf16*)(ws + WS_XM), (bf16*)(ws + WS_V), (bf16*)(ws + WS_Z), (float*)(ws + WS_G), args.in[12]};
        pg8::gemm_phase<EpiP2, SchedP2, true, true>(lds, g, S, E);
        if (rep_ == 0 && G > 168 && bx >= 168) tr_items(args, lds, TR_EARLY, TR_ALL, (bx - 168) * NWAVES + (tid >> 6), (G - 168) * NWAVES);
    } SEAM(2); PH_T1(2);
    PH_T0(3); if (IN(3)) REP(3) {
        for (int rr_ = 0; rr_ <= ((REP_MASK >> 12) & 1); ++rr_) { int cur_h = -1; PrepLd pld; if (bx < NUNIT) prep_issue(args, bx, tid, pld); for (int it = bx; it < NUNIT; it += G) prep_unit(args, lds, it, (it + G < NUNIT) ? it + G : -1, cur_h, pld, tp); }
        __syncthreads();
        for (int rr_ = 0; rr_ <= ((REP_MASK >> 13) & 1); ++rr_) fft1_phase(args, lds, vcu, G);
    } SEAM(3); PH_T1(3);
    PH_T0(4); if (IN(4)) REP(4) {
        for (int rr_ = 0; rr_ <= ((REP_MASK >> 14) & 1); ++rr_) fft2_phase(args, lds, vcu, G);
        for (int rr_ = 0; rr_ <= ((REP_MASK >> 15) & 1); ++rr_) p4_scan(args, G);
    } SEAM(4); PH_T1(4);
    PH_T0(5); if (IN(5)) REP(5) { { OutLd old_; if (bx < NUNIT_L) out_issue(args, bx, tid, old_); for (int it = bx; it < NUNIT_L; it += G) out_unit(args, lds, it, (it + G < NUNIT_L) ? it + G : -1, old_, tp); } __syncthreads(); } SEAM(5); PH_T1(5);
    PH_T0(6); if (IN(6)) REP(6) {
        pg8::Gemm g{(const bf16*)(ws + WS_YM), (const bf16*)(ws + WS_WOUT), MROWS, DM, 1024}; pg8::StaticOrder S; S.init(MROWS, DM, G, bx);
        EpiGate16 E{(bf16*)args.out, 2048, (const float*)(ws + WS_MOD) + 2048, nullptr};
        pg8::gemm_phase<EpiGate16, pg8::StaticOrder, true, true>(lds, g, S, E);
    } SEAM(6); PH_T1(6);
    PH_T0(7); if (IN(7)) REP(7) { p7_rows(args, vcu, G); } SEAM(7); PH_T1(7);
    PH_T0(8); if (IN(8)) REP(8) {
        pg8::Gemm g{(const bf16*)(ws + WS_H2), (const bf16*)(ws + WS_WUP), MROWS, UPW, DM}; pg8::StaticOrder S; S.init(MROWS, UPW, G, bx);
        EpiUp E{(bf16*)(ws + WS_U), args.in[18]};
        pg8::gemm_phase<EpiUp, pg8::StaticOrder, true, true>(lds, g, S, E);
    } SEAM(8); PH_T1(8);
    PH_T0(9); if (IN(9)) REP(9) { p9_conv(args, vcu, G); } SEAM(9); PH_T1(9);
    PH_T0(10); if (IN(10)) {
        pg8::Gemm g{(const bf16*)(ws + WS_ACT), (const bf16*)(ws + WS_WDN), MROWS, DM, DFF}; pg8::StaticOrder S; S.init(MROWS, DM, G, bx);
        EpiGate16 E{(bf16*)(ws + WS_U), 1024, (const float*)(ws + WS_MOD) + 5120, args.in[22]};
        for (int rr_ = 0; rr_ <= ((REP_MASK >> 10) & 1); ++rr_) { if (rr_) __syncthreads(); pg8::gemm_phase<EpiGate16, pg8::StaticOrder, true, true>(lds, g, S, E); }
    } SEAM(10); PH_T1(10);
    PH_T0(11); if (IN(11)) { if ((REP_MASK >> 11) & 1) p11_rows(args, vcu, G, (float*)(ws + 0)); p11_rows(args, vcu, G, args.out); }
    PH_T1(11);
    if (TP_SEL && bx == 0 && tid == 0) { const unsigned long long t0_ = __builtin_amdgcn_s_memrealtime(), dl_ = (TP_SEL >= 32) ? tp.t[0] * 4ull : tp.t[(TP_SEL - 1) & 7] * 16ull; while (__builtin_amdgcn_s_memrealtime() - t0_ < dl_) __builtin_amdgcn_s_sleep(8); }
#undef IN
#undef SEAM
}

extern "C" void kernel_launch(void* const* d_in, const int* in_sizes, int n_in, void* d_out, int out_size, void* d_ws, size_t ws_size, hipStream_t stream) {
    static int grid = 0;
    if (grid == 0) {
        if (n_in != 24 || out_size != MROWS * DM || ws_size < WS_END) { fprintf(stderr, "kernel_launch: unexpected problem (n_in %d, out %d, ws %zu); nothing launched\n", n_in, out_size, ws_size); grid = -1; return; }
        int dev = 0, cus = 0, per_cu = 0;
        if (hipGetDevice(&dev) != hipSuccess || hipDeviceGetAttribute(&cus, hipDeviceAttributeMultiprocessorCount, dev) != hipSuccess) { grid = -1; return; }
        if (hipFuncSetAttribute((const void*)mk_fwd, hipFuncAttributeMaxDynamicSharedMemorySize, LDS_BYTES) != hipSuccess) { fprintf(stderr, "kernel_launch: hipFuncSetAttribute failed\n"); grid = -1; return; }
        if (hipOccupancyMaxActiveBlocksPerMultiprocessor(&per_cu, (const void*)mk_fwd, NTHR, LDS_BYTES) != hipSuccess || per_cu < 1) { fprintf(stderr, "kernel_launch: occupancy query says %d blocks per CU\n", per_cu); grid = -1; (void)hipGetLastError(); return; }
        grid = cus;
    }
    if (grid < 0) return;
    (void)hipMemsetAsync((char*)d_ws + WS_ZERO0, 0, WS_ZERO_BYTES, stream);
    Args a{};
    for (int i = 0; i < 24; ++i) a.in[i] = (const float*)d_in[i];
    a.out = (float*)d_out; a.ws = (uchar*)d_ws;
#if MK_PER_PHASE
    for (int p = 0; p < NPHASE; ++p) { a.ph_lo = p; a.ph_hi = p + 1; hipLaunchKernelGGL(mk_fwd, dim3(grid), dim3(NTHR), LDS_BYTES, stream, a); }
#else
    a.ph_lo = 0; a.ph_hi = NPHASE; hipLaunchKernelGGL(mk_fwd, dim3(grid), dim3(NTHR), LDS_BYTES, stream, a);
#endif
}
```

```cpp
#include <hip/hip_runtime.h>
#include <cstdio>
#include <cstdint>
#ifndef REP_MASK
#define REP_MASK 0
#endif
#ifndef TP_SEL
#define TP_SEL 0
#endif
namespace pg8 {
#define PG8_LAS __attribute__((address_space(3)))
typedef unsigned short bf16_t;
typedef short bf16x8 __attribute__((ext_vector_type(8)));
typedef float f32x4 __attribute__((ext_vector_type(4)));
typedef unsigned u32x4 __attribute__((ext_vector_type(4)));
constexpr int BM = 256, BK = 64, HALF = 128, HTB = HALF * BK * 2  , STAGE_BYTES = 8 * HTB, NXCD = 8, WGM = 8;

__host__ __device__ __forceinline__ int lds_byte(int r, int c) { const int st = (r >> 4) * 2 + (c >> 5), rr = r & 15, cc = c & 31, ob = rr * 64 + cc * 2; return st * 1024 + (ob ^ (((ob >> 9) & 1) << 5)); }
__host__ __device__ __forceinline__ void stage_rc(int b, int& R, int& C) { const int st = b / 1024, sb = b % 1024, swz = sb ^ (((sb >> 9) & 1) << 5); R = (st >> 1) * 16 + swz / 64; C = (st & 1) * 32 + (swz % 64) / 2; }
__host__ __device__ __forceinline__ int perm32(int rho) { const int n = rho >> 4, i = rho & 15; return 8 * (i >> 2) + 4 * n + (i & 3); }

struct Unit { int pm, pn; };
struct Gemm { const bf16_t* A; const bf16_t* Bt; int M, N, K; };

struct StaticOrder {
    int nM, nN, nwg, G, c;
    __host__ __device__ void init(int M, int N, int G_, int c_) { nM = M / BM; nN = N / BM; nwg = nM * nN; G = G_; c = c_; }
    __host__ __device__ bool next(int i, Unit& u) const {
        const long L = (long)i * G + c; if (L >= nwg) return false;
        int wgid = (int)L; { const int q = nwg / NXCD, r = nwg % NXCD, xcd = wgid % NXCD, off = wgid / NXCD; wgid = (xcd < r ? xcd * (q + 1) : r * (q + 1) + (xcd - r) * q) + off; }
        const int nig = WGM * nN, gid = wgid / nig, fm = gid * WGM, gsz = (nM - fm) < WGM ? (nM - fm) : WGM;
        u.pm = fm + ((wgid % nig) % gsz); u.pn = (wgid % nig) / gsz; return true;
    }
    __device__ __forceinline__ void a_ready(const Unit&) const {}
    __device__ __forceinline__ void done(const Unit&) const {}
};
__device__ __forceinline__ unsigned cvt_pk_bf16(float lo, float hi) { unsigned r; asm volatile("v_cvt_pk_bf16_f32 %0, %1, %2" : "=v"(r) : "v"(lo), "v"(hi)); return r; }
template <class Epi, class Sched, bool ALIGN_EPI = false, bool SP2 = false>
__device__ __forceinline__ void gemm_phase(PG8_LAS unsigned char* lds, const Gemm g, const Sched& S, const Epi& E) {
    const int tid = threadIdx.x, wid = __builtin_amdgcn_readfirstlane(tid >> 6), lane = tid & 63, wr = wid >> 2, wc = wid & 3, fr = lane & 15, fq = lane >> 4;
    const int K = g.K, nt = K / BK;
    unsigned voffA[2], voffB[2];
#pragma unroll
    for (int i = 0; i < 2; ++i) { int R, C; stage_rc(tid * 16 + i * 8192, R, C); const int Rb = Epi::PERM ? ((R & ~31) + perm32(R & 31)) : R;
        voffA[i] = (unsigned)(R * K + C) * 2u; voffB[i] = (unsigned)(Rb * K + C) * 2u; }
    const size_t kstep = (size_t)(BK * 2);
    const size_t hstep = (size_t)HALF * K * 2;
    const size_t tstep = 2 * hstep;
    const unsigned ldsw = (unsigned)wid * 1024u;
    const int aoff = lds_byte(wr * 64 + fr, fq * 8), boff = lds_byte(wc * 32 + fr, fq * 8);
#define PG8_SA(b, h) (((b) * 2 + (h)) * HTB)
#define PG8_SB(b, h) ((4 + (b) * 2 + (h)) * HTB)
#define PG8_STAGE(bufoff, gbase, voff) do { _Pragma("unroll") for (int _i = 0; _i < 2; ++_i) \
        __builtin_amdgcn_global_load_lds((const unsigned*)((const char*)(gbase) + (voff)[_i]), (PG8_LAS unsigned*)(lds + (bufoff) + ldsw + _i * 8192), 16, 0, 0); } while (0)
#define PG8_LDA(dst, b, h) do { _Pragma("unroll") for (int m = 0; m < 4; ++m) _Pragma("unroll") for (int k = 0; k < 2; ++k) dst[m][k] = *(const PG8_LAS bf16x8*)(lds + PG8_SA(b, h) + aoff + m * 2048 + k * 1024); } while (0)
#define PG8_LDB(dst, b, h) do { _Pragma("unroll") for (int n = 0; n < 2; ++n) _Pragma("unroll") for (int k = 0; k < 2; ++k) dst[n][k] = *(const PG8_LAS bf16x8*)(lds + PG8_SB(b, h) + boff + n * 2048 + k * 1024); } while (0)
#define PG8_MMA(ai, bj, At, Bt) do { __builtin_amdgcn_s_setprio(1); _Pragma("unroll") for (int m = 0; m < 4; ++m) _Pragma("unroll") for (int n = 0; n < 2; ++n) _Pragma("unroll") for (int k = 0; k < 2; ++k) \
        acc[ai][bj][m][n] = __builtin_amdgcn_mfma_f32_16x16x32_bf16(Bt[n][k], At[m][k], acc[ai][bj][m][n], 0, 0, 0); __builtin_amdgcn_s_setprio(0); } while (0)
#define PG8_WAIT_V(n) asm volatile("s_waitcnt vmcnt(" #n ")" ::: "memory")
#define PG8_WAIT_L(n) asm volatile("s_waitcnt lgkmcnt(" #n ")" ::: "memory")
#define PG8_BAR __builtin_amdgcn_s_barrier()
#define PG8_SCHED __builtin_amdgcn_sched_barrier(0)
    Unit cur, nxt; int ui = 0;
    if (!S.next(0, cur)) return;
    f32x4 acc[2][2][4][2];
#pragma unroll
    for (int a = 0; a < 2; ++a)
#pragma unroll
        for (int b = 0; b < 2; ++b)
#pragma unroll
            for (int m = 0; m < 4; ++m)
#pragma unroll
                for (int n = 0; n < 2; ++n) acc[a][b][m][n] = (f32x4){0.f, 0.f, 0.f, 0.f};
    bf16x8 At[4][2], B0[2][2], B1[2][2];
    const char* cA = (const char*)g.A + (size_t)cur.pm * tstep; const char* cB = (const char*)g.Bt + (size_t)cur.pn * tstep;
    S.a_ready(cur);
    if constexpr (SP2) {
        PG8_STAGE(PG8_SB(0, 0), cB, voffB); PG8_STAGE(PG8_SB(0, 1), cB + hstep, voffB); PG8_STAGE(PG8_SA(0, 0), cA, voffA); PG8_STAGE(PG8_SA(0, 1), cA + hstep, voffA);
        if (wr == 1) PG8_BAR;
        PG8_WAIT_V(2); PG8_BAR;
        PG8_STAGE(PG8_SB(1, 0), cB + kstep, voffB); PG8_STAGE(PG8_SA(1, 0), cA + kstep, voffA); PG8_STAGE(PG8_SB(1, 1), cB + hstep + kstep, voffB);
        PG8_WAIT_V(6); PG8_BAR;
    } else {
        PG8_STAGE(PG8_SB(0, 0), cB, voffB); PG8_STAGE(PG8_SA(0, 0), cA, voffA); PG8_STAGE(PG8_SB(0, 1), cB + hstep, voffB); PG8_STAGE(PG8_SA(0, 1), cA + hstep, voffA);
        if (wr == 1) PG8_BAR;
        PG8_WAIT_V(4); PG8_BAR;
        PG8_STAGE(PG8_SB(1, 0), cB + kstep, voffB); PG8_STAGE(PG8_SA(1, 0), cA + kstep, voffA); PG8_STAGE(PG8_SB(1, 1), cB + hstep + kstep, voffB);
        PG8_WAIT_V(6); PG8_BAR;
    }
    for (;;) {
        const bool has_next = S.next(ui + 1, nxt);
        const char* nA = has_next ? (const char*)g.A + (size_t)nxt.pm * tstep : cA; const char* nB = has_next ? (const char*)g.Bt + (size_t)nxt.pn * tstep : cB;
        for (int t = 0; t < nt; t += 2) {
            const bool last = (t == nt - 2);
            const char* a1 = cA + (size_t)(t + 1) * kstep;
            const char* a2 = last ? nA : cA + (size_t)(t + 2) * kstep; const char* b2 = last ? nB : cB + (size_t)(t + 2) * kstep;
            const char* a3 = a2 + kstep; const char* b3 = b2 + kstep;
            if (last && has_next) S.a_ready(nxt);
            if constexpr (SP2) {
            PG8_LDB(B0, 0, 0); PG8_LDB(B1, 0, 1); PG8_SCHED; PG8_LDA(At, 0, 0); PG8_STAGE(PG8_SA(1, 1), a1 + hstep, voffA);
            PG8_WAIT_V(8); PG8_WAIT_L(0); PG8_BAR; PG8_MMA(0, 0, At, B0); PG8_MMA(0, 1, At, B1); PG8_BAR; PG8_SCHED;
            PG8_LDA(At, 0, 1); PG8_STAGE(PG8_SB(0, 0), b2, voffB); PG8_STAGE(PG8_SB(0, 1), b2 + hstep, voffB); PG8_STAGE(PG8_SA(0, 0), a2, voffA);
            PG8_WAIT_V(8); PG8_WAIT_L(0); PG8_BAR; PG8_MMA(1, 0, At, B0); PG8_MMA(1, 1, At, B1); PG8_BAR; PG8_SCHED;
            PG8_LDB(B0, 1, 0); PG8_LDB(B1, 1, 1); PG8_SCHED; PG8_LDA(At, 1, 0); PG8_STAGE(PG8_SA(0, 1), a2 + hstep, voffA);
            PG8_WAIT_V(8); PG8_WAIT_L(0); PG8_BAR; PG8_MMA(0, 0, At, B0); PG8_MMA(0, 1, At, B1); PG8_BAR; PG8_SCHED;
            PG8_LDA(At, 1, 1); PG8_STAGE(PG8_SB(1, 0), b3, voffB); PG8_STAGE(PG8_SB(1, 1), b3 + hstep, voffB); PG8_STAGE(PG8_SA(1, 0), a3, voffA);
            PG8_WAIT_V(8); PG8_WAIT_L(0); PG8_BAR; PG8_MMA(1, 0, At, B0); PG8_MMA(1, 1, At, B1); PG8_BAR; PG8_SCHED;
            } else {
            PG8_LDB(B0, 0, 0); PG8_SCHED; PG8_LDA(At, 0, 0); PG8_STAGE(PG8_SA(1, 1), a1 + hstep, voffA);
            PG8_WAIT_L(8); PG8_BAR; PG8_WAIT_L(0); PG8_MMA(0, 0, At, B0); PG8_BAR; PG8_SCHED;
            PG8_LDB(B1, 0, 1); PG8_STAGE(PG8_SB(0, 0), b2, voffB);
            PG8_BAR; PG8_WAIT_L(0); PG8_MMA(0, 1, At, B1); PG8_BAR;
            PG8_LDA(At, 0, 1); PG8_STAGE(PG8_SA(0, 0), a2, voffA);
            PG8_BAR; PG8_WAIT_L(0); PG8_MMA(1, 0, At, B0); PG8_BAR; PG8_SCHED;
            PG8_STAGE(PG8_SB(0, 1), b2 + hstep, voffB);
            PG8_WAIT_V(6); PG8_BAR; PG8_MMA(1, 1, At, B1); PG8_BAR;
            PG8_LDB(B0, 1, 0); PG8_SCHED; PG8_LDA(At, 1, 0); PG8_STAGE(PG8_SA(0, 1), a2 + hstep, voffA);
            PG8_WAIT_L(8); PG8_BAR; PG8_WAIT_L(0); PG8_MMA(0, 0, At, B0); PG8_BAR; PG8_SCHED;
            PG8_LDB(B1, 1, 1); PG8_STAGE(PG8_SB(1, 0), b3, voffB);
            PG8_BAR; PG8_WAIT_L(0); PG8_MMA(0, 1, At, B1); PG8_BAR;
            PG8_LDA(At, 1, 1); PG8_STAGE(PG8_SA(1, 0), a3, voffA);
            PG8_BAR; PG8_WAIT_L(0); PG8_MMA(1, 0, At, B0); PG8_BAR; PG8_SCHED;
            PG8_STAGE(PG8_SB(1, 1), b3 + hstep, voffB);
            PG8_WAIT_V(6); PG8_BAR; PG8_MMA(1, 1, At, B1); PG8_BAR;
            }
        }
        if constexpr (ALIGN_EPI) { if (wr == 0) PG8_BAR; }
        if constexpr (!Epi::AFTER_DRAIN) { E(acc, cur, wr, wc, fr, fq); S.done(cur); }
        if (!has_next) break;
#pragma unroll
        for (int a = 0; a < 2; ++a)
#pragma unroll
            for (int b = 0; b < 2; ++b)
#pragma unroll
                for (int m = 0; m < 4; ++m)
#pragma unroll
                    for (int n = 0; n < 2; ++n) acc[a][b][m][n] = (f32x4){0.f, 0.f, 0.f, 0.f};
        cur = nxt; cA = nA; cB = nB; ++ui;
        if constexpr (ALIGN_EPI) { if (wr == 1) PG8_BAR; }
    }
    PG8_WAIT_V(0);
    if constexpr (!ALIGN_EPI) { if (wr == 0) PG8_BAR; }
    PG8_BAR;
    if constexpr (Epi::AFTER_DRAIN) { E.fused(acc, cur, wr, wc, fr, fq, lds, wid, lane); S.done(cur); }
#undef PG8_SA
#undef PG8_SB
#undef PG8_STAGE
#undef PG8_LDA
#undef PG8_LDB
#undef PG8_MMA
#undef PG8_WAIT_V
#undef PG8_WAIT_L
#undef PG8_BAR
#undef PG8_SCHED
}
}

#define GAS __attribute__((address_space(1)))
#define LAS __attribute__((address_space(3)))
typedef unsigned short bf16;
typedef unsigned char uchar;
typedef unsigned v4u __attribute__((ext_vector_type(4)));
typedef unsigned v2u __attribute__((ext_vector_type(2)));
typedef float f32x4 __attribute__((ext_vector_type(4)));
typedef float f32x2 __attribute__((ext_vector_type(2)));
typedef short bf16x8 __attribute__((ext_vector_type(8)));
#define LDS_WAIT() asm volatile("s_waitcnt lgkmcnt(0)" ::: "memory")
#define VM_WAIT() asm volatile("s_waitcnt vmcnt(0)" ::: "memory")

constexpr int NWAVES = 8, NTHR = 512;
constexpr int NB = 8, SEQ = 4096, DM = 1024, CTXL = 256;
constexpr int MROWS = NB * SEQ;
constexpr int CROWS = NB * CTXL;
constexpr int TROWS = MROWS + CROWS;
constexpr int NHEAD = 4, HD = 128, INW = 2064, DFF = 2560, UPW = 5120;
constexpr float EPS = 1e-6f;
constexpr int NUNIT_L = NB * NHEAD * 32, NUNIT_C = NB * NHEAD * 2, NUNIT = NUNIT_L + NUNIT_C;
constexpr int CT_SLOT = 129 * 128;

constexpr size_t MiB = 1u << 20;
constexpr size_t WS_HX = 0, WS_TP = 0, WS_H2 = 0, WS_ACT = 0;
constexpr size_t WS_UF = 68 * MiB, WS_XM = 100 * MiB, WS_CT = 68 * MiB;
constexpr size_t WS_G = 134 * MiB, WS_SC = 137 * MiB, WS_MS = 138 * MiB;
constexpr size_t WS_V = 160 * MiB, WS_Z = 194 * MiB, WS_DC = 226 * MiB, WS_YM = 364 * MiB, WS_U = 160 * MiB;
constexpr size_t WS_WIN = 480 * MiB  , WS_WOUT = 485 * MiB, WS_WUP = 487 * MiB, WS_WDN = 497 * MiB, WS_WQ = 502 * MiB, WS_WK = WS_WQ + 131072;
constexpr size_t WS_F1 = WS_WQ + 512 * 1024, WS_G2 = WS_F1 + 16384, WS_TW = WS_G2 + 16384;
constexpr size_t WS_MOD = 503 * MiB, WS_CTL = 504 * MiB, WS_ZERO0 = WS_MOD, WS_ZERO_BYTES = 2 * MiB, WS_END = 512 * MiB;
static_assert(WS_DC + (size_t)NUNIT * 2 * CT_SLOT * 4 <= WS_YM && WS_YM + (size_t)MROWS * 1024 * 2 <= WS_U + (size_t)MROWS * UPW * 2 && WS_U + (size_t)MROWS * UPW * 2 <= WS_WIN, "ws map");
static_assert(WS_CT + (size_t)NUNIT_L * 2 * CT_SLOT * 2 <= WS_G && WS_XM + (size_t)TROWS * 512 * 2 <= WS_G && (size_t)MROWS * DFF * 2 <= WS_U, "ws map 2");
constexpr size_t DO_AB = 0, DO_Q = 32 * MiB, DO_K = 64 * MiB;

__device__ __forceinline__ unsigned f2bf(float f) { unsigned u = __builtin_bit_cast(unsigned, f); return (u + 0x7fffu + ((u >> 16) & 1u)) >> 16; }
__device__ __forceinline__ unsigned pk2(float lo, float hi) { return f2bf(lo) | (f2bf(hi) << 16); }
__device__ __forceinline__ float bflo(unsigned w) { return __builtin_bit_cast(float, w << 16); }
__device__ __forceinline__ float bfhi(unsigned w) { return __builtin_bit_cast(float, w & 0xffff0000u); }
__device__ __forceinline__ f32x4 bf4(v2u x) { return (f32x4){bflo(x.x), bfhi(x.x), bflo(x.y), bfhi(x.y)}; }
__device__ __forceinline__ float silu_f(float x) { return x * __builtin_amdgcn_rcpf(1.0f + __expf(-x)); }
__device__ __forceinline__ float logsig_f(float x) { return fminf(x, 0.f) - log1pf(__expf(-fabsf(x))); }
__device__ __forceinline__ float wave_sum(float v) {
#pragma unroll
    for (int o = 1; o < 64; o <<= 1) v += __shfl_xor(v, o);
    return v;
}
__device__ __forceinline__ int img_off(int row, int ch) { return row * 256 + ((ch ^ (row & 15)) << 4); }
struct BFrag { bf16x8 f[4]; };
__device__ __forceinline__ BFrag load_bfrag(const LAS uchar* Bimg, int brow, int kq) { BFrag b;
#pragma unroll
    for (int s = 0; s < 4; ++s) b.f[s] = *(const LAS bf16x8*)(Bimg + img_off(brow, 4 * s + kq));
    return b; }
__device__ __forceinline__ f32x4 mma_a(f32x4 acc, const LAS uchar* Aimg, int arow, const BFrag& b, int kq) {
    bf16x8 a[4];
#pragma unroll
    for (int s = 0; s < 4; ++s) a[s] = *(const LAS bf16x8*)(Aimg + img_off(arow, 4 * s + kq));
#pragma unroll
    for (int s = 0; s < 4; ++s) acc = __builtin_amdgcn_mfma_f32_16x16x32_bf16(a[s], b.f[s], acc, 0, 0, 0);
    return acc; }
#define MEMFENCE() asm volatile("" ::: "memory")


template <int S> __device__ __forceinline__ unsigned tr_lane_off(int lane) { return (unsigned)((8 * (lane >> 4) + ((lane & 15) >> 2)) * S + 8 * (lane & 3)); }
__device__ __forceinline__ unsigned lds_addr(const LAS uchar* p) { return (unsigned)(unsigned long long)p; }
__device__ __forceinline__ bf16x8 pack_frag(v2u lo, v2u hi) { const v4u w = (v4u){lo.x, lo.y, hi.x, hi.y}; return __builtin_bit_cast(bf16x8, w); }
template <int S> __device__ __forceinline__ void tr_load4(unsigned addr, BFrag& f) {
    v2u r0, r1, r2, r3, r4, r5, r6, r7;
    asm volatile("ds_read_b64_tr_b16 %0, %8\n\tds_read_b64_tr_b16 %1, %8 offset:%9\n\tds_read_b64_tr_b16 %2, %8 offset:%10\n\tds_read_b64_tr_b16 %3, %8 offset:%11\n\t"
                 "ds_read_b64_tr_b16 %4, %8 offset:%12\n\tds_read_b64_tr_b16 %5, %8 offset:%13\n\tds_read_b64_tr_b16 %6, %8 offset:%14\n\tds_read_b64_tr_b16 %7, %8 offset:%15\n\ts_waitcnt lgkmcnt(0)"
                 : "=&v"(r0), "=&v"(r1), "=&v"(r2), "=&v"(r3), "=&v"(r4), "=&v"(r5), "=&v"(r6), "=&v"(r7)
                 : "v"(addr), "i"(4 * S), "i"(32 * S), "i"(36 * S), "i"(64 * S), "i"(68 * S), "i"(96 * S), "i"(100 * S) : "memory");
    f.f[0] = pack_frag(r0, r1); f.f[1] = pack_frag(r2, r3); f.f[2] = pack_frag(r4, r5); f.f[3] = pack_frag(r6, r7);
}
template <int S> __device__ __forceinline__ void tr_load2(unsigned addr, bf16x8& f0, bf16x8& f1) {
    v2u r0, r1, r2, r3;
    asm volatile("ds_read_b64_tr_b16 %0, %4\n\tds_read_b64_tr_b16 %1, %4 offset:%5\n\tds_read_b64_tr_b16 %2, %4 offset:%6\n\tds_read_b64_tr_b16 %3, %4 offset:%7\n\ts_waitcnt lgkmcnt(0)"
                 : "=&v"(r0), "=&v"(r1), "=&v"(r2), "=&v"(r3) : "v"(addr), "i"(4 * S), "i"(32 * S), "i"(36 * S) : "memory");
    f0 = pack_frag(r0, r1); f1 = pack_frag(r2, r3);
}
template <int S> __device__ __forceinline__ unsigned tr_lane_off_p(int lane) { return (unsigned)((4 * (lane >> 4) + ((lane & 15) >> 2)) * S + 8 * (lane & 3)); }
template <int S> __device__ __forceinline__ void tr_load4p(unsigned addr, BFrag& f) {
    v2u r0, r1, r2, r3, r4, r5, r6, r7;
    asm volatile("ds_read_b64_tr_b16 %0, %8\n\tds_read_b64_tr_b16 %1, %8 offset:%9\n\tds_read_b64_tr_b16 %2, %8 offset:%10\n\tds_read_b64_tr_b16 %3, %8 offset:%11\n\t"
                 "ds_read_b64_tr_b16 %4, %8 offset:%12\n\tds_read_b64_tr_b16 %5, %8 offset:%13\n\tds_read_b64_tr_b16 %6, %8 offset:%14\n\tds_read_b64_tr_b16 %7, %8 offset:%15\n\ts_waitcnt lgkmcnt(0)"
                 : "=&v"(r0), "=&v"(r1), "=&v"(r2), "=&v"(r3), "=&v"(r4), "=&v"(r5), "=&v"(r6), "=&v"(r7)
                 : "v"(addr), "i"(16 * S), "i"(32 * S), "i"(48 * S), "i"(64 * S), "i"(80 * S), "i"(96 * S), "i"(112 * S) : "memory");
    f.f[0] = pack_frag(r0, r1); f.f[1] = pack_frag(r2, r3); f.f[2] = pack_frag(r4, r5); f.f[3] = pack_frag(r6, r7);
}
__device__ __forceinline__ f32x4 mma_ff(f32x4 acc, const BFrag& a, const BFrag& b) {
#pragma unroll
    for (int s = 0; s < 4; ++s) acc = __builtin_amdgcn_mfma_f32_16x16x32_bf16(a.f[s], b.f[s], acc, 0, 0, 0);
    return acc; }
__device__ __forceinline__ float lane_scan_add(float v, int lane) {
#pragma unroll
    for (int o = 1; o < 64; o <<= 1) { const float t = __shfl_up(v, o); if (lane >= o) v += t; }
    return v; }
__device__ __forceinline__ float lane_scan_max(float v, int lane) {
#pragma unroll
    for (int o = 1; o < 64; o <<= 1) { const float t = __shfl_up(v, o); if (lane >= o) v = fmaxf(v, t); }
    return v; }
__device__ __forceinline__ float wave_max(float v) {
#pragma unroll
    for (int o = 1; o < 64; o <<= 1) v = fmaxf(v, __shfl_xor(v, o));
    return v; }

#define XB_TMO      128
#define XB_XCNT(j)  (256  + 64 * (j))
#define XB_XSUB(j)  (1280 + 64 * (j))
#define XB_XGEN(j)  (2304 + 64 * (j))
#define XB_TOP      3328
#define XB_TOPGEN   3392
#define XCD_BAR_WORDS 3456
#define XB_SPIN_CAP (1u << 18)

__device__ __forceinline__ unsigned xb_ld(unsigned* p)              { return __hip_atomic_load(p, __ATOMIC_RELAXED, __HIP_MEMORY_SCOPE_AGENT); }
__device__ __forceinline__ unsigned xb_add(unsigned* p, unsigned v) { return __hip_atomic_fetch_add(p, v, __ATOMIC_RELAXED, __HIP_MEMORY_SCOPE_AGENT); }
__device__ __forceinline__ unsigned xb_xcc_id() { return (unsigned)__builtin_amdgcn_s_getreg((3 << 11) | 20) & 0xFu; }
#define XB_SPIN(cond, bar) do { unsigned _sp = 0; while (cond) { __builtin_amdgcn_s_sleep(1); \
    if ((++_sp & 255u) == 0u) { if (xb_ld(&(bar)[XB_TMO])) break; if (_sp > XB_SPIN_CAP) { atomicAdd(&(bar)[XB_TMO], 1u); break; } } } } while (0)

struct XcdBarrier {
    unsigned* bar; unsigned x;
    volatile LAS unsigned* st;
};

__device__ __forceinline__ XcdBarrier xcd_barrier_post(unsigned* bar, volatile LAS unsigned* st) {
    XcdBarrier b; b.bar = bar; b.x = xb_xcc_id(); b.st = st;
    if (threadIdx.x == 0) (void)xb_add(&bar[XB_XCNT(b.x)], 1u);
    return b;
}
__device__ __forceinline__ void xcd_barrier_complete(unsigned* bar, unsigned x, unsigned& nloc, unsigned& nx) {
    const unsigned G = gridDim.x * gridDim.y * gridDim.z;
    unsigned sum, cnt, mine, sp = 0u;
    for (;;) {
        sum = 0u; cnt = 0u; mine = 0u;
#pragma unroll
        for (unsigned j = 0; j < 16; ++j) { const unsigned c = xb_ld(&bar[XB_XCNT(j)]); sum += c; cnt += (c > 0u) ? 1u : 0u; mine = (j == x) ? c : mine; }
        if (sum == G) break;
        __builtin_amdgcn_s_sleep(1);
        if ((++sp & 255u) == 0u) { if (xb_ld(&bar[XB_TMO])) break; if (sp > XB_SPIN_CAP) { atomicAdd(&bar[XB_TMO], 1u); break; } }
    }
    nloc = mine > 0u ? mine : 1u; nx = cnt > 0u ? cnt : 1u;
}

__device__ __forceinline__ void xcd_barrier(const XcdBarrier& b) {
    asm volatile("s_waitcnt vmcnt(0)" ::: "memory");
    __syncthreads();
    if (threadIdx.x == 0) {
        unsigned* bar = b.bar;
        __builtin_amdgcn_s_waitcnt(0);
        unsigned nloc = b.st[0], nx = b.st[1];
        if (nloc == 0u) { xcd_barrier_complete(bar, b.x, nloc, nx); b.st[0] = nloc; b.st[1] = nx; }
        const unsigned old = xb_add(&bar[XB_XSUB(b.x)], 1u);
        const unsigned gen = old / nloc;
        if (old + 1u == (gen + 1u) * nloc) {
            __builtin_amdgcn_fence(__ATOMIC_RELEASE, "agent");
            asm volatile("s_waitcnt vmcnt(0)" ::: "memory");
            const unsigned og = xb_add(&bar[XB_TOP], 1u);
            const unsigned tg = og / nx;
            if (og + 1u == (tg + 1u) * nx) xb_add(&bar[XB_TOPGEN], 1u);
            else XB_SPIN(xb_ld(&bar[XB_TOPGEN]) == tg, bar);
            __builtin_amdgcn_fence(__ATOMIC_ACQUIRE, "agent");
            xb_add(&bar[XB_XGEN(b.x)], 1u);
            asm volatile("s_waitcnt vmcnt(0)" ::: "memory");
        } else {
            XB_SPIN(xb_ld(&bar[XB_XGEN(b.x)]) == gen, bar);
            __builtin_amdgcn_fence(__ATOMIC_ACQUIRE, "agent");
            asm volatile("s_waitcnt vmcnt(0)" ::: "memory");
        }
    }
    __syncthreads();
}


struct TProbe { unsigned long long t[8]; unsigned long long last; unsigned long long ph; };
#define TP_MARK(tp, i) do { if (TP_SEL) { const unsigned long long n_ = __builtin_amdgcn_s_memrealtime(); (tp).t[i] += n_ - (tp).last; (tp).last = n_; } } while (0)
#define TP_P (TP_SEL && !(TP_SEL & 8))
#define TP_O (TP_SEL & 8)
#define TP_START(tp) do { if (TP_SEL) (tp).last = __builtin_amdgcn_s_memrealtime(); } while (0)
struct Args { const float* in[24]; float* out; uchar* ws; int ph_lo, ph_hi; };

template <class F>
__device__ __forceinline__ void tr_item(F src, bf16* WT, size_t drow0, int ldk, int dk0, LAS float* scr, int lane) {
#pragma unroll 4
    for (int i = 0; i < 32; ++i) { const int kk = 2 * i + (lane >> 5); scr[kk * 33 + (lane & 31)] = src(kk, lane & 31); }
    LDS_WAIT(); asm volatile("" ::: "memory");
    const int c = lane & 7;
#pragma unroll
    for (int j = 0; j < 4; ++j) { const int n = (lane >> 3) + 8 * j; const LAS float* s = scr + (8 * c) * 33 + n;
        v4u o; o.x = pk2(s[0 * 33], s[1 * 33]); o.y = pk2(s[2 * 33], s[3 * 33]); o.z = pk2(s[4 * 33], s[5 * 33]); o.w = pk2(s[6 * 33], s[7 * 33]);
        *(v4u*)(WT + (drow0 + n) * ldk + dk0 + 8 * c) = o; }
    LDS_WAIT(); asm volatile("" ::: "memory");
}

__device__ __forceinline__ void tr_item_vec(const float* W, size_t ldn, float scale, bf16* WT, size_t drow0, int ldk, int dk0, LAS float* scr, int lane) {
    f32x4 tv[8];
#pragma unroll
    for (int i = 0; i < 8; ++i) tv[i] = *(const f32x4*)(W + (size_t)(8 * i + (lane >> 3)) * ldn + 4 * (lane & 7));
#pragma unroll
    for (int i = 0; i < 8; ++i) { LAS float* d = scr + (8 * i + (lane >> 3)) * 33 + 4 * (lane & 7); d[0] = tv[i].x * scale; d[1] = tv[i].y * scale; d[2] = tv[i].z * scale; d[3] = tv[i].w * scale; }
    LDS_WAIT(); asm volatile("" ::: "memory");
    const int c = lane & 7;
#pragma unroll
    for (int j = 0; j < 4; ++j) { const int n = (lane >> 3) + 8 * j; const LAS float* s = scr + (8 * c) * 33 + n;
        v4u o; o.x = pk2(s[0 * 33], s[1 * 33]); o.y = pk2(s[2 * 33], s[3 * 33]); o.z = pk2(s[4 * 33], s[5 * 33]); o.w = pk2(s[6 * 33], s[7 * 33]);
        *(v4u*)(WT + (drow0 + n) * ldk + dk0 + 8 * c) = o; }
    LDS_WAIT(); asm volatile("" ::: "memory");
}
constexpr int I_XV = 16 * 32, I_Z = 16 * 16, I_QK = 2 * 4 * 4, I_G = 16 * 8, I_OF = 8 * 32, I_OM = 8 * 32, I_UP = 16 * 160, I_DN = 40 * 32;
constexpr int TR_EARLY = I_XV + I_Z + 2 * I_QK + I_G, TR_ALL = TR_EARLY + I_OF + I_OM + I_UP + I_DN;
__device__ __forceinline__ void tr_items(const Args& a, LAS uchar* lds, int lo, int hi, int gw, int NGW) {
    const int tid = threadIdx.x, lane = tid & 63, wave = __builtin_amdgcn_readfirstlane(tid >> 6);
    uchar* ws = a.ws;
    LAS float* scr = (LAS float*)(lds + wave * 16384);
    const float* w_in = a.in[7]; const float* w_out = a.in[15]; const float* w_up = a.in[17]; const float* w_dn = a.in[21];
    const float* w_q = a.in[10]; const float* w_k = a.in[11];
    bf16* WIN = (bf16*)(ws + WS_WIN); bf16* WOUT = (bf16*)(ws + WS_WOUT); bf16* WUP = (bf16*)(ws + WS_WUP); bf16* WDN = (bf16*)(ws + WS_WDN);
    bf16* WQ = (bf16*)(ws + WS_WQ); bf16* WK = (bf16*)(ws + WS_WK);
    for (int it = lo + gw; it < hi; it += NGW) {
        int r = it;
        if (r < I_XV) { const int kb = r / 32, nb = r % 32, k0 = kb * 64, n0 = nb * 32;
            tr_item_vec(w_in + (size_t)k0 * INW + 512 + n0, INW, 1.f, WIN, (size_t)(512 + n0), DM, k0, scr, lane); continue; } r -= I_XV;
        if (r < I_Z) { const int kb = r / 16, nb = r % 16, k0 = kb * 64, n0 = nb * 32;
            tr_item_vec(w_in + (size_t)k0 * INW + 1552 + n0, INW, 1.f, WIN, (size_t)(1536 + n0), DM, k0, scr, lane); continue; } r -= I_Z;
        if (r < 2 * I_QK) { const bool isk = r >= I_QK; if (isk) r -= I_QK;
            const int h = r / 8, kb = (r % 8) / 4, nb = r % 4, k0 = kb * 64, n0 = nb * 32;
            const float* W = (isk ? w_k : w_q) + (size_t)h * HD * HD; const float sc = isk ? 0.08838834764831845f : 1.0f;
            tr_item_vec(W + (size_t)k0 * HD + n0, HD, sc, (isk ? WK : WQ) + (size_t)h * HD * HD, (size_t)n0, HD, k0, scr, lane); continue; } r -= 2 * I_QK;
        if (r < I_G) { const int kb = r / 8, nb = r % 8, k0 = kb * 64, n0 = nb * 32;
            auto src = [&](int kk, int nn) -> float { return (n0 + nn < 16) ? w_in[(size_t)(k0 + kk) * INW + 1536 + n0 + nn] : 0.f; };
            tr_item(src, WIN, (size_t)(2048 + n0), DM, k0, scr, lane); continue; } r -= I_G;
        if (r < I_OF) { const int kb = r / 32, nb = r % 32, k0 = kb * 64, n0 = nb * 32;
            auto src = [&](int kk, int nn) -> float { const int k = k0 + kk, g = k >> 7, s = k & 127; const float* wo = w_out + (size_t)(g * 128) * DM + n0 + nn;
                if (s == 0 || s == 64) return wo[(size_t)s * DM];
                if (s < 64) return wo[(size_t)s * DM] + wo[(size_t)(128 - s) * DM];
                const int kq = s - 64; return wo[(size_t)(128 - kq) * DM] - wo[(size_t)kq * DM]; };
            tr_item(src, WOUT, (size_t)n0, DM, k0, scr, lane); continue; } r -= I_OF;
        if (r < I_OM) { const int kb = r / 32, nb = r % 32, k0 = kb * 64, n0 = nb * 32;
            tr_item_vec(w_out + (size_t)(512 + k0) * DM + n0, DM, 1.f, WOUT, (size_t)n0, DM, 512 + k0, scr, lane); continue; } r -= I_OM;
        if (r < I_UP) { const int kb = r / 160, nb = r % 160, k0 = kb * 64, n0 = nb * 32;
            tr_item_vec(w_up + (size_t)k0 * UPW + n0, UPW, 1.f, WUP, (size_t)n0, DM, k0, scr, lane); continue; } r -= I_UP;
        { const int kb = r / 32, nb = r % 32, k0 = kb * 64, n0 = nb * 32;
            tr_item_vec(w_dn + (size_t)k0 * DM + n0, DM, 1.f, WDN, (size_t)n0, DFF, k0, scr, lane); }
    }
}

__device__ __forceinline__ void p0_prologue(const Args& a, LAS uchar* lds, int vcu, int G, size_t mod_off) {
    const int tid = threadIdx.x, lane = tid & 63, wave = __builtin_amdgcn_readfirstlane(tid >> 6);
    uchar* ws = a.ws;
    {
        LAS float* sl = (LAS float*)lds;
        float* MOD = (float*)(ws + mod_off);
        const float* w_ada = a.in[4]; const float* b_ada = a.in[5];
        for (int it = blockIdx.x; it < 32 * 12; it += G) {
            const int kc = it / 12, nb = it % 12;
            __syncthreads();
            if (tid < 288) { const int r = tid >> 5, kk = tid & 31; const float cv = (r < 8) ? a.in[1][r * DM + kc * 32 + kk] : a.in[3][kc * 32 + kk]; sl[tid] = silu_f(cv); }
            __syncthreads();
            const int n = nb * 512 + tid;
            float acc[9];
#pragma unroll
            for (int r = 0; r < 9; ++r) acc[r] = 0.f;
#pragma unroll 8
            for (int kk = 0; kk < 32; ++kk) { const float w = w_ada[(size_t)(kc * 32 + kk) * 6144 + n];
#pragma unroll
                for (int r = 0; r < 9; ++r) acc[r] += sl[r * 32 + kk] * w; }
            const float bb = (kc == 0) ? b_ada[n] : 0.f;
#pragma unroll
            for (int r = 0; r < 9; ++r) atomicAdd(&MOD[r * 6144 + n], acc[r] + bb);
        }
        __syncthreads();
    }
    {
        LAS float* tab = (LAS float*)(lds + 8 * 16384);
        if (tid < 128) tab[tid] = cospif((float)tid * (1.0f / 64.0f)) * 0.08838834764831845f;
        __syncthreads();
        const int gt = blockIdx.x * NTHR + tid;
        bf16* F1 = (bf16*)(ws + WS_F1); bf16* G2 = (bf16*)(ws + WS_G2); float* TW = (float*)(ws + WS_TW);
        if (gt < 8192) { const int row = gt >> 6, n1 = gt & 63, ri = row >> 6, k1 = row & 63; const float ang = (float)((k1 * n1) & 63) * (1.0f / 32.0f);
            F1[gt] = (bf16)f2bf((ri == 0 ? cospif(ang) : -sinpif(ang)) * 0.125f); }
        else if (gt < 16384) { const int i = gt - 8192, k2 = i >> 7, kap = i & 127, n2 = kap & 63; const float ang = (float)((k2 * n2) & 63) * (1.0f / 32.0f);
            G2[i] = (bf16)f2bf((kap < 64 ? cospif(ang) : sinpif(ang)) * 0.125f); }
        else if (gt < 16384 + 4096) { const int i = gt - 16384; TW[i] = cospif((float)i * (1.0f / 2048.0f)); }
    }
    {
        const LAS float* tab = (const LAS float*)(lds + 8 * 16384);
        LAS float* Tm = (LAS float*)lds;
        LAS float* wT = (LAS float*)(lds + 65536);
        const float* w_in = a.in[7]; bf16* WIN = (bf16*)(a.ws + WS_WIN);
        bool have_T = false;
        for (int it = blockIdx.x; it < 64; it += G) {
            const int g = it >> 4, k0 = (it & 15) * 64;
            __syncthreads();
            if (!have_T) { for (int id = tid; id < 128 * 128; id += NTHR) { const int c = id >> 7, s_ = id & 127; const int mult = (s_ <= 64) ? s_ : (s_ - 64), off = (s_ <= 64) ? 0 : 96; Tm[id] = tab[(c * mult + off) & 127]; } have_T = true; }
            for (int id = tid; id < 64 * 32; id += NTHR) { const int kk = id >> 5, c4 = id & 31; const f32x4 v = *(const f32x4*)(w_in + (size_t)(k0 + kk) * INW + g * 128 + 4 * c4);
                wT[(4 * c4 + 0) * 64 + kk] = v.x; wT[(4 * c4 + 1) * 64 + kk] = v.y; wT[(4 * c4 + 2) * 64 + kk] = v.z; wT[(4 * c4 + 3) * 64 + kk] = v.w; }
            __syncthreads();
            const int s4 = (tid & 31) * 4, k4 = (tid >> 5) * 4;
            f32x4 acc[4];
#pragma unroll
            for (int j = 0; j < 4; ++j) acc[j] = (f32x4){0.f, 0.f, 0.f, 0.f};
#pragma unroll 4
            for (int c = 0; c < 128; ++c) { const f32x4 tv = *(const LAS f32x4*)(Tm + c * 128 + s4), wv_ = *(const LAS f32x4*)(wT + c * 64 + k4);
                acc[0] += wv_ * tv.x; acc[1] += wv_ * tv.y; acc[2] += wv_ * tv.z; acc[3] += wv_ * tv.w; }
#pragma unroll
            for (int j = 0; j < 4; ++j) *(v2u*)(WIN + (size_t)(g * 128 + s4 + j) * DM + k0 + k4) = (v2u){pk2(acc[j].x, acc[j].y), pk2(acc[j].z, acc[j].w)};
        }
        __syncthreads();
    }
    tr_items(a, lds, 0, (G > 168) ? TR_EARLY : TR_ALL, vcu * NWAVES + wave, G * NWAVES);
}

__device__ __forceinline__ void p1_rows(const Args& a, LAS uchar* lds, int vcu, int G) {
    const int tid = threadIdx.x, lane = tid & 63, wave = __builtin_amdgcn_readfirstlane(tid >> 6);
    uchar* ws = a.ws;
    const float* MOD = (const float*)(ws + WS_MOD);
    const float* nw = a.in[6];
    bf16* HX = (bf16*)(ws + WS_HX);
    const int gw = vcu * NWAVES + wave, NGW = G * NWAVES;
    for (int row = gw; row < TROWS; row += NGW) {
        const float* xr; const float* md;
        if (row < MROWS) { xr = a.in[0] + (size_t)row * DM; md = MOD + (size_t)(row >> 12) * 6144; }
        else { xr = a.in[2] + (size_t)(row - MROWS) * DM; md = MOD + (size_t)8 * 6144; }
        f32x4 v[4]; float s = 0.f;
#pragma unroll
        for (int j = 0; j < 4; ++j) { v[j] = *(const f32x4*)(xr + 4 * lane + 256 * j); s += (v[j].x * v[j].x + v[j].y * v[j].y) + (v[j].z * v[j].z + v[j].w * v[j].w); }
        const float rstd = rsqrtf(wave_sum(s) * (1.0f / DM) + EPS);
#pragma unroll
        for (int j = 0; j < 4; ++j) {
            const f32x4 w = *(const f32x4*)(nw + 4 * lane + 256 * j), sh = *(const f32x4*)(md + 4 * lane + 256 * j), sc = *(const f32x4*)(md + 1024 + 4 * lane + 256 * j);
            const f32x4 hv = v[j] * rstd * w * (sc + 1.0f) + sh;
            *(v2u*)(HX + (size_t)row * DM + 4 * lane + 256 * j) = (v2u){pk2(hv.x, hv.y), pk2(hv.z, hv.w)};
        }
    }
}
__device__ __forceinline__ void p7_rows(const Args& a, int vcu, int G) {
    const int tid = threadIdx.x, lane = tid & 63, wave = __builtin_amdgcn_readfirstlane(tid >> 6);
    const float* MOD = (const float*)(a.ws + WS_MOD); const float* nw = a.in[16]; bf16* H2 = (bf16*)(a.ws + WS_H2);
    const int gw = vcu * NWAVES + wave, NGW = G * NWAVES;
    for (int row = gw; row < MROWS; row += NGW) {
        const float* xr = a.in[0] + (size_t)row * DM; const float* md = MOD + (size_t)(row >> 12) * 6144; const bf16* y1 = (const bf16*)a.out + (size_t)row * 2048;
        f32x4 v[4]; float s = 0.f;
#pragma unroll
        for (int j = 0; j < 4; ++j) { v[j] = *(const f32x4*)(xr + 4 * lane + 256 * j) + bf4(*(const v2u*)(y1 + 4 * lane + 256 * j)); s += (v[j].x * v[j].x + v[j].y * v[j].y) + (v[j].z * v[j].z + v[j].w * v[j].w); }
        const float rstd = rsqrtf(wave_sum(s) * (1.0f / DM) + EPS);
#pragma unroll
        for (int j = 0; j < 4; ++j) {
            const f32x4 w = *(const f32x4*)(nw + 4 * lane + 256 * j), sh = *(const f32x4*)(md + 3072 + 4 * lane + 256 * j), sc = *(const f32x4*)(md + 4096 + 4 * lane + 256 * j);
            const f32x4 hv = v[j] * rstd * w * (sc + 1.0f) + sh;
            *(v2u*)(H2 + (size_t)row * DM + 4 * lane + 256 * j) = (v2u){pk2(hv.x, hv.y), pk2(hv.z, hv.w)}; }
    }
}
__device__ __forceinline__ void p11_rows(const Args& a, int vcu, int G, float* dst) {
    const int tid = threadIdx.x, lane = tid & 63, wave = __builtin_amdgcn_readfirstlane(tid >> 6);
    const float* nw = a.in[23];
    const int gw = vcu * NWAVES + wave, NGW = G * NWAVES;
    for (int row = gw; row < MROWS; row += NGW) {
        const float* xr = a.in[0] + (size_t)row * DM; const bf16* y1 = (const bf16*)a.out + (size_t)row * 2048; const bf16* d2 = (const bf16*)(a.ws + WS_U) + (size_t)row * DM;
        f32x4 v[4]; float s = 0.f;
#pragma unroll
        for (int j = 0; j < 4; ++j) { v[j] = *(const f32x4*)(xr + 4 * lane + 256 * j) + bf4(*(const v2u*)(y1 + 4 * lane + 256 * j)) + bf4(*(const v2u*)(d2 + 4 * lane + 256 * j)); s += (v[j].x * v[j].x + v[j].y * v[j].y) + (v[j].z * v[j].z + v[j].w * v[j].w); }
        const float rstd = rsqrtf(wave_sum(s) * (1.0f / DM) + EPS);
#pragma unroll
        for (int j = 0; j < 4; ++j) { const f32x4 w = *(const f32x4*)(nw + 4 * lane + 256 * j); *(f32x4*)(dst + (size_t)row * DM + 4 * lane + 256 * j) = v[j] * rstd * w; }
    }
}

struct SchedP2 {
    pg8::StaticOrder so;
    __device__ void init(int G, int c) { so.init(MROWS, 2048, G, c); }
    __device__ bool next(int i, pg8::Unit& u) const {
        const long L = (long)i * so.G + so.c;
        if (L < so.nwg) return so.next(i, u);
        const int r = (int)(L - so.nwg); if (r >= 32 + 136) return false;
        if (r < 32) { u.pm = 128 + (r & 7); u.pn = 2 + (r >> 3); }
        else { u.pm = r - 32; u.pn = 8; }
        return true;
    }
    __device__ __forceinline__ void a_ready(const pg8::Unit&) const {}
    __device__ __forceinline__ void done(const pg8::Unit&) const {}
};
struct EpiP2 {
    static constexpr bool PERM = true, AFTER_DRAIN = false;
    bf16 *base0, *base1, *base2, *base3;
    float* gates; const float* bgate;
    __device__ __forceinline__ void operator()(const f32x4 (&acc)[2][2][4][2], const pg8::Unit& u, int wr, int wc, int fr, int fq) const {
        if (u.pn == 8) {
            if (wc == 0 && fq < 2) { const int row0 = u.pm * 256 + wr * 64 + fr; const f32x4 b0 = *(const f32x4*)(bgate + 8 * fq), b1 = *(const f32x4*)(bgate + 8 * fq + 4);
#pragma unroll
                for (int ai = 0; ai < 2; ++ai)
#pragma unroll
                    for (int m = 0; m < 4; ++m) { float* gp = gates + (size_t)(row0 + ai * 128 + m * 16) * 16 + 8 * fq; *(f32x4*)gp = acc[ai][0][m][0] + b0; *(f32x4*)(gp + 4) = acc[ai][0][m][1] + b1; } }
            return; }
        const int row0 = u.pm * 256 + wr * 64 + fr; const int sel = u.pn >> 1; bf16* O = sel == 0 ? base0 : (sel == 1 ? base1 : (sel == 2 ? base2 : base3)); const int col0 = (u.pn & 1) * 256 + wc * 32 + 8 * fq;
#pragma unroll
        for (int ai = 0; ai < 2; ++ai)
#pragma unroll
            for (int m = 0; m < 4; ++m) { bf16* rowp = O + (size_t)(row0 + ai * 128 + m * 16) * 512 + col0;
#pragma unroll
                for (int bj = 0; bj < 2; ++bj) { const f32x4 v0 = acc[ai][bj][m][0], v1 = acc[ai][bj][m][1];
                    v4u w; w.x = pg8::cvt_pk_bf16(v0[0], v0[1]); w.y = pg8::cvt_pk_bf16(v0[2], v0[3]); w.z = pg8::cvt_pk_bf16(v1[0], v1[1]); w.w = pg8::cvt_pk_bf16(v1[2], v1[3]);
                    *(v4u*)(rowp + bj * 128) = w; } }
    }
};
struct EpiBias16 {
    static constexpr bool PERM = true, AFTER_DRAIN = false;
    bf16* O; int ldc; const float* bias;
    __device__ __forceinline__ void operator()(const f32x4 (&acc)[2][2][4][2], const pg8::Unit& u, int wr, int wc, int fr, int fq) const {
        const int row0 = u.pm * 256 + wr * 64 + fr; const int col0 = u.pn * 256 + wc * 32 + 8 * fq;
        f32x4 bv[2][2];
#pragma unroll
        for (int bj = 0; bj < 2; ++bj)
#pragma unroll
            for (int n = 0; n < 2; ++n) bv[bj][n] = *(const f32x4*)(bias + col0 + bj * 128 + 4 * n);
#pragma unroll
        for (int ai = 0; ai < 2; ++ai)
#pragma unroll
            for (int m = 0; m < 4; ++m) { bf16* rowp = O + (size_t)(row0 + ai * 128 + m * 16) * ldc + col0;
#pragma unroll
                for (int bj = 0; bj < 2; ++bj) { const f32x4 v0 = acc[ai][bj][m][0] + bv[bj][0], v1 = acc[ai][bj][m][1] + bv[bj][1];
                    v4u w; w.x = pg8::cvt_pk_bf16(v0[0], v0[1]); w.y = pg8::cvt_pk_bf16(v0[2], v0[3]); w.z = pg8::cvt_pk_bf16(v1[0], v1[1]); w.w = pg8::cvt_pk_bf16(v1[2], v1[3]);
                    *(v4u*)(rowp + bj * 128) = w; } }
    }
};
struct EpiUp {
    static constexpr bool PERM = true, AFTER_DRAIN = false;
    bf16* O; const float* bias;
    __device__ __forceinline__ void operator()(const f32x4 (&acc)[2][2][4][2], const pg8::Unit& u, int wr, int wc, int fr, int fq) const {
        const int row0 = u.pm * 256 + wr * 64 + fr; const int col0 = u.pn * 256 + wc * 32 + 8 * fq;
        const int isg = u.pn >= 10 ? 1 : 0, qb = u.pn - 10 * isg, b = row0 >> 12;
        bf16* base = O + ((size_t)(b * 10 + qb) * SEQ) * 512 + isg * 256 + wc * 32 + 8 * fq;
        f32x4 bv[2][2];
#pragma unroll
        for (int bj = 0; bj < 2; ++bj)
#pragma unroll
            for (int n = 0; n < 2; ++n) bv[bj][n] = *(const f32x4*)(bias + col0 + bj * 128 + 4 * n);
#pragma unroll
        for (int ai = 0; ai < 2; ++ai)
#pragma unroll
            for (int m = 0; m < 4; ++m) { bf16* rowp = base + (size_t)((row0 + ai * 128 + m * 16) & (SEQ - 1)) * 512;
#pragma unroll
                for (int bj = 0; bj < 2; ++bj) { const f32x4 v0 = acc[ai][bj][m][0] + bv[bj][0], v1 = acc[ai][bj][m][1] + bv[bj][1];
                    v4u w; w.x = pg8::cvt_pk_bf16(v0[0], v0[1]); w.y = pg8::cvt_pk_bf16(v0[2], v0[3]); w.z = pg8::cvt_pk_bf16(v1[0], v1[1]); w.w = pg8::cvt_pk_bf16(v1[2], v1[3]);
                    *(v4u*)(rowp + bj * 128) = w; } }
    }
};
struct EpiGate16 {
    static constexpr bool PERM = true, AFTER_DRAIN = false;
    bf16* O; int ldc; const float* gate; const float* bias;
    __device__ __forceinline__ void operator()(const f32x4 (&acc)[2][2][4][2], const pg8::Unit& u, int wr, int wc, int fr, int fq) const {
        const int row0 = u.pm * 256 + wr * 64 + fr; const int col0 = u.pn * 256 + wc * 32 + 8 * fq;
        const float* gp = gate + (size_t)((u.pm * 256) >> 12) * 6144 + col0;
        f32x4 gv[2][2], bv[2][2];
#pragma unroll
        for (int bj = 0; bj < 2; ++bj)
#pragma unroll
            for (int n = 0; n < 2; ++n) { gv[bj][n] = *(const f32x4*)(gp + bj * 128 + 4 * n); bv[bj][n] = bias ? *(const f32x4*)(bias + col0 + bj * 128 + 4 * n) : (f32x4){0.f, 0.f, 0.f, 0.f}; }
#pragma unroll
        for (int ai = 0; ai < 2; ++ai)
#pragma unroll
            for (int m = 0; m < 4; ++m) { bf16* rowp = O + (size_t)(row0 + ai * 128 + m * 16) * ldc + col0;
#pragma unroll
                for (int bj = 0; bj < 2; ++bj) { const f32x4 v0 = gv[bj][0] * (acc[ai][bj][m][0] + bv[bj][0]), v1 = gv[bj][1] * (acc[ai][bj][m][1] + bv[bj][1]);
                    v4u w; w.x = pg8::cvt_pk_bf16(v0[0], v0[1]); w.y = pg8::cvt_pk_bf16(v0[2], v0[3]); w.z = pg8::cvt_pk_bf16(v1[0], v1[1]); w.w = pg8::cvt_pk_bf16(v1[2], v1[3]);
                    *(v4u*)(rowp + bj * 128) = w; } }
    }
};
struct EpiRes {
    static constexpr bool PERM = false, AFTER_DRAIN = false;
    const float* res; float* out; const float* gate; const float* bias;
    __device__ __forceinline__ void operator()(const f32x4 (&acc)[2][2][4][2], const pg8::Unit& u, int wr, int wc, int fr, int fq) const {
        const int row0 = u.pm * 256 + wr * 64 + fr, col0 = u.pn * 256 + wc * 32 + 4 * fq;
        const float* gp = gate + (size_t)((u.pm * 256) >> 12) * 6144 + col0;
        f32x4 gv[2][2], bv[2][2];
#pragma unroll
        for (int bj = 0; bj < 2; ++bj)
#pragma unroll
            for (int n = 0; n < 2; ++n) { gv[bj][n] = *(const f32x4*)(gp + bj * 128 + n * 16); bv[bj][n] = bias ? *(const f32x4*)(bias + col0 + bj * 128 + n * 16) : (f32x4){0.f, 0.f, 0.f, 0.f}; }
#pragma unroll
        for (int ai = 0; ai < 2; ++ai)
#pragma unroll
            for (int m = 0; m < 4; ++m) { const size_t off = (size_t)(row0 + ai * 128 + m * 16) * DM + col0;
#pragma unroll
                for (int bj = 0; bj < 2; ++bj)
#pragma unroll
                    for (int n = 0; n < 2; ++n) { const f32x4 r = *(const f32x4*)(res + off + bj * 128 + n * 16);
                        *(f32x4*)(out + off + bj * 128 + n * 16) = r + gv[bj][n] * (acc[ai][bj][m][n] + bv[bj][n]); }
                if (m & 1) asm volatile("" ::: "memory"); }
    }
};

__device__ __forceinline__ void lds_barrier() { asm volatile("s_waitcnt lgkmcnt(0)" ::: "memory"); __builtin_amdgcn_s_barrier(); asm volatile("" ::: "memory"); }
constexpr int PA_WQ = 0, PA_WK = 32768, PA_A = 65536, PA_V = 98304, PA_SM = 135168, VS = 288;
__device__ __forceinline__ void unit_decode(int unit, int& bh, int& row0, int& t0, int& L) {
    if (unit < NUNIT_L) { bh = unit >> 5; const int c = unit & 31; row0 = (bh >> 2) * SEQ + c * 128; t0 = c * 128; L = SEQ; }
    else { const int uc = unit - NUNIT_L; bh = uc >> 1; const int cc = uc & 1; row0 = MROWS + (bh >> 2) * CTXL + cc * 128; t0 = cc * 128; L = CTXL; }
}
__device__ __forceinline__ void stage_v128(const bf16* V, int row0, int h, LAS uchar* img, int tid) {
    const int j = tid >> 2, seg = tid & 3; const bf16* vr = V + (size_t)(row0 + j) * 512 + h * HD + seg * 32;
#pragma unroll
    for (int i = 0; i < 4; ++i) *(LAS v4u*)(img + j * VS + (seg * 32 + 8 * i) * 2) = *(const v4u*)(vr + 8 * i);
}
struct PrepLd { v4u xp[4], xc[4], xn[4], vv[4]; float g[4]; };
__device__ __forceinline__ void prep_issue(const Args& a, int unit, int tid, PrepLd& ld) {
    int bh, row0, t0, L; unit_decode(unit, bh, row0, t0, L);
    const int h = bh & 3, lane = tid & 63, wave = tid >> 6;
    const bf16* XM = (const bf16*)(a.ws + WS_XM); const bf16* V = (const bf16*)(a.ws + WS_V);
    { const int l = tid >> 2, seg = tid & 3, t = t0 + l; const bf16* xc = XM + (size_t)(row0 + l) * 512 + h * HD + seg * 32; const bool hp = t > 0, hn = t + 1 < L;
#pragma unroll
      for (int i = 0; i < 4; ++i) { ld.xc[i] = *(const v4u*)(xc + 8 * i); ld.xp[i] = (v4u){0u, 0u, 0u, 0u}; ld.xn[i] = (v4u){0u, 0u, 0u, 0u};
          if (hp) ld.xp[i] = *(const v4u*)(xc - 512 + 8 * i);
          if (hn) ld.xn[i] = *(const v4u*)(xc + 512 + 8 * i); }
      const bf16* vr = V + (size_t)(row0 + l) * 512 + h * HD + seg * 32;
#pragma unroll
      for (int i = 0; i < 4; ++i) ld.vv[i] = *(const v4u*)(vr + 8 * i); }
    if (wave < 2) { const float* GG = (const float*)(a.ws + WS_G) + (size_t)row0 * 16 + wave * 8 + h;
        const int j0 = wave ? 127 - 2 * lane : 2 * lane, j1 = wave ? 126 - 2 * lane : 2 * lane + 1;
        ld.g[0] = GG[j0 * 16]; ld.g[1] = GG[j0 * 16 + 4]; ld.g[2] = GG[j1 * 16]; ld.g[3] = GG[j1 * 16 + 4]; }
}
constexpr int PA_CW = PA_SM + 2048;
__device__ __forceinline__ void prep_unit(const Args& a, LAS uchar* lds, int unit, int next_unit, int& cur_h, PrepLd& ld, TProbe& tp) {
    int tid_ = threadIdx.x; asm volatile("" : "+v"(tid_)); const int tid = tid_, lane = tid & 63, wave = __builtin_amdgcn_readfirstlane(tid >> 6), kq = lane >> 4, fr = lane & 15;
    uchar* ws = a.ws;
    int bh, row0, t0, L; unit_decode(unit, bh, row0, t0, L);
    const int h = bh & 3; const bool latent = unit < NUNIT_L;
    LAS float* sm = (LAS float*)(lds + PA_SM);
    bf16* AB = (bf16*)((uchar*)a.out + DO_AB); bf16* Q = (bf16*)((uchar*)a.out + DO_Q); bf16* K = (bf16*)((uchar*)a.out + DO_K);
    lds_barrier();
    if (TP_P) TP_START(tp);
    if (cur_h != h) {
        const bf16* WQ = (const bf16*)(ws + WS_WQ) + (size_t)h * HD * HD; const bf16* WK = (const bf16*)(ws + WS_WK) + (size_t)h * HD * HD;
#pragma unroll
        for (int i = 0; i < 4; ++i) { const int id = tid + NTHR * i, row = id >> 4, ch = id & 15;
            *(LAS v4u*)(lds + PA_WQ + img_off(row, ch)) = *(const v4u*)(WQ + row * 128 + ch * 8); *(LAS v4u*)(lds + PA_WK + img_off(row, ch)) = *(const v4u*)(WK + row * 128 + ch * 8); }
        { const int arr = tid >> 7, cidx = tid & 127; ((LAS float*)(lds + PA_CW))[tid] = (arr < 3) ? a.in[8][arr * 512 + h * HD + cidx] : a.in[9][h * HD + cidx]; }
        cur_h = h;
        lds_barrier();
    }
    if (wave < 2) {
        const int j0 = wave ? 127 - 2 * lane : 2 * lane, j1 = wave ? 126 - 2 * lane : 2 * lane + 1;
        const float li0 = ld.g[0], lf0 = logsig_f(ld.g[1]), li1 = ld.g[2], lf1 = logsig_f(ld.g[3]);
        const float incl = lane_scan_add(lf0 + lf1, lane), total = __shfl(incl, 63);
        const float g0 = total - (incl - lf1) + li0, g1 = total - incl + li1;
        const float mx = wave_max(fmaxf(g0, g1));
        sm[wave * 128 + j0] = __expf(g0 - mx); sm[wave * 128 + j1] = __expf(g1 - mx);
        if (lane == 0) { sm[256 + 2 * wave] = total; sm[257 + 2 * wave] = mx; }
    }
    {
        const int l = tid >> 2, seg = tid & 3; const int colg = h * HD + seg * 32;
        const LAS float* cw = (const LAS float*)(lds + PA_CW) + seg * 32;
#pragma unroll
        for (int i = 0; i < 4; ++i) {
            const v4u c = ld.xc[i], p = ld.xp[i], n = ld.xn[i];
            float o[8];
#pragma unroll
            for (int hf = 0; hf < 2; ++hf) {
                const f32x4 w0 = *(const LAS f32x4*)(cw + 8 * i + 4 * hf), w1 = *(const LAS f32x4*)(cw + 128 + 8 * i + 4 * hf), w2 = *(const LAS f32x4*)(cw + 256 + 8 * i + 4 * hf), bb = *(const LAS f32x4*)(cw + 384 + 8 * i + 4 * hf);
                const f32x4 xp = bf4((v2u){p[2 * hf], p[2 * hf + 1]}), xcv = bf4((v2u){c[2 * hf], c[2 * hf + 1]}), xn = bf4((v2u){n[2 * hf], n[2 * hf + 1]});
                const f32x4 y = w0 * xp + w1 * xcv + w2 * xn + bb;
#pragma unroll
                for (int e = 0; e < 4; ++e) o[4 * hf + e] = silu_f(y[e]); }
            const v4u w = (v4u){pk2(o[0], o[1]), pk2(o[2], o[3]), pk2(o[4], o[5]), pk2(o[6], o[7])};
            *(LAS v4u*)(lds + PA_A + img_off(l, seg * 4 + i)) = w;
            if (latent) *(v4u*)(AB + (size_t)(row0 + l) * 512 + colg + 8 * i) = w;
            *(LAS v4u*)(lds + PA_V + l * VS + (seg * 32 + 8 * i) * 2) = ld.vv[i];
        }
    }
    if (TP_P) TP_MARK(tp, 0);
    lds_barrier();
    if (TP_P) TP_MARK(tp, 1);
    { int tid2 = tid; asm volatile("" : "+v"(tid2)); if (next_unit >= 0) prep_issue(a, next_unit, tid2, ld); }
    if (latent) {
        const BFrag ba = load_bfrag(lds + PA_A, 16 * wave + fr, kq);
        const size_t tok = (size_t)(row0 + 16 * wave + fr);
#pragma unroll 1
        for (int pass = 0; pass < 2; ++pass) {
            const LAS uchar* wimg = lds + (pass ? PA_WK : PA_WQ);
            bf16* dst = (pass ? K : Q) + tok * 512 + h * HD + 4 * kq;
#pragma unroll
            for (int mt = 0; mt < 8; ++mt) { const f32x4 acc = mma_a((f32x4){0.f, 0.f, 0.f, 0.f}, wimg, 16 * mt + fr, ba, kq);
                *(v2u*)(dst + 16 * mt) = (v2u){pk2(acc[0], acc[1]), pk2(acc[2], acc[3])}; if (mt & 1) MEMFENCE(); }
        }
    }
    if (TP_P) TP_MARK(tp, 2);
    f32x4 kacc[8];
    { const BFrag bk = load_bfrag(lds + PA_WK, 16 * wave + fr, kq);
#pragma unroll
      for (int mt = 0; mt < 8; ++mt) { kacc[mt] = mma_a((f32x4){0.f, 0.f, 0.f, 0.f}, lds + PA_A, 16 * mt + fr, bk, kq); if (mt & 1) MEMFENCE(); } }
    if (TP_P) TP_MARK(tp, 3);
    {
        bf16* DC = (bf16*)(ws + WS_DC); float* SC = (float*)(ws + WS_SC);
        BFrag akf, akb;
#pragma unroll
        for (int ks = 0; ks < 4; ++ks) { unsigned wf_[4], wb_[4];
#pragma unroll
            for (int hh = 0; hh < 2; ++hh) { const int mt = 2 * ks + hh; const f32x4 wf4 = *(const LAS f32x4*)(sm + 16 * mt + 4 * kq), wb4 = *(const LAS f32x4*)(sm + 128 + 16 * mt + 4 * kq);
                const f32x4 kf = kacc[mt] * wf4, kb = kacc[mt] * wb4;
                wf_[2 * hh] = pk2(kf[0], kf[1]); wf_[2 * hh + 1] = pk2(kf[2], kf[3]); wb_[2 * hh] = pk2(kb[0], kb[1]); wb_[2 * hh + 1] = pk2(kb[2], kb[3]); }
            akf.f[ks] = __builtin_bit_cast(bf16x8, (v4u){wf_[0], wf_[1], wf_[2], wf_[3]}); akb.f[ks] = __builtin_bit_cast(bf16x8, (v4u){wb_[0], wb_[1], wb_[2], wb_[3]}); }
        const unsigned vbase = lds_addr(lds + PA_V) + tr_lane_off_p<VS>(lane);
        bf16* df = DC + (size_t)(unit * 2) * CT_SLOT + 16 * wave + 4 * kq; bf16* db = df + CT_SLOT;
#pragma unroll
        for (int c = 0; c < 8; ++c) { BFrag bv; tr_load4p<VS>(vbase + 32 * c, bv);
            const f32x4 af = mma_ff((f32x4){0.f, 0.f, 0.f, 0.f}, akf, bv), ab = mma_ff((f32x4){0.f, 0.f, 0.f, 0.f}, akb, bv);
            *(v2u*)(df + (size_t)(16 * c + fr) * 128) = (v2u){pk2(af[0], af[1]), pk2(af[2], af[3])};
            *(v2u*)(db + (size_t)(16 * c + fr) * 128) = (v2u){pk2(ab[0], ab[1]), pk2(ab[2], ab[3])}; }
        { const unsigned onesw = (fr == 0) ? 0x3f803f80u : 0u; BFrag ones;
#pragma unroll
          for (int s_ = 0; s_ < 4; ++s_) ones.f[s_] = __builtin_bit_cast(bf16x8, (v4u){onesw, onesw, onesw, onesw});
          const f32x4 nf = mma_ff((f32x4){0.f, 0.f, 0.f, 0.f}, akf, ones), nb = mma_ff((f32x4){0.f, 0.f, 0.f, 0.f}, akb, ones);
          if (fr == 0) { *(v2u*)(df + (size_t)128 * 128) = (v2u){pk2(nf[0], nf[1]), pk2(nf[2], nf[3])}; *(v2u*)(db + (size_t)128 * 128) = (v2u){pk2(nb[0], nb[1]), pk2(nb[2], nb[3])}; } }
        if (TP_P) TP_MARK(tp, 4);
        if (tid == 0) { SC[(unit * 2) * 2] = sm[256]; SC[(unit * 2) * 2 + 1] = sm[257]; SC[(unit * 2 + 1) * 2] = sm[258]; SC[(unit * 2 + 1) * 2 + 1] = sm[259]; }
    }
}

constexpr int F1S = 144, F2S = 80;
__device__ __forceinline__ void fft1_wave(const Args& a, LAS uchar* wl, int item, const bf16x8 (&bfr)[8][2], int lane) {
    const int kq = lane >> 4, fr = lane & 15;
    const int b = item >> 9, chunk = item & 511, cg0 = chunk * 64, n2 = cg0 >> 9, colb = cg0 & 511;
    const bf16* UF = (const bf16*)(a.ws + WS_UF) + (size_t)b * SEQ * 512 + cg0;
    bf16* TP = (bf16*)(a.ws + WS_TP); const float* TW = (const float*)(a.ws + WS_TW);
    v4u ld[8];
#pragma unroll
    for (int i = 0; i < 8; ++i) ld[i] = *(const v4u*)(UF + (size_t)(i * 8 + (lane >> 3)) * 32768 + (lane & 7) * 8);
#pragma unroll
    for (int i = 0; i < 8; ++i) *(LAS v4u*)(wl + (i * 8 + (lane >> 3)) * F1S + (lane & 7) * 16) = ld[i];
    LDS_WAIT();
    const unsigned base = lds_addr(wl) + tr_lane_off<F1S>(lane);
#pragma unroll 1
    for (int mt = 0; mt < 4; ++mt) {
        bf16x8 a0, a1; tr_load2<F1S>(base + 32 * mt, a0, a1);
        f32x4 acc[8];
#pragma unroll
        for (int nt = 0; nt < 8; ++nt) { acc[nt] = __builtin_amdgcn_mfma_f32_16x16x32_bf16(a0, bfr[nt][0], (f32x4){0.f, 0.f, 0.f, 0.f}, 0, 0, 0); acc[nt] = __builtin_amdgcn_mfma_f32_16x16x32_bf16(a1, bfr[nt][1], acc[nt], 0, 0, 0); }
        const int c0 = 16 * mt + 4 * kq, col0 = colb + c0;
#pragma unroll
        for (int nt = 0; nt < 4; ++nt) { const int k1 = 16 * nt + fr; const int idx = (n2 * k1) & 4095; const float cs = TW[idx], sn = TW[(idx - 1024) & 4095];
            float pr[4], pi[4];
#pragma unroll
            for (int r = 0; r < 4; ++r) { const float tr = acc[nt][r], ti = acc[nt + 4][r]; const float xr = tr * cs + ti * sn, xi = ti * cs - tr * sn;
                const bool st = ((col0 + r) & 127) >= 65; pr[r] = st ? -xi : xr; pi[r] = st ? xr : xi; }
            const size_t o = ((size_t)(b * 2) * 64 + k1) * 32768 + (size_t)cg0 + c0;
            *(v2u*)(TP + o) = (v2u){pk2(pr[0], pr[1]), pk2(pr[2], pr[3])};
            *(v2u*)(TP + o + (size_t)64 * 32768) = (v2u){pk2(pi[0], pi[1]), pk2(pi[2], pi[3])}; }
    }
}
__device__ __forceinline__ void fft2_wave(const Args& a, LAS uchar* wl, int item, const bf16x8 (&bfr)[4][4], int lane) {
    const int kq = lane >> 4, fr = lane & 15;
    const int b = item >> 10, k1 = (item >> 4) & 63, chunk = item & 15;
    const bf16* TP = (const bf16*)(a.ws + WS_TP); bf16* YM = (bf16*)(a.ws + WS_YM);
    v4u ld[8];
#pragma unroll
    for (int i = 0; i < 8; ++i) { const int kap = i * 16 + (lane >> 2), ri = kap >> 6, n2 = kap & 63;
        ld[i] = *(const v4u*)(TP + ((size_t)(b * 2 + ri) * 64 + k1) * 32768 + (size_t)n2 * 512 + chunk * 32 + (lane & 3) * 8); }
#pragma unroll
    for (int i = 0; i < 8; ++i) *(LAS v4u*)(wl + (i * 16 + (lane >> 2)) * F2S + (lane & 3) * 16) = ld[i];
    LDS_WAIT();
    const unsigned base = lds_addr(wl) + tr_lane_off<F2S>(lane);
#pragma unroll
    for (int mt = 0; mt < 2; ++mt) {
        BFrag af; tr_load4<F2S>(base + 32 * mt, af);
#pragma unroll
        for (int nt = 0; nt < 4; ++nt) { f32x4 acc = (f32x4){0.f, 0.f, 0.f, 0.f};
#pragma unroll
            for (int s_ = 0; s_ < 4; ++s_) acc = __builtin_amdgcn_mfma_f32_16x16x32_bf16(af.f[s_], bfr[nt][s_], acc, 0, 0, 0);
            const int k2 = 16 * nt + fr; const size_t row = (size_t)b * SEQ + k1 + 64 * k2;
            *(v2u*)(YM + row * 1024 + chunk * 32 + 16 * mt + 4 * kq) = (v2u){pk2(acc[0], acc[1]), pk2(acc[2], acc[3])}; }
    }
}
__device__ __forceinline__ void fft1_phase(const Args& a, LAS uchar* lds, int vcu, int G) {
    const int tid = threadIdx.x, lane = tid & 63, wave = __builtin_amdgcn_readfirstlane(tid >> 6), kq = lane >> 4, fr = lane & 15;
    const bf16* F1 = (const bf16*)(a.ws + WS_F1);
    bf16x8 bfr[8][2];
#pragma unroll
    for (int nt = 0; nt < 8; ++nt)
#pragma unroll
        for (int s_ = 0; s_ < 2; ++s_) bfr[nt][s_] = *(const bf16x8*)(F1 + (16 * nt + fr) * 64 + 32 * s_ + 8 * kq);
    LAS uchar* wl = lds + wave * 9216;
    if (G == 256) {
        const int bx = blockIdx.x;
        if (bx < 64) fft1_wave(a, wl, bx * NWAVES + wave, bfr, lane);
        else for (int it = 512 + (bx - 64) * NWAVES + wave; it < NB * 512; it += 192 * NWAVES) fft1_wave(a, wl, it, bfr, lane);
    } else for (int it = vcu * NWAVES + wave; it < NB * 512; it += G * NWAVES) fft1_wave(a, wl, it, bfr, lane);
}
__device__ __forceinline__ void fft2_phase(const Args& a, LAS uchar* lds, int vcu, int G) {
    const int tid = threadIdx.x, lane = tid & 63, wave = __builtin_amdgcn_readfirstlane(tid >> 6), kq = lane >> 4, fr = lane & 15;
    const bf16* G2 = (const bf16*)(a.ws + WS_G2);
    bf16x8 bfr[4][4];
#pragma unroll
    for (int nt = 0; nt < 4; ++nt)
#pragma unroll
        for (int s_ = 0; s_ < 4; ++s_) bfr[nt][s_] = *(const bf16x8*)(G2 + (16 * nt + fr) * 128 + 32 * s_ + 8 * kq);
    LAS uchar* wl = lds + wave * 10240;
    for (int it = vcu * NWAVES + wave; it < NB * 1024; it += G * NWAVES) fft2_wave(a, wl, it, bfr, lane);
}

__device__ __forceinline__ void p4_scan(const Args& a, int G) {
    uchar* ws = a.ws;
    const bf16* DC = (const bf16*)(ws + WS_DC); const float* SC = (const float*)(ws + WS_SC);
    bf16* CT = (bf16*)(ws + WS_CT); float* MS = (float*)(ws + WS_MS);
    constexpr int F4 = CT_SLOT / 4;
    const int total = 64 * F4;
    for (int gi = blockIdx.x * NTHR + threadIdx.x; gi < total; gi += G * NTHR) {
        const int seq = gi / F4, i = gi - seq * F4; const int bh = seq >> 1, dir = seq & 1;
        v2u dv[34]; f32x2 sc[34];
#pragma unroll
        for (int step = 0; step < 34; ++step) {
            const int unit = (step < 2) ? NUNIT_L + bh * 2 + (dir ? 1 - step : step) : bh * 32 + (dir ? 33 - step : step - 2);
            const int slot = unit * 2 + dir;
            dv[step] = *(const v2u*)(DC + (size_t)slot * CT_SLOT + 4 * i); sc[step] = *(const f32x2*)(SC + slot * 2);
        }
        f32x4 s = (f32x4){0.f, 0.f, 0.f, 0.f}; float m = 0.f;
#pragma unroll
        for (int step = 0; step < 34; ++step) {
            const int unit = (step < 2) ? NUNIT_L + bh * 2 + (dir ? 1 - step : step) : bh * 32 + (dir ? 33 - step : step - 2);
            const int slot = unit * 2 + dir;
            if (step >= 2) { *(v2u*)(CT + (size_t)slot * CT_SLOT + 4 * i) = (v2u){pk2(s.x, s.y), pk2(s.z, s.w)}; if (i == 0) MS[slot] = m; }
            const float bend = sc[step].x, mloc = sc[step].y;
            const float mn = fmaxf(bend + m, mloc), al = __expf(bend + m - mn), be = __expf(mloc - mn);
            s = s * al + bf4(dv[step]) * be; m = mn;
        }
    }
}

constexpr int OU_CF = 0, OU_CB = 33792, OU_V = 67584, OU_K = 104448, OU_SM = 137216;
struct OutLd { v4u cf[4], cb[4], kk[4], vv[4]; BFrag bq; float g[4], mf, mb; };
__device__ __forceinline__ void out_issue(const Args& a, int unit, int tid, OutLd& ld) {
    const int bh = unit >> 5, c = unit & 31, h = bh & 3, row0 = (bh >> 2) * SEQ + c * 128, lane = tid & 63, wave = tid >> 6, kq = lane >> 4, fr = lane & 15;
    const bf16* Q = (const bf16*)((const uchar*)a.out + DO_Q); const bf16* K = (const bf16*)((const uchar*)a.out + DO_K);
    const bf16* V = (const bf16*)(a.ws + WS_V); const bf16* CT = (const bf16*)(a.ws + WS_CT); const float* MS = (const float*)(a.ws + WS_MS);
    const bf16* sf = CT + (size_t)(unit * 2) * CT_SLOT; const bf16* sb = sf + CT_SLOT;
#pragma unroll
    for (int i = 0; i < 4; ++i) { const int id = tid + NTHR * i; ld.cf[i] = *(const v4u*)(sf + id * 8); ld.cb[i] = *(const v4u*)(sb + id * 8); }
#pragma unroll
    for (int i = 0; i < 4; ++i) { const int id = tid + NTHR * i, row = id >> 4, ch = id & 15; ld.kk[i] = *(const v4u*)(K + (size_t)(row0 + row) * 512 + h * HD + ch * 8); }
    { const int j = tid >> 2, seg = tid & 3; const bf16* vr = V + (size_t)(row0 + j) * 512 + h * HD + seg * 32;
#pragma unroll
      for (int i = 0; i < 4; ++i) ld.vv[i] = *(const v4u*)(vr + 8 * i); }
    { const size_t tok = (size_t)(row0 + 16 * wave + fr);
#pragma unroll
      for (int s_ = 0; s_ < 4; ++s_) ld.bq.f[s_] = *(const bf16x8*)(Q + tok * 512 + h * HD + 32 * s_ + 8 * kq); }
    if (wave < 2) { const float* GG = (const float*)(a.ws + WS_G) + (size_t)row0 * 16 + wave * 8 + h;
        const int j0 = wave ? 127 - 2 * lane : 2 * lane, j1 = wave ? 126 - 2 * lane : 2 * lane + 1;
        ld.g[0] = GG[j0 * 16]; ld.g[1] = GG[j0 * 16 + 4]; ld.g[2] = GG[j1 * 16]; ld.g[3] = GG[j1 * 16 + 4]; }
    ld.mf = MS[unit * 2]; ld.mb = MS[unit * 2 + 1];
}
__device__ __forceinline__ void out_unit(const Args& a, LAS uchar* lds, int unit, int next_unit, OutLd& ld, TProbe& tp) {
    int tid_ = threadIdx.x; asm volatile("" : "+v"(tid_)); const int tid = tid_, lane = tid & 63, wave = __builtin_amdgcn_readfirstlane(tid >> 6), kq = lane >> 4, fr = lane & 15;
    uchar* ws = a.ws;
    const int bh = unit >> 5, c = unit & 31, h = bh & 3, row0 = (bh >> 2) * SEQ + c * 128;
    LAS float* sm = (LAS float*)(lds + OU_SM);
    const bf16* AB = (const bf16*)((const uchar*)a.out + DO_AB); const bf16* Z = (const bf16*)(ws + WS_Z);
    bf16* YM = (bf16*)(ws + WS_YM);
    const float m_f = ld.mf, m_b = ld.mb;
    lds_barrier();
    if (TP_O) TP_START(tp);
    if (wave < 2) {
        const int j0 = wave ? 127 - 2 * lane : 2 * lane, j1 = wave ? 126 - 2 * lane : 2 * lane + 1;
        const float li0 = ld.g[0], lf0 = logsig_f(ld.g[1]), li1 = ld.g[2], lf1 = logsig_f(ld.g[3]);
        const float incl = lane_scan_add(lf0 + lf1, lane);
        const float b0 = incl - lf1, b1 = incl, r0 = li0 - b0, r1 = li1 - b1;
        const float mi = lane_scan_max(fmaxf(r0, r1), lane); float mprev = __shfl_up(mi, 1); if (lane == 0) mprev = -3.0e38f;
        const float R0 = fmaxf(mprev, r0), R1 = mi, mst = wave ? m_b : m_f;
        LAS float* d = sm + wave * 384;
        d[j0] = r0; d[j1] = r1; d[128 + j0] = fmaxf(mst, R0); d[128 + j1] = fmaxf(mst, R1); d[256 + j0] = b0; d[256 + j1] = b1;
    }
    {
        if (tid < 256) sm[768 + tid] = (tid < 128) ? a.in[13][h * HD + tid] : a.in[14][h * HD + tid - 128];
#pragma unroll
        for (int i = 0; i < 4; ++i) { const int id = tid + NTHR * i, row = id >> 4, ch = id & 15;
            *(LAS v4u*)(lds + OU_CF + img_off(row, ch)) = ld.cf[i]; *(LAS v4u*)(lds + OU_CB + img_off(row, ch)) = ld.cb[i]; }
        if (tid < 32) { const int dirn = tid >> 4, ch = tid & 15; const bf16* sn = (const bf16*)(ws + WS_CT) + (size_t)(unit * 2 + dirn) * CT_SLOT + 128 * 128 + ch * 8;
            *(LAS v4u*)(lds + (dirn ? OU_CB : OU_CF) + img_off(128, ch)) = *(const v4u*)sn; }
#pragma unroll
        for (int i = 0; i < 4; ++i) { const int id = tid + NTHR * i, row = id >> 4, ch = id & 15; *(LAS v4u*)(lds + OU_K + img_off(row, ch)) = ld.kk[i]; }
        { const int j = tid >> 2, seg = tid & 3;
#pragma unroll
          for (int i = 0; i < 4; ++i) *(LAS v4u*)(lds + OU_V + j * VS + (seg * 32 + 8 * i) * 2) = ld.vv[i]; }
    }
    const int l = 16 * wave + fr; const int tok = row0 + l;
    const BFrag bq = ld.bq;
    if (TP_O) TP_MARK(tp, 0);
    lds_barrier();
    if (TP_O) TP_MARK(tp, 1);
    f32x4 S[8];
#pragma unroll
    for (int mt = 0; mt < 8; ++mt) { S[mt] = mma_a((f32x4){0.f, 0.f, 0.f, 0.f}, lds + OU_K, 16 * mt + fr, bq, kq); if (mt & 1) MEMFENCE(); }
    if (TP_O) TP_MARK(tp, 2);
    const unsigned vbase = lds_addr(lds + OU_V) + tr_lane_off_p<VS>(lane);
    const unsigned onesw = (fr == 0) ? 0x3f803f80u : 0u; BFrag ones;
#pragma unroll
    for (int s_ = 0; s_ < 4; ++s_) ones.f[s_] = __builtin_bit_cast(bf16x8, (v4u){onesw, onesw, onesw, onesw});
    f32x4 hs[8];
    for (int dir = 0; dir < 2; ++dir) {
        const LAS float* rr = sm + dir * 384; const LAS float* rho = rr + 128; const LAS float* bl = rr + 256;
        const float rho_l = rho[l], mst = dir ? m_b : m_f;
        BFrag bp;
#pragma unroll
        for (int ks = 0; ks < 4; ++ks) { unsigned w[4];
#pragma unroll
            for (int hh = 0; hh < 2; ++hh) { const int mt = 2 * ks + hh; float p[4]; const f32x4 rv = *(const LAS f32x4*)(rr + 16 * mt + 4 * kq);
#pragma unroll
                for (int r = 0; r < 4; ++r) { const int j = 16 * mt + 4 * kq + r; const bool ok = dir ? (j >= l) : (j <= l); p[r] = ok ? S[mt][r] * __expf(fminf(rv[r] - rho_l, 0.f)) : 0.f; }
                w[2 * hh] = pk2(p[0], p[1]); w[2 * hh + 1] = pk2(p[2], p[3]); }
            bp.f[ks] = __builtin_bit_cast(bf16x8, (v4u){w[0], w[1], w[2], w[3]}); }
        f32x4 acc[9];
        const float wi = __expf(mst - rho_l);
        const LAS uchar* cimg = lds + (dir ? OU_CB : OU_CF);
#pragma unroll
        for (int mt = 0; mt < 9; ++mt) { acc[mt] = mma_a((f32x4){0.f, 0.f, 0.f, 0.f}, cimg, 16 * mt + fr, bq, kq) * wi; if (mt & 1) MEMFENCE(); }
#pragma unroll
        for (int mt = 0; mt < 8; ++mt) { BFrag av; tr_load4p<VS>(vbase + 32 * mt, av); acc[mt] = mma_ff(acc[mt], av, bp); }
        acc[8] = mma_ff(acc[8], ones, bp);
        const float den = __shfl(acc[8][0], fr);
        const float sc = 1.0f / fmaxf(fabsf(den), __expf(-bl[l] - rho_l));
#pragma unroll
        for (int mt = 0; mt < 8; ++mt) hs[mt] = dir ? hs[mt] + acc[mt] * sc : acc[mt] * sc;
    }
    if (TP_O) TP_MARK(tp, 3);
    v2u av8[8], zv8[8];
#pragma unroll
    for (int mt = 0; mt < 8; ++mt) { const int e0 = 16 * mt + 4 * kq; av8[mt] = *(const v2u*)(AB + (size_t)tok * 512 + h * HD + e0); zv8[mt] = *(const v2u*)(Z + (size_t)tok * 512 + h * HD + e0); }
    MEMFENCE();
    { int tid2 = tid; asm volatile("" : "+v"(tid2)); if (next_unit >= 0) out_issue(a, next_unit, tid2, ld); }
    float s1 = 0.f;
#pragma unroll
    for (int mt = 0; mt < 8; ++mt) s1 += (hs[mt][0] + hs[mt][1]) + (hs[mt][2] + hs[mt][3]);
    s1 += __shfl_xor(s1, 16); s1 += __shfl_xor(s1, 32);
    const float mu = s1 * (1.0f / 128.0f); float s2 = 0.f;
#pragma unroll
    for (int mt = 0; mt < 8; ++mt) { const f32x4 d = hs[mt] - mu; s2 += (d[0] * d[0] + d[1] * d[1]) + (d[2] * d[2] + d[3] * d[3]); }
    s2 += __shfl_xor(s2, 16); s2 += __shfl_xor(s2, 32);
    const float rstd = rsqrtf(s2 * (1.0f / 128.0f) + EPS);
    const LAS float* mw = sm + 768; const LAS float* msk = sm + 896;
#pragma unroll
    for (int mt = 0; mt < 8; ++mt) { const int e0 = 16 * mt + 4 * kq;
        const f32x4 w = *(const LAS f32x4*)(mw + e0), k4 = *(const LAS f32x4*)(msk + e0);
        const f32x4 a4 = bf4(av8[mt]), z4 = bf4(zv8[mt]);
        float y[4];
#pragma unroll
        for (int r = 0; r < 4; ++r) y[r] = ((hs[mt][r] - mu) * rstd * w[r] + k4[r] * a4[r]) * silu_f(z4[r]);
        *(v2u*)(YM + (size_t)tok * 1024 + 512 + h * HD + e0) = (v2u){pk2(y[0], y[1]), pk2(y[2], y[3])}; }
    if (TP_O) TP_MARK(tp, 4);
}

__device__ __forceinline__ void p9_conv(const Args& a, int vcu, int G) {
    const int tid = threadIdx.x, lane = tid & 63, wave = __builtin_amdgcn_readfirstlane(tid >> 6);
    const bf16* U = (const bf16*)(a.ws + WS_U); bf16* ACT = (bf16*)(a.ws + WS_ACT);
    const float* fw = a.in[19]; const float* fb = a.in[20];
    const int gw = vcu * NWAVES + wave, NGW = G * NWAVES;
    const int hk = lane >> 5, li = lane & 31;
    const bool xmap = (G == 256);
    for (int k = 0; k < (xmap ? 5 : (NB * 64 * 10 * 2 + NGW - 1) / NGW); ++k) {
        int half, qb, r, b;
        if (xmap) { const int idx = (vcu & 31) * NWAVES + wave + 256 * k; b = vcu >> 5; qb = idx >> 7; r = (idx & 127) >> 1; half = idx & 1; }
        else { const int it = gw + k * NGW; if (it >= NB * 64 * 10 * 2) break; half = it & 1; qb = (it >> 1) % 10; const int br = (it >> 1) / 10; r = br & 63; b = br >> 6; }
        const int ch = hk * DFF + qb * 256 + 8 * li;
        const float z0 = (r > 0) ? 1.f : 0.f, z2 = (r < 63) ? 1.f : 0.f;
        f32x4 w0[9], w1[9];
#pragma unroll
        for (int t = 0; t < 9; ++t) { const float zz = (t < 3) ? z0 : (t >= 6 ? z2 : 1.f); w0[t] = *(const f32x4*)(fw + t * UPW + ch) * zz; w1[t] = *(const f32x4*)(fw + t * UPW + ch + 4) * zz; }
        const f32x4 b0 = *(const f32x4*)(fb + ch), b1 = *(const f32x4*)(fb + ch + 4);
        const bf16* rp[3];
        rp[1] = U + ((size_t)(b * 10 + qb) * SEQ + r * 64) * 512 + lane * 8;
        rp[0] = (r > 0) ? rp[1] - (size_t)64 * 512 : rp[1];
        rp[2] = (r < 63) ? rp[1] + (size_t)64 * 512 : rp[1];
        v4u x[3][6];
        const int c0 = half * 32;
        { const int cm = (c0 > 0) ? c0 - 1 : 0;
#pragma unroll
          for (int i = 0; i < 3; ++i) { x[i][0] = *(const v4u*)(rp[i] + (size_t)cm * 512); x[i][1] = *(const v4u*)(rp[i] + (size_t)c0 * 512); }
          if (c0 == 0) {
#pragma unroll
              for (int i = 0; i < 3; ++i) x[i][0] = (v4u){0u, 0u, 0u, 0u}; } }
        bf16* orow = ACT + (size_t)(b * SEQ + r * 64) * DFF + qb * 256 + 8 * li + 4 * hk;
#pragma unroll 1
        for (int cb = 0; cb < 8; ++cb) {
            const int c = c0 + 4 * cb;
            const int cl = (c + 4 <= 63) ? c + 4 : 63;
#pragma unroll
            for (int i = 0; i < 3; ++i) {
#pragma unroll
                for (int j = 0; j < 3; ++j) x[i][2 + j] = *(const v4u*)(rp[i] + (size_t)(c + 1 + j) * 512);
                x[i][5] = *(const v4u*)(rp[i] + (size_t)cl * 512);
            }
            if (c + 4 > 63) {
#pragma unroll
                for (int i = 0; i < 3; ++i) x[i][5] = (v4u){0u, 0u, 0u, 0u}; }
#pragma unroll
            for (int o = 0; o < 4; ++o) {
                f32x4 a0 = b0, a1 = b1;
#pragma unroll
                for (int i = 0; i < 3; ++i)
#pragma unroll
                    for (int j = 0; j < 3; ++j) { const v4u xx = x[i][o + j]; a0 += w0[i * 3 + j] * bf4((v2u){xx.x, xx.y}); a1 += w1[i * 3 + j] * bf4((v2u){xx.z, xx.w}); }
                f32x4 snd = hk ? a0 : a1, rcv;
#pragma unroll
                for (int e = 0; e < 4; ++e) rcv[e] = __shfl_xor(snd[e], 32);
                float ov[4];
#pragma unroll
                for (int e = 0; e < 4; ++e) ov[e] = hk ? rcv[e] * silu_f(a1[e]) : a0[e] * silu_f(rcv[e]);
                *(v2u*)(orow + (size_t)(c + o) * DFF) = (v2u){pk2(ov[0], ov[1]), pk2(ov[2], ov[3])};
            }
#pragma unroll
            for (int i = 0; i < 3; ++i) { x[i][0] = x[i][4]; x[i][1] = x[i][5]; }
        }
    }
}

constexpr int LDS_BYTES = 147456, MISC_OFF = 147456 - 256;
constexpr int NPHASE = 12;
#ifndef MK_PER_PHASE
#define MK_PER_PHASE 0
#endif
__global__ void __launch_bounds__(NTHR, 2) mk_fwd(Args args) {
    extern __shared__ __attribute__((aligned(16))) uchar lds_raw[];
    LAS uchar* lds = (LAS uchar*)lds_raw;
    const int tid = threadIdx.x;
    const int G = gridDim.x; const int bx = blockIdx.x; const int vcu = (G % 8 == 0) ? (bx % 8) * (G / 8) + bx / 8 : bx;
    volatile LAS unsigned* MISC = (volatile LAS unsigned*)(lds + MISC_OFF);
    if (tid < 64) MISC[tid] = 0u;
    __syncthreads();
    XcdBarrier bar; bar.bar = (unsigned*)(args.ws + WS_CTL); bar.x = 0; bar.st = nullptr;
    if (!MK_PER_PHASE) bar = xcd_barrier_post((unsigned*)(args.ws + WS_CTL), MISC + 8);
    TProbe tp; for (int i_ = 0; i_ < 8; ++i_) tp.t[i_] = 0; tp.last = 0; tp.ph = 0;
    const int lo = args.ph_lo, hi = args.ph_hi;
#ifndef PH_MASK
#define PH_MASK 0xFFF
#endif
#define IN(k) (((PH_MASK >> (k)) & 1) && lo <= (k) && (k) < hi)
#define REP(k) for (int rep_ = 0; rep_ <= ((REP_MASK >> (k)) & 1); ++rep_, __syncthreads())
#define PH_T0(k) do { if (TP_SEL == 32 + (k)) tp.ph = __builtin_amdgcn_s_memrealtime(); } while (0)
#define PH_T1(k) do { if (TP_SEL == 32 + (k)) tp.t[0] = __builtin_amdgcn_s_memrealtime() - tp.ph; } while (0)
#define SEAM(k) do { if (IN(k) && IN((k) + 1)) { xcd_barrier(bar); if ((REP_MASK >> 20) & 1) { xcd_barrier(bar); xcd_barrier(bar); } } } while (0)
    uchar* ws = args.ws;
    PH_T0(0); if (IN(0)) { if ((REP_MASK >> 16) & 1) { p0_prologue(args, lds, vcu, G, WS_MOD + 512 * 1024); __syncthreads(); } p0_prologue(args, lds, vcu, G, WS_MOD); } SEAM(0); PH_T1(0);
    PH_T0(1); if (IN(1)) REP(1) { p1_rows(args, lds, vcu, G); } SEAM(1); PH_T1(1);
    PH_T0(2); if (IN(2)) REP(2) {
        pg8::Gemm g{(const bf16*)(ws + WS_HX), (const bf16*)(ws + WS_WIN), TROWS, 2304, DM}; SchedP2 S; S.init(G, bx);
        EpiP2 E{(bf16*)(ws + WS_UF), (bf16*)(ws + WS_XM), (bf16*)(ws + WS_V), (bf16*)(ws + WS_Z), (float*)(ws + WS_G), args.in[12]};
        pg8::gemm_phase<EpiP2, SchedP2, true, true>(lds, g, S, E);
        if (rep_ == 0 && G > 168 && bx >= 168) tr_items(args, lds, TR_EARLY, TR_ALL, (bx - 168) * NWAVES + (tid >> 6), (G - 168) * NWAVES);
    } SEAM(2); PH_T1(2);
    PH_T0(3); if (IN(3)) REP(3) {
        for (int rr_ = 0; rr_ <= ((REP_MASK >> 12) & 1); ++rr_) { int cur_h = -1; PrepLd pld; if (bx < NUNIT) prep_issue(args, bx, tid, pld); for (int it = bx; it < NUNIT; it += G) prep_unit(args, lds, it, (it + G < NUNIT) ? it + G : -1, cur_h, pld, tp); }
        __syncthreads();
        for (int rr_ = 0; rr_ <= ((REP_MASK >> 13) & 1); ++rr_) fft1_phase(args, lds, vcu, G);
    } SEAM(3); PH_T1(3);
    PH_T0(4); if (IN(4)) REP(4) {
        for (int rr_ = 0; rr_ <= ((REP_MASK >> 14) & 1); ++rr_) fft2_phase(args, lds, vcu, G);
        for (int rr_ = 0; rr_ <= ((REP_MASK >> 15) & 1); ++rr_) p4_scan(args, G);
    } SEAM(4); PH_T1(4);
    PH_T0(5); if (IN(5)) REP(5) { { OutLd old_; if (bx < NUNIT_L) out_issue(args, bx, tid, old_); for (int it = bx; it < NUNIT_L; it += G) out_unit(args, lds, it, (it + G < NUNIT_L) ? it + G : -1, old_, tp); } __syncthreads(); } SEAM(5); PH_T1(5);
    PH_T0(6); if (IN(6)) REP(6) {
        pg8::Gemm g{(const bf16*)(ws + WS_YM), (const bf16*)(ws + WS_WOUT), MROWS, DM, 1024}; pg8::StaticOrder S; S.init(MROWS, DM, G, bx);
        EpiGate16 E{(bf16*)args.out, 2048, (const float*)(ws + WS_MOD) + 2048, nullptr};
        pg8::gemm_phase<EpiGate16, pg8::StaticOrder, true, true>(lds, g, S, E);
    } SEAM(6); PH_T1(6);
    PH_T0(7); if (IN(7)) REP(7) { p7_rows(args, vcu, G); } SEAM(7); PH_T1(7);
    PH_T0(8); if (IN(8)) REP(8) {
        pg8::Gemm g{(const bf16*)(ws + WS_H2), (const bf16*)(ws + WS_WUP), MROWS, UPW, DM}; pg8::StaticOrder S; S.init(MROWS, UPW, G, bx);
        EpiUp E{(bf16*)(ws + WS_U), args.in[18]};
        pg8::gemm_phase<EpiUp, pg8::StaticOrder, true, true>(lds, g, S, E);
    } SEAM(8); PH_T1(8);
    PH_T0(9); if (IN(9)) REP(9) { p9_conv(args, vcu, G); } SEAM(9); PH_T1(9);
    PH_T0(10); if (IN(10)) {
        pg8::Gemm g{(const bf16*)(ws + WS_ACT), (const bf16*)(ws + WS_WDN), MROWS, DM, DFF}; pg8::StaticOrder S; S.init(MROWS, DM, G, bx);
        EpiGate16 E{(bf16*)(ws + WS_U), 1024, (const float*)(ws + WS_MOD) + 5120, args.in[22]};
        for (int rr_ = 0; rr_ <= ((REP_MASK >> 10) & 1); ++rr_) { if (rr_) __syncthreads(); pg8::gemm_phase<EpiGate16, pg8::StaticOrder, true, true>(lds, g, S, E); }
    } SEAM(10); PH_T1(10);
    PH_T0(11); if (IN(11)) { if ((REP_MASK >> 11) & 1) p11_rows(args, vcu, G, (float*)(ws + 0)); p11_rows(args, vcu, G, args.out); }
    PH_T1(11);
    if (TP_SEL && bx == 0 && tid == 0) { const unsigned long long t0_ = __builtin_amdgcn_s_memrealtime(), dl_ = (TP_SEL >= 32) ? tp.t[0] * 4ull : tp.t[(TP_SEL - 1) & 7] * 16ull; while (__builtin_amdgcn_s_memrealtime() - t0_ < dl_) __builtin_amdgcn_s_sleep(8); }
#undef IN
#undef SEAM
}

extern "C" void kernel_launch(void* const* d_in, const int* in_sizes, int n_in, void* d_out, int out_size, void* d_ws, size_t ws_size, hipStream_t stream) {
    static int grid = 0;
    if (grid == 0) {
        if (n_in != 24 || out_size != MROWS * DM || ws_size < WS_END) { fprintf(stderr, "kernel_launch: unexpected problem (n_in %d, out %d, ws %zu); nothing launched\n", n_in, out_size, ws_size); grid = -1; return; }
        int dev = 0, cus = 0, per_cu = 0;
        if (hipGetDevice(&dev) != hipSuccess || hipDeviceGetAttribute(&cus, hipDeviceAttributeMultiprocessorCount, dev) != hipSuccess) { grid = -1; return; }
        if (hipFuncSetAttribute((const void*)mk_fwd, hipFuncAttributeMaxDynamicSharedMemorySize, LDS_BYTES) != hipSuccess) { fprintf(stderr, "kernel_launch: hipFuncSetAttribute failed\n"); grid = -1; return; }
        if (hipOccupancyMaxActiveBlocksPerMultiprocessor(&per_cu, (const void*)mk_fwd, NTHR, LDS_BYTES) != hipSuccess || per_cu < 1) { fprintf(stderr, "kernel_launch: occupancy query says %d blocks per CU\n", per_cu); grid = -1; (void)hipGetLastError(); return; }
        grid = cus;
    }
    if (grid < 0) return;
    (void)hipMemsetAsync((char*)d_ws + WS_ZERO0, 0, WS_ZERO_BYTES, stream);
    Args a{};
    for (int i = 0; i < 24; ++i) a.in[i] = (const float*)d_in[i];
    a.out = (float*)d_out; a.ws = (uchar*)d_ws;
#if MK_PER_PHASE
    for (int p = 0; p < NPHASE; ++p) { a.ph_lo = p; a.ph_hi = p + 1; hipLaunchKernelGGL(mk_fwd, dim3(grid), dim3(NTHR), LDS_BYTES, stream, a); }
#else
    a.ph_lo = 0; a.ph_hi = NPHASE; hipLaunchKernelGGL(mk_fwd, dim3(grid), dim3(NTHR), LDS_BYTES, stream, a);
#endif
}
```
